# Optimizing an MI355X kernel written in HIP

```python
import math
import jax
import jax.numpy as jnp
from jax import lax
import numpy as np

D_MODEL = 1024
BATCH = 8
SEQ = 4096
DEPTH = 2

MIX_WIDTH = D_MODEL
N_MIXERS = 4
GROUP_WIDTH = MIX_WIDTH // N_MIXERS
HEADS_PER_GROUP = 4
HEAD_DIM = GROUP_WIDTH // HEADS_PER_GROUP
CONV_WIDTH = 31
MOBA_BLOCK = 256
MOBA_TOPK = 3
Q_CHUNK = 128
N_BUCKETS = 32
T5_MAX_DISTANCE = 128
POOL_WINDOWS = (2, 4, 8, 16)
N_POOL_GROUPS = len(POOL_WINDOWS)
POOL_GROUP_WIDTH = GROUP_WIDTH // N_POOL_GROUPS
SGU_CHUNK = 128
N_EXPERTS = 32
TOP_K = 4
D_FF = D_MODEL
SWIGLU_LIMIT = 7.0
SWIGLU_ALPHA = 1.702
EXPERT_BLOCK = 128
EPS = 1e-6

CONV_IN = 2 * GROUP_WIDTH
ATTN_IN = 3 * GROUP_WIDTH
POOL_IN = GROUP_WIDTH
SGU_IN = 2 * GROUP_WIDTH
CONV_OFF = 0
ATTN_OFF = CONV_OFF + CONV_IN
POOL_OFF = ATTN_OFF + ATTN_IN
SGU_OFF = POOL_OFF + POOL_IN
IN_WIDTH = SGU_OFF + SGU_IN

kernel_name = "hybrid_conv_moba_pool_sgu_moe"


def _rmsnorm(x, g):
    xf = x.astype(jnp.float32)
    y = xf * lax.rsqrt(jnp.mean(xf * xf, axis=-1, keepdims=True) + EPS)
    return (y * g.astype(jnp.float32)).astype(x.dtype)


def _layernorm(x, g, b):
    xf = x.astype(jnp.float32)
    mu = jnp.mean(xf, axis=-1, keepdims=True)
    xc = xf - mu
    y = xc * lax.rsqrt(jnp.mean(xc * xc, axis=-1, keepdims=True) + EPS)
    return (y * g.astype(jnp.float32) + b.astype(jnp.float32)).astype(x.dtype)


def _modulate(h, shift, scale):
    return h * (1 + scale[:, None, :]) + shift[:, None, :]


def conformer_conv(z, conv_w, conv_b, norm_g, norm_b):
    a, gte = jnp.split(z, 2, axis=-1)
    y = a * jax.nn.sigmoid(gte)
    y = lax.conv_general_dilated(
        y, conv_w[:, None, :], window_strides=(1,), padding=[(CONV_WIDTH - 1, 0)],
        dimension_numbers=('NWC', 'WIO', 'NWC'), feature_group_count=GROUP_WIDTH) + conv_b
    B, S, C = y.shape
    y = _layernorm(y.reshape(B, S, HEADS_PER_GROUP, HEAD_DIM),
                   norm_g.reshape(HEADS_PER_GROUP, HEAD_DIM),
                   norm_b.reshape(HEADS_PER_GROUP, HEAD_DIM)).reshape(B, S, C)
    return jax.nn.silu(y)


def _t5_bucket(dist):
    n = jnp.maximum(dist, 0)
    max_exact = N_BUCKETS // 2
    nf = jnp.maximum(n, 1).astype(jnp.float32)
    large = max_exact + (jnp.log(nf / max_exact) / math.log(T5_MAX_DISTANCE / max_exact)
                         * (N_BUCKETS - max_exact)).astype(jnp.int32)
    large = jnp.minimum(large, N_BUCKETS - 1)
    return jnp.where(n < max_exact, n, large)


def moba_attention(q, k, v, rel_bias):
    B, S, H, Dh = q.shape
    q = q.transpose(0, 2, 1, 3)
    k = k.transpose(0, 2, 1, 3)
    v = v.transpose(0, 2, 1, 3)
    n_blocks = -(-S // MOBA_BLOCK)
    s_pad = n_blocks * MOBA_BLOCK
    pad = ((0, 0), (0, 0), (0, s_pad - S), (0, 0))
    k = jnp.pad(k, pad)
    v = jnp.pad(v, pad)
    kb = k.reshape(B, H, n_blocks, MOBA_BLOCK, Dh)
    vb = v.reshape(B, H, n_blocks, MOBA_BLOCK, Dh)
    k_mean = jnp.mean(kb.astype(jnp.float32), axis=3).astype(q.dtype)
    k_sel = min(MOBA_TOPK, n_blocks)
    scale = HEAD_DIM ** -0.5
    bias_table = rel_bias.T.astype(jnp.float32)
    head_idx = jnp.arange(H)
    offs = jnp.arange(MOBA_BLOCK)
    gather_blocks = jax.vmap(jax.vmap(lambda blocks, idx: blocks[idx]))

    def chunk(ci):
        q0 = ci * Q_CHUNK
        qc = lax.dynamic_slice_in_dim(q, q0, Q_CHUNK, axis=2)
        qpos = q0 + jnp.arange(Q_CHUNK)
        own = q0 // MOBA_BLOCK
        gate = jnp.einsum('bhqd,bhnd->bhqn', qc, k_mean).astype(jnp.float32)
        gate = jnp.where(jnp.arange(n_blocks) < own, gate, -jnp.inf)
        _, idx = lax.top_k(gate, k_sel)
        valid = idx < own
        kg = gather_blocks(kb, idx)
        vg = gather_blocks(vb, idx)
        dist_sel = qpos[:, None, None] - (idx[..., None] * MOBA_BLOCK + offs)
        bias_sel = bias_table[head_idx[:, None, None, None], _t5_bucket(dist_sel)]
        s_sel = jnp.einsum('bhqd,bhqnkd->bhqnk', qc, kg).astype(jnp.float32) * scale + bias_sel
        s_sel = jnp.where(valid[..., None], s_sel, -jnp.inf).reshape(B, H, Q_CHUNK, k_sel * MOBA_BLOCK)
        own_start = own * MOBA_BLOCK
        ko = lax.dynamic_slice_in_dim(k, own_start, MOBA_BLOCK, axis=2)
        vo = lax.dynamic_slice_in_dim(v, own_start, MOBA_BLOCK, axis=2)
        dist_own = qpos[:, None] - (own_start + offs)[None, :]
        bias_own = bias_table[:, _t5_bucket(dist_own)]
        s_own = jnp.einsum('bhqd,bhkd->bhqk', qc, ko).astype(jnp.float32) * scale + bias_own
        s_own = jnp.where(dist_own >= 0, s_own, -jnp.inf)
        p = jax.nn.softmax(jnp.concatenate([s_sel, s_own], axis=-1), axis=-1).astype(v.dtype)
        p_sel = p[..., :k_sel * MOBA_BLOCK].reshape(B, H, Q_CHUNK, k_sel, MOBA_BLOCK)
        p_own = p[..., k_sel * MOBA_BLOCK:]
        return (jnp.einsum('bhqnk,bhqnkd->bhqd', p_sel, vg)
                + jnp.einsum('bhqk,bhkd->bhqd', p_own, vo))

    out = lax.map(chunk, jnp.arange(S // Q_CHUNK))
    return out.transpose(1, 0, 3, 2, 4).reshape(B, S, H * Dh)


def multiscale_pool(z, pool_w, pool_scale):
    B, S, C = z.shape
    zg = z.reshape(B, S, N_POOL_GROUPS, POOL_GROUP_WIDTH).astype(jnp.float32)
    csum = jnp.cumsum(zg, axis=1)
    t = jnp.arange(1, S + 1, dtype=jnp.float32)
    pooled = []
    for gi, w in enumerate(POOL_WINDOWS):
        cs = csum[:, :, gi]
        lag = jnp.pad(cs, ((0, 0), (w, 0), (0, 0)))[:, :S]
        pooled.append((cs - lag) / jnp.minimum(t, w)[None, :, None])
    pooled = jnp.stack(pooled, axis=2) - zg
    y = jnp.einsum('bsgc,gcd->bsgd', pooled.astype(z.dtype), pool_w)
    return y.reshape(B, S, C) * pool_scale


def spatial_gating(z, norm_g, norm_b, sgu_w, sgu_b):
    z = jax.nn.gelu(z, approximate=False)
    u, v = jnp.split(z, 2, axis=-1)
    v = _layernorm(v, norm_g, norm_b)
    B, S, C = v.shape
    vc = v.reshape(B, S // SGU_CHUNK, SGU_CHUNK, HEADS_PER_GROUP, HEAD_DIM)
    w = jnp.tril(sgu_w)
    mixed = jnp.einsum('hij,bnjhc->bnihc', w, vc) + sgu_b.T[None, None, :, :, None]
    return u * mixed.reshape(B, S, C)


def _clamped_swiglu(xb, w1, b1, w2, b2):
    hh = xb @ w1 + b1
    x_glu, x_lin = jnp.split(hh, 2, axis=-1)
    x_glu = jnp.minimum(x_glu, SWIGLU_LIMIT)
    x_lin = jnp.clip(x_lin, -SWIGLU_LIMIT, SWIGLU_LIMIT)
    act = x_glu * jax.nn.sigmoid(SWIGLU_ALPHA * x_glu) * (x_lin + 1)
    return act @ w2 + b2


def moe_ffn(h, router_w, router_b, w1, b1, w2, b2):
    B, S, D = h.shape
    N = B * S
    hf = h.reshape(N, D)
    logits = (hf @ router_w + router_b).astype(jnp.float32)
    top_vals, top_idx = lax.top_k(logits, TOP_K)
    gates = jax.nn.softmax(top_vals, axis=-1)
    A = N * TOP_K
    e_flat = top_idx.reshape(A)
    tok_flat = jnp.arange(A) // TOP_K
    order = jnp.argsort(e_flat)
    e_sorted = e_flat[order]
    tok_sorted = tok_flat[order]
    g_sorted = gates.reshape(A)[order]
    sizes = jnp.bincount(e_flat, length=N_EXPERTS)
    padded = ((sizes + EXPERT_BLOCK - 1) // EXPERT_BLOCK) * EXPERT_BLOCK
    pad_end = jnp.cumsum(padded)
    pad_start = pad_end - padded
    grp_start = jnp.cumsum(sizes) - sizes
    dest = pad_start[e_sorted] + jnp.arange(A) - grp_start[e_sorted]
    P = A + N_EXPERTS * EXPERT_BLOCK
    n_blk = P // EXPERT_BLOCK
    row_token = jnp.full((P,), N, dtype=jnp.int32).at[dest].set(tok_sorted.astype(jnp.int32))
    block_expert = jnp.minimum(
        jnp.searchsorted(pad_end, jnp.arange(n_blk) * EXPERT_BLOCK, side='right'), N_EXPERTS - 1)
    x_pad = jnp.concatenate([hf, jnp.zeros((1, D), hf.dtype)], axis=0)
    xs = x_pad[row_token].reshape(n_blk, EXPERT_BLOCK, D)

    def expert_block(args):
        xb, e = args
        return _clamped_swiglu(xb, w1[e], b1[e], w2[e], b2[e])

    ys = lax.map(expert_block, (xs, block_expert)).reshape(P, D)
    y_assign = ys[dest] * g_sorted[:, None].astype(ys.dtype)
    out = jax.ops.segment_sum(y_assign, tok_sorted, num_segments=N)
    return out.reshape(B, S, D).astype(h.dtype)


def setup_inputs(seed: int = 0) -> dict:
    key = jax.random.key(seed)
    ks = jax.random.split(key, 28)
    f32 = jnp.float32

    def nrm(k, shape, scale):
        return jax.random.normal(k, shape, f32) * scale

    L, D, GW, H = DEPTH, D_MODEL, GROUP_WIDTH, HEADS_PER_GROUP
    return {
        'x': nrm(ks[0], (BATCH, SEQ, D), 1.0),
        'c': nrm(ks[1], (BATCH, D), 1.0),
        'w_mod': nrm(ks[2], (L, D, 6 * D), 0.5 * D ** -0.5),
        'b_mod': nrm(ks[3], (L, 6 * D), 0.02),
        'norm1_g': 1.0 + nrm(ks[4], (L, D), 0.05),
        'w_in': nrm(ks[5], (L, D, IN_WIDTH), D ** -0.5),
        'conv_w': nrm(ks[6], (L, CONV_WIDTH, GW), CONV_WIDTH ** -0.5),
        'conv_b': nrm(ks[7], (L, GW), 0.02),
        'conv_norm_g': 1.0 + nrm(ks[8], (L, GW), 0.05),
        'conv_norm_b': nrm(ks[9], (L, GW), 0.02),
        'rel_bias': nrm(ks[10], (N_BUCKETS, H), 0.3),
        'pool_w': nrm(ks[11], (L, N_POOL_GROUPS, POOL_GROUP_WIDTH, POOL_GROUP_WIDTH), POOL_GROUP_WIDTH ** -0.5),
        'pool_scale': 1.0 + nrm(ks[12], (L, GW), 0.05),
        'sgu_norm_g': 1.0 + nrm(ks[13], (L, GW), 0.05),
        'sgu_norm_b': nrm(ks[14], (L, GW), 0.02),
        'sgu_w': nrm(ks[15], (L, H, SGU_CHUNK, SGU_CHUNK), SGU_CHUNK ** -0.5),
        'sgu_b': 1.0 + nrm(ks[16], (L, H, SGU_CHUNK), 0.05),
        'mix_out_g': 1.0 + nrm(ks[17], (L, MIX_WIDTH), 0.05),
        'w_out': nrm(ks[18], (L, MIX_WIDTH, D), MIX_WIDTH ** -0.5),
        'norm2_g': 1.0 + nrm(ks[19], (L, D), 0.05),
        'router_w': nrm(ks[20], (L, D, N_EXPERTS), D ** -0.5),
        'router_b': nrm(ks[21], (L, N_EXPERTS), 0.01),
        'exp_w1': nrm(ks[22], (L, N_EXPERTS, D, 2 * D_FF), D ** -0.5),
        'exp_b1': nrm(ks[23], (L, N_EXPERTS, 2 * D_FF), 0.02),
        'exp_w2': nrm(ks[24], (L, N_EXPERTS, D_FF, D), D_FF ** -0.5),
        'exp_b2': nrm(ks[25], (L, N_EXPERTS, D), 0.02),
        'final_norm_g': 1.0 + nrm(ks[26], (D,), 0.05),
    }


def reference(x, c, w_mod, b_mod, norm1_g, w_in, conv_w, conv_b, conv_norm_g, conv_norm_b,
              rel_bias, pool_w, pool_scale, sgu_norm_g, sgu_norm_b, sgu_w, sgu_b, mix_out_g,
              w_out, norm2_g, router_w, router_b, exp_w1, exp_b1, exp_w2, exp_b2, final_norm_g):
    B, S, D = x.shape
    cond = jax.nn.silu(c)
    for l in range(DEPTH):
        mod = cond @ w_mod[l] + b_mod[l]
        shift1, scale1, gate1, shift2, scale2, gate2 = jnp.split(mod, 6, axis=-1)
        h = _modulate(_rmsnorm(x, norm1_g[l]), shift1, scale1)
        proj = h @ w_in[l]
        y_conv = conformer_conv(proj[..., CONV_OFF:CONV_OFF + CONV_IN],
                                conv_w[l], conv_b[l], conv_norm_g[l], conv_norm_b[l])
        qkv = proj[..., ATTN_OFF:ATTN_OFF + ATTN_IN].reshape(B, S, 3, HEADS_PER_GROUP, HEAD_DIM)
        y_attn = moba_attention(qkv[:, :, 0], qkv[:, :, 1], qkv[:, :, 2], rel_bias)
        y_pool = multiscale_pool(proj[..., POOL_OFF:POOL_OFF + POOL_IN], pool_w[l], pool_scale[l])
        y_sgu = spatial_gating(proj[..., SGU_OFF:SGU_OFF + SGU_IN],
                               sgu_norm_g[l], sgu_norm_b[l], sgu_w[l], sgu_b[l])
        mixed = jnp.concatenate([y_conv, y_attn, y_pool, y_sgu], axis=-1)
        mixed = _rmsnorm(mixed.reshape(B, S, N_MIXERS, GROUP_WIDTH),
                         mix_out_g[l].reshape(N_MIXERS, GROUP_WIDTH)).reshape(B, S, MIX_WIDTH)
        x = x + gate1[:, None, :] * (mixed @ w_out[l])
        h = _modulate(_rmsnorm(x, norm2_g[l]), shift2, scale2)
        x = x + gate2[:, None, :] * moe_ffn(h, router_w[l], router_b[l],
                                            exp_w1[l], exp_b1[l], exp_w2[l], exp_b2[l])
    return _rmsnorm(x, final_norm_g)
```

```cpp
#include <hip/hip_runtime.h>
#include <cstdio>
#include <cstdint>

#define LAS __attribute__((address_space(3)))
#define GAS __attribute__((address_space(1)))
#define CAS __attribute__((address_space(4)))
typedef _Float16 f16;
typedef _Float16 f16x8 __attribute__((ext_vector_type(8)));
typedef _Float16 f16x4 __attribute__((ext_vector_type(4)));
typedef _Float16 f16x2 __attribute__((ext_vector_type(2)));
typedef float f32x2 __attribute__((ext_vector_type(2)));
typedef float f32x4 __attribute__((ext_vector_type(4)));
typedef float f32x16 __attribute__((ext_vector_type(16)));
typedef unsigned u32x2 __attribute__((ext_vector_type(2)));
typedef unsigned u32x4 __attribute__((ext_vector_type(4)));

constexpr int DM = 1024, NB = 8, SEQ = 4096, NTOK = NB * SEQ, DEPTH = 2, GW = 256, INW = 2048;
constexpr int NEXP = 32, TOPK = 4;
constexpr int PROWS = NTOK * TOPK + NEXP * 256;
constexpr float EPS = 1e-6f;
constexpr int LISTCAP = NTOK;

__device__ __forceinline__ unsigned pk_f16(float lo, float hi) { f32x2 v = {lo, hi}; f16x2 h = __builtin_convertvector(v, f16x2); return __builtin_bit_cast(unsigned, h); }
__device__ __forceinline__ float wave_sum(float v) {
#pragma unroll
    for (int o = 1; o < 64; o <<= 1) v += __shfl_xor(v, o);
    return v;
}
__device__ __forceinline__ float sigmoidf_(float x) { return 1.f / (1.f + __expf(-x)); }
__device__ __forceinline__ float gelu_erf(float v) { return 0.5f * v * (1.f + erff(v * 0.70710678118654752f)); }

namespace pg8 {
#define PG8_LAS __attribute__((address_space(3)))
typedef unsigned short h16_t;
constexpr int BM = 256, BK = 64, HALF = 128, HTB = HALF * BK * 2, STAGE_BYTES = 8 * HTB, NXCD = 8, WGM = 8;

__host__ __device__ __forceinline__ int lds_byte(int r, int c) { const int st = (r >> 4) * 2 + (c >> 5), rr = r & 15, cc = c & 31, ob = rr * 64 + cc * 2; return st * 1024 + (ob ^ (((ob >> 9) & 1) << 5)); }
__host__ __device__ __forceinline__ void stage_rc(int b, int& R, int& C) { const int st = b / 1024, sb = b % 1024, swz = sb ^ (((sb >> 9) & 1) << 5); R = (st >> 1) * 16 + swz / 64; C = (st & 1) * 32 + (swz % 64) / 2; }
__host__ __device__ __forceinline__ int perm32(int rho) { const int n = rho >> 4, i = rho & 15; return 8 * (i >> 2) + 4 * n + (i & 3); }

struct Unit { int pm, pn; };
struct Gemm { const h16_t* A; const h16_t* Bt; int M, N, K; };

struct StaticOrder {
    int nM, nN, nwg, G, c;
    __host__ __device__ void init(int M, int N, int G_, int c_) { nM = M / BM; nN = N / BM; nwg = nM * nN; G = G_; c = c_; }
    __host__ __device__ bool next(int i, Unit& u) const {
        const long L = (long)i * G + c; if (L >= nwg) return false;
        int wgid = (int)L; { const int q = nwg / NXCD, r = nwg % NXCD, xcd = wgid % NXCD, off = wgid / NXCD; wgid = (xcd < r ? xcd * (q + 1) : r * (q + 1) + (xcd - r) * q) + off; }
        const int nig = WGM * nN, gid = wgid / nig, fm = gid * WGM, gsz = (nM - fm) < WGM ? (nM - fm) : WGM;
        u.pm = fm + ((wgid % nig) % gsz); u.pn = (wgid % nig) / gsz; return true;
    }
    __device__ __forceinline__ void a_ready(const Unit&) const {}
    __device__ __forceinline__ void done(const Unit&) const {}
};
struct ListOrder {
    const PG8_LAS int* list; int n;
    __device__ __forceinline__ bool next(int i, Unit& u) const { if (i >= n) return false; const int v = __builtin_amdgcn_readfirstlane(list[i]); u.pm = v & 0xffff; u.pn = v >> 16; return true; }
    __device__ __forceinline__ void a_ready(const Unit&) const {}
    __device__ __forceinline__ void done(const Unit&) const {}
};

struct EpiF16 {
    static constexpr bool PERM = true, AFTER_DRAIN = false;
    h16_t* O; int ldc;
    __device__ __forceinline__ void operator()(const f32x4 (&acc)[2][2][4][2], const Unit& u, int wr, int wc, int fr, int fq) const {
        const int row0 = u.pm * BM + wr * 64 + fr, col0 = u.pn * BM + wc * 32 + 8 * fq;
#pragma unroll
        for (int ai = 0; ai < 2; ++ai)
#pragma unroll
            for (int m = 0; m < 4; ++m) { h16_t* rowp = O + (size_t)(row0 + ai * HALF + m * 16) * ldc + col0;
#pragma unroll
                for (int bj = 0; bj < 2; ++bj) { const f32x4 v0 = acc[ai][bj][m][0], v1 = acc[ai][bj][m][1];
                    u32x4 w; w.x = pk_f16(v0[0], v0[1]); w.y = pk_f16(v0[2], v0[3]); w.z = pk_f16(v1[0], v1[1]); w.w = pk_f16(v1[2], v1[3]);
                    *(u32x4*)(rowp + bj * HALF) = w; } }
    }
};
struct EpiResid {
    static constexpr bool PERM = false, AFTER_DRAIN = false;
    const float* base; float* out; const float* gate;
    __device__ __forceinline__ void operator()(const f32x4 (&acc)[2][2][4][2], const Unit& u, int wr, int wc, int fr, int fq) const {
        const int row0 = u.pm * BM + wr * 64 + fr, col0 = u.pn * BM + wc * 32 + 4 * fq;
        const float* gp = gate + (size_t)((u.pm * BM) >> 12) * 6144;
        f32x4 gv[2][2];
#pragma unroll
        for (int bj = 0; bj < 2; ++bj)
#pragma unroll
            for (int n = 0; n < 2; ++n) gv[bj][n] = *(const f32x4*)(gp + col0 + bj * HALF + n * 16);
#pragma unroll
        for (int ai = 0; ai < 2; ++ai)
#pragma unroll
            for (int m = 0; m < 4; ++m) { const size_t off = (size_t)(row0 + ai * HALF + m * 16) * DM + col0;
#pragma unroll
                for (int bj = 0; bj < 2; ++bj)
#pragma unroll
                    for (int n = 0; n < 2; ++n) { const f32x4 bs = *(const f32x4*)(base + off + bj * HALF + n * 16);
                        *(f32x4*)(out + off + bj * HALF + n * 16) = bs + gv[bj][n] * acc[ai][bj][m][n]; } }
    }
};
struct EpiSwiglu {
    static constexpr bool PERM = true, AFTER_DRAIN = false;
    h16_t* O; const float* b1;
    __device__ __forceinline__ void operator()(const f32x4 (&acc)[2][2][4][2], const Unit& u, int wr, int wc, int fr, int fq) const {
        const int e = u.pn >> 3, p = u.pn & 7;
        const int row0 = u.pm * BM + wr * 64 + fr, hc = p * 128 + wc * 32 + 8 * fq;
        const float* bp = b1 + (size_t)e * 2048 + hc;
        f32x4 bg[2], bl[2];
#pragma unroll
        for (int n = 0; n < 2; ++n) { bg[n] = *(const f32x4*)(bp + 4 * n); bl[n] = *(const f32x4*)(bp + 1024 + 4 * n); }
#pragma unroll
        for (int ai = 0; ai < 2; ++ai)
#pragma unroll
            for (int m = 0; m < 4; ++m) { h16_t* rowp = O + (size_t)(row0 + ai * HALF + m * 16) * DM + hc; float r[8];
#pragma unroll
                for (int n = 0; n < 2; ++n) { const f32x4 g = acc[ai][0][m][n] + bg[n], li = acc[ai][1][m][n] + bl[n];
#pragma unroll
                    for (int i = 0; i < 4; ++i) { const float xg = fminf(g[i], 7.0f), xl = fminf(fmaxf(li[i], -7.0f), 7.0f);
                        r[4 * n + i] = xg * (1.f / (1.f + __expf(-1.702f * xg))) * (xl + 1.0f); } }
                u32x4 w; w.x = pk_f16(r[0], r[1]); w.y = pk_f16(r[2], r[3]); w.z = pk_f16(r[4], r[5]); w.w = pk_f16(r[6], r[7]);
                *(u32x4*)rowp = w; }
    }
};
struct EpiDown {
    static constexpr bool PERM = true, AFTER_DRAIN = false;
    h16_t* O; const float* b2;
    __device__ __forceinline__ void operator()(const f32x4 (&acc)[2][2][4][2], const Unit& u, int wr, int wc, int fr, int fq) const {
        const int e = u.pn >> 2, p = u.pn & 3;
        const int row0 = u.pm * BM + wr * 64 + fr, col0 = p * BM + wc * 32 + 8 * fq;
        const float* bp = b2 + (size_t)e * 1024 + col0;
        f32x4 bv[2][2];
#pragma unroll
        for (int bj = 0; bj < 2; ++bj)
#pragma unroll
            for (int n = 0; n < 2; ++n) bv[bj][n] = *(const f32x4*)(bp + bj * HALF + 4 * n);
#pragma unroll
        for (int ai = 0; ai < 2; ++ai)
#pragma unroll
            for (int m = 0; m < 4; ++m) { h16_t* rowp = O + (size_t)(row0 + ai * HALF + m * 16) * DM + col0;
#pragma unroll
                for (int bj = 0; bj < 2; ++bj) { const f32x4 v0 = acc[ai][bj][m][0] + bv[bj][0], v1 = acc[ai][bj][m][1] + bv[bj][1];
                    u32x4 w; w.x = pk_f16(v0[0], v0[1]); w.y = pk_f16(v0[2], v0[3]); w.z = pk_f16(v1[0], v1[1]); w.w = pk_f16(v1[2], v1[3]);
                    *(u32x4*)(rowp + bj * HALF) = w; } }
    }
};

template <class Epi, class Sched, bool ALIGN_EPI = false, bool SP2 = false>
__device__ __forceinline__ void gemm_phase(PG8_LAS unsigned char* lds, const Gemm g, const Sched& S, const Epi& E, const int tid) {
    const int wid = __builtin_amdgcn_readfirstlane(tid >> 6), lane = tid & 63, wr = wid >> 2, wc = wid & 3, fr = lane & 15, fq = lane >> 4;
    const int K = g.K, nt = K / BK;
    unsigned voffA[2], voffB[2];
#pragma unroll
    for (int i = 0; i < 2; ++i) { int R, C; stage_rc(tid * 16 + i * 8192, R, C); const int Rb = Epi::PERM ? ((R & ~31) + perm32(R & 31)) : R;
        voffA[i] = (unsigned)(R * K + C) * 2u; voffB[i] = (unsigned)(Rb * K + C) * 2u; }
    const size_t kstep = (size_t)(BK * 2);
    const size_t hstep = (size_t)HALF * K * 2;
    const size_t tstep = 2 * hstep;
    const unsigned ldsw = (unsigned)wid * 1024u;
    const int aoff = lds_byte(wr * 64 + fr, fq * 8), boff = lds_byte(wc * 32 + fr, fq * 8);
#define PG8_SA(b, h) (((b) * 2 + (h)) * HTB)
#define PG8_SB(b, h) ((4 + (b) * 2 + (h)) * HTB)
#define PG8_STAGE(bufoff, gbase, voff) do { _Pragma("unroll") for (int _i = 0; _i < 2; ++_i) \
        __builtin_amdgcn_global_load_lds((const unsigned*)((const char*)(gbase) + (voff)[_i]), (PG8_LAS unsigned*)(lds + (bufoff) + ldsw + _i * 8192), 16, 0, 0); } while (0)
#define PG8_LDA(dst, b, h) do { _Pragma("unroll") for (int m = 0; m < 4; ++m) _Pragma("unroll") for (int k = 0; k < 2; ++k) dst[m][k] = *(const PG8_LAS f16x8*)(lds + PG8_SA(b, h) + aoff + m * 2048 + k * 1024); } while (0)
#define PG8_LDB(dst, b, h) do { _Pragma("unroll") for (int n = 0; n < 2; ++n) _Pragma("unroll") for (int k = 0; k < 2; ++k) dst[n][k] = *(const PG8_LAS f16x8*)(lds + PG8_SB(b, h) + boff + n * 2048 + k * 1024); } while (0)
#define PG8_MMA(ai, bj, At, Bt) do { __builtin_amdgcn_s_setprio(1); _Pragma("unroll") for (int m = 0; m < 4; ++m) _Pragma("unroll") for (int n = 0; n < 2; ++n) _Pragma("unroll") for (int k = 0; k < 2; ++k) \
        acc[ai][bj][m][n] = __builtin_amdgcn_mfma_f32_16x16x32_f16(Bt[n][k], At[m][k], acc[ai][bj][m][n], 0, 0, 0); __builtin_amdgcn_s_setprio(0); } while (0)
#define PG8_WAIT_V(n) asm volatile("s_waitcnt vmcnt(" #n ")" ::: "memory")
#define PG8_WAIT_L(n) asm volatile("s_waitcnt lgkmcnt(" #n ")" ::: "memory")
#define PG8_BAR __builtin_amdgcn_s_barrier()
#define PG8_SCHED __builtin_amdgcn_sched_barrier(0)
    Unit cur, nxt; int ui = 0;
    if (!S.next(0, cur)) return;
    f32x4 acc[2][2][4][2];
#pragma unroll
    for (int a = 0; a < 2; ++a)
#pragma unroll
        for (int b = 0; b < 2; ++b)
#pragma unroll
            for (int m = 0; m < 4; ++m)
#pragma unroll
                for (int n = 0; n < 2; ++n) acc[a][b][m][n] = (f32x4){0.f, 0.f, 0.f, 0.f};
    f16x8 At[4][2], B0[2][2], B1[2][2];
    const char* cA = (const char*)g.A + (size_t)cur.pm * tstep; const char* cB = (const char*)g.Bt + (size_t)cur.pn * tstep;
    S.a_ready(cur);
    if constexpr (SP2) {
        PG8_STAGE(PG8_SB(0, 0), cB, voffB); PG8_STAGE(PG8_SB(0, 1), cB + hstep, voffB); PG8_STAGE(PG8_SA(0, 0), cA, voffA); PG8_STAGE(PG8_SA(0, 1), cA + hstep, voffA);
        if (wr == 1) PG8_BAR;
        PG8_WAIT_V(2); PG8_BAR;
        PG8_STAGE(PG8_SB(1, 0), cB + kstep, voffB); PG8_STAGE(PG8_SA(1, 0), cA + kstep, voffA); PG8_STAGE(PG8_SB(1, 1), cB + hstep + kstep, voffB);
        PG8_WAIT_V(6); PG8_BAR;
    } else {
        PG8_STAGE(PG8_SB(0, 0), cB, voffB); PG8_STAGE(PG8_SA(0, 0), cA, voffA); PG8_STAGE(PG8_SB(0, 1), cB + hstep, voffB); PG8_STAGE(PG8_SA(0, 1), cA + hstep, voffA);
        if (wr == 1) PG8_BAR;
        PG8_WAIT_V(4); PG8_BAR;
        PG8_STAGE(PG8_SB(1, 0), cB + kstep, voffB); PG8_STAGE(PG8_SA(1, 0), cA + kstep, voffA); PG8_STAGE(PG8_SB(1, 1), cB + hstep + kstep, voffB);
        PG8_WAIT_V(6); PG8_BAR;
    }
    for (;;) {
        const bool has_next = S.next(ui + 1, nxt);
        const char* nA = has_next ? (const char*)g.A + (size_t)nxt.pm * tstep : cA; const char* nB = has_next ? (const char*)g.Bt + (size_t)nxt.pn * tstep : cB;
        for (int t = 0; t < nt; t += 2) {
            const bool last = (t == nt - 2);
            const char* a1 = cA + (size_t)(t + 1) * kstep;
            const char* a2 = last ? nA : cA + (size_t)(t + 2) * kstep; const char* b2 = last ? nB : cB + (size_t)(t + 2) * kstep;
            const char* a3 = a2 + kstep; const char* b3 = b2 + kstep;
            if (last && has_next) S.a_ready(nxt);
            if constexpr (SP2) {
            PG8_LDB(B0, 0, 0); PG8_LDB(B1, 0, 1); PG8_SCHED; PG8_LDA(At, 0, 0); PG8_STAGE(PG8_SA(1, 1), a1 + hstep, voffA);
            PG8_WAIT_V(8); PG8_WAIT_L(0); PG8_BAR; PG8_MMA(0, 0, At, B0); PG8_MMA(0, 1, At, B1); PG8_BAR; PG8_SCHED;
            PG8_LDA(At, 0, 1); PG8_STAGE(PG8_SB(0, 0), b2, voffB); PG8_STAGE(PG8_SB(0, 1), b2 + hstep, voffB); PG8_STAGE(PG8_SA(0, 0), a2, voffA);
            PG8_WAIT_V(8); PG8_WAIT_L(0); PG8_BAR; PG8_MMA(1, 0, At, B0); PG8_MMA(1, 1, At, B1); PG8_BAR; PG8_SCHED;
            PG8_LDB(B0, 1, 0); PG8_LDB(B1, 1, 1); PG8_SCHED; PG8_LDA(At, 1, 0); PG8_STAGE(PG8_SA(0, 1), a2 + hstep, voffA);
            PG8_WAIT_V(8); PG8_WAIT_L(0); PG8_BAR; PG8_MMA(0, 0, At, B0); PG8_MMA(0, 1, At, B1); PG8_BAR; PG8_SCHED;
            PG8_LDA(At, 1, 1); PG8_STAGE(PG8_SB(1, 0), b3, voffB); PG8_STAGE(PG8_SB(1, 1), b3 + hstep, voffB); PG8_STAGE(PG8_SA(1, 0), a3, voffA);
            PG8_WAIT_V(8); PG8_WAIT_L(0); PG8_BAR; PG8_MMA(1, 0, At, B0); PG8_MMA(1, 1, At, B1); PG8_BAR; PG8_SCHED;
            } else {
            PG8_LDB(B0, 0, 0); PG8_SCHED; PG8_LDA(At, 0, 0); PG8_STAGE(PG8_SA(1, 1), a1 + hstep, voffA);
            PG8_WAIT_L(8); PG8_BAR; PG8_WAIT_L(0); PG8_MMA(0, 0, At, B0); PG8_BAR; PG8_SCHED;
            PG8_LDB(B1, 0, 1); PG8_STAGE(PG8_SB(0, 0), b2, voffB);
            PG8_BAR; PG8_WAIT_L(0); PG8_MMA(0, 1, At, B1); PG8_BAR;
            PG8_LDA(At, 0, 1); PG8_STAGE(PG8_SA(0, 0), a2, voffA);
            PG8_BAR; PG8_WAIT_L(0); PG8_MMA(1, 0, At, B0); PG8_BAR; PG8_SCHED;
            PG8_STAGE(PG8_SB(0, 1), b2 + hstep, voffB);
            PG8_WAIT_V(6); PG8_BAR; PG8_MMA(1, 1, At, B1); PG8_BAR;
            PG8_LDB(B0, 1, 0); PG8_SCHED; PG8_LDA(At, 1, 0); PG8_STAGE(PG8_SA(0, 1), a2 + hstep, voffA);
            PG8_WAIT_L(8); PG8_BAR; PG8_WAIT_L(0); PG8_MMA(0, 0, At, B0); PG8_BAR; PG8_SCHED;
            PG8_LDB(B1, 1, 1); PG8_STAGE(PG8_SB(1, 0), b3, voffB);
            PG8_BAR; PG8_WAIT_L(0); PG8_MMA(0, 1, At, B1); PG8_BAR;
            PG8_LDA(At, 1, 1); PG8_STAGE(PG8_SA(1, 0), a3, voffA);
            PG8_BAR; PG8_WAIT_L(0); PG8_MMA(1, 0, At, B0); PG8_BAR; PG8_SCHED;
            PG8_STAGE(PG8_SB(1, 1), b3 + hstep, voffB);
            PG8_WAIT_V(6); PG8_BAR; PG8_MMA(1, 1, At, B1); PG8_BAR;
            }
        }
        if constexpr (ALIGN_EPI) { if (wr == 0) PG8_BAR; }
        if constexpr (!Epi::AFTER_DRAIN) { E(acc, cur, wr, wc, fr, fq); S.done(cur); }
        if (!has_next) break;
#pragma unroll
        for (int a = 0; a < 2; ++a)
#pragma unroll
            for (int b = 0; b < 2; ++b)
#pragma unroll
                for (int m = 0; m < 4; ++m)
#pragma unroll
                    for (int n = 0; n < 2; ++n) acc[a][b][m][n] = (f32x4){0.f, 0.f, 0.f, 0.f};
        cur = nxt; cA = nA; cB = nB; ++ui;
        if constexpr (ALIGN_EPI) { if (wr == 1) PG8_BAR; }
    }
    PG8_WAIT_V(0);
    if constexpr (!ALIGN_EPI) { if (wr == 0) PG8_BAR; }
    PG8_BAR;
#undef PG8_SA
#undef PG8_SB
#undef PG8_STAGE
#undef PG8_LDA
#undef PG8_LDB
#undef PG8_MMA
#undef PG8_WAIT_V
#undef PG8_WAIT_L
#undef PG8_BAR
#undef PG8_SCHED
}
}

constexpr size_t MiB = 1u << 20;
constexpr size_t WS_CTL   = 0,            CTL_ZERO_BYTES = 1 * MiB;
constexpr size_t WS_MOD   = 1 * MiB;
constexpr size_t WS_KMEAN = 2 * MiB;
constexpr size_t WS_SGUW  = 3 * MiB;
constexpr size_t WS_ROUTE = 4 * MiB;
constexpr size_t WS_LIST  = 6 * MiB;
constexpr size_t WS_WIN   = 10 * MiB;
constexpr size_t WS_WOUT  = 18 * MiB;
constexpr size_t WS_W1    = 22 * MiB;
constexpr size_t WS_W2    = 278 * MiB;
constexpr size_t WS_X     = 406 * MiB;
constexpr size_t WS_H     = 534 * MiB;
constexpr size_t WS_PROJ  = 598 * MiB;
constexpr size_t WS_MIX   = 726 * MiB;
constexpr size_t WS_XS    = 790 * MiB;
constexpr size_t WS_ACT   = 1062 * MiB;
constexpr size_t WS_END   = 1334 * MiB;
constexpr int CW_BAR = 4096;
constexpr int CW_CNT = 16384;

constexpr int RING_BYTES = 131072;
constexpr int LDS_BYTES = 147456;
constexpr int BARST_OFF = LDS_BYTES - 64;
constexpr int NWAVES = 8;
#ifndef PH3
#define PH3 15
#endif
#ifndef PHMASK
#define PHMASK 0xFFFF
#endif

#define XB_TMO      128
#define XB_XCNT(j)  (256  + 64 * (j))
#define XB_XSUB(j)  (1280 + 64 * (j))
#define XB_XGEN(j)  (2304 + 64 * (j))
#define XB_TOP      3328
#define XB_TOPGEN   3392
#define XCD_BAR_WORDS 3456
#define XB_SPIN_CAP (1u << 20)
__device__ __forceinline__ unsigned xb_ld(unsigned* p)              { return __hip_atomic_load(p, __ATOMIC_RELAXED, __HIP_MEMORY_SCOPE_AGENT); }
__device__ __forceinline__ unsigned xb_add(unsigned* p, unsigned v) { return __hip_atomic_fetch_add(p, v, __ATOMIC_RELAXED, __HIP_MEMORY_SCOPE_AGENT); }
__device__ __forceinline__ unsigned xb_xcc_id() { return (unsigned)__builtin_amdgcn_s_getreg((3 << 11) | 20) & 0xFu; }
#define XB_SPIN(cond, bar) do { unsigned _sp = 0; while (cond) { __builtin_amdgcn_s_sleep(1); \
    if ((++_sp & 255u) == 0u) { if (xb_ld(&(bar)[XB_TMO])) break; if (_sp > XB_SPIN_CAP) { atomicAdd(&(bar)[XB_TMO], 1u); break; } } } } while (0)
struct XcdBarrier { unsigned* bar; unsigned x; volatile LAS unsigned* st; };
__device__ __forceinline__ XcdBarrier xcd_barrier_post(unsigned* bar, volatile LAS unsigned* st) {
    XcdBarrier b; b.bar = bar; b.x = xb_xcc_id(); b.st = st;
    if (threadIdx.x == 0) (void)xb_add(&bar[XB_XCNT(b.x)], 1u);
    return b;
}
__device__ __forceinline__ void xcd_barrier_complete(unsigned* bar, unsigned x, unsigned& nloc, unsigned& nx) {
    const unsigned G = gridDim.x * gridDim.y * gridDim.z;
    unsigned sum, cnt, mine, sp = 0u;
    for (;;) {
        sum = 0u; cnt = 0u; mine = 0u;
#pragma unroll
        for (unsigned j = 0; j < 16; ++j) { const unsigned c = xb_ld(&bar[XB_XCNT(j)]); sum += c; cnt += (c > 0u) ? 1u : 0u; mine = (j == x) ? c : mine; }
        if (sum == G) break;
        __builtin_amdgcn_s_sleep(1);
        if ((++sp & 255u) == 0u) { if (xb_ld(&bar[XB_TMO])) break; if (sp > XB_SPIN_CAP) { atomicAdd(&bar[XB_TMO], 1u); break; } }
    }
    nloc = mine > 0u ? mine : 1u; nx = cnt > 0u ? cnt : 1u;
}
__device__ __forceinline__ void xcd_barrier(const XcdBarrier& b) {
    asm volatile("s_waitcnt vmcnt(0)" ::: "memory");
    __syncthreads();
    if (threadIdx.x == 0) {
        unsigned* bar = b.bar; asm volatile("" : "+s"(bar));
        unsigned bx = b.x; asm volatile("" : "+s"(bx));
        __builtin_amdgcn_s_waitcnt(0);
        unsigned nloc = b.st[0], nx = b.st[1];
        if (nloc == 0u) { xcd_barrier_complete(bar, bx, nloc, nx); b.st[0] = nloc; b.st[1] = nx; }
        const unsigned old = xb_add(&bar[XB_XSUB(bx)], 1u);
        const unsigned gen = old / nloc;
        if (old + 1u == (gen + 1u) * nloc) {
            __builtin_amdgcn_fence(__ATOMIC_RELEASE, "agent");
            asm volatile("s_waitcnt vmcnt(0)" ::: "memory");
            const unsigned og = xb_add(&bar[XB_TOP], 1u);
            const unsigned tg = og / nx;
            if (og + 1u == (tg + 1u) * nx) xb_add(&bar[XB_TOPGEN], 1u);
            else XB_SPIN(xb_ld(&bar[XB_TOPGEN]) == tg, bar);
            __builtin_amdgcn_fence(__ATOMIC_ACQUIRE, "agent");
            xb_add(&bar[XB_XGEN(bx)], 1u);
            asm volatile("s_waitcnt vmcnt(0)" ::: "memory");
        } else {
            XB_SPIN(xb_ld(&bar[XB_XGEN(bx)]) == gen, bar);
            __builtin_amdgcn_fence(__ATOMIC_ACQUIRE, "agent");
            asm volatile("s_waitcnt vmcnt(0)" ::: "memory");
        }
    }
    __syncthreads();
}

struct Args { const float* in[27]; float* out; unsigned char* ws; };
enum { I_X = 0, I_C, I_WMOD, I_BMOD, I_N1G, I_WIN, I_CONVW, I_CONVB, I_CNG, I_CNB, I_RELB, I_POOLW, I_POOLS, I_SNG, I_SNB, I_SGUW, I_SGUB, I_MIXG, I_WOUT, I_N2G, I_RW, I_RB, I_W1, I_B1, I_W2, I_B2, I_FNG };

__device__ __forceinline__ int t5_bucket(int n) {
    if (n < 16) return n;
    int b = 16;
    b += (n >= 19); b += (n >= 21); b += (n >= 24); b += (n >= 27); b += (n >= 31); b += (n >= 35); b += (n >= 40); b += (n >= 46);
    b += (n >= 52); b += (n >= 59); b += (n >= 67); b += (n >= 77); b += (n >= 87); b += (n >= 99); b += (n >= 113);
    return b;
}

__device__ __forceinline__ void transpose_item(const float* W, int K, int N, f16* WT, int orow0, int k0, int n0, const float* kscale, LAS float* scr, int lane) {
#pragma unroll 8
    for (int i = 0; i < 32; ++i) { const int kk = 2 * i + (lane >> 5); float v = W[(size_t)(k0 + kk) * N + n0 + (lane & 31)]; if (kscale) v *= kscale[k0 + kk]; scr[kk * 33 + (lane & 31)] = v; }
    asm volatile("s_waitcnt lgkmcnt(0)" ::: "memory");
    const int c = lane & 7;
#pragma unroll
    for (int j = 0; j < 4; ++j) { const int n = (lane >> 3) + 8 * j; const LAS float* s = scr + (8 * c) * 33 + n;
        u32x4 o; o.x = pk_f16(s[0 * 33], s[1 * 33]); o.y = pk_f16(s[2 * 33], s[3 * 33]); o.z = pk_f16(s[4 * 33], s[5 * 33]); o.w = pk_f16(s[6 * 33], s[7 * 33]);
        *(u32x4*)(WT + (size_t)(orow0 + n) * K + k0 + 8 * c) = o; }
    asm volatile("s_waitcnt lgkmcnt(0)" ::: "memory");
}

__device__ __forceinline__ void norm_mod_row(const float* xrow, const float* g, const float* shift, const float* scale, f16* orow, int lane) {
    f32x4 v[4]; float s = 0.f;
#pragma unroll
    for (int j = 0; j < 4; ++j) { v[j] = *(const f32x4*)(xrow + 4 * lane + 256 * j); s += (v[j].x * v[j].x + v[j].y * v[j].y) + (v[j].z * v[j].z + v[j].w * v[j].w); }
    const float rstd = rsqrtf(wave_sum(s) * (1.f / DM) + EPS);
#pragma unroll
    for (int j = 0; j < 4; ++j) { const int c = 4 * lane + 256 * j; const f32x4 gg = *(const f32x4*)(g + c), sh = *(const f32x4*)(shift + c), sc = *(const f32x4*)(scale + c);
        const f32x4 h = (v[j] * rstd) * gg * (sc + 1.0f) + sh;
        u32x2 w; w.x = pk_f16(h.x, h.y); w.y = pk_f16(h.z, h.w); *(u32x2*)(orow + c) = w; }
}

__global__ void __launch_bounds__(NWAVES * 64, 2) fwd_megakernel(Args args) {
    extern __shared__ __attribute__((aligned(16))) unsigned char lds[];
    const int tid0 = threadIdx.x, wave0 = __builtin_amdgcn_readfirstlane(tid0 >> 6);
    const int G = gridDim.x, bid = blockIdx.x;
    const int NGW = G * NWAVES;
#define LAUNDER() int tid = tid0; asm volatile("" : "+v"(tid)); const int lane = tid & 63; int wave = wave0; asm volatile("" : "+s"(wave)); const int gw = bid * NWAVES + wave; (void)gw; (void)lane; const CAS Args* AP = (const CAS Args*)__builtin_amdgcn_kernarg_segment_ptr(); asm volatile("" : "+s"(AP)); (void)AP; LAS unsigned char* Lp = (LAS unsigned char*)lds; asm volatile("" : "+s"(Lp)); (void)Lp; unsigned char* ws = AP->ws; unsigned* ctl = (unsigned*)(ws + WS_CTL); float* MOD = (float*)(ws + WS_MOD); float* KMEAN = (float*)(ws + WS_KMEAN); f16* SGUW = (f16*)(ws + WS_SGUW); int* ROUTE_E = (int*)(ws + WS_ROUTE); int* ROUTE_POS = ROUTE_E + NTOK * 4; float* ROUTE_G = (float*)(ROUTE_POS + NTOK * 4); int* LIST = (int*)(ws + WS_LIST); f16* WIN_T = (f16*)(ws + WS_WIN); f16* WOUT_T = (f16*)(ws + WS_WOUT); f16* W1_T = (f16*)(ws + WS_W1); f16* W2_T = (f16*)(ws + WS_W2); float* X = (float*)(ws + WS_X); f16* H = (f16*)(ws + WS_H); f16* PROJ = (f16*)(ws + WS_PROJ); f16* MIX = (f16*)(ws + WS_MIX); f16* XS = (f16*)(ws + WS_XS); f16* ACT = (f16*)(ws + WS_ACT); (void)ctl; (void)MOD; (void)KMEAN; (void)SGUW; (void)ROUTE_E; (void)ROUTE_POS; (void)ROUTE_G; (void)LIST; (void)WIN_T; (void)WOUT_T; (void)W1_T; (void)W2_T; (void)X; (void)H; (void)PROJ; (void)MIX; (void)XS; (void)ACT;
    LAS unsigned char* L = (LAS unsigned char*)lds;

    if (tid0 < 16) ((LAS unsigned*)(L + BARST_OFF))[tid0] = 0u;
    __syncthreads();
    XcdBarrier bar = xcd_barrier_post((unsigned*)(args.ws + WS_CTL) + CW_BAR, (volatile LAS unsigned*)(L + BARST_OFF));

if (PHMASK & 1) { LAUNDER();
    {
        LAS float* cond = (LAS float*)Lp;
        LAS float* red = (LAS float*)(Lp + 32768);
        bool cond_ready = false;
        for (int it = bid; it < 192; it += G) {
            if (!cond_ready) { for (int i = tid; i < NB * DM; i += 512) { const float v = AP->in[I_C][i]; cond[i] = v * sigmoidf_(v); } __syncthreads(); cond_ready = true; }
            const int l = it / 96, n0 = (it % 96) * 64;
            const float* wm = AP->in[I_WMOD] + (size_t)l * DM * 6144 + n0 + lane;
            float a[8];
#pragma unroll
            for (int b = 0; b < 8; ++b) a[b] = 0.f;
            for (int k = wave * 128; k < wave * 128 + 128; ++k) { const float w = wm[(size_t)k * 6144];
#pragma unroll
                for (int b = 0; b < 8; ++b) a[b] += cond[b * DM + k] * w; }
#pragma unroll
            for (int b = 0; b < 8; ++b) red[(wave * 8 + b) * 64 + lane] = a[b];
            __syncthreads();
            { const int b = tid >> 6; float s = AP->in[I_BMOD][l * 6144 + n0 + lane];
#pragma unroll
              for (int w = 0; w < 8; ++w) s += red[(w * 8 + b) * 64 + lane];
              MOD[(size_t)(l * 8 + b) * 6144 + n0 + lane] = s; }
            __syncthreads();
        }
        __syncthreads();
        LAS float* scr = (LAS float*)(Lp + wave * 16384);
        constexpr int PER_L = 1024 + 512 + 32768 + 16384;
        for (int it = gw; it < DEPTH * PER_L; it += NGW) {
            const int l = it / PER_L; int r = it % PER_L;
            if (r < 1024) { const int kb = r >> 6, nb = r & 63; transpose_item(AP->in[I_WIN] + (size_t)l * DM * INW, DM, INW, WIN_T + (size_t)l * INW * DM, 32 * nb, 64 * kb, 32 * nb, nullptr, scr, lane); continue; } r -= 1024;
            if (r < 512) { const int kb = r >> 5, nb = r & 31; transpose_item(AP->in[I_WOUT] + (size_t)l * DM * DM, DM, DM, WOUT_T + (size_t)l * DM * DM, 32 * nb, 64 * kb, 32 * nb, AP->in[I_MIXG] + l * DM, scr, lane); continue; } r -= 512;
            if (r < 32768) { const int e = r >> 10, q = r & 1023, kb = q >> 6, nb = q & 63, n0 = 32 * nb;
                const int bj = n0 >> 10, jj = n0 & 1023, orow = (jj >> 7) * 256 + bj * 128 + (jj & 127);
                transpose_item(AP->in[I_W1] + ((size_t)l * NEXP + e) * DM * 2048, DM, 2048, W1_T + ((size_t)l * NEXP + e) * 2048 * DM, orow, 64 * kb, n0, nullptr, scr, lane); continue; } r -= 32768;
            { const int e = r >> 9, q = r & 511, kb = q >> 5, nb = q & 31;
                transpose_item(AP->in[I_W2] + ((size_t)l * NEXP + e) * DM * DM, DM, DM, W2_T + ((size_t)l * NEXP + e) * DM * DM, 32 * nb, 64 * kb, 32 * nb, nullptr, scr, lane); }
        }
        for (int i = bid * 512 + tid; i < DEPTH * 4 * 128 * 128; i += G * 512) { const int jj = i & 127, ii = (i >> 7) & 127; SGUW[i] = (f16)(jj <= ii ? AP->in[I_SGUW][i] : 0.f); }
    }
}
    xcd_barrier(bar);

if (PHMASK & 2) { LAUNDER();
    for (int m = gw; m < NTOK; m += NGW) { const int b = m >> 12; const float* md = MOD + (size_t)b * 6144;
        norm_mod_row(AP->in[I_X] + (size_t)m * DM, AP->in[I_N1G], md, md + 1024, H + (size_t)m * DM, lane); }
}
    xcd_barrier(bar);

    for (int l = 0; l < DEPTH; ++l) {
#define MODL (MOD + (size_t)l * 8 * 6144)
if (PHMASK & 4) { LAUNDER();
        { pg8::Gemm g{(const pg8::h16_t*)H, (const pg8::h16_t*)(WIN_T + (size_t)l * INW * DM), NTOK, INW, DM}; pg8::StaticOrder S; S.init(NTOK, INW, G, bid);
          pg8::EpiF16 E{(pg8::h16_t*)PROJ, INW};
          pg8::gemm_phase<pg8::EpiF16, pg8::StaticOrder, true, true>(Lp, g, S, E, tid); }
}
        xcd_barrier(bar);

if (PHMASK & 8) {
        for (int it_ = bid; it_ < 256 + 512 + 512 + 128; it_ += G) { int it = it_; asm volatile("" : "+s"(it));
            if ((PH3 & 1) && it < 256) {
                LAUNDER();
                const int T0 = it * 128;
                LAS f16* vT = (LAS f16*)Lp;
                constexpr int VS = 136;
                const float* sng = AP->in[I_SNG] + l * GW; const float* snb = AP->in[I_SNB] + l * GW;
                for (int t = 0; t < 16; ++t) { const int tl = wave * 16 + t; const f16* pr = PROJ + (size_t)(T0 + tl) * INW + 1792 + 4 * lane;
                    const f16x4 hv = *(const f16x4*)pr; float v[4]; float s = 0.f;
#pragma unroll
                    for (int i = 0; i < 4; ++i) { v[i] = gelu_erf((float)hv[i]); s += v[i]; }
                    const float mean = wave_sum(s) * (1.f / 256.f); float q = 0.f;
#pragma unroll
                    for (int i = 0; i < 4; ++i) { v[i] -= mean; q += v[i] * v[i]; }
                    const float rstd = rsqrtf(wave_sum(q) * (1.f / 256.f) + EPS);
#pragma unroll
                    for (int i = 0; i < 4; ++i) { const int c = 4 * lane + i; vT[c * VS + tl] = (f16)(v[i] * rstd * sng[c] + snb[c]); } }
                __syncthreads();
                f32x4 acc[4][4];
#pragma unroll
                for (int h = 0; h < 4; ++h)
#pragma unroll
                    for (int ct = 0; ct < 4; ++ct) acc[h][ct] = (f32x4){0.f, 0.f, 0.f, 0.f};
                const int nk = (wave >> 1) + 1, fr = lane & 15, fq = lane >> 4;
                for (int ks = 0; ks < nk; ++ks) {
#pragma unroll
                    for (int h = 0; h < 4; ++h) {
                        const f16x8 a = *(const f16x8*)(SGUW + ((size_t)(l * 4 + h) * 128 + 16 * wave + fr) * 128 + 32 * ks + 8 * fq);
#pragma unroll
                        for (int ct = 0; ct < 4; ++ct) { const f16x8 b = *(const LAS f16x8*)(vT + (h * 64 + ct * 16 + fr) * VS + 32 * ks + 8 * fq);
                            acc[h][ct] = __builtin_amdgcn_mfma_f32_16x16x32_f16(a, b, acc[h][ct], 0, 0, 0); } } }
                const float* sb = AP->in[I_SGUB] + (size_t)l * 4 * 128;
#pragma unroll
                for (int reg = 0; reg < 4; ++reg) { const int il = 16 * wave + 4 * fq + reg; const size_t tok = (size_t)(T0 + il); float ss = 0.f; float val[4][4];
#pragma unroll
                    for (int h = 0; h < 4; ++h) { const float bia = sb[h * 128 + il];
#pragma unroll
                        for (int ct = 0; ct < 4; ++ct) { const int c = h * 64 + ct * 16 + fr; const float u = gelu_erf((float)PROJ[tok * INW + 1536 + c]);
                            const float x = (acc[h][ct][reg] + bia) * u; val[h][ct] = x; ss += x * x; } }
                    ss += __shfl_xor(ss, 1); ss += __shfl_xor(ss, 2); ss += __shfl_xor(ss, 4); ss += __shfl_xor(ss, 8);
                    const float rstd = rsqrtf(ss * (1.f / 256.f) + EPS);
#pragma unroll
                    for (int h = 0; h < 4; ++h)
#pragma unroll
                        for (int ct = 0; ct < 4; ++ct) MIX[tok * DM + 768 + h * 64 + ct * 16 + fr] = (f16)(val[h][ct] * rstd); }
                __syncthreads();
            } else if ((PH3 & 2) && it < 768) {
                LAUNDER();
                const int T0 = (it - 256) * 64, p0 = T0 & (SEQ - 1);
                LAS float* y = (LAS float*)Lp;
                for (int task = tid; task < 94 * 32; task += 512) { const int r = task >> 5, c8 = (task & 31) * 8; float o[8];
                    if (p0 - 30 + r >= 0) { const f16* pr = PROJ + (size_t)(T0 - 30 + r) * INW + c8; const f16x8 a = *(const f16x8*)pr, gt = *(const f16x8*)(pr + 256);
#pragma unroll
                        for (int i = 0; i < 8; ++i) o[i] = (float)a[i] * sigmoidf_((float)gt[i]); }
                    else {
#pragma unroll
                        for (int i = 0; i < 8; ++i) o[i] = 0.f; }
                    *(LAS f32x4*)(y + r * 256 + c8) = (f32x4){o[0], o[1], o[2], o[3]}; *(LAS f32x4*)(y + r * 256 + c8 + 4) = (f32x4){o[4], o[5], o[6], o[7]}; }
                __syncthreads();
                float psq[8];
#pragma unroll
                for (int t = 0; t < 8; ++t) psq[t] = 0.f;
#pragma unroll 1
                for (int h = 0; h < 4; ++h) { const int c = h * 64 + lane; float w[31];
#pragma unroll
                    for (int j = 0; j < 31; ++j) w[j] = AP->in[I_CONVW][((size_t)l * 31 + j) * GW + c];
                    const float cb = AP->in[I_CONVB][l * GW + c], ng = AP->in[I_CNG][l * GW + c], nb_ = AP->in[I_CNB][l * GW + c];
#pragma unroll
                    for (int t = 0; t < 8; ++t) { const int tl = wave * 8 + t; float a = cb;
#pragma unroll
                        for (int j = 0; j < 31; ++j) a += w[j] * y[(tl + j) * 256 + c];
                        const float mean = wave_sum(a) * (1.f / 64.f); const float xc = a - mean; const float var = wave_sum(xc * xc) * (1.f / 64.f);
                        const float yn = xc * rsqrtf(var + EPS) * ng + nb_; const float sv = yn * sigmoidf_(yn);
                        psq[t] += sv * sv; MIX[(size_t)(T0 + tl) * DM + c] = (f16)sv; } }
#pragma unroll
                for (int t = 0; t < 8; ++t) psq[t] = rsqrtf(wave_sum(psq[t]) * (1.f / 256.f) + EPS);
#pragma unroll 1
                for (int h = 0; h < 4; ++h) {
#pragma unroll
                    for (int t = 0; t < 8; ++t) { f16* p = MIX + (size_t)(T0 + wave * 8 + t) * DM + h * 64 + lane; *p = (f16)((float)*p * psq[t]); } }
                __syncthreads();
            } else if ((PH3 & 4) && it < 1280) {
                LAUNDER();
                const int T0 = (it - 768) * 64, p0 = T0 & (SEQ - 1);
                LAS float* P = (LAS float*)Lp;
                LAS float* Wp = (LAS float*)(Lp + 65536);
                for (int i = tid; i < 4096; i += 512) *(LAS f32x4*)(Wp + 4 * i) = *(const f32x4*)(AP->in[I_POOLW] + (size_t)l * 16384 + 4 * i);
                { const int c8 = (tid & 31) * 8, seg = tid >> 5, gi = c8 >> 6, w = 2 << gi;
                  for (int t = 0; t < 4; ++t) { const int tl = seg * 4 + t, p = p0 + tl; float s[8], z0[8];
#pragma unroll
                      for (int i = 0; i < 8; ++i) s[i] = 0.f;
                      for (int d = 0; d < w; ++d) { if (p - d >= 0) { const f16x8 z = *(const f16x8*)(PROJ + (size_t)(T0 + tl - d) * INW + 1280 + c8);
#pragma unroll
                              for (int i = 0; i < 8; ++i) { const float zf = (float)z[i]; s[i] += zf; if (d == 0) z0[i] = zf; } } }
                      const float inv = 1.f / (float)(p + 1 < w ? p + 1 : w);
#pragma unroll
                      for (int i = 0; i < 8; ++i) P[tl * 256 + c8 + i] = s[i] * inv - z0[i]; } }
                __syncthreads();
                float o[8][4];
#pragma unroll
                for (int gi = 0; gi < 4; ++gi) { float a[8];
#pragma unroll
                    for (int t = 0; t < 8; ++t) a[t] = 0.f;
                    for (int c = 0; c < 64; ++c) { const float wv = Wp[(gi * 64 + c) * 64 + lane];
#pragma unroll
                        for (int t = 0; t < 8; ++t) a[t] += P[(wave * 8 + t) * 256 + gi * 64 + c] * wv; }
                    const float ps = AP->in[I_POOLS][l * GW + gi * 64 + lane];
#pragma unroll
                    for (int t = 0; t < 8; ++t) o[t][gi] = a[t] * ps; }
#pragma unroll
                for (int t = 0; t < 8; ++t) { float ss = o[t][0] * o[t][0] + o[t][1] * o[t][1] + o[t][2] * o[t][2] + o[t][3] * o[t][3];
                    const float rstd = rsqrtf(wave_sum(ss) * (1.f / 256.f) + EPS); const size_t tok = (size_t)(T0 + wave * 8 + t);
#pragma unroll
                    for (int gi = 0; gi < 4; ++gi) MIX[tok * DM + 512 + gi * 64 + lane] = (f16)(o[t][gi] * rstd); }
                __syncthreads();
            } else if (PH3 & 8) {
                LAUNDER();
                const int ib = it - 1280, T0 = ib * 256;
                LAS float* part = (LAS float*)Lp;
                const int c4 = (tid & 63) * 4, sl = tid >> 6; float s[4] = {0.f, 0.f, 0.f, 0.f};
                for (int t = 0; t < 32; ++t) { const f16x4 k4 = *(const f16x4*)(PROJ + (size_t)(T0 + sl * 32 + t) * INW + 768 + c4);
#pragma unroll
                    for (int i = 0; i < 4; ++i) s[i] += (float)k4[i]; }
#pragma unroll
                for (int i = 0; i < 4; ++i) part[sl * 256 + c4 + i] = s[i];
                __syncthreads();
                if (tid < 256) { float a = 0.f;
#pragma unroll
                    for (int w = 0; w < 8; ++w) a += part[w * 256 + tid];
                    KMEAN[(size_t)ib * 256 + tid] = a * (1.f / 256.f); }
                __syncthreads();
            }
        }
}
        xcd_barrier(bar);

if (PHMASK & 16) { LAUNDER();
        {
            LAS f16* Kt = (LAS f16*)Lp;
            LAS f16* VT = (LAS f16*)(Lp + 9216);
            LAS float* kml = (LAS float*)(Lp + 18432);
            LAS float* lut = (LAS float*)(Lp + 18432 + 4096);
            constexpr int KS = 72, VSTR = 68;
            constexpr float LOG2E = 1.4426950408889634f, SC2 = 0.125f * LOG2E;
            const int r32 = lane & 31, hh = lane >> 5;
            for (int pi = bid; pi < 256; pi += G) {
                const int bh = pi >> 3, pp = pi & 7;
                for (int half = 0; half < 2; ++half) {
                    const int own = half == 0 ? 15 - pp : pp;
                    const int b = bh >> 2, h = bh & 3;
                    const size_t TB = (size_t)b * SEQ;
                    const int qpos = own * 256 + 32 * wave + r32;
                    __syncthreads();
                    for (int i = tid; i < 1024; i += 512) kml[i] = KMEAN[((size_t)(b * 16 + (i >> 6))) * 256 + h * 64 + (i & 63)];
                    if (tid < 128) lut[tid] = AP->in[I_RELB][t5_bucket(tid) * 4 + h] * LOG2E;
                    f16x8 qf[4];
                    { const f16* qp = PROJ + (TB + qpos) * INW + 512 + h * 64 + 8 * hh;
#pragma unroll
                      for (int s = 0; s < 4; ++s) qf[s] = *(const f16x8*)(qp + 16 * s); }
                    __syncthreads();
                    unsigned mask = 0u;
                    { float gsc[16];
#pragma unroll
                      for (int n = 0; n < 16; ++n) { float a = 0.f;
                          if (n < own) {
#pragma unroll
                              for (int s = 0; s < 4; ++s)
#pragma unroll
                                  for (int j = 0; j < 8; ++j) a += (float)qf[s][j] * kml[n * 64 + 16 * s + 8 * hh + j]; }
                          a += __shfl_xor(a, 32); gsc[n] = a; }
#pragma unroll
                      for (int k = 0; k < 3; ++k) { float best = -INFINITY; int bi = -1;
#pragma unroll
                          for (int n = 0; n < 16; ++n) { const bool ok = (n < own) && !((mask >> n) & 1u) && (gsc[n] > best); if (ok) { best = gsc[n]; bi = n; } }
                          if (bi >= 0) mask |= 1u << bi; } }
                    f32x16 o0, o1;
#pragma unroll
                    for (int i = 0; i < 16; ++i) { o0[i] = 0.f; o1[i] = 0.f; }
                    float mrun = -INFINITY, lrun = 0.f;
                    const int ntile = own * 4 + 4;
                    const int lk = tid >> 3, lc = tid & 7;
                    f16x8 kreg, vreg;
                    { const f16* kp = PROJ + (TB + lk) * INW + 768 + h * 64 + 8 * lc; kreg = *(const f16x8*)kp; vreg = *(const f16x8*)(kp + 256); }
                    for (int j = 0; j < ntile; ++j) {
                        __syncthreads();
                        *(LAS f16x8*)(Kt + lk * KS + 8 * lc) = kreg;
#pragma unroll
                        for (int i = 0; i < 8; ++i) VT[(8 * lc + i) * VSTR + lk] = vreg[i];
                        __syncthreads();
                        if (j + 1 < ntile) { const f16* kp = PROJ + (TB + (size_t)(j + 1) * 64 + lk) * INW + 768 + h * 64 + 8 * lc; kreg = *(const f16x8*)kp; vreg = *(const f16x8*)(kp + 256); }
                        const int n = j >> 2, kbase = j * 64;
                        bool active; bool sel;
                        if (n < own) { sel = (mask >> n) & 1u; active = __any(sel); }
                        else { sel = true; active = (kbase <= own * 256 + 32 * wave + 31); }
                        if (active) {
                            f32x16 p0, p1;
#pragma unroll
                            for (int i = 0; i < 16; ++i) { p0[i] = 0.f; p1[i] = 0.f; }
#pragma unroll
                            for (int s = 0; s < 4; ++s) { const f16x8 a0 = *(const LAS f16x8*)(Kt + r32 * KS + 16 * s + 8 * hh), a1 = *(const LAS f16x8*)(Kt + (32 + r32) * KS + 16 * s + 8 * hh);
                                p0 = __builtin_amdgcn_mfma_f32_32x32x16_f16(a0, qf[s], p0, 0, 0, 0); p1 = __builtin_amdgcn_mfma_f32_32x32x16_f16(a1, qf[s], p1, 0, 0, 0); }
                            const int dmin = own * 256 + 32 * wave - (kbase + 63);
                            float mx = -INFINITY;
                            if (dmin >= 127) { const float bc = lut[127];
#pragma unroll
                                for (int i = 0; i < 16; ++i) { p0[i] = sel ? p0[i] * SC2 + bc : -INFINITY; p1[i] = sel ? p1[i] * SC2 + bc : -INFINITY; mx = fmaxf(mx, fmaxf(p0[i], p1[i])); } }
                            else {
#pragma unroll
                                for (int i = 0; i < 16; ++i) { const int kr = (i & 3) + 8 * (i >> 2) + 4 * hh; const int d0 = qpos - (kbase + kr), d1 = d0 - 32;
                                    p0[i] = (sel && d0 >= 0) ? p0[i] * SC2 + lut[d0 > 127 ? 127 : d0] : -INFINITY;
                                    p1[i] = (sel && d1 >= 0) ? p1[i] * SC2 + lut[d1 > 127 ? 127 : (d1 < 0 ? 0 : d1)] : -INFINITY;
                                    mx = fmaxf(mx, fmaxf(p0[i], p1[i])); } }
                            mx = fmaxf(mx, __shfl_xor(mx, 32));
                            const float mnew = fmaxf(mrun, mx), msafe = (mnew == -INFINITY) ? 0.f : mnew;
                            const float alpha = exp2f(mrun - msafe);
                            float ps = 0.f;
#pragma unroll
                            for (int i = 0; i < 16; ++i) { p0[i] = exp2f(p0[i] - msafe); p1[i] = exp2f(p1[i] - msafe); ps += p0[i] + p1[i]; }
                            lrun = lrun * alpha + ps; mrun = mnew;
#pragma unroll
                            for (int i = 0; i < 16; ++i) { o0[i] *= alpha; o1[i] *= alpha; }
                            f16x8 pb[4];
#pragma unroll
                            for (int i = 0; i < 8; ++i) { pb[0][i] = (f16)p0[i]; pb[1][i] = (f16)p0[8 + i]; pb[2][i] = (f16)p1[i]; pb[3][i] = (f16)p1[8 + i]; }
#pragma unroll
                            for (int kk = 0; kk < 4; ++kk) {
                                const f16x4 a0l = *(const LAS f16x4*)(VT + r32 * VSTR + 16 * kk + 4 * hh), a0h = *(const LAS f16x4*)(VT + r32 * VSTR + 16 * kk + 8 + 4 * hh);
                                const f16x4 a1l = *(const LAS f16x4*)(VT + (32 + r32) * VSTR + 16 * kk + 4 * hh), a1h = *(const LAS f16x4*)(VT + (32 + r32) * VSTR + 16 * kk + 8 + 4 * hh);
                                const f16x8 av0 = {a0l[0], a0l[1], a0l[2], a0l[3], a0h[0], a0h[1], a0h[2], a0h[3]};
                                const f16x8 av1 = {a1l[0], a1l[1], a1l[2], a1l[3], a1h[0], a1h[1], a1h[2], a1h[3]};
                                o0 = __builtin_amdgcn_mfma_f32_32x32x16_f16(av0, pb[kk], o0, 0, 0, 0);
                                o1 = __builtin_amdgcn_mfma_f32_32x32x16_f16(av1, pb[kk], o1, 0, 0, 0); }
                        }
                    }
                    const float ltot = lrun + __shfl_xor(lrun, 32), inv = 1.f / ltot;
                    f16* op = MIX + (TB + qpos) * DM + 256 + h * 64;
#pragma unroll
                    for (int g4 = 0; g4 < 4; ++g4) { const int d0 = 8 * g4 + 4 * hh;
                        u32x2 w0, w1; w0.x = pk_f16(o0[4 * g4] * inv, o0[4 * g4 + 1] * inv); w0.y = pk_f16(o0[4 * g4 + 2] * inv, o0[4 * g4 + 3] * inv);
                        w1.x = pk_f16(o1[4 * g4] * inv, o1[4 * g4 + 1] * inv); w1.y = pk_f16(o1[4 * g4 + 2] * inv, o1[4 * g4 + 3] * inv);
                        *(u32x2*)(op + d0) = w0; *(u32x2*)(op + 32 + d0) = w1; }
                }
            }
        }
}
        xcd_barrier(bar);

if (PHMASK & 32) { LAUNDER();
        for (int m = gw; m < NTOK; m += NGW) { f16* p = MIX + (size_t)m * DM + 256 + 4 * lane; const f16x4 v = *(const f16x4*)p;
            float f[4], ss = 0.f;
#pragma unroll
            for (int i = 0; i < 4; ++i) { f[i] = (float)v[i]; ss += f[i] * f[i]; }
            const float rstd = rsqrtf(wave_sum(ss) * (1.f / 256.f) + EPS);
            u32x2 w; w.x = pk_f16(f[0] * rstd, f[1] * rstd); w.y = pk_f16(f[2] * rstd, f[3] * rstd); *(u32x2*)p = w; }
}
        xcd_barrier(bar);

if (PHMASK & 64) { LAUNDER();
        { pg8::Gemm g{(const pg8::h16_t*)MIX, (const pg8::h16_t*)(WOUT_T + (size_t)l * DM * DM), NTOK, DM, DM}; pg8::StaticOrder S; S.init(NTOK, DM, G, bid);
          pg8::EpiResid E{l == 0 ? AP->in[I_X] : X, X, MODL + 2048};
          pg8::gemm_phase<pg8::EpiResid, pg8::StaticOrder, true, true>(Lp, g, S, E, tid); }
}
        xcd_barrier(bar);

if (PHMASK & 128) { LAUNDER();
        {
            LAS float* WT = (LAS float*)Lp;
            constexpr int WS_ = 1028;
            LAS int* sel_e = (LAS int*)(Lp + 131584);
            LAS int* rank_ = (LAS int*)(Lp + 131584 + 2048);
            LAS int* lcnt = (LAS int*)(Lp + 131584 + 4096);
            LAS int* lbase = (LAS int*)(Lp + 131584 + 4096 + 128);
            const float* rw = AP->in[I_RW] + (size_t)l * DM * NEXP;
            for (int e = 0; e < 32; ++e) { WT[e * WS_ + tid] = rw[(size_t)tid * 32 + e]; WT[e * WS_ + 512 + tid] = rw[(size_t)(512 + tid) * 32 + e]; }
            unsigned* gcnt = ctl + CW_CNT + l * 32 * 64;
            for (int ch = bid; ch < NTOK / 128; ch += G) {
                if (tid < 32) lcnt[tid] = 0;
                __syncthreads();
                const int b = (ch * 128) >> 12; const float* md = MODL + (size_t)b * 6144;
                const float* g2 = AP->in[I_N2G] + l * DM;
                for (int pass = 0; pass < 8; ++pass) {
                    const int tl0 = wave * 16 + pass * 2; const size_t tok0 = (size_t)ch * 128 + tl0;
                    float hv[2][16];
#pragma unroll
                    for (int r = 0; r < 2; ++r) { const float* xr = X + (tok0 + r) * DM; f32x4 v[4]; float s = 0.f;
#pragma unroll
                        for (int j = 0; j < 4; ++j) { v[j] = *(const f32x4*)(xr + 4 * lane + 256 * j); s += (v[j].x * v[j].x + v[j].y * v[j].y) + (v[j].z * v[j].z + v[j].w * v[j].w); }
                        const float rstd = rsqrtf(wave_sum(s) * (1.f / DM) + EPS);
#pragma unroll
                        for (int j = 0; j < 4; ++j) { const int c = 4 * lane + 256 * j; const f32x4 gg = *(const f32x4*)(g2 + c), sh = *(const f32x4*)(md + 3072 + c), sc = *(const f32x4*)(md + 4096 + c);
                            const f32x4 hq = (v[j] * rstd) * gg * (sc + 1.0f) + sh;
                            hv[r][4 * j] = hq.x; hv[r][4 * j + 1] = hq.y; hv[r][4 * j + 2] = hq.z; hv[r][4 * j + 3] = hq.w;
                            u32x2 w; w.x = pk_f16(hq.x, hq.y); w.y = pk_f16(hq.z, hq.w); *(u32x2*)(H + (tok0 + r) * DM + c) = w; } }
                    float a0[32], a1[32];
#pragma unroll
                    for (int e = 0; e < 32; ++e) { float s0 = 0.f, s1 = 0.f;
#pragma unroll
                        for (int j = 0; j < 4; ++j) { const f32x4 w = *(const LAS f32x4*)(WT + e * WS_ + 4 * lane + 256 * j);
                            s0 += hv[0][4 * j] * w.x + hv[0][4 * j + 1] * w.y + hv[0][4 * j + 2] * w.z + hv[0][4 * j + 3] * w.w;
                            s1 += hv[1][4 * j] * w.x + hv[1][4 * j + 1] * w.y + hv[1][4 * j + 2] * w.z + hv[1][4 * j + 3] * w.w; }
                        a0[e] = s0; a1[e] = s1; }
                    float t1[32];
                    { const bool up = (lane & 32) != 0;
#pragma unroll
                      for (int e = 0; e < 32; ++e) { const float snd = up ? a0[e] : a1[e], kp = up ? a1[e] : a0[e]; t1[e] = kp + __shfl_xor(snd, 32); } }
                    float t2[16];
                    { const bool up = (lane & 16) != 0;
#pragma unroll
                      for (int e = 0; e < 16; ++e) { const float snd = up ? t1[e] : t1[e + 16], kp = up ? t1[e + 16] : t1[e]; t2[e] = kp + __shfl_xor(snd, 16); } }
                    float t3[8];
                    { const bool up = (lane & 8) != 0;
#pragma unroll
                      for (int e = 0; e < 8; ++e) { const float snd = up ? t2[e] : t2[e + 8], kp = up ? t2[e + 8] : t2[e]; t3[e] = kp + __shfl_xor(snd, 8); } }
                    float t4[4];
                    { const bool up = (lane & 4) != 0;
#pragma unroll
                      for (int e = 0; e < 4; ++e) { const float snd = up ? t3[e] : t3[e + 4], kp = up ? t3[e + 4] : t3[e]; t4[e] = kp + __shfl_xor(snd, 4); } }
                    float t5[2];
                    { const bool up = (lane & 2) != 0;
#pragma unroll
                      for (int e = 0; e < 2; ++e) { const float snd = up ? t4[e] : t4[e + 2], kp = up ? t4[e + 2] : t4[e]; t5[e] = kp + __shfl_xor(snd, 2); } }
                    float logit;
                    { const bool up = (lane & 1) != 0; const float snd = up ? t5[0] : t5[1], kp = up ? t5[1] : t5[0]; logit = kp + __shfl_xor(snd, 1); }
                    const int mye = lane & 31;
                    logit += AP->in[I_RB][l * NEXP + mye];
                    float topv[4]; int topi[4]; float myv = logit;
#pragma unroll
                    for (int k = 0; k < 4; ++k) { float bv = myv; int bi = mye;
#pragma unroll
                        for (int off = 1; off < 32; off <<= 1) { const float ov = __shfl_xor(bv, off); const int oi = __shfl_xor(bi, off); if (ov > bv || (ov == bv && oi < bi)) { bv = ov; bi = oi; } }
                        topv[k] = bv; topi[k] = bi; if (mye == bi) myv = -INFINITY; }
                    if (mye == 0) { const int tl = tl0 + (lane >> 5); const size_t tok = (size_t)ch * 128 + tl;
                        const float e1 = __expf(topv[1] - topv[0]), e2 = __expf(topv[2] - topv[0]), e3 = __expf(topv[3] - topv[0]); const float inv = 1.f / (1.f + e1 + e2 + e3);
                        *(f32x4*)(ROUTE_G + tok * 4) = (f32x4){inv, e1 * inv, e2 * inv, e3 * inv};
#pragma unroll
                        for (int k = 0; k < 4; ++k) sel_e[tl * 4 + k] = topi[k]; }
                }
                __syncthreads();
                const int e = sel_e[tid];
                rank_[tid] = __hip_atomic_fetch_add(&lcnt[e], 1, __ATOMIC_RELAXED, __HIP_MEMORY_SCOPE_WORKGROUP);
                __syncthreads();
                if (tid < 32) lbase[tid] = (int)__hip_atomic_fetch_add(gcnt + tid * 64, (unsigned)lcnt[tid], __ATOMIC_RELAXED, __HIP_MEMORY_SCOPE_AGENT);
                __syncthreads();
                { const int pos = lbase[e] + rank_[tid]; const size_t tok = (size_t)ch * 128 + (tid >> 2);
                  LIST[(size_t)e * LISTCAP + pos] = (int)tok; ROUTE_E[tok * 4 + (tid & 3)] = e; ROUTE_POS[tok * 4 + (tid & 3)] = pos; }
                __syncthreads();
            }
        }
}
        xcd_barrier(bar);

#define cnts ((LAS int*)(Lp + RING_BYTES + 1024))
#define mbase ((LAS int*)(Lp + RING_BYTES + 1024 + 256))
        { LAUNDER(); unsigned* gcnt = ctl + CW_CNT + l * 32 * 64;
          if (tid < 32) cnts[tid] = (int)xb_ld(gcnt + tid * 64);
          __syncthreads();
          if (tid == 0) { int a = 0; for (int e = 0; e < 32; ++e) { mbase[e] = a; a += (cnts[e] + 255) >> 8; } mbase[32] = a; }
          __syncthreads(); }

if (PHMASK & 256) { LAUNDER(); const int MT = mbase[32];
        for (int r = gw; r < MT * 256; r += NGW) { const int mt = r >> 8; int e = 0;
#pragma unroll
            for (int q = 1; q < 32; ++q) e += (mbase[q] <= mt) ? 1 : 0;
            const int ri = r - mbase[e] * 256; u32x4 v0 = {0u, 0u, 0u, 0u}, v1 = {0u, 0u, 0u, 0u};
            if (ri < cnts[e]) { const int tok = LIST[(size_t)e * LISTCAP + ri]; const f16* src = H + (size_t)tok * DM; v0 = *(const u32x4*)(src + 8 * lane); v1 = *(const u32x4*)(src + 512 + 8 * lane); }
            f16* dst = XS + (size_t)r * DM; *(u32x4*)(dst + 8 * lane) = v0; *(u32x4*)(dst + 512 + 8 * lane) = v1; }
}
        xcd_barrier(bar);

        for (int ph = 0; ph < 2; ++ph) {
            if (!(PHMASK & (512 << ph))) continue;
            LAUNDER(); const int MT = mbase[32]; LAS int* ulist = (LAS int*)(Lp + RING_BYTES); const int NT = ph == 0 ? 8 : 4, U = MT * NT;
            __syncthreads();
            int nu = 0;
            { const int q = U / 8, rr = U % 8, nig = 8 * NT;
              for (int i = 0; i < 64; ++i) { const long Lid = (long)i * G + bid; if (Lid >= U) break; ++nu;
                  if (tid == i) { int wg = (int)Lid; const int xcd = wg % 8, off = wg / 8; wg = (xcd < rr ? xcd * (q + 1) : rr * (q + 1) + (xcd - rr) * q) + off;
                      const int gid = wg / nig, fm = gid * 8, gsz = (MT - fm) < 8 ? (MT - fm) : 8; const int pm = fm + ((wg % nig) % gsz), pn = (wg % nig) / gsz;
                      int e = 0;
                      for (int qq = 1; qq < 32; ++qq) e += (mbase[qq] <= pm) ? 1 : 0;
                      ulist[i] = pm | ((e * NT + pn) << 16); } } }
            __syncthreads();
            pg8::ListOrder S{ulist, nu};
            if (ph == 0) { pg8::Gemm g{(const pg8::h16_t*)XS, (const pg8::h16_t*)(W1_T + (size_t)l * NEXP * 2048 * DM), PROWS, 2048, DM};
                pg8::EpiSwiglu E{(pg8::h16_t*)ACT, AP->in[I_B1] + (size_t)l * NEXP * 2048};
                pg8::gemm_phase<pg8::EpiSwiglu, pg8::ListOrder, true, true>(Lp, g, S, E, tid); }
            else { pg8::Gemm g{(const pg8::h16_t*)ACT, (const pg8::h16_t*)(W2_T + (size_t)l * NEXP * DM * DM), PROWS, 1024, DM};
                pg8::EpiDown E{(pg8::h16_t*)XS, AP->in[I_B2] + (size_t)l * NEXP * DM};
                pg8::gemm_phase<pg8::EpiDown, pg8::ListOrder, true, true>(Lp, g, S, E, tid); }
            xcd_barrier(bar);
        }

if (PHMASK & 2048) { LAUNDER();
        for (int m = gw; m < NTOK; m += NGW) {
            const int b = m >> 12; const float* md = MODL + (size_t)b * 6144;
            const f16* yr[4]; float gk[4];
#pragma unroll
            for (int k = 0; k < 4; ++k) { const int e = ROUTE_E[(size_t)m * 4 + k], pos = ROUTE_POS[(size_t)m * 4 + k]; gk[k] = ROUTE_G[(size_t)m * 4 + k]; yr[k] = XS + ((size_t)mbase[e] * 256 + pos) * DM; }
            f32x4 v[4]; float s = 0.f;
#pragma unroll
            for (int j = 0; j < 4; ++j) { const int c = 4 * lane + 256 * j; f32x4 a = {0.f, 0.f, 0.f, 0.f};
#pragma unroll
                for (int k = 0; k < 4; ++k) { const f16x4 y4 = *(const f16x4*)(yr[k] + c); a.x += gk[k] * (float)y4[0]; a.y += gk[k] * (float)y4[1]; a.z += gk[k] * (float)y4[2]; a.w += gk[k] * (float)y4[3]; }
                const f32x4 x1 = *(const f32x4*)(X + (size_t)m * DM + c), g2 = *(const f32x4*)(md + 5120 + c);
                v[j] = x1 + g2 * a; s += (v[j].x * v[j].x + v[j].y * v[j].y) + (v[j].z * v[j].z + v[j].w * v[j].w); }
            const float rstd = rsqrtf(wave_sum(s) * (1.f / DM) + EPS);
            if (l + 1 < DEPTH) {
                const float* mdn = MOD + (size_t)((l + 1) * 8 + b) * 6144; const float* g1 = AP->in[I_N1G] + (l + 1) * DM;
#pragma unroll
                for (int j = 0; j < 4; ++j) { const int c = 4 * lane + 256 * j; *(f32x4*)(X + (size_t)m * DM + c) = v[j];
                    const f32x4 gg = *(const f32x4*)(g1 + c), sh = *(const f32x4*)(mdn + c), sc = *(const f32x4*)(mdn + 1024 + c);
                    const f32x4 hq = (v[j] * rstd) * gg * (sc + 1.0f) + sh; u32x2 w; w.x = pk_f16(hq.x, hq.y); w.y = pk_f16(hq.z, hq.w); *(u32x2*)(H + (size_t)m * DM + c) = w; }
            } else {
#pragma unroll
                for (int j = 0; j < 4; ++j) { const int c = 4 * lane + 256 * j; const f32x4 gg = *(const f32x4*)(AP->in[I_FNG] + c); *(f32x4*)(AP->out + (size_t)m * DM + c) = (v[j] * rstd) * gg; }
            }
        }
}
        if (l + 1 < DEPTH) xcd_barrier(bar);
    }
}

extern "C" void kernel_launch(void* const* d_in, const int* in_sizes, int n_in, void* d_out, int out_size, void* d_ws, size_t ws_size, hipStream_t stream) {
    static int grid = 0;
    if (grid == 0) {
        if (n_in != 27 || out_size != NTOK * DM || ws_size < WS_END) { fprintf(stderr, "kernel_launch: unexpected shapes (n_in %d, out %d, ws %zu)\n", n_in, out_size, ws_size); grid = -1; return; }
        int dev = 0, cus = 0, per_cu = 0;
        if (hipGetDevice(&dev) != hipSuccess || hipDeviceGetAttribute(&cus, hipDeviceAttributeMultiprocessorCount, dev) != hipSuccess) { grid = -1; return; }
        if (hipFuncSetAttribute((const void*)fwd_megakernel, hipFuncAttributeMaxDynamicSharedMemorySize, LDS_BYTES) != hipSuccess) { fprintf(stderr, "kernel_launch: hipFuncSetAttribute failed\n"); grid = -1; return; }
        if (hipOccupancyMaxActiveBlocksPerMultiprocessor(&per_cu, (const void*)fwd_megakernel, NWAVES * 64, LDS_BYTES) != hipSuccess || per_cu < 1) { fprintf(stderr, "kernel_launch: occupancy query says %d blocks per CU\n", per_cu); (void)hipGetLastError(); grid = -1; return; }
        grid = cus;
    }
    if (grid < 0) return;
    (void)hipMemsetAsync((char*)d_ws + WS_CTL, 0, CTL_ZERO_BYTES, stream);
    Args a{};
    for (int i = 0; i < 27; ++i) a.in[i] = (const float*)d_in[i];
    a.out = (float*)d_out; a.ws = (unsigned char*)d_ws;
    hipLaunchKernelGGL(fwd_megakernel, dim3(grid), dim3(NWAVES * 64), LDS_BYTES, stream, a);
}
```

```cpp
#include <hip/hip_runtime.h>
#include <cstdio>
#include <cstdint>

#define LAS __attribute__((address_space(3)))
#define GAS __attribute__((address_space(1)))
#define CAS __attribute__((address_space(4)))
typedef _Float16 f16;
typedef _Float16 f16x8 __attribute__((ext_vector_type(8)));
typedef _Float16 f16x4 __attribute__((ext_vector_type(4)));
typedef _Float16 f16x2 __attribute__((ext_vector_type(2)));
typedef float f32x2 __attribute__((ext_vector_type(2)));
typedef float f32x4 __attribute__((ext_vector_type(4)));
typedef float f32x16 __attribute__((ext_vector_type(16)));
typedef unsigned u32x2 __attribute__((ext_vector_type(2)));
typedef unsigned u32x4 __attribute__((ext_vector_type(4)));

constexpr int DM = 1024, NB = 8, SEQ = 4096, NTOK = NB * SEQ, DEPTH = 2, GW = 256, INW = 2048;
constexpr int NEXP = 32, TOPK = 4;
constexpr int PROWS = NTOK * TOPK + NEXP * 256;
constexpr float EPS = 1e-6f;
constexpr int LISTCAP = NTOK;

__device__ __forceinline__ unsigned pk_f16(float lo, float hi) { f32x2 v = {lo, hi}; f16x2 h = __builtin_convertvector(v, f16x2); return __builtin_bit_cast(unsigned, h); }
__device__ __forceinline__ float wave_sum(float v) {
#pragma unroll
    for (int o = 1; o < 64; o <<= 1) v += __shfl_xor(v, o);
    return v;
}
__device__ __forceinline__ float sigmoidf_(float x) { return 1.f / (1.f + __expf(-x)); }
__device__ __forceinline__ float gelu_erf(float v) {
    const float av = fabsf(v), d = av * 0.2316418882f + 1.0f, t = __builtin_amdgcn_rcpf(d);
    float q = t * 0.5307027145f + (-0.7265760135f); q = q * t + 0.7107068705f; q = q * t + (-0.142248368f); q = q * t + 0.127414796f; q = q * t;
    const float e = __builtin_amdgcn_exp2f((v * v) * (-0.72134752044f));
    const float m = v * (q * e);
    return v < 0.f ? m : v - m;
}

namespace pg8 {
#define PG8_LAS __attribute__((address_space(3)))
typedef unsigned short h16_t;
constexpr int BM = 256, BK = 64, HALF = 128, HTB = HALF * BK * 2, STAGE_BYTES = 8 * HTB, NXCD = 8, WGM = 8;

__host__ __device__ __forceinline__ int lds_byte(int r, int c) { const int st = (r >> 4) * 2 + (c >> 5), rr = r & 15, cc = c & 31, ob = rr * 64 + cc * 2; return st * 1024 + (ob ^ (((ob >> 9) & 1) << 5)); }
__host__ __device__ __forceinline__ void stage_rc(int b, int& R, int& C) { const int st = b / 1024, sb = b % 1024, swz = sb ^ (((sb >> 9) & 1) << 5); R = (st >> 1) * 16 + swz / 64; C = (st & 1) * 32 + (swz % 64) / 2; }
__host__ __device__ __forceinline__ int perm32(int rho) { const int n = rho >> 4, i = rho & 15; return 8 * (i >> 2) + 4 * n + (i & 3); }

struct Unit { int pm, pn; };
struct Gemm { const GAS h16_t* A; const GAS h16_t* Bt; int M, N, K; };

struct StaticOrder {
    int nM, nN, nwg, G, c;
    __host__ __device__ void init(int M, int N, int G_, int c_) { nM = M / BM; nN = N / BM; nwg = nM * nN; G = G_; c = c_; }
    __host__ __device__ bool next(int i, Unit& u) const {
        const long L = (long)i * G + c; if (L >= nwg) return false;
        int wgid = (int)L; { const int q = nwg / NXCD, r = nwg % NXCD, xcd = wgid % NXCD, off = wgid / NXCD; wgid = (xcd < r ? xcd * (q + 1) : r * (q + 1) + (xcd - r) * q) + off; }
        const int nig = WGM * nN, gid = wgid / nig, fm = gid * WGM, gsz = (nM - fm) < WGM ? (nM - fm) : WGM;
        u.pm = fm + ((wgid % nig) % gsz); u.pn = (wgid % nig) / gsz; return true;
    }
    __device__ __forceinline__ void a_ready(const Unit&) const {}
    __device__ __forceinline__ void done(const Unit&) const {}
};
struct ListOrder {
    const PG8_LAS int* list; int n;
    __device__ __forceinline__ bool next(int i, Unit& u) const { if (i >= n) return false; const int v = __builtin_amdgcn_readfirstlane(list[i]); u.pm = v & 0xffff; u.pn = v >> 16; return true; }
    __device__ __forceinline__ void a_ready(const Unit&) const {}
    __device__ __forceinline__ void done(const Unit&) const {}
};

struct EpiF16 {
    static constexpr bool PERM = true, AFTER_DRAIN = false;
    GAS h16_t* O; int ldc;
    __device__ __forceinline__ void operator()(const f32x4 (&acc)[2][2][4][2], const Unit& u, int wr, int wc, int fr, int fq) const {
        const int row0 = u.pm * BM + wr * 64 + fr, col0 = u.pn * BM + wc * 32 + 8 * fq;
#pragma unroll
        for (int ai = 0; ai < 2; ++ai)
#pragma unroll
            for (int m = 0; m < 4; ++m) { GAS h16_t* rowp = O + (size_t)(row0 + ai * HALF + m * 16) * ldc + col0;
#pragma unroll
                for (int bj = 0; bj < 2; ++bj) { const f32x4 v0 = acc[ai][bj][m][0], v1 = acc[ai][bj][m][1];
                    u32x4 w; w.x = pk_f16(v0[0], v0[1]); w.y = pk_f16(v0[2], v0[3]); w.z = pk_f16(v1[0], v1[1]); w.w = pk_f16(v1[2], v1[3]);
                    *(GAS u32x4*)(rowp + bj * HALF) = w; } }
    }
};
struct EpiResid {
    static constexpr bool PERM = false, AFTER_DRAIN = false;
    const GAS float* base; GAS float* out; const GAS float* gate;
    __device__ __forceinline__ void operator()(const f32x4 (&acc)[2][2][4][2], const Unit& u, int wr, int wc, int fr, int fq) const {
        const int row0 = u.pm * BM + wr * 64 + fr, col0 = u.pn * BM + wc * 32 + 4 * fq;
        const GAS float* gp = gate + (size_t)((u.pm * BM) >> 12) * 6144;
        f32x4 gv[2][2];
#pragma unroll
        for (int bj = 0; bj < 2; ++bj)
#pragma unroll
            for (int n = 0; n < 2; ++n) gv[bj][n] = *(const GAS f32x4*)(gp + col0 + bj * HALF + n * 16);
#pragma unroll
        for (int ai = 0; ai < 2; ++ai)
#pragma unroll
            for (int m = 0; m < 4; ++m) { const size_t off = (size_t)(row0 + ai * HALF + m * 16) * DM + col0;
#pragma unroll
                for (int bj = 0; bj < 2; ++bj)
#pragma unroll
                    for (int n = 0; n < 2; ++n) { const f32x4 bs = *(const GAS f32x4*)(base + off + bj * HALF + n * 16);
                        *(GAS f32x4*)(out + off + bj * HALF + n * 16) = bs + gv[bj][n] * acc[ai][bj][m][n]; } }
    }
};
struct EpiSwiglu {
    static constexpr bool PERM = true, AFTER_DRAIN = false;
    GAS h16_t* O; const GAS float* b1;
    __device__ __forceinline__ void operator()(const f32x4 (&acc)[2][2][4][2], const Unit& u, int wr, int wc, int fr, int fq) const {
        const int e = u.pn >> 3, p = u.pn & 7;
        const int row0 = u.pm * BM + wr * 64 + fr, hc = p * 128 + wc * 32 + 8 * fq;
        const GAS float* bp = b1 + (size_t)e * 2048 + hc;
        f32x4 bg[2], bl[2];
#pragma unroll
        for (int n = 0; n < 2; ++n) { bg[n] = *(const GAS f32x4*)(bp + 4 * n); bl[n] = *(const GAS f32x4*)(bp + 1024 + 4 * n); }
#pragma unroll
        for (int ai = 0; ai < 2; ++ai)
#pragma unroll
            for (int m = 0; m < 4; ++m) { GAS h16_t* rowp = O + (size_t)(row0 + ai * HALF + m * 16) * DM + hc; float r[8];
#pragma unroll
                for (int n = 0; n < 2; ++n) { const f32x4 g = acc[ai][0][m][n] + bg[n], li = acc[ai][1][m][n] + bl[n];
#pragma unroll
                    for (int i = 0; i < 4; ++i) { const float xg = fminf(g[i], 7.0f), xl = fminf(fmaxf(li[i], -7.0f), 7.0f);
                        r[4 * n + i] = xg * (1.f / (1.f + __expf(-1.702f * xg))) * (xl + 1.0f); } }
                u32x4 w; w.x = pk_f16(r[0], r[1]); w.y = pk_f16(r[2], r[3]); w.z = pk_f16(r[4], r[5]); w.w = pk_f16(r[6], r[7]);
                *(GAS u32x4*)rowp = w; }
    }
};
struct EpiDown {
    static constexpr bool PERM = true, AFTER_DRAIN = false;
    GAS h16_t* O; const GAS float* b2;
    __device__ __forceinline__ void operator()(const f32x4 (&acc)[2][2][4][2], const Unit& u, int wr, int wc, int fr, int fq) const {
        const int e = u.pn >> 2, p = u.pn & 3;
        const int row0 = u.pm * BM + wr * 64 + fr, col0 = p * BM + wc * 32 + 8 * fq;
        const GAS float* bp = b2 + (size_t)e * 1024 + col0;
        f32x4 bv[2][2];
#pragma unroll
        for (int bj = 0; bj < 2; ++bj)
#pragma unroll
            for (int n = 0; n < 2; ++n) bv[bj][n] = *(const GAS f32x4*)(bp + bj * HALF + 4 * n);
#pragma unroll
        for (int ai = 0; ai < 2; ++ai)
#pragma unroll
            for (int m = 0; m < 4; ++m) { GAS h16_t* rowp = O + (size_t)(row0 + ai * HALF + m * 16) * DM + col0;
#pragma unroll
                for (int bj = 0; bj < 2; ++bj) { const f32x4 v0 = acc[ai][bj][m][0] + bv[bj][0], v1 = acc[ai][bj][m][1] + bv[bj][1];
                    u32x4 w; w.x = pk_f16(v0[0], v0[1]); w.y = pk_f16(v0[2], v0[3]); w.z = pk_f16(v1[0], v1[1]); w.w = pk_f16(v1[2], v1[3]);
                    *(GAS u32x4*)(rowp + bj * HALF) = w; } }
    }
};

template <class Epi, class Sched, bool ALIGN_EPI = false, bool SP2 = false>
__device__ __forceinline__ void gemm_phase(PG8_LAS unsigned char* lds, const Gemm g, const Sched& S, const Epi& E, const int tid) {
    const int wid = __builtin_amdgcn_readfirstlane(tid >> 6), lane = tid & 63, wr = wid >> 2, wc = wid & 3, fr = lane & 15, fq = lane >> 4;
    const int K = g.K, nt = K / BK;
    unsigned voffA[2], voffB[2];
#pragma unroll
    for (int i = 0; i < 2; ++i) { int R, C; stage_rc(tid * 16 + i * 8192, R, C); const int Rb = Epi::PERM ? ((R & ~31) + perm32(R & 31)) : R;
        voffA[i] = (unsigned)(R * K + C) * 2u; voffB[i] = (unsigned)(Rb * K + C) * 2u; }
    const size_t kstep = (size_t)(BK * 2);
    const size_t hstep = (size_t)HALF * K * 2;
    const size_t tstep = 2 * hstep;
    const unsigned ldsw = (unsigned)wid * 1024u;
    const int aoff = lds_byte(wr * 64 + fr, fq * 8), boff = lds_byte(wc * 32 + fr, fq * 8);
#define PG8_SA(b, h) (((b) * 2 + (h)) * HTB)
#define PG8_SB(b, h) ((4 + (b) * 2 + (h)) * HTB)
#define PG8_STAGE(bufoff, gbase, voff) do { _Pragma("unroll") for (int _i = 0; _i < 2; ++_i) \
        __builtin_amdgcn_global_load_lds((const GAS unsigned*)((const GAS char*)(gbase) + (voff)[_i]), (PG8_LAS unsigned*)(lds + (bufoff) + ldsw + _i * 8192), 16, 0, 0); } while (0)
#define PG8_LDA(dst, b, h) do { _Pragma("unroll") for (int m = 0; m < 4; ++m) _Pragma("unroll") for (int k = 0; k < 2; ++k) dst[m][k] = *(const PG8_LAS f16x8*)(lds + PG8_SA(b, h) + aoff + m * 2048 + k * 1024); } while (0)
#define PG8_LDB(dst, b, h) do { _Pragma("unroll") for (int n = 0; n < 2; ++n) _Pragma("unroll") for (int k = 0; k < 2; ++k) dst[n][k] = *(const PG8_LAS f16x8*)(lds + PG8_SB(b, h) + boff + n * 2048 + k * 1024); } while (0)
#define PG8_MMA(ai, bj, At, Bt) do { __builtin_amdgcn_s_setprio(1); _Pragma("unroll") for (int m = 0; m < 4; ++m) _Pragma("unroll") for (int n = 0; n < 2; ++n) _Pragma("unroll") for (int k = 0; k < 2; ++k) \
        acc[ai][bj][m][n] = __builtin_amdgcn_mfma_f32_16x16x32_f16(Bt[n][k], At[m][k], acc[ai][bj][m][n], 0, 0, 0); __builtin_amdgcn_s_setprio(0); } while (0)
#define PG8_WAIT_V(n) asm volatile("s_waitcnt vmcnt(" #n ")" ::: "memory")
#define PG8_WAIT_L(n) asm volatile("s_waitcnt lgkmcnt(" #n ")" ::: "memory")
#define PG8_BAR __builtin_amdgcn_s_barrier()
#define PG8_SCHED __builtin_amdgcn_sched_barrier(0)
    Unit cur, nxt; int ui = 0;
    if (!S.next(0, cur)) return;
    f32x4 acc[2][2][4][2];
#pragma unroll
    for (int a = 0; a < 2; ++a)
#pragma unroll
        for (int b = 0; b < 2; ++b)
#pragma unroll
            for (int m = 0; m < 4; ++m)
#pragma unroll
                for (int n = 0; n < 2; ++n) acc[a][b][m][n] = (f32x4){0.f, 0.f, 0.f, 0.f};
    f16x8 At[4][2], B0[2][2], B1[2][2];
    const GAS char* cA = (const GAS char*)g.A + (size_t)cur.pm * tstep; const GAS char* cB = (const GAS char*)g.Bt + (size_t)cur.pn * tstep;
    S.a_ready(cur);
    if constexpr (SP2) {
        PG8_STAGE(PG8_SB(0, 0), cB, voffB); PG8_STAGE(PG8_SB(0, 1), cB + hstep, voffB); PG8_STAGE(PG8_SA(0, 0), cA, voffA); PG8_STAGE(PG8_SA(0, 1), cA + hstep, voffA);
        if (wr == 1) PG8_BAR;
        PG8_WAIT_V(2); PG8_BAR;
        PG8_STAGE(PG8_SB(1, 0), cB + kstep, voffB); PG8_STAGE(PG8_SA(1, 0), cA + kstep, voffA); PG8_STAGE(PG8_SB(1, 1), cB + hstep + kstep, voffB);
        PG8_WAIT_V(6); PG8_BAR;
    } else {
        PG8_STAGE(PG8_SB(0, 0), cB, voffB); PG8_STAGE(PG8_SA(0, 0), cA, voffA); PG8_STAGE(PG8_SB(0, 1), cB + hstep, voffB); PG8_STAGE(PG8_SA(0, 1), cA + hstep, voffA);
        if (wr == 1) PG8_BAR;
        PG8_WAIT_V(4); PG8_BAR;
        PG8_STAGE(PG8_SB(1, 0), cB + kstep, voffB); PG8_STAGE(PG8_SA(1, 0), cA + kstep, voffA); PG8_STAGE(PG8_SB(1, 1), cB + hstep + kstep, voffB);
        PG8_WAIT_V(6); PG8_BAR;
    }
    for (;;) {
        const bool has_next = S.next(ui + 1, nxt);
        const GAS char* nA = has_next ? (const GAS char*)g.A + (size_t)nxt.pm * tstep : cA; const GAS char* nB = has_next ? (const GAS char*)g.Bt + (size_t)nxt.pn * tstep : cB;
        for (int t = 0; t < nt; t += 2) {
            const bool last = (t == nt - 2);
            const GAS char* a1 = cA + (size_t)(t + 1) * kstep;
            const GAS char* a2 = last ? nA : cA + (size_t)(t + 2) * kstep; const GAS char* b2 = last ? nB : cB + (size_t)(t + 2) * kstep;
            const GAS char* a3 = a2 + kstep; const GAS char* b3 = b2 + kstep;
            if (last && has_next) S.a_ready(nxt);
            if constexpr (SP2) {
            PG8_LDB(B0, 0, 0); PG8_LDB(B1, 0, 1); PG8_SCHED; PG8_LDA(At, 0, 0); PG8_STAGE(PG8_SA(1, 1), a1 + hstep, voffA);
            PG8_WAIT_V(8); PG8_WAIT_L(0); PG8_BAR; PG8_MMA(0, 0, At, B0); PG8_MMA(0, 1, At, B1); PG8_BAR; PG8_SCHED;
            PG8_LDA(At, 0, 1); PG8_STAGE(PG8_SB(0, 0), b2, voffB); PG8_STAGE(PG8_SB(0, 1), b2 + hstep, voffB); PG8_STAGE(PG8_SA(0, 0), a2, voffA);
            PG8_WAIT_V(8); PG8_WAIT_L(0); PG8_BAR; PG8_MMA(1, 0, At, B0); PG8_MMA(1, 1, At, B1); PG8_BAR; PG8_SCHED;
            PG8_LDB(B0, 1, 0); PG8_LDB(B1, 1, 1); PG8_SCHED; PG8_LDA(At, 1, 0); PG8_STAGE(PG8_SA(0, 1), a2 + hstep, voffA);
            PG8_WAIT_V(8); PG8_WAIT_L(0); PG8_BAR; PG8_MMA(0, 0, At, B0); PG8_MMA(0, 1, At, B1); PG8_BAR; PG8_SCHED;
            PG8_LDA(At, 1, 1); PG8_STAGE(PG8_SB(1, 0), b3, voffB); PG8_STAGE(PG8_SB(1, 1), b3 + hstep, voffB); PG8_STAGE(PG8_SA(1, 0), a3, voffA);
            PG8_WAIT_V(8); PG8_WAIT_L(0); PG8_BAR; PG8_MMA(1, 0, At, B0); PG8_MMA(1, 1, At, B1); PG8_BAR; PG8_SCHED;
            } else {
            PG8_LDB(B0, 0, 0); PG8_SCHED; PG8_LDA(At, 0, 0); PG8_STAGE(PG8_SA(1, 1), a1 + hstep, voffA);
            PG8_WAIT_L(8); PG8_BAR; PG8_WAIT_L(0); PG8_MMA(0, 0, At, B0); PG8_BAR; PG8_SCHED;
            PG8_LDB(B1, 0, 1); PG8_STAGE(PG8_SB(0, 0), b2, voffB);
            PG8_BAR; PG8_WAIT_L(0); PG8_MMA(0, 1, At, B1); PG8_BAR;
            PG8_LDA(At, 0, 1); PG8_STAGE(PG8_SA(0, 0), a2, voffA);
            PG8_BAR; PG8_WAIT_L(0); PG8_MMA(1, 0, At, B0); PG8_BAR; PG8_SCHED;
            PG8_STAGE(PG8_SB(0, 1), b2 + hstep, voffB);
            PG8_WAIT_V(6); PG8_BAR; PG8_MMA(1, 1, At, B1); PG8_BAR;
            PG8_LDB(B0, 1, 0); PG8_SCHED; PG8_LDA(At, 1, 0); PG8_STAGE(PG8_SA(0, 1), a2 + hstep, voffA);
            PG8_WAIT_L(8); PG8_BAR; PG8_WAIT_L(0); PG8_MMA(0, 0, At, B0); PG8_BAR; PG8_SCHED;
            PG8_LDB(B1, 1, 1); PG8_STAGE(PG8_SB(1, 0), b3, voffB);
            PG8_BAR; PG8_WAIT_L(0); PG8_MMA(0, 1, At, B1); PG8_BAR;
            PG8_LDA(At, 1, 1); PG8_STAGE(PG8_SA(1, 0), a3, voffA);
            PG8_BAR; PG8_WAIT_L(0); PG8_MMA(1, 0, At, B0); PG8_BAR; PG8_SCHED;
            PG8_STAGE(PG8_SB(1, 1), b3 + hstep, voffB);
            PG8_WAIT_V(6); PG8_BAR; PG8_MMA(1, 1, At, B1); PG8_BAR;
            }
        }
        if constexpr (ALIGN_EPI) { if (wr == 0) PG8_BAR; }
        if constexpr (!Epi::AFTER_DRAIN) { E(acc, cur, wr, wc, fr, fq); S.done(cur); }
        if (!has_next) break;
#pragma unroll
        for (int a = 0; a < 2; ++a)
#pragma unroll
            for (int b = 0; b < 2; ++b)
#pragma unroll
                for (int m = 0; m < 4; ++m)
#pragma unroll
                    for (int n = 0; n < 2; ++n) acc[a][b][m][n] = (f32x4){0.f, 0.f, 0.f, 0.f};
        cur = nxt; cA = nA; cB = nB; ++ui;
        if constexpr (ALIGN_EPI) { if (wr == 1) PG8_BAR; }
    }
    PG8_WAIT_V(0);
    if constexpr (!ALIGN_EPI) { if (wr == 0) PG8_BAR; }
    PG8_BAR;
#undef PG8_SA
#undef PG8_SB
#undef PG8_STAGE
#undef PG8_LDA
#undef PG8_LDB
#undef PG8_MMA
#undef PG8_WAIT_V
#undef PG8_WAIT_L
#undef PG8_BAR
#undef PG8_SCHED
}
}

constexpr size_t MiB = 1u << 20;
constexpr size_t WS_CTL   = 0,            CTL_ZERO_BYTES = 1 * MiB;
constexpr size_t WS_MOD   = 1 * MiB;
constexpr size_t WS_KMEAN = 2 * MiB;
constexpr size_t WS_SGUW  = 3 * MiB;
constexpr size_t WS_ROUTE = 4 * MiB;
constexpr size_t WS_LIST  = 6 * MiB;
constexpr size_t WS_WIN   = 10 * MiB;
constexpr size_t WS_WOUT  = 18 * MiB;
constexpr size_t WS_W1    = 22 * MiB;
constexpr size_t WS_W2    = 278 * MiB;
constexpr size_t WS_X     = 406 * MiB;
constexpr size_t WS_H     = 534 * MiB;
constexpr size_t WS_PROJ  = 598 * MiB;
constexpr size_t WS_MIX   = 726 * MiB;
constexpr size_t WS_XS    = 790 * MiB;
constexpr size_t WS_ACT   = 1062 * MiB;
constexpr size_t WS_END   = 1334 * MiB;
constexpr int CW_BAR = 4096;
constexpr int CW_CNT = 16384;

constexpr int RING_BYTES = 131072;
constexpr int LDS_BYTES = 147456;
constexpr int BARST_OFF = LDS_BYTES - 64;
constexpr int NWAVES = 8;
#ifndef PH3
#define PH3 15
#endif
#ifndef PROBE
#define PROBE 0
#endif
#define GIN(k) ((const GAS float*)AP->in[k])
#define REPS(bit) (((PROBE) & (bit)) ? 2 : 1)
#ifndef PHMASK
#define PHMASK 0xFFFF
#endif

#define XB_TMO      128
#define XB_XCNT(j)  (256  + 64 * (j))
#define XB_XSUB(j)  (1280 + 64 * (j))
#define XB_XGEN(j)  (2304 + 64 * (j))
#define XB_TOP      3328
#define XB_TOPGEN   3392
#define XCD_BAR_WORDS 3456
#define XB_SPIN_CAP (1u << 20)
__device__ __forceinline__ unsigned xb_ld(unsigned* p)              { return __hip_atomic_load(p, __ATOMIC_RELAXED, __HIP_MEMORY_SCOPE_AGENT); }
__device__ __forceinline__ unsigned xb_add(unsigned* p, unsigned v) { return __hip_atomic_fetch_add(p, v, __ATOMIC_RELAXED, __HIP_MEMORY_SCOPE_AGENT); }
__device__ __forceinline__ unsigned xb_xcc_id() { return (unsigned)__builtin_amdgcn_s_getreg((3 << 11) | 20) & 0xFu; }
#define XB_SPIN(cond, bar) do { unsigned _sp = 0; while (cond) { __builtin_amdgcn_s_sleep(1); \
    if ((++_sp & 255u) == 0u) { if (xb_ld(&(bar)[XB_TMO])) break; if (_sp > XB_SPIN_CAP) { atomicAdd(&(bar)[XB_TMO], 1u); break; } } } } while (0)
struct XcdBarrier { unsigned* bar; unsigned x; volatile LAS unsigned* st; };
__device__ __forceinline__ XcdBarrier xcd_barrier_post(unsigned* bar, volatile LAS unsigned* st) {
    XcdBarrier b; b.bar = bar; b.x = xb_xcc_id(); b.st = st;
    if (threadIdx.x == 0) (void)xb_add(&bar[XB_XCNT(b.x)], 1u);
    return b;
}
__device__ __forceinline__ void xcd_barrier_complete(unsigned* bar, unsigned x, unsigned& nloc, unsigned& nx) {
    const unsigned G = gridDim.x * gridDim.y * gridDim.z;
    unsigned sum, cnt, mine, sp = 0u;
    for (;;) {
        sum = 0u; cnt = 0u; mine = 0u;
#pragma unroll
        for (unsigned j = 0; j < 16; ++j) { const unsigned c = xb_ld(&bar[XB_XCNT(j)]); sum += c; cnt += (c > 0u) ? 1u : 0u; mine = (j == x) ? c : mine; }
        if (sum == G) break;
        __builtin_amdgcn_s_sleep(1);
        if ((++sp & 255u) == 0u) { if (xb_ld(&bar[XB_TMO])) break; if (sp > XB_SPIN_CAP) { atomicAdd(&bar[XB_TMO], 1u); break; } }
    }
    nloc = mine > 0u ? mine : 1u; nx = cnt > 0u ? cnt : 1u;
}
__device__ __forceinline__ void xcd_barrier(const XcdBarrier& b) {
    asm volatile("s_waitcnt vmcnt(0)" ::: "memory");
    __syncthreads();
    if (threadIdx.x == 0) {
        unsigned* bar = b.bar; asm volatile("" : "+s"(bar));
        unsigned bx = b.x; asm volatile("" : "+s"(bx));
        __builtin_amdgcn_s_waitcnt(0);
        unsigned nloc = b.st[0], nx = b.st[1];
        if (nloc == 0u) { xcd_barrier_complete(bar, bx, nloc, nx); b.st[0] = nloc; b.st[1] = nx; }
        const unsigned old = xb_add(&bar[XB_XSUB(bx)], 1u);
        const unsigned gen = old / nloc;
        if (old + 1u == (gen + 1u) * nloc) {
            __builtin_amdgcn_fence(__ATOMIC_RELEASE, "agent");
            asm volatile("s_waitcnt vmcnt(0)" ::: "memory");
            const unsigned og = xb_add(&bar[XB_TOP], 1u);
            const unsigned tg = og / nx;
            if (og + 1u == (tg + 1u) * nx) xb_add(&bar[XB_TOPGEN], 1u);
            else XB_SPIN(xb_ld(&bar[XB_TOPGEN]) == tg, bar);
            __builtin_amdgcn_fence(__ATOMIC_ACQUIRE, "agent");
            xb_add(&bar[XB_XGEN(bx)], 1u);
            asm volatile("s_waitcnt vmcnt(0)" ::: "memory");
        } else {
            XB_SPIN(xb_ld(&bar[XB_XGEN(bx)]) == gen, bar);
            __builtin_amdgcn_fence(__ATOMIC_ACQUIRE, "agent");
            asm volatile("s_waitcnt vmcnt(0)" ::: "memory");
        }
    }
    __syncthreads();
}

struct Args { const float* in[27]; float* out; unsigned char* ws; };
enum { I_X = 0, I_C, I_WMOD, I_BMOD, I_N1G, I_WIN, I_CONVW, I_CONVB, I_CNG, I_CNB, I_RELB, I_POOLW, I_POOLS, I_SNG, I_SNB, I_SGUW, I_SGUB, I_MIXG, I_WOUT, I_N2G, I_RW, I_RB, I_W1, I_B1, I_W2, I_B2, I_FNG };

__device__ __forceinline__ int t5_bucket(int n) {
    if (n < 16) return n;
    int b = 16;
    b += (n >= 19); b += (n >= 21); b += (n >= 24); b += (n >= 27); b += (n >= 31); b += (n >= 35); b += (n >= 40); b += (n >= 46);
    b += (n >= 52); b += (n >= 59); b += (n >= 67); b += (n >= 77); b += (n >= 87); b += (n >= 99); b += (n >= 113);
    return b;
}

__device__ __forceinline__ void transpose_item(const GAS float* W, int K, int N, GAS f16* WT, int orow0, int k0, int n0, const GAS float* kscale, LAS float* scr, int lane) {
#pragma unroll 8
    for (int i = 0; i < 32; ++i) { const int kk = 2 * i + (lane >> 5); float v = W[(size_t)(k0 + kk) * N + n0 + (lane & 31)]; if (kscale) v *= kscale[k0 + kk]; scr[kk * 33 + (lane & 31)] = v; }
    asm volatile("s_waitcnt lgkmcnt(0)" ::: "memory");
    const int c = lane & 7;
#pragma unroll
    for (int j = 0; j < 4; ++j) { const int n = (lane >> 3) + 8 * j; const LAS float* s = scr + (8 * c) * 33 + n;
        u32x4 o; o.x = pk_f16(s[0 * 33], s[1 * 33]); o.y = pk_f16(s[2 * 33], s[3 * 33]); o.z = pk_f16(s[4 * 33], s[5 * 33]); o.w = pk_f16(s[6 * 33], s[7 * 33]);
        *(GAS u32x4*)(WT + (size_t)(orow0 + n) * K + k0 + 8 * c) = o; }
    asm volatile("s_waitcnt lgkmcnt(0)" ::: "memory");
}

__device__ __forceinline__ void norm_mod_row(const GAS float* xrow, const GAS float* g, const GAS float* shift, const GAS float* scale, GAS f16* orow, int lane) {
    f32x4 v[4]; float s = 0.f;
#pragma unroll
    for (int j = 0; j < 4; ++j) { v[j] = *(const GAS f32x4*)(xrow + 4 * lane + 256 * j); s += (v[j].x * v[j].x + v[j].y * v[j].y) + (v[j].z * v[j].z + v[j].w * v[j].w); }
    const float rstd = rsqrtf(wave_sum(s) * (1.f / DM) + EPS);
#pragma unroll
    for (int j = 0; j < 4; ++j) { const int c = 4 * lane + 256 * j; const f32x4 gg = *(const GAS f32x4*)(g + c), sh = *(const GAS f32x4*)(shift + c), sc = *(const GAS f32x4*)(scale + c);
        const f32x4 h = (v[j] * rstd) * gg * (sc + 1.0f) + sh;
        u32x2 w; w.x = pk_f16(h.x, h.y); w.y = pk_f16(h.z, h.w); *(GAS u32x2*)(orow + c) = w; }
}

extern __shared__ __attribute__((aligned(16))) unsigned char lds[];
#define LAUNDER() int tid = tid0; asm volatile("" : "+v"(tid)); const int lane = tid & 63; int wave = wave0; asm volatile("" : "+s"(wave)); const int gw = bid * NWAVES + wave; (void)gw; (void)lane; const CAS Args* AP = (const CAS Args*)__builtin_amdgcn_kernarg_segment_ptr(); asm volatile("" : "+s"(AP)); (void)AP; LAS unsigned char* Lp = (LAS unsigned char*)lds; asm volatile("" : "+s"(Lp)); (void)Lp; GAS unsigned char* ws = (GAS unsigned char*)AP->ws; GAS unsigned* ctl = (GAS unsigned*)(ws + WS_CTL); GAS float* MOD = (GAS float*)(ws + WS_MOD); GAS float* KMEAN = (GAS float*)(ws + WS_KMEAN); GAS f16* SGUW = (GAS f16*)(ws + WS_SGUW); GAS int* ROUTE_E = (GAS int*)(ws + WS_ROUTE); GAS int* ROUTE_POS = ROUTE_E + NTOK * 4; GAS float* ROUTE_G = (GAS float*)(ROUTE_POS + NTOK * 4); GAS int* LIST = (GAS int*)(ws + WS_LIST); GAS f16* WIN_T = (GAS f16*)(ws + WS_WIN); GAS f16* WOUT_T = (GAS f16*)(ws + WS_WOUT); GAS f16* W1_T = (GAS f16*)(ws + WS_W1); GAS f16* W2_T = (GAS f16*)(ws + WS_W2); GAS float* X = (GAS float*)(ws + WS_X); GAS f16* H = (GAS f16*)(ws + WS_H); GAS f16* PROJ = (GAS f16*)(ws + WS_PROJ); GAS f16* MIX = (GAS f16*)(ws + WS_MIX); GAS f16* XS = (GAS f16*)(ws + WS_XS); GAS f16* ACT = (GAS f16*)(ws + WS_ACT); (void)ctl; (void)MOD; (void)KMEAN; (void)SGUW; (void)ROUTE_E; (void)ROUTE_POS; (void)ROUTE_G; (void)LIST; (void)WIN_T; (void)WOUT_T; (void)W1_T; (void)W2_T; (void)X; (void)H; (void)PROJ; (void)MIX; (void)XS; (void)ACT;
__device__ __forceinline__ void layer_body(const int l, const XcdBarrier bar, const int tid0, const int wave0, const int G, const int bid, const int NGW) {
#define MODL (MOD + (size_t)l * 8 * 6144)
for (int rep_ = 0; rep_ < REPS(4); ++rep_) if (PHMASK & 4) { LAUNDER();
        { pg8::Gemm g{(const GAS pg8::h16_t*)H, (const GAS pg8::h16_t*)(WIN_T + (size_t)l * INW * DM), NTOK, INW, DM}; pg8::StaticOrder S; S.init(NTOK, INW, G, bid);
          pg8::EpiF16 E{(GAS pg8::h16_t*)PROJ, INW};
          pg8::gemm_phase<pg8::EpiF16, pg8::StaticOrder, true, true>(Lp, g, S, E, tid); }
}
        xcd_barrier(bar);

for (int rep_ = 0; rep_ < REPS(8); ++rep_) if (PHMASK & 8) {
        for (int it_ = bid; it_ < 256 + 512 + 512 + 128; it_ += G) { int it = it_; asm volatile("" : "+s"(it));
            if ((PH3 & 1) && it < 256) {
                LAUNDER();
                const int T0 = it * 128;
                LAS f16* vT = (LAS f16*)Lp;
                constexpr int VS = 136;
                const GAS float* sng = GIN(I_SNG) + l * GW; const GAS float* snb = GIN(I_SNB) + l * GW;
                for (int t = 0; t < 16; ++t) { const int tl = wave * 16 + t; const GAS f16* pr = PROJ + (size_t)(T0 + tl) * INW + 1792 + 4 * lane;
                    const f16x4 hv = *(const GAS f16x4*)pr; float v[4]; float s = 0.f;
#pragma unroll
                    for (int i = 0; i < 4; ++i) { v[i] = gelu_erf((float)hv[i]); s += v[i]; }
                    const float mean = wave_sum(s) * (1.f / 256.f); float q = 0.f;
#pragma unroll
                    for (int i = 0; i < 4; ++i) { v[i] -= mean; q += v[i] * v[i]; }
                    const float rstd = rsqrtf(wave_sum(q) * (1.f / 256.f) + EPS);
#pragma unroll
                    for (int i = 0; i < 4; ++i) { const int c = 4 * lane + i; vT[c * VS + tl] = (f16)(v[i] * rstd * sng[c] + snb[c]); } }
                __syncthreads();
                f32x4 acc[4][4];
#pragma unroll
                for (int h = 0; h < 4; ++h)
#pragma unroll
                    for (int ct = 0; ct < 4; ++ct) acc[h][ct] = (f32x4){0.f, 0.f, 0.f, 0.f};
                const int nk = (wave >> 1) + 1, fr = lane & 15, fq = lane >> 4;
                for (int ks = 0; ks < nk; ++ks) {
#pragma unroll
                    for (int h = 0; h < 4; ++h) {
                        const f16x8 a = *(const GAS f16x8*)(SGUW + ((size_t)(l * 4 + h) * 128 + 16 * wave + fr) * 128 + 32 * ks + 8 * fq);
#pragma unroll
                        for (int ct = 0; ct < 4; ++ct) { const f16x8 b = *(const LAS f16x8*)(vT + (h * 64 + ct * 16 + fr) * VS + 32 * ks + 8 * fq);
                            acc[h][ct] = __builtin_amdgcn_mfma_f32_16x16x32_f16(a, b, acc[h][ct], 0, 0, 0); } } }
                const GAS float* sb = GIN(I_SGUB) + (size_t)l * 4 * 128;
#pragma unroll
                for (int reg = 0; reg < 4; ++reg) { const int il = 16 * wave + 4 * fq + reg; const size_t tok = (size_t)(T0 + il); float ss = 0.f; float val[4][4];
#pragma unroll
                    for (int h = 0; h < 4; ++h) { const float bia = sb[h * 128 + il];
#pragma unroll
                        for (int ct = 0; ct < 4; ++ct) { const int c = h * 64 + ct * 16 + fr; const float u = gelu_erf((float)PROJ[tok * INW + 1536 + c]);
                            const float x = (acc[h][ct][reg] + bia) * u; val[h][ct] = x; ss += x * x; } }
                    ss += __shfl_xor(ss, 1); ss += __shfl_xor(ss, 2); ss += __shfl_xor(ss, 4); ss += __shfl_xor(ss, 8);
                    const float rstd = rsqrtf(ss * (1.f / 256.f) + EPS);
#pragma unroll
                    for (int h = 0; h < 4; ++h)
#pragma unroll
                        for (int ct = 0; ct < 4; ++ct) MIX[tok * DM + 768 + h * 64 + ct * 16 + fr] = (f16)(val[h][ct] * rstd); }
                __syncthreads();
            } else if ((PH3 & 2) && it < 768) {
                LAUNDER();
                const int T0 = (it - 256) * 64, p0 = T0 & (SEQ - 1);
                LAS float* y = (LAS float*)Lp;
                for (int task = tid; task < 94 * 32; task += 512) { const int r = task >> 5, c8 = (task & 31) * 8; float o[8];
                    if (p0 - 30 + r >= 0) { const GAS f16* pr = PROJ + (size_t)(T0 - 30 + r) * INW + c8; const f16x8 a = *(const GAS f16x8*)pr, gt = *(const GAS f16x8*)(pr + 256);
#pragma unroll
                        for (int i = 0; i < 8; ++i) o[i] = (float)a[i] * sigmoidf_((float)gt[i]); }
                    else {
#pragma unroll
                        for (int i = 0; i < 8; ++i) o[i] = 0.f; }
                    *(LAS f32x4*)(y + r * 256 + c8) = (f32x4){o[0], o[1], o[2], o[3]}; *(LAS f32x4*)(y + r * 256 + c8 + 4) = (f32x4){o[4], o[5], o[6], o[7]}; }
                __syncthreads();
                float psq[8];
#pragma unroll
                for (int t = 0; t < 8; ++t) psq[t] = 0.f;
#pragma unroll 1
                for (int h = 0; h < 4; ++h) { const int c = h * 64 + lane; float w[31];
#pragma unroll
                    for (int j = 0; j < 31; ++j) w[j] = GIN(I_CONVW)[((size_t)l * 31 + j) * GW + c];
                    const float cb = GIN(I_CONVB)[l * GW + c], ng = GIN(I_CNG)[l * GW + c], nb_ = GIN(I_CNB)[l * GW + c];
#pragma unroll
                    for (int t = 0; t < 8; ++t) { const int tl = wave * 8 + t; float a = cb;
#pragma unroll
                        for (int j = 0; j < 31; ++j) a += w[j] * y[(tl + j) * 256 + c];
                        const float mean = wave_sum(a) * (1.f / 64.f); const float xc = a - mean; const float var = wave_sum(xc * xc) * (1.f / 64.f);
                        const float yn = xc * rsqrtf(var + EPS) * ng + nb_; const float sv = yn * sigmoidf_(yn);
                        psq[t] += sv * sv; MIX[(size_t)(T0 + tl) * DM + c] = (f16)sv; } }
#pragma unroll
                for (int t = 0; t < 8; ++t) psq[t] = rsqrtf(wave_sum(psq[t]) * (1.f / 256.f) + EPS);
#pragma unroll 1
                for (int h = 0; h < 4; ++h) {
#pragma unroll
                    for (int t = 0; t < 8; ++t) { GAS f16* p = MIX + (size_t)(T0 + wave * 8 + t) * DM + h * 64 + lane; *p = (f16)((float)*p * psq[t]); } }
                __syncthreads();
            } else if ((PH3 & 4) && it < 1280) {
                LAUNDER();
                const int T0 = (it - 768) * 64, p0 = T0 & (SEQ - 1);
                LAS f16* zt = (LAS f16*)Lp;
                LAS float* P = (LAS float*)(Lp + 40960);
                for (int task = tid; task < 79 * 32; task += 512) { const int r = task >> 5, c8 = (task & 31) * 8; u32x4 z = {0u, 0u, 0u, 0u};
                    if (p0 - 15 + r >= 0) z = *(const GAS u32x4*)(PROJ + (size_t)(T0 - 15 + r) * INW + 1280 + c8);
                    *(LAS u32x4*)(zt + r * 256 + c8) = z; }
                __syncthreads();
                { const int c8 = (tid & 31) * 8, seg = tid >> 5, gi = c8 >> 6, w = 2 << gi; float s[8];
#pragma unroll
                  for (int i = 0; i < 8; ++i) s[i] = 0.f;
                  for (int d = 1; d < w; ++d) { const f16x8 z = *(const LAS f16x8*)(zt + (seg * 4 + 15 - d) * 256 + c8);
#pragma unroll
                      for (int i = 0; i < 8; ++i) s[i] += (float)z[i]; }
#pragma unroll
                  for (int t = 0; t < 4; ++t) { const int tl = seg * 4 + t, p = p0 + tl;
                      const f16x8 zn = *(const LAS f16x8*)(zt + (tl + 15) * 256 + c8);
                      const float inv = 1.f / (float)(p + 1 < w ? p + 1 : w);
#pragma unroll
                      for (int i = 0; i < 8; ++i) { s[i] += (float)zn[i]; P[tl * 256 + c8 + i] = s[i] * inv - (float)zn[i]; }
                      const f16x8 zo = *(const LAS f16x8*)(zt + (tl + 15 - (w - 1)) * 256 + c8);
#pragma unroll
                      for (int i = 0; i < 8; ++i) s[i] -= (float)zo[i]; } }
                __syncthreads();
                const GAS float* Wp = GIN(I_POOLW) + (size_t)l * 16384;
                float o[8][4];
#pragma unroll
                for (int gi = 0; gi < 4; ++gi) { float a[8];
#pragma unroll
                    for (int t = 0; t < 8; ++t) a[t] = 0.f;
                    for (int c = 0; c < 64; ++c) { const float wv = Wp[(gi * 64 + c) * 64 + lane];
#pragma unroll
                        for (int t = 0; t < 8; ++t) a[t] += P[(wave * 8 + t) * 256 + gi * 64 + c] * wv; }
                    const float ps = GIN(I_POOLS)[l * GW + gi * 64 + lane];
#pragma unroll
                    for (int t = 0; t < 8; ++t) o[t][gi] = a[t] * ps; }
#pragma unroll
                for (int t = 0; t < 8; ++t) { float ss = o[t][0] * o[t][0] + o[t][1] * o[t][1] + o[t][2] * o[t][2] + o[t][3] * o[t][3];
                    const float rstd = rsqrtf(wave_sum(ss) * (1.f / 256.f) + EPS); const size_t tok = (size_t)(T0 + wave * 8 + t);
#pragma unroll
                    for (int gi = 0; gi < 4; ++gi) MIX[tok * DM + 512 + gi * 64 + lane] = (f16)(o[t][gi] * rstd); }
                __syncthreads();
            } else if (PH3 & 8) {
                LAUNDER();
                const int ib = it - 1280, T0 = ib * 256;
                LAS float* part = (LAS float*)Lp;
                const int c4 = (tid & 63) * 4, sl = tid >> 6; float s[4] = {0.f, 0.f, 0.f, 0.f};
                for (int t = 0; t < 32; ++t) { const f16x4 k4 = *(const GAS f16x4*)(PROJ + (size_t)(T0 + sl * 32 + t) * INW + 768 + c4);
#pragma unroll
                    for (int i = 0; i < 4; ++i) s[i] += (float)k4[i]; }
#pragma unroll
                for (int i = 0; i < 4; ++i) part[sl * 256 + c4 + i] = s[i];
                __syncthreads();
                if (tid < 256) { float a = 0.f;
#pragma unroll
                    for (int w = 0; w < 8; ++w) a += part[w * 256 + tid];
                    KMEAN[(size_t)ib * 256 + tid] = a * (1.f / 256.f); }
                __syncthreads();
            }
        }
}
        xcd_barrier(bar);

for (int rep_ = 0; rep_ < REPS(16); ++rep_) if (PHMASK & 16) { LAUNDER();
        {
            LAS f16* Kt = (LAS f16*)Lp;
            LAS f16* VT = (LAS f16*)(Lp + 9216);
            LAS float* kml = (LAS float*)(Lp + 18432);
            LAS float* lut = (LAS float*)(Lp + 18432 + 4096);
            constexpr int KS = 72, VSTR = 68;
            constexpr float LOG2E = 1.4426950408889634f, SC2 = 0.125f * LOG2E;
            const int r32 = lane & 31, hh = lane >> 5;
            for (int pi = bid; pi < 256; pi += G) {
                const int bh = pi >> 3, pp = pi & 7;
                for (int half = 0; half < 2; ++half) {
                    const int own = half == 0 ? 15 - pp : pp;
                    const int b = bh >> 2, h = bh & 3;
                    const size_t TB = (size_t)b * SEQ;
                    const int qpos = own * 256 + 32 * wave + r32;
                    __syncthreads();
                    for (int i = tid; i < 1024; i += 512) kml[i] = KMEAN[((size_t)(b * 16 + (i >> 6))) * 256 + h * 64 + (i & 63)];
                    if (tid < 128) lut[tid] = GIN(I_RELB)[t5_bucket(tid) * 4 + h] * LOG2E;
                    f16x8 qf[4];
                    { const GAS f16* qp = PROJ + (TB + qpos) * INW + 512 + h * 64 + 8 * hh;
#pragma unroll
                      for (int s = 0; s < 4; ++s) qf[s] = *(const GAS f16x8*)(qp + 16 * s); }
                    __syncthreads();
                    unsigned mask = 0u;
                    { float gsc[16];
#pragma unroll
                      for (int n = 0; n < 16; ++n) { float a = 0.f;
                          if (n < own) {
#pragma unroll
                              for (int s = 0; s < 4; ++s)
#pragma unroll
                                  for (int j = 0; j < 8; ++j) a += (float)qf[s][j] * kml[n * 64 + 16 * s + 8 * hh + j]; }
                          a += __shfl_xor(a, 32); gsc[n] = a; }
#pragma unroll
                      for (int k = 0; k < 3; ++k) { float best = -INFINITY; int bi = -1;
#pragma unroll
                          for (int n = 0; n < 16; ++n) { const bool ok = (n < own) && !((mask >> n) & 1u) && (gsc[n] > best); if (ok) { best = gsc[n]; bi = n; } }
                          if (bi >= 0) mask |= 1u << bi; } }
                    f32x16 o0, o1;
#pragma unroll
                    for (int i = 0; i < 16; ++i) { o0[i] = 0.f; o1[i] = 0.f; }
                    float mrun = -INFINITY, lrun = 0.f;
                    const int ntile = own * 4 + 4;
                    const int lk = tid >> 3, lc = tid & 7;
                    f16x8 kreg, vreg;
                    { const GAS f16* kp = PROJ + (TB + lk) * INW + 768 + h * 64 + 8 * lc; kreg = *(const GAS f16x8*)kp; vreg = *(const GAS f16x8*)(kp + 256); }
                    for (int j = 0; j < ntile; ++j) {
                        __syncthreads();
                        *(LAS f16x8*)(Kt + lk * KS + 8 * lc) = kreg;
#pragma unroll
                        for (int i = 0; i < 8; ++i) VT[(8 * lc + i) * VSTR + lk] = vreg[i];
                        __syncthreads();
                        if (j + 1 < ntile) { const GAS f16* kp = PROJ + (TB + (size_t)(j + 1) * 64 + lk) * INW + 768 + h * 64 + 8 * lc; kreg = *(const GAS f16x8*)kp; vreg = *(const GAS f16x8*)(kp + 256); }
                        const int n = j >> 2, kbase = j * 64;
                        bool active; bool sel;
                        if (n < own) { sel = (mask >> n) & 1u; active = __any(sel); }
                        else { sel = true; active = (kbase <= own * 256 + 32 * wave + 31); }
                        if (active) {
                            f32x16 p0, p1;
#pragma unroll
                            for (int i = 0; i < 16; ++i) { p0[i] = 0.f; p1[i] = 0.f; }
#pragma unroll
                            for (int s = 0; s < 4; ++s) { const f16x8 a0 = *(const LAS f16x8*)(Kt + r32 * KS + 16 * s + 8 * hh), a1 = *(const LAS f16x8*)(Kt + (32 + r32) * KS + 16 * s + 8 * hh);
                                p0 = __builtin_amdgcn_mfma_f32_32x32x16_f16(a0, qf[s], p0, 0, 0, 0); p1 = __builtin_amdgcn_mfma_f32_32x32x16_f16(a1, qf[s], p1, 0, 0, 0); }
                            const int dmin = own * 256 + 32 * wave - (kbase + 63);
                            float mx = -INFINITY;
                            if (dmin >= 127) { const float bc = lut[127];
#pragma unroll
                                for (int i = 0; i < 16; ++i) { p0[i] = sel ? p0[i] * SC2 + bc : -INFINITY; p1[i] = sel ? p1[i] * SC2 + bc : -INFINITY; mx = fmaxf(mx, fmaxf(p0[i], p1[i])); } }
                            else {
#pragma unroll
                                for (int i = 0; i < 16; ++i) { const int kr = (i & 3) + 8 * (i >> 2) + 4 * hh; const int d0 = qpos - (kbase + kr), d1 = d0 - 32;
                                    p0[i] = (sel && d0 >= 0) ? p0[i] * SC2 + lut[d0 > 127 ? 127 : d0] : -INFINITY;
                                    p1[i] = (sel && d1 >= 0) ? p1[i] * SC2 + lut[d1 > 127 ? 127 : (d1 < 0 ? 0 : d1)] : -INFINITY;
                                    mx = fmaxf(mx, fmaxf(p0[i], p1[i])); } }
                            mx = fmaxf(mx, __shfl_xor(mx, 32));
                            const float mnew = fmaxf(mrun, mx), msafe = (mnew == -INFINITY) ? 0.f : mnew;
                            const float alpha = exp2f(mrun - msafe);
                            float ps = 0.f;
#pragma unroll
                            for (int i = 0; i < 16; ++i) { p0[i] = exp2f(p0[i] - msafe); p1[i] = exp2f(p1[i] - msafe); ps += p0[i] + p1[i]; }
                            lrun = lrun * alpha + ps; mrun = mnew;
#pragma unroll
                            for (int i = 0; i < 16; ++i) { o0[i] *= alpha; o1[i] *= alpha; }
                            f16x8 pb[4];
#pragma unroll
                            for (int i = 0; i < 8; ++i) { pb[0][i] = (f16)p0[i]; pb[1][i] = (f16)p0[8 + i]; pb[2][i] = (f16)p1[i]; pb[3][i] = (f16)p1[8 + i]; }
#pragma unroll
                            for (int kk = 0; kk < 4; ++kk) {
                                const f16x4 a0l = *(const LAS f16x4*)(VT + r32 * VSTR + 16 * kk + 4 * hh), a0h = *(const LAS f16x4*)(VT + r32 * VSTR + 16 * kk + 8 + 4 * hh);
                                const f16x4 a1l = *(const LAS f16x4*)(VT + (32 + r32) * VSTR + 16 * kk + 4 * hh), a1h = *(const LAS f16x4*)(VT + (32 + r32) * VSTR + 16 * kk + 8 + 4 * hh);
                                const f16x8 av0 = {a0l[0], a0l[1], a0l[2], a0l[3], a0h[0], a0h[1], a0h[2], a0h[3]};
                                const f16x8 av1 = {a1l[0], a1l[1], a1l[2], a1l[3], a1h[0], a1h[1], a1h[2], a1h[3]};
                                o0 = __builtin_amdgcn_mfma_f32_32x32x16_f16(av0, pb[kk], o0, 0, 0, 0);
                                o1 = __builtin_amdgcn_mfma_f32_32x32x16_f16(av1, pb[kk], o1, 0, 0, 0); }
                        }
                    }
                    const float ltot = lrun + __shfl_xor(lrun, 32), inv = 1.f / ltot;
                    GAS f16* op = MIX + (TB + qpos) * DM + 256 + h * 64;
#pragma unroll
                    for (int g4 = 0; g4 < 4; ++g4) { const int d0 = 8 * g4 + 4 * hh;
                        u32x2 w0, w1; w0.x = pk_f16(o0[4 * g4] * inv, o0[4 * g4 + 1] * inv); w0.y = pk_f16(o0[4 * g4 + 2] * inv, o0[4 * g4 + 3] * inv);
                        w1.x = pk_f16(o1[4 * g4] * inv, o1[4 * g4 + 1] * inv); w1.y = pk_f16(o1[4 * g4 + 2] * inv, o1[4 * g4 + 3] * inv);
                        *(GAS u32x2*)(op + d0) = w0; *(GAS u32x2*)(op + 32 + d0) = w1; }
                }
            }
        }
}
        xcd_barrier(bar);

for (int rep_ = 0; rep_ < REPS(32); ++rep_) if (PHMASK & 32) { LAUNDER();
        for (int m = gw; m < NTOK; m += NGW) { GAS f16* p = MIX + (size_t)m * DM + 256 + 4 * lane; const f16x4 v = *(const GAS f16x4*)p;
            float f[4], ss = 0.f;
#pragma unroll
            for (int i = 0; i < 4; ++i) { f[i] = (float)v[i]; ss += f[i] * f[i]; }
            const float rstd = rsqrtf(wave_sum(ss) * (1.f / 256.f) + EPS);
            u32x2 w; w.x = pk_f16(f[0] * rstd, f[1] * rstd); w.y = pk_f16(f[2] * rstd, f[3] * rstd); *(GAS u32x2*)p = w; }
}
        xcd_barrier(bar);

if (PHMASK & 64) { LAUNDER();
        { pg8::Gemm g{(const GAS pg8::h16_t*)MIX, (const GAS pg8::h16_t*)(WOUT_T + (size_t)l * DM * DM), NTOK, DM, DM}; pg8::StaticOrder S; S.init(NTOK, DM, G, bid);
          pg8::EpiResid E{l == 0 ? GIN(I_X) : X, X, MODL + 2048};
          pg8::gemm_phase<pg8::EpiResid, pg8::StaticOrder, true, true>(Lp, g, S, E, tid); }
}
        xcd_barrier(bar);

if (PHMASK & 128) { LAUNDER();
        {
            LAS float* WT = (LAS float*)Lp;
            constexpr int WS_ = 1028;
            LAS int* sel_e = (LAS int*)(Lp + 131584);
            LAS int* rank_ = (LAS int*)(Lp + 131584 + 2048);
            LAS int* lcnt = (LAS int*)(Lp + 131584 + 4096);
            LAS int* lbase = (LAS int*)(Lp + 131584 + 4096 + 128);
            const GAS float* rw = GIN(I_RW) + (size_t)l * DM * NEXP;
            for (int e = 0; e < 32; ++e) { WT[e * WS_ + tid] = rw[(size_t)tid * 32 + e]; WT[e * WS_ + 512 + tid] = rw[(size_t)(512 + tid) * 32 + e]; }
            GAS unsigned* gcnt = ctl + CW_CNT + l * 32 * 64;
            for (int ch = bid; ch < NTOK / 128; ch += G) {
                if (tid < 32) lcnt[tid] = 0;
                __syncthreads();
                const int b = (ch * 128) >> 12; const GAS float* md = MODL + (size_t)b * 6144;
                const GAS float* g2 = GIN(I_N2G) + l * DM;
                for (int pass = 0; pass < 8; ++pass) {
                    const int tl0 = wave * 16 + pass * 2; const size_t tok0 = (size_t)ch * 128 + tl0;
                    float hv[2][16];
#pragma unroll
                    for (int r = 0; r < 2; ++r) { const GAS float* xr = X + (tok0 + r) * DM; f32x4 v[4]; float s = 0.f;
#pragma unroll
                        for (int j = 0; j < 4; ++j) { v[j] = *(const GAS f32x4*)(xr + 4 * lane + 256 * j); s += (v[j].x * v[j].x + v[j].y * v[j].y) + (v[j].z * v[j].z + v[j].w * v[j].w); }
                        const float rstd = rsqrtf(wave_sum(s) * (1.f / DM) + EPS);
#pragma unroll
                        for (int j = 0; j < 4; ++j) { const int c = 4 * lane + 256 * j; const f32x4 gg = *(const GAS f32x4*)(g2 + c), sh = *(const GAS f32x4*)(md + 3072 + c), sc = *(const GAS f32x4*)(md + 4096 + c);
                            const f32x4 hq = (v[j] * rstd) * gg * (sc + 1.0f) + sh;
                            hv[r][4 * j] = hq.x; hv[r][4 * j + 1] = hq.y; hv[r][4 * j + 2] = hq.z; hv[r][4 * j + 3] = hq.w;
                            u32x2 w; w.x = pk_f16(hq.x, hq.y); w.y = pk_f16(hq.z, hq.w); *(GAS u32x2*)(H + (tok0 + r) * DM + c) = w; } }
                    float a0[32], a1[32];
#pragma unroll
                    for (int e = 0; e < 32; ++e) { float s0 = 0.f, s1 = 0.f;
#pragma unroll
                        for (int j = 0; j < 4; ++j) { const f32x4 w = *(const LAS f32x4*)(WT + e * WS_ + 4 * lane + 256 * j);
                            s0 += hv[0][4 * j] * w.x + hv[0][4 * j + 1] * w.y + hv[0][4 * j + 2] * w.z + hv[0][4 * j + 3] * w.w;
                            s1 += hv[1][4 * j] * w.x + hv[1][4 * j + 1] * w.y + hv[1][4 * j + 2] * w.z + hv[1][4 * j + 3] * w.w; }
                        a0[e] = s0; a1[e] = s1; }
                    float t1[32];
                    { const bool up = (lane & 32) != 0;
#pragma unroll
                      for (int e = 0; e < 32; ++e) { const float snd = up ? a0[e] : a1[e], kp = up ? a1[e] : a0[e]; t1[e] = kp + __shfl_xor(snd, 32); } }
                    float t2[16];
                    { const bool up = (lane & 16) != 0;
#pragma unroll
                      for (int e = 0; e < 16; ++e) { const float snd = up ? t1[e] : t1[e + 16], kp = up ? t1[e + 16] : t1[e]; t2[e] = kp + __shfl_xor(snd, 16); } }
                    float t3[8];
                    { const bool up = (lane & 8) != 0;
#pragma unroll
                      for (int e = 0; e < 8; ++e) { const float snd = up ? t2[e] : t2[e + 8], kp = up ? t2[e + 8] : t2[e]; t3[e] = kp + __shfl_xor(snd, 8); } }
                    float t4[4];
                    { const bool up = (lane & 4) != 0;
#pragma unroll
                      for (int e = 0; e < 4; ++e) { const float snd = up ? t3[e] : t3[e + 4], kp = up ? t3[e + 4] : t3[e]; t4[e] = kp + __shfl_xor(snd, 4); } }
                    float t5[2];
                    { const bool up = (lane & 2) != 0;
#pragma unroll
                      for (int e = 0; e < 2; ++e) { const float snd = up ? t4[e] : t4[e + 2], kp = up ? t4[e + 2] : t4[e]; t5[e] = kp + __shfl_xor(snd, 2); } }
                    float logit;
                    { const bool up = (lane & 1) != 0; const float snd = up ? t5[0] : t5[1], kp = up ? t5[1] : t5[0]; logit = kp + __shfl_xor(snd, 1); }
                    const int mye = lane & 31;
                    logit += GIN(I_RB)[l * NEXP + mye];
                    float topv[4]; int topi[4]; float myv = logit;
#pragma unroll
                    for (int k = 0; k < 4; ++k) { float bv = myv; int bi = mye;
#pragma unroll
                        for (int off = 1; off < 32; off <<= 1) { const float ov = __shfl_xor(bv, off); const int oi = __shfl_xor(bi, off); if (ov > bv || (ov == bv && oi < bi)) { bv = ov; bi = oi; } }
                        topv[k] = bv; topi[k] = bi; if (mye == bi) myv = -INFINITY; }
                    if (mye == 0) { const int tl = tl0 + (lane >> 5); const size_t tok = (size_t)ch * 128 + tl;
                        const float e1 = __expf(topv[1] - topv[0]), e2 = __expf(topv[2] - topv[0]), e3 = __expf(topv[3] - topv[0]); const float inv = 1.f / (1.f + e1 + e2 + e3);
                        *(GAS f32x4*)(ROUTE_G + tok * 4) = (f32x4){inv, e1 * inv, e2 * inv, e3 * inv};
#pragma unroll
                        for (int k = 0; k < 4; ++k) sel_e[tl * 4 + k] = topi[k]; }
                }
                __syncthreads();
                const int e = sel_e[tid];
                rank_[tid] = __hip_atomic_fetch_add(&lcnt[e], 1, __ATOMIC_RELAXED, __HIP_MEMORY_SCOPE_WORKGROUP);
                __syncthreads();
                if (tid < 32) lbase[tid] = (int)__hip_atomic_fetch_add(gcnt + tid * 64, (unsigned)lcnt[tid], __ATOMIC_RELAXED, __HIP_MEMORY_SCOPE_AGENT);
                __syncthreads();
                { const int pos = lbase[e] + rank_[tid]; const size_t tok = (size_t)ch * 128 + (tid >> 2);
                  LIST[(size_t)e * LISTCAP + pos] = (int)tok; ROUTE_E[tok * 4 + (tid & 3)] = e; ROUTE_POS[tok * 4 + (tid & 3)] = pos; }
                __syncthreads();
            }
        }
}
        xcd_barrier(bar);

#define cnts ((LAS int*)(Lp + RING_BYTES + 1024))
#define mbase ((LAS int*)(Lp + RING_BYTES + 1024 + 256))
        { LAUNDER(); GAS unsigned* gcnt = ctl + CW_CNT + l * 32 * 64;
          if (tid < 32) cnts[tid] = (int)__hip_atomic_load(gcnt + tid * 64, __ATOMIC_RELAXED, __HIP_MEMORY_SCOPE_AGENT);
          __syncthreads();
          if (tid == 0) { int a = 0; for (int e = 0; e < 32; ++e) { mbase[e] = a; a += (cnts[e] + 255) >> 8; } mbase[32] = a; }
          __syncthreads(); }

for (int rep_ = 0; rep_ < REPS(256); ++rep_) if (PHMASK & 256) { LAUNDER(); const int MT = mbase[32];
        for (int r = gw; r < MT * 256; r += NGW) { const int mt = r >> 8; int e = 0;
#pragma unroll
            for (int q = 1; q < 32; ++q) e += (mbase[q] <= mt) ? 1 : 0;
            const int ri = r - mbase[e] * 256; u32x4 v0 = {0u, 0u, 0u, 0u}, v1 = {0u, 0u, 0u, 0u};
            if (ri < cnts[e]) { const int tok = LIST[(size_t)e * LISTCAP + ri]; const GAS f16* src = H + (size_t)tok * DM; v0 = *(const GAS u32x4*)(src + 8 * lane); v1 = *(const GAS u32x4*)(src + 512 + 8 * lane); }
            GAS f16* dst = XS + (size_t)r * DM; *(GAS u32x4*)(dst + 8 * lane) = v0; *(GAS u32x4*)(dst + 512 + 8 * lane) = v1; }
}
        xcd_barrier(bar);

        for (int ph = 0; ph < 2; ++ph) {
            if (!(PHMASK & (512 << ph))) continue;
            for (int rep_ = 0; rep_ < REPS(512 << ph); ++rep_) {
            LAUNDER(); const int MT = mbase[32]; LAS int* ulist = (LAS int*)(Lp + RING_BYTES); const int NT = ph == 0 ? 8 : 4, U = MT * NT;
            __syncthreads();
            int nu = 0;
            { const int q = U / 8, rr = U % 8, nig = 8 * NT;
              for (int i = 0; i < 64; ++i) { const long Lid = (long)i * G + bid; if (Lid >= U) break; ++nu;
                  if (tid == i) { int wg = (int)Lid; const int xcd = wg % 8, off = wg / 8; wg = (xcd < rr ? xcd * (q + 1) : rr * (q + 1) + (xcd - rr) * q) + off;
                      const int gid = wg / nig, fm = gid * 8, gsz = (MT - fm) < 8 ? (MT - fm) : 8; const int pm = fm + ((wg % nig) % gsz), pn = (wg % nig) / gsz;
                      int e = 0;
                      for (int qq = 1; qq < 32; ++qq) e += (mbase[qq] <= pm) ? 1 : 0;
                      ulist[i] = pm | ((e * NT + pn) << 16); } } }
            __syncthreads();
            pg8::ListOrder S{ulist, nu};
            if (ph == 0) { pg8::Gemm g{(const GAS pg8::h16_t*)XS, (const GAS pg8::h16_t*)(W1_T + (size_t)l * NEXP * 2048 * DM), PROWS, 2048, DM};
                pg8::EpiSwiglu E{(GAS pg8::h16_t*)ACT, GIN(I_B1) + (size_t)l * NEXP * 2048};
                pg8::gemm_phase<pg8::EpiSwiglu, pg8::ListOrder, true, true>(Lp, g, S, E, tid); }
            else { pg8::Gemm g{(const GAS pg8::h16_t*)ACT, (const GAS pg8::h16_t*)(W2_T + (size_t)l * NEXP * DM * DM), PROWS, 1024, DM};
                pg8::EpiDown E{(GAS pg8::h16_t*)XS, GIN(I_B2) + (size_t)l * NEXP * DM};
                pg8::gemm_phase<pg8::EpiDown, pg8::ListOrder, true, true>(Lp, g, S, E, tid); }
            }
            xcd_barrier(bar);
        }

if (PHMASK & 2048) { LAUNDER();
        for (int m = gw; m < NTOK; m += NGW) {
            const int b = m >> 12; const GAS float* md = MODL + (size_t)b * 6144;
            const GAS f16* yr[4]; float gk[4];
#pragma unroll
            for (int k = 0; k < 4; ++k) { const int e = ROUTE_E[(size_t)m * 4 + k], pos = ROUTE_POS[(size_t)m * 4 + k]; gk[k] = ROUTE_G[(size_t)m * 4 + k]; yr[k] = XS + ((size_t)mbase[e] * 256 + pos) * DM; }
            f32x4 v[4]; float s = 0.f;
#pragma unroll
            for (int j = 0; j < 4; ++j) { const int c = 4 * lane + 256 * j; f32x4 a = {0.f, 0.f, 0.f, 0.f};
#pragma unroll
                for (int k = 0; k < 4; ++k) { const f16x4 y4 = *(const GAS f16x4*)(yr[k] + c); a.x += gk[k] * (float)y4[0]; a.y += gk[k] * (float)y4[1]; a.z += gk[k] * (float)y4[2]; a.w += gk[k] * (float)y4[3]; }
                const f32x4 x1 = *(const GAS f32x4*)(X + (size_t)m * DM + c), g2 = *(const GAS f32x4*)(md + 5120 + c);
                v[j] = x1 + g2 * a; s += (v[j].x * v[j].x + v[j].y * v[j].y) + (v[j].z * v[j].z + v[j].w * v[j].w); }
            const float rstd = rsqrtf(wave_sum(s) * (1.f / DM) + EPS);
            if (l + 1 < DEPTH) {
                const GAS float* mdn = MOD + (size_t)((l + 1) * 8 + b) * 6144; const GAS float* g1 = GIN(I_N1G) + (l + 1) * DM;
#pragma unroll
                for (int j = 0; j < 4; ++j) { const int c = 4 * lane + 256 * j; *(GAS f32x4*)(X + (size_t)m * DM + c) = v[j];
                    const f32x4 gg = *(const GAS f32x4*)(g1 + c), sh = *(const GAS f32x4*)(mdn + c), sc = *(const GAS f32x4*)(mdn + 1024 + c);
                    const f32x4 hq = (v[j] * rstd) * gg * (sc + 1.0f) + sh; u32x2 w; w.x = pk_f16(hq.x, hq.y); w.y = pk_f16(hq.z, hq.w); *(GAS u32x2*)(H + (size_t)m * DM + c) = w; }
            } else {
#pragma unroll
                for (int j = 0; j < 4; ++j) { const int c = 4 * lane + 256 * j; const f32x4 gg = *(const GAS f32x4*)(GIN(I_FNG) + c); *(GAS f32x4*)(((GAS float*)AP->out) + (size_t)m * DM + c) = (v[j] * rstd) * gg; }
            }
        }
}
        if (l + 1 < DEPTH) xcd_barrier(bar);
}

__global__ void __launch_bounds__(NWAVES * 64, 2) fwd_megakernel(Args args) {
    const int tid0 = threadIdx.x, wave0 = __builtin_amdgcn_readfirstlane(tid0 >> 6);
    const int G = gridDim.x, bid = blockIdx.x;
    const int NGW = G * NWAVES;
    LAS unsigned char* L = (LAS unsigned char*)lds;

    if (tid0 < 16) ((LAS unsigned*)(L + BARST_OFF))[tid0] = 0u;
    __syncthreads();
    XcdBarrier bar = xcd_barrier_post((unsigned*)(args.ws + WS_CTL) + CW_BAR, (volatile LAS unsigned*)(L + BARST_OFF));

for (int rep_ = 0; rep_ < REPS(1); ++rep_) if (PHMASK & 1) { LAUNDER(); __syncthreads();
    {
        LAS float* cond = (LAS float*)Lp;
        LAS float* red = (LAS float*)(Lp + 32768);
        bool cond_ready = false;
        for (int it = bid; it < 192; it += G) {
            if (!cond_ready) { for (int i = tid; i < NB * DM; i += 512) { const float v = GIN(I_C)[i]; cond[i] = v * sigmoidf_(v); } __syncthreads(); cond_ready = true; }
            const int l = it / 96, n0 = (it % 96) * 64;
            const GAS float* wm = GIN(I_WMOD) + (size_t)l * DM * 6144 + n0 + lane;
            float a[8];
#pragma unroll
            for (int b = 0; b < 8; ++b) a[b] = 0.f;
            for (int k = wave * 128; k < wave * 128 + 128; ++k) { const float w = wm[(size_t)k * 6144];
#pragma unroll
                for (int b = 0; b < 8; ++b) a[b] += cond[b * DM + k] * w; }
#pragma unroll
            for (int b = 0; b < 8; ++b) red[(wave * 8 + b) * 64 + lane] = a[b];
            __syncthreads();
            { const int b = tid >> 6; float s = GIN(I_BMOD)[l * 6144 + n0 + lane];
#pragma unroll
              for (int w = 0; w < 8; ++w) s += red[(w * 8 + b) * 64 + lane];
              MOD[(size_t)(l * 8 + b) * 6144 + n0 + lane] = s; }
            __syncthreads();
        }
        __syncthreads();
        LAS float* scr = (LAS float*)(Lp + wave * 16384);
        constexpr int PER_L = 1024 + 512 + 32768 + 16384;
        for (int it = gw; it < DEPTH * PER_L; it += NGW) {
            const int l = it / PER_L; int r = it % PER_L;
            if (r < 1024) { const int kb = r >> 6, nb = r & 63; transpose_item(GIN(I_WIN) + (size_t)l * DM * INW, DM, INW, WIN_T + (size_t)l * INW * DM, 32 * nb, 64 * kb, 32 * nb, nullptr, scr, lane); continue; } r -= 1024;
            if (r < 512) { const int kb = r >> 5, nb = r & 31; transpose_item(GIN(I_WOUT) + (size_t)l * DM * DM, DM, DM, WOUT_T + (size_t)l * DM * DM, 32 * nb, 64 * kb, 32 * nb, GIN(I_MIXG) + l * DM, scr, lane); continue; } r -= 512;
            if (r < 32768) { const int e = r >> 10, q = r & 1023, kb = q >> 6, nb = q & 63, n0 = 32 * nb;
                const int bj = n0 >> 10, jj = n0 & 1023, orow = (jj >> 7) * 256 + bj * 128 + (jj & 127);
                transpose_item(GIN(I_W1) + ((size_t)l * NEXP + e) * DM * 2048, DM, 2048, W1_T + ((size_t)l * NEXP + e) * 2048 * DM, orow, 64 * kb, n0, nullptr, scr, lane); continue; } r -= 32768;
            { const int e = r >> 9, q = r & 511, kb = q >> 5, nb = q & 31;
                transpose_item(GIN(I_W2) + ((size_t)l * NEXP + e) * DM * DM, DM, DM, W2_T + ((size_t)l * NEXP + e) * DM * DM, 32 * nb, 64 * kb, 32 * nb, nullptr, scr, lane); }
        }
        for (int i = bid * 512 + tid; i < DEPTH * 4 * 128 * 128; i += G * 512) { const int jj = i & 127, ii = (i >> 7) & 127; SGUW[i] = (f16)(jj <= ii ? GIN(I_SGUW)[i] : 0.f); }
    }
}
    xcd_barrier(bar);

for (int rep_ = 0; rep_ < REPS(2); ++rep_) if (PHMASK & 2) { LAUNDER();
    for (int m = gw; m < NTOK; m += NGW) { const int b = m >> 12; const GAS float* md = MOD + (size_t)b * 6144;
        norm_mod_row(GIN(I_X) + (size_t)m * DM, GIN(I_N1G), md, md + 1024, H + (size_t)m * DM, lane); }
}
    xcd_barrier(bar);

    layer_body(0, bar, tid0, wave0, G, bid, NGW);
    layer_body(1, bar, tid0, wave0, G, bid, NGW);
}


extern "C" void kernel_launch(void* const* d_in, const int* in_sizes, int n_in, void* d_out, int out_size, void* d_ws, size_t ws_size, hipStream_t stream) {
    static int grid = 0;
    if (grid == 0) {
        if (n_in != 27 || out_size != NTOK * DM || ws_size < WS_END) { fprintf(stderr, "kernel_launch: unexpected shapes (n_in %d, out %d, ws %zu)\n", n_in, out_size, ws_size); grid = -1; return; }
        int dev = 0, cus = 0, per_cu = 0;
        if (hipGetDevice(&dev) != hipSuccess || hipDeviceGetAttribute(&cus, hipDeviceAttributeMultiprocessorCount, dev) != hipSuccess) { grid = -1; return; }
        if (hipFuncSetAttribute((const void*)fwd_megakernel, hipFuncAttributeMaxDynamicSharedMemorySize, LDS_BYTES) != hipSuccess) { fprintf(stderr, "kernel_launch: hipFuncSetAttribute failed\n"); grid = -1; return; }
        if (hipOccupancyMaxActiveBlocksPerMultiprocessor(&per_cu, (const void*)fwd_megakernel, NWAVES * 64, LDS_BYTES) != hipSuccess || per_cu < 1) { fprintf(stderr, "kernel_launch: occupancy query says %d blocks per CU\n", per_cu); (void)hipGetLastError(); grid = -1; return; }
        grid = cus;
    }
    if (grid < 0) return;
    (void)hipMemsetAsync((char*)d_ws + WS_CTL, 0, CTL_ZERO_BYTES, stream);
    Args a{};
    for (int i = 0; i < 27; ++i) a.in[i] = (const float*)d_in[i];
    a.out = (float*)d_out; a.ws = (unsigned char*)d_ws;
    hipLaunchKernelGGL(fwd_megakernel, dim3(grid), dim3(NWAVES * 64), LDS_BYTES, stream, a);
}
```

```cpp
#include <hip/hip_runtime.h>
#include <cstdio>
#include <cstdint>

#define LAS __attribute__((address_space(3)))
#define GAS __attribute__((address_space(1)))
#define CAS __attribute__((address_space(4)))
typedef _Float16 f16;
typedef _Float16 f16x8 __attribute__((ext_vector_type(8)));
typedef _Float16 f16x4 __attribute__((ext_vector_type(4)));
typedef _Float16 f16x2 __attribute__((ext_vector_type(2)));
typedef float f32x2 __attribute__((ext_vector_type(2)));
typedef float f32x4 __attribute__((ext_vector_type(4)));
typedef float f32x16 __attribute__((ext_vector_type(16)));
typedef unsigned u32x2 __attribute__((ext_vector_type(2)));
typedef unsigned u32x4 __attribute__((ext_vector_type(4)));

constexpr int DM = 1024, NB = 8, SEQ = 4096, NTOK = NB * SEQ, DEPTH = 2, GW = 256, INW = 2048;
constexpr int NEXP = 32, TOPK = 4;
constexpr int PROWS = NTOK * TOPK + NEXP * 256;
constexpr float EPS = 1e-6f;
constexpr int LISTCAP = NTOK;

__device__ __forceinline__ unsigned pk_f16(float lo, float hi) { f32x2 v = {lo, hi}; f16x2 h = __builtin_convertvector(v, f16x2); return __builtin_bit_cast(unsigned, h); }
__device__ __forceinline__ float wave_sum(float v) {
#pragma unroll
    for (int o = 1; o < 64; o <<= 1) v += __shfl_xor(v, o);
    return v;
}
__device__ __forceinline__ float sigmoidf_(float x) { return 1.f / (1.f + __expf(-x)); }
__device__ __forceinline__ float gelu_erf(float v) {
    const float av = fabsf(v), d = av * 0.2316418882f + 1.0f, t = __builtin_amdgcn_rcpf(d);
    float q = t * 0.5307027145f + (-0.7265760135f); q = q * t + 0.7107068705f; q = q * t + (-0.142248368f); q = q * t + 0.127414796f; q = q * t;
    const float e = __builtin_amdgcn_exp2f((v * v) * (-0.72134752044f));
    const float m = v * (q * e);
    return v < 0.f ? m : v - m;
}

namespace pg8 {
#define PG8_LAS __attribute__((address_space(3)))
typedef unsigned short h16_t;
constexpr int BM = 256, BK = 64, HALF = 128, HTB = HALF * BK * 2, STAGE_BYTES = 8 * HTB, NXCD = 8, WGM = 8;

__host__ __device__ __forceinline__ int lds_byte(int r, int c) { const int st = (r >> 4) * 2 + (c >> 5), rr = r & 15, cc = c & 31, ob = rr * 64 + cc * 2; return st * 1024 + (ob ^ (((ob >> 9) & 1) << 5)); }
__host__ __device__ __forceinline__ void stage_rc(int b, int& R, int& C) { const int st = b / 1024, sb = b % 1024, swz = sb ^ (((sb >> 9) & 1) << 5); R = (st >> 1) * 16 + swz / 64; C = (st & 1) * 32 + (swz % 64) / 2; }
__host__ __device__ __forceinline__ int perm32(int rho) { const int n = rho >> 4, i = rho & 15; return 8 * (i >> 2) + 4 * n + (i & 3); }

struct Unit { int pm, pn; };
struct Gemm { const GAS h16_t* A; const GAS h16_t* Bt; int M, N, K; const GAS int* rl; };

struct StaticOrder {
    int nM, nN, nwg, G, c;
    __host__ __device__ void init(int M, int N, int G_, int c_) { nM = M / BM; nN = N / BM; nwg = nM * nN; G = G_; c = c_; }
    __host__ __device__ bool next(int i, Unit& u) const {
        const long L = (long)i * G + c; if (L >= nwg) return false;
        int wgid = (int)L; { const int q = nwg / NXCD, r = nwg % NXCD, xcd = wgid % NXCD, off = wgid / NXCD; wgid = (xcd < r ? xcd * (q + 1) : r * (q + 1) + (xcd - r) * q) + off; }
        const int nig = WGM * nN, gid = wgid / nig, fm = gid * WGM, gsz = (nM - fm) < WGM ? (nM - fm) : WGM;
        u.pm = fm + ((wgid % nig) % gsz); u.pn = (wgid % nig) / gsz; return true;
    }
    __device__ __forceinline__ void a_ready(const Unit&) const {}
    __device__ __forceinline__ void done(const Unit&) const {}
    __device__ __forceinline__ void rows(int, int& r0, int& cnt) const { r0 = 0; cnt = 1; }
};
struct ListOrder {
    const PG8_LAS int* list; int n;
    __device__ __forceinline__ bool next(int i, Unit& u) const { if (i >= n) return false; const int v = __builtin_amdgcn_readfirstlane(list[3 * i]); u.pm = v & 0xffff; u.pn = v >> 16; return true; }
    __device__ __forceinline__ void rows(int i, int& r0, int& cnt) const { r0 = __builtin_amdgcn_readfirstlane(list[3 * i + 1]); cnt = __builtin_amdgcn_readfirstlane(list[3 * i + 2]); }
    __device__ __forceinline__ void a_ready(const Unit&) const {}
    __device__ __forceinline__ void done(const Unit&) const {}
};

struct EpiF16 {
    static constexpr bool PERM = true, AFTER_DRAIN = false;
    GAS h16_t* O; int ldc;
    __device__ __forceinline__ void operator()(const f32x4 (&acc)[2][2][4][2], const Unit& u, int wr, int wc, int fr, int fq) const {
        const int row0 = u.pm * BM + wr * 64 + fr, col0 = u.pn * BM + wc * 32 + 8 * fq;
#pragma unroll
        for (int ai = 0; ai < 2; ++ai)
#pragma unroll
            for (int m = 0; m < 4; ++m) { GAS h16_t* rowp = O + (size_t)(row0 + ai * HALF + m * 16) * ldc + col0;
#pragma unroll
                for (int bj = 0; bj < 2; ++bj) { const f32x4 v0 = acc[ai][bj][m][0], v1 = acc[ai][bj][m][1];
                    u32x4 w; w.x = pk_f16(v0[0], v0[1]); w.y = pk_f16(v0[2], v0[3]); w.z = pk_f16(v1[0], v1[1]); w.w = pk_f16(v1[2], v1[3]);
                    *(GAS u32x4*)(rowp + bj * HALF) = w; } }
    }
};
struct EpiResid {
    static constexpr bool PERM = false, AFTER_DRAIN = false;
    const GAS float* base; GAS float* out; const GAS float* gate;
    __device__ __forceinline__ void operator()(const f32x4 (&acc)[2][2][4][2], const Unit& u, int wr, int wc, int fr, int fq) const {
        const int row0 = u.pm * BM + wr * 64 + fr, col0 = u.pn * BM + wc * 32 + 4 * fq;
        const GAS float* gp = gate + (size_t)((u.pm * BM) >> 12) * 6144;
        f32x4 gv[2][2];
#pragma unroll
        for (int bj = 0; bj < 2; ++bj)
#pragma unroll
            for (int n = 0; n < 2; ++n) gv[bj][n] = *(const GAS f32x4*)(gp + col0 + bj * HALF + n * 16);
#pragma unroll
        for (int ai = 0; ai < 2; ++ai)
#pragma unroll
            for (int m = 0; m < 4; ++m) { const size_t off = (size_t)(row0 + ai * HALF + m * 16) * DM + col0;
#pragma unroll
                for (int bj = 0; bj < 2; ++bj)
#pragma unroll
                    for (int n = 0; n < 2; ++n) { const f32x4 bs = *(const GAS f32x4*)(base + off + bj * HALF + n * 16);
                        *(GAS f32x4*)(out + off + bj * HALF + n * 16) = bs + gv[bj][n] * acc[ai][bj][m][n]; } }
    }
};
struct EpiSwiglu {
    static constexpr bool PERM = true, AFTER_DRAIN = false;
    GAS h16_t* O; const GAS float* b1;
    __device__ __forceinline__ void operator()(const f32x4 (&acc)[2][2][4][2], const Unit& u, int wr, int wc, int fr, int fq) const {
        const int e = u.pn >> 3, p = u.pn & 7;
        const int row0 = u.pm * BM + wr * 64 + fr, hc = p * 128 + wc * 32 + 8 * fq;
        const GAS float* bp = b1 + (size_t)e * 2048 + hc;
        f32x4 bg[2], bl[2];
#pragma unroll
        for (int n = 0; n < 2; ++n) { bg[n] = *(const GAS f32x4*)(bp + 4 * n); bl[n] = *(const GAS f32x4*)(bp + 1024 + 4 * n); }
#pragma unroll
        for (int ai = 0; ai < 2; ++ai)
#pragma unroll
            for (int m = 0; m < 4; ++m) { GAS h16_t* rowp = O + (size_t)(row0 + ai * HALF + m * 16) * DM + hc; float r[8];
#pragma unroll
                for (int n = 0; n < 2; ++n) { const f32x4 g = acc[ai][0][m][n] + bg[n], li = acc[ai][1][m][n] + bl[n];
#pragma unroll
                    for (int i = 0; i < 4; ++i) { const float xg = fminf(g[i], 7.0f), xl = fminf(fmaxf(li[i], -7.0f), 7.0f);
                        r[4 * n + i] = xg * (1.f / (1.f + __expf(-1.702f * xg))) * (xl + 1.0f); } }
                u32x4 w; w.x = pk_f16(r[0], r[1]); w.y = pk_f16(r[2], r[3]); w.z = pk_f16(r[4], r[5]); w.w = pk_f16(r[6], r[7]);
                *(GAS u32x4*)rowp = w; }
    }
};
struct EpiDown {
    static constexpr bool PERM = true, AFTER_DRAIN = false;
    GAS h16_t* O; const GAS float* b2;
    __device__ __forceinline__ void operator()(const f32x4 (&acc)[2][2][4][2], const Unit& u, int wr, int wc, int fr, int fq) const {
        const int e = u.pn >> 2, p = u.pn & 3;
        const int row0 = u.pm * BM + wr * 64 + fr, col0 = p * BM + wc * 32 + 8 * fq;
        const GAS float* bp = b2 + (size_t)e * 1024 + col0;
        f32x4 bv[2][2];
#pragma unroll
        for (int bj = 0; bj < 2; ++bj)
#pragma unroll
            for (int n = 0; n < 2; ++n) bv[bj][n] = *(const GAS f32x4*)(bp + bj * HALF + 4 * n);
#pragma unroll
        for (int ai = 0; ai < 2; ++ai)
#pragma unroll
            for (int m = 0; m < 4; ++m) { GAS h16_t* rowp = O + (size_t)(row0 + ai * HALF + m * 16) * DM + col0;
#pragma unroll
                for (int bj = 0; bj < 2; ++bj) { const f32x4 v0 = acc[ai][bj][m][0] + bv[bj][0], v1 = acc[ai][bj][m][1] + bv[bj][1];
                    u32x4 w; w.x = pk_f16(v0[0], v0[1]); w.y = pk_f16(v0[2], v0[3]); w.z = pk_f16(v1[0], v1[1]); w.w = pk_f16(v1[2], v1[3]);
                    *(GAS u32x4*)(rowp + bj * HALF) = w; } }
    }
};

template <class Epi, class Sched, bool GATHER = false>
__device__ __forceinline__ void gemm_phase(PG8_LAS unsigned char* lds, const Gemm g, const Sched& S, const Epi& E, const int tid) {
    const int wid = __builtin_amdgcn_readfirstlane(tid >> 6), lane = tid & 63, wr = wid >> 2, wc = wid & 3, fr = lane & 15, fq = lane >> 4;
    const int K = g.K, nt = K / BK;
    const size_t kstep = (size_t)(BK * 2);
    const size_t hstep = (size_t)HALF * K * 2;
    const size_t tstep = 2 * hstep;
    unsigned voffB[2], oc0[2], oc1[2], on0[2], on1[2]; int Rr[2]; unsigned Cc2[2];
#pragma unroll
    for (int i = 0; i < 2; ++i) { int R, C; stage_rc(tid * 16 + i * 8192, R, C); const int Rb = Epi::PERM ? ((R & ~31) + perm32(R & 31)) : R;
        Rr[i] = R; Cc2[i] = (unsigned)C * 2u; voffB[i] = (unsigned)(Rb * K + C) * 2u;
        oc0[i] = (unsigned)(R * K + C) * 2u; oc1[i] = oc0[i] + (unsigned)hstep; on0[i] = oc0[i]; on1[i] = oc1[i]; }
    const unsigned ldsw = (unsigned)wid * 1024u;
    const int aoff = lds_byte(wr * 64 + fr, fq * 8), boff = lds_byte(wc * 32 + fr, fq * 8);
#define PG8_SA(b, h) (((b) * 2 + (h)) * HTB)
#define PG8_SB(b, h) ((4 + (b) * 2 + (h)) * HTB)
#define PG8_STAGE(bufoff, gbase, voff) do { _Pragma("unroll") for (int _i = 0; _i < 2; ++_i) \
        __builtin_amdgcn_global_load_lds((const GAS unsigned*)((const GAS char*)(gbase) + (voff)[_i]), (PG8_LAS unsigned*)(lds + (bufoff) + ldsw + _i * 8192), 16, 0, 0); } while (0)
#define PG8_LDA(dst, b, h) do { _Pragma("unroll") for (int m = 0; m < 4; ++m) _Pragma("unroll") for (int k = 0; k < 2; ++k) dst[m][k] = *(const PG8_LAS f16x8*)(lds + PG8_SA(b, h) + aoff + m * 2048 + k * 1024); } while (0)
#define PG8_LDB(dst, b, h) do { _Pragma("unroll") for (int n = 0; n < 2; ++n) _Pragma("unroll") for (int k = 0; k < 2; ++k) dst[n][k] = *(const PG8_LAS f16x8*)(lds + PG8_SB(b, h) + boff + n * 2048 + k * 1024); } while (0)
#define PG8_MMA(ai, bj, At, Bt) do { __builtin_amdgcn_s_setprio(1); _Pragma("unroll") for (int m = 0; m < 4; ++m) _Pragma("unroll") for (int n = 0; n < 2; ++n) _Pragma("unroll") for (int k = 0; k < 2; ++k) \
        acc[ai][bj][m][n] = __builtin_amdgcn_mfma_f32_16x16x32_f16(Bt[n][k], At[m][k], acc[ai][bj][m][n], 0, 0, 0); __builtin_amdgcn_s_setprio(0); } while (0)
#define PG8_WAIT_V(n) asm volatile("s_waitcnt vmcnt(" #n ")" ::: "memory")
#define PG8_WAIT_L(n) asm volatile("s_waitcnt lgkmcnt(" #n ")" ::: "memory")
#define PG8_BAR __builtin_amdgcn_s_barrier()
#define PG8_SCHED __builtin_amdgcn_sched_barrier(0)
#define PG8_GOFF(ix, un, o0, o1) do { int r0_, cnt_; S.rows(ix, r0_, cnt_); const GAS int* lp_ = g.rl + (size_t)((un).pn >> 3) * LISTCAP; \
        _Pragma("unroll") for (int _i = 0; _i < 2; ++_i) { int ra_ = r0_ + Rr[_i], rb_ = ra_ + HALF; ra_ = ra_ < cnt_ ? ra_ : cnt_ - 1; rb_ = rb_ < cnt_ ? rb_ : cnt_ - 1; \
            (o0)[_i] = (unsigned)lp_[ra_] * (unsigned)(K * 2) + Cc2[_i]; (o1)[_i] = (unsigned)lp_[rb_] * (unsigned)(K * 2) + Cc2[_i]; } } while (0)
    Unit cur, nxt; int ui = 0;
    if (!S.next(0, cur)) return;
    f32x4 acc[2][2][4][2];
#pragma unroll
    for (int a = 0; a < 2; ++a)
#pragma unroll
        for (int b = 0; b < 2; ++b)
#pragma unroll
            for (int m = 0; m < 4; ++m)
#pragma unroll
                for (int n = 0; n < 2; ++n) acc[a][b][m][n] = (f32x4){0.f, 0.f, 0.f, 0.f};
    f16x8 At[4][2], B0[2][2], B1[2][2];
    const GAS char* cA = (const GAS char*)g.A + (GATHER ? (size_t)0 : (size_t)cur.pm * tstep); const GAS char* cB = (const GAS char*)g.Bt + (size_t)cur.pn * tstep;
    if constexpr (GATHER) PG8_GOFF(0, cur, oc0, oc1);
    S.a_ready(cur);
    PG8_STAGE(PG8_SB(0, 0), cB, voffB); PG8_STAGE(PG8_SB(0, 1), cB + hstep, voffB); PG8_STAGE(PG8_SA(0, 0), cA, oc0); PG8_STAGE(PG8_SA(0, 1), cA, oc1);
    if (wr == 1) PG8_BAR;
    PG8_WAIT_V(2); PG8_BAR;
    PG8_STAGE(PG8_SB(1, 0), cB + kstep, voffB); PG8_STAGE(PG8_SA(1, 0), cA + kstep, oc0); PG8_STAGE(PG8_SB(1, 1), cB + hstep + kstep, voffB);
    PG8_WAIT_V(6); PG8_BAR;
    for (;;) {
        const bool has_next = S.next(ui + 1, nxt);
        const GAS char* nA = (has_next && !GATHER) ? (const GAS char*)g.A + (size_t)nxt.pm * tstep : cA; const GAS char* nB = has_next ? (const GAS char*)g.Bt + (size_t)nxt.pn * tstep : cB;
        if constexpr (GATHER) { if (has_next) PG8_GOFF(ui + 1, nxt, on0, on1); }
        for (int t = 0; t < nt; t += 2) {
            const bool last = (t == nt - 2);
            const GAS char* a1 = cA + (size_t)(t + 1) * kstep;
            const GAS char* a2 = last ? nA : cA + (size_t)(t + 2) * kstep; const GAS char* b2 = last ? nB : cB + (size_t)(t + 2) * kstep;
            const GAS char* a3 = a2 + kstep; const GAS char* b3 = b2 + kstep;
            unsigned x0[2], x1[2];
#pragma unroll
            for (int i = 0; i < 2; ++i) { const bool ln = GATHER && last && has_next; x0[i] = ln ? on0[i] : oc0[i]; x1[i] = ln ? on1[i] : oc1[i]; }
            if (last && has_next) S.a_ready(nxt);
            PG8_LDB(B0, 0, 0); PG8_LDB(B1, 0, 1); PG8_SCHED; PG8_LDA(At, 0, 0); PG8_STAGE(PG8_SA(1, 1), a1, oc1);
            PG8_WAIT_V(8); PG8_WAIT_L(0); PG8_BAR; PG8_MMA(0, 0, At, B0); PG8_MMA(0, 1, At, B1); PG8_BAR; PG8_SCHED;
            PG8_LDA(At, 0, 1); PG8_STAGE(PG8_SB(0, 0), b2, voffB); PG8_STAGE(PG8_SB(0, 1), b2 + hstep, voffB); PG8_STAGE(PG8_SA(0, 0), a2, x0);
            PG8_WAIT_V(8); PG8_WAIT_L(0); PG8_BAR; PG8_MMA(1, 0, At, B0); PG8_MMA(1, 1, At, B1); PG8_BAR; PG8_SCHED;
            PG8_LDB(B0, 1, 0); PG8_LDB(B1, 1, 1); PG8_SCHED; PG8_LDA(At, 1, 0); PG8_STAGE(PG8_SA(0, 1), a2, x1);
            PG8_WAIT_V(8); PG8_WAIT_L(0); PG8_BAR; PG8_MMA(0, 0, At, B0); PG8_MMA(0, 1, At, B1); PG8_BAR; PG8_SCHED;
            PG8_LDA(At, 1, 1); PG8_STAGE(PG8_SB(1, 0), b3, voffB); PG8_STAGE(PG8_SB(1, 1), b3 + hstep, voffB); PG8_STAGE(PG8_SA(1, 0), a3, x0);
            PG8_WAIT_V(8); PG8_WAIT_L(0); PG8_BAR; PG8_MMA(1, 0, At, B0); PG8_MMA(1, 1, At, B1); PG8_BAR; PG8_SCHED;
        }
        if (wr == 0) PG8_BAR;
        E(acc, cur, wr, wc, fr, fq); S.done(cur);
        if (!has_next) break;
#pragma unroll
        for (int a = 0; a < 2; ++a)
#pragma unroll
            for (int b = 0; b < 2; ++b)
#pragma unroll
                for (int m = 0; m < 4; ++m)
#pragma unroll
                    for (int n = 0; n < 2; ++n) acc[a][b][m][n] = (f32x4){0.f, 0.f, 0.f, 0.f};
        cur = nxt; cA = nA; cB = nB; ++ui;
        if constexpr (GATHER) {
#pragma unroll
            for (int i = 0; i < 2; ++i) { oc0[i] = on0[i]; oc1[i] = on1[i]; } }
        if (wr == 1) PG8_BAR;
    }
    PG8_WAIT_V(0);
    PG8_BAR;
#undef PG8_SA
#undef PG8_SB
#undef PG8_STAGE
#undef PG8_LDA
#undef PG8_LDB
#undef PG8_MMA
#undef PG8_WAIT_V
#undef PG8_WAIT_L
#undef PG8_BAR
#undef PG8_SCHED
#undef PG8_GOFF
}
}

constexpr size_t MiB = 1u << 20;
constexpr size_t WS_CTL   = 0,            CTL_ZERO_BYTES = 1 * MiB;
constexpr size_t WS_MOD   = 1 * MiB;
constexpr size_t WS_KMEAN = 2 * MiB;
constexpr size_t WS_SGUW  = 3 * MiB;
constexpr size_t WS_ROUTE = 4 * MiB;
constexpr size_t WS_LIST  = 6 * MiB;
constexpr size_t WS_WIN   = 10 * MiB;
constexpr size_t WS_WOUT  = 18 * MiB;
constexpr size_t WS_W1    = 22 * MiB;
constexpr size_t WS_W2    = 278 * MiB;
constexpr size_t WS_X     = 406 * MiB;
constexpr size_t WS_H     = 534 * MiB;
constexpr size_t WS_PROJ  = 598 * MiB;
constexpr size_t WS_MIX   = 726 * MiB;
constexpr size_t WS_XS    = 790 * MiB;
constexpr size_t WS_ACT   = 1062 * MiB;
constexpr size_t WS_END   = 1334 * MiB;
constexpr int CW_BAR = 4096;
constexpr int CW_CNT = 16384;

constexpr int RING_BYTES = 131072;
constexpr int LDS_BYTES = 147456;
constexpr int BARST_OFF = LDS_BYTES - 64;
constexpr int NWAVES = 8;
#ifndef PH3
#define PH3 15
#endif
#ifndef PROBE
#define PROBE 0
#endif
#define GIN(k) ((const GAS float*)AP->in[k])
#define REPS(bit) (((PROBE) & (bit)) ? 2 : 1)
#ifndef PHMASK
#define PHMASK 0xFFFF
#endif

#define XB_TMO      128
#define XB_XCNT(j)  (256  + 64 * (j))
#define XB_XSUB(j)  (1280 + 64 * (j))
#define XB_XGEN(j)  (2304 + 64 * (j))
#define XB_TOP      3328
#define XB_TOPGEN   3392
#define XCD_BAR_WORDS 3456
#define XB_SPIN_CAP (1u << 20)
__device__ __forceinline__ unsigned xb_ld(unsigned* p)              { return __hip_atomic_load(p, __ATOMIC_RELAXED, __HIP_MEMORY_SCOPE_AGENT); }
__device__ __forceinline__ unsigned xb_add(unsigned* p, unsigned v) { return __hip_atomic_fetch_add(p, v, __ATOMIC_RELAXED, __HIP_MEMORY_SCOPE_AGENT); }
__device__ __forceinline__ unsigned xb_xcc_id() { return (unsigned)__builtin_amdgcn_s_getreg((3 << 11) | 20) & 0xFu; }
#define XB_SPIN(cond, bar) do { unsigned _sp = 0; while (cond) { __builtin_amdgcn_s_sleep(1); \
    if ((++_sp & 255u) == 0u) { if (xb_ld(&(bar)[XB_TMO])) break; if (_sp > XB_SPIN_CAP) { atomicAdd(&(bar)[XB_TMO], 1u); break; } } } } while (0)
struct XcdBarrier { unsigned* bar; unsigned x; volatile LAS unsigned* st; };
__device__ __forceinline__ XcdBarrier xcd_barrier_post(unsigned* bar, volatile LAS unsigned* st) {
    XcdBarrier b; b.bar = bar; b.x = xb_xcc_id(); b.st = st;
    if (threadIdx.x == 0) (void)xb_add(&bar[XB_XCNT(b.x)], 1u);
    return b;
}
__device__ __forceinline__ void xcd_barrier_complete(unsigned* bar, unsigned x, unsigned& nloc, unsigned& nx) {
    const unsigned G = gridDim.x * gridDim.y * gridDim.z;
    unsigned sum, cnt, mine, sp = 0u;
    for (;;) {
        sum = 0u; cnt = 0u; mine = 0u;
#pragma unroll
        for (unsigned j = 0; j < 16; ++j) { const unsigned c = xb_ld(&bar[XB_XCNT(j)]); sum += c; cnt += (c > 0u) ? 1u : 0u; mine = (j == x) ? c : mine; }
        if (sum == G) break;
        __builtin_amdgcn_s_sleep(1);
        if ((++sp & 255u) == 0u) { if (xb_ld(&bar[XB_TMO])) break; if (sp > XB_SPIN_CAP) { atomicAdd(&bar[XB_TMO], 1u); break; } }
    }
    nloc = mine > 0u ? mine : 1u; nx = cnt > 0u ? cnt : 1u;
}
__device__ __forceinline__ void xcd_barrier(const XcdBarrier& b) {
    asm volatile("s_waitcnt vmcnt(0)" ::: "memory");
    __syncthreads();
    if (threadIdx.x == 0) {
        unsigned* bar = b.bar; asm volatile("" : "+s"(bar));
        unsigned bx = b.x; asm volatile("" : "+s"(bx));
        __builtin_amdgcn_s_waitcnt(0);
        unsigned nloc = b.st[0], nx = b.st[1];
        if (nloc == 0u) { xcd_barrier_complete(bar, bx, nloc, nx); b.st[0] = nloc; b.st[1] = nx; }
        const unsigned old = xb_add(&bar[XB_XSUB(bx)], 1u);
        const unsigned gen = old / nloc;
        if (old + 1u == (gen + 1u) * nloc) {
            __builtin_amdgcn_fence(__ATOMIC_RELEASE, "agent");
            asm volatile("s_waitcnt vmcnt(0)" ::: "memory");
            const unsigned og = xb_add(&bar[XB_TOP], 1u);
            const unsigned tg = og / nx;
            if (og + 1u == (tg + 1u) * nx) xb_add(&bar[XB_TOPGEN], 1u);
            else XB_SPIN(xb_ld(&bar[XB_TOPGEN]) == tg, bar);
            __builtin_amdgcn_fence(__ATOMIC_ACQUIRE, "agent");
            xb_add(&bar[XB_XGEN(bx)], 1u);
            asm volatile("s_waitcnt vmcnt(0)" ::: "memory");
        } else {
            XB_SPIN(xb_ld(&bar[XB_XGEN(bx)]) == gen, bar);
            __builtin_amdgcn_fence(__ATOMIC_ACQUIRE, "agent");
            asm volatile("s_waitcnt vmcnt(0)" ::: "memory");
        }
    }
    __syncthreads();
}

struct Args { const float* in[27]; float* out; unsigned char* ws; };
enum { I_X = 0, I_C, I_WMOD, I_BMOD, I_N1G, I_WIN, I_CONVW, I_CONVB, I_CNG, I_CNB, I_RELB, I_POOLW, I_POOLS, I_SNG, I_SNB, I_SGUW, I_SGUB, I_MIXG, I_WOUT, I_N2G, I_RW, I_RB, I_W1, I_B1, I_W2, I_B2, I_FNG };

__device__ __forceinline__ int t5_bucket(int n) {
    if (n < 16) return n;
    int b = 16;
    b += (n >= 19); b += (n >= 21); b += (n >= 24); b += (n >= 27); b += (n >= 31); b += (n >= 35); b += (n >= 40); b += (n >= 46);
    b += (n >= 52); b += (n >= 59); b += (n >= 67); b += (n >= 77); b += (n >= 87); b += (n >= 99); b += (n >= 113);
    return b;
}

__device__ __forceinline__ void transpose_item(const GAS float* W, int K, int N, GAS f16* WT, int orow0, int k0, int n0, const GAS float* kscale, LAS float* scr, int lane) {
#pragma unroll 8
    for (int i = 0; i < 32; ++i) { const int kk = 2 * i + (lane >> 5); float v = W[(size_t)(k0 + kk) * N + n0 + (lane & 31)]; if (kscale) v *= kscale[k0 + kk]; scr[kk * 33 + (lane & 31)] = v; }
    asm volatile("s_waitcnt lgkmcnt(0)" ::: "memory");
    const int c = lane & 7;
#pragma unroll
    for (int j = 0; j < 4; ++j) { const int n = (lane >> 3) + 8 * j; const LAS float* s = scr + (8 * c) * 33 + n;
        u32x4 o; o.x = pk_f16(s[0 * 33], s[1 * 33]); o.y = pk_f16(s[2 * 33], s[3 * 33]); o.z = pk_f16(s[4 * 33], s[5 * 33]); o.w = pk_f16(s[6 * 33], s[7 * 33]);
        *(GAS u32x4*)(WT + (size_t)(orow0 + n) * K + k0 + 8 * c) = o; }
    asm volatile("s_waitcnt lgkmcnt(0)" ::: "memory");
}

__device__ __forceinline__ void norm_mod_row(const GAS float* xrow, const GAS float* g, const GAS float* shift, const GAS float* scale, GAS f16* orow, int lane) {
    f32x4 v[4]; float s = 0.f;
#pragma unroll
    for (int j = 0; j < 4; ++j) { v[j] = *(const GAS f32x4*)(xrow + 4 * lane + 256 * j); s += (v[j].x * v[j].x + v[j].y * v[j].y) + (v[j].z * v[j].z + v[j].w * v[j].w); }
    const float rstd = rsqrtf(wave_sum(s) * (1.f / DM) + EPS);
#pragma unroll
    for (int j = 0; j < 4; ++j) { const int c = 4 * lane + 256 * j; const f32x4 gg = *(const GAS f32x4*)(g + c), sh = *(const GAS f32x4*)(shift + c), sc = *(const GAS f32x4*)(scale + c);
        const f32x4 h = (v[j] * rstd) * gg * (sc + 1.0f) + sh;
        u32x2 w; w.x = pk_f16(h.x, h.y); w.y = pk_f16(h.z, h.w); *(GAS u32x2*)(orow + c) = w; }
}

extern __shared__ __attribute__((aligned(16))) unsigned char lds[];
#define LAUNDER() int tid = tid0; asm volatile("" : "+v"(tid)); const int lane = tid & 63; int wave = wave0; asm volatile("" : "+s"(wave)); const int gw = bid * NWAVES + wave; (void)gw; (void)lane; const CAS Args* AP = (const CAS Args*)__builtin_amdgcn_kernarg_segment_ptr(); asm volatile("" : "+s"(AP)); (void)AP; LAS unsigned char* Lp = (LAS unsigned char*)lds; asm volatile("" : "+s"(Lp)); (void)Lp; GAS unsigned char* ws = (GAS unsigned char*)AP->ws; GAS unsigned* ctl = (GAS unsigned*)(ws + WS_CTL); GAS float* MOD = (GAS float*)(ws + WS_MOD); GAS float* KMEAN = (GAS float*)(ws + WS_KMEAN); GAS f16* SGUW = (GAS f16*)(ws + WS_SGUW); GAS int* ROUTE_E = (GAS int*)(ws + WS_ROUTE); GAS int* ROUTE_POS = ROUTE_E + NTOK * 4; GAS float* ROUTE_G = (GAS float*)(ROUTE_POS + NTOK * 4); GAS int* LIST = (GAS int*)(ws + WS_LIST); GAS f16* WIN_T = (GAS f16*)(ws + WS_WIN); GAS f16* WOUT_T = (GAS f16*)(ws + WS_WOUT); GAS f16* W1_T = (GAS f16*)(ws + WS_W1); GAS f16* W2_T = (GAS f16*)(ws + WS_W2); GAS float* X = (GAS float*)(ws + WS_X); GAS f16* H = (GAS f16*)(ws + WS_H); GAS f16* PROJ = (GAS f16*)(ws + WS_PROJ); GAS f16* MIX = (GAS f16*)(ws + WS_MIX); GAS f16* XS = (GAS f16*)(ws + WS_XS); GAS f16* ACT = (GAS f16*)(ws + WS_ACT); (void)ctl; (void)MOD; (void)KMEAN; (void)SGUW; (void)ROUTE_E; (void)ROUTE_POS; (void)ROUTE_G; (void)LIST; (void)WIN_T; (void)WOUT_T; (void)W1_T; (void)W2_T; (void)X; (void)H; (void)PROJ; (void)MIX; (void)XS; (void)ACT;
__device__ __forceinline__ void layer_body(const int l, const XcdBarrier bar, const int tid0, const int wave0, const int G, const int bid, const int NGW) {
#define MODL (MOD + (size_t)l * 8 * 6144)
for (int rep_ = 0; rep_ < REPS(4); ++rep_) if (PHMASK & 4) { LAUNDER();
        { pg8::Gemm g{(const GAS pg8::h16_t*)H, (const GAS pg8::h16_t*)(WIN_T + (size_t)l * INW * DM), NTOK, INW, DM, nullptr}; pg8::StaticOrder S; S.init(NTOK, INW, G, bid);
          pg8::EpiF16 E{(GAS pg8::h16_t*)PROJ, INW};
          pg8::gemm_phase<pg8::EpiF16, pg8::StaticOrder, false>(Lp, g, S, E, tid); }
}
        xcd_barrier(bar);

for (int rep_ = 0; rep_ < REPS(8); ++rep_) if (PHMASK & 8) {
        for (int it_ = bid; it_ < 256 + 512 + 512 + 128; it_ += G) { int it = it_; asm volatile("" : "+s"(it));
            if ((PH3 & 1) && it < 256) {
                LAUNDER();
                const int T0 = it * 128;
                LAS f16* vT = (LAS f16*)Lp;
                constexpr int VS = 136;
                const GAS float* sng = GIN(I_SNG) + l * GW; const GAS float* snb = GIN(I_SNB) + l * GW;
                for (int t = 0; t < 16; ++t) { const int tl = wave * 16 + t; const GAS f16* pr = PROJ + (size_t)(T0 + tl) * INW + 1792 + 4 * lane;
                    const f16x4 hv = *(const GAS f16x4*)pr; float v[4]; float s = 0.f;
#pragma unroll
                    for (int i = 0; i < 4; ++i) { v[i] = gelu_erf((float)hv[i]); s += v[i]; }
                    const float mean = wave_sum(s) * (1.f / 256.f); float q = 0.f;
#pragma unroll
                    for (int i = 0; i < 4; ++i) { v[i] -= mean; q += v[i] * v[i]; }
                    const float rstd = rsqrtf(wave_sum(q) * (1.f / 256.f) + EPS);
#pragma unroll
                    for (int i = 0; i < 4; ++i) { const int c = 4 * lane + i; vT[c * VS + tl] = (f16)(v[i] * rstd * sng[c] + snb[c]); } }
                __syncthreads();
                f32x4 acc[4][4];
#pragma unroll
                for (int h = 0; h < 4; ++h)
#pragma unroll
                    for (int ct = 0; ct < 4; ++ct) acc[h][ct] = (f32x4){0.f, 0.f, 0.f, 0.f};
                const int nk = (wave >> 1) + 1, fr = lane & 15, fq = lane >> 4;
                for (int ks = 0; ks < nk; ++ks) {
#pragma unroll
                    for (int h = 0; h < 4; ++h) {
                        const f16x8 a = *(const GAS f16x8*)(SGUW + ((size_t)(l * 4 + h) * 128 + 16 * wave + fr) * 128 + 32 * ks + 8 * fq);
#pragma unroll
                        for (int ct = 0; ct < 4; ++ct) { const f16x8 b = *(const LAS f16x8*)(vT + (h * 64 + ct * 16 + fr) * VS + 32 * ks + 8 * fq);
                            acc[h][ct] = __builtin_amdgcn_mfma_f32_16x16x32_f16(a, b, acc[h][ct], 0, 0, 0); } } }
                const GAS float* sb = GIN(I_SGUB) + (size_t)l * 4 * 128;
#pragma unroll
                for (int reg = 0; reg < 4; ++reg) { const int il = 16 * wave + 4 * fq + reg; const size_t tok = (size_t)(T0 + il); float ss = 0.f; float val[4][4];
#pragma unroll
                    for (int h = 0; h < 4; ++h) { const float bia = sb[h * 128 + il];
#pragma unroll
                        for (int ct = 0; ct < 4; ++ct) { const int c = h * 64 + ct * 16 + fr; const float u = gelu_erf((float)PROJ[tok * INW + 1536 + c]);
                            const float x = (acc[h][ct][reg] + bia) * u; val[h][ct] = x; ss += x * x; } }
                    ss += __shfl_xor(ss, 1); ss += __shfl_xor(ss, 2); ss += __shfl_xor(ss, 4); ss += __shfl_xor(ss, 8);
                    const float rstd = rsqrtf(ss * (1.f / 256.f) + EPS);
#pragma unroll
                    for (int h = 0; h < 4; ++h)
#pragma unroll
                        for (int ct = 0; ct < 4; ++ct) MIX[tok * DM + 768 + h * 64 + ct * 16 + fr] = (f16)(val[h][ct] * rstd); }
                __syncthreads();
            } else if ((PH3 & 2) && it < 768) {
                LAUNDER();
                const int T0 = (it - 256) * 64, p0 = T0 & (SEQ - 1);
                LAS float* y = (LAS float*)Lp;
                for (int task = tid; task < 94 * 32; task += 512) { const int r = task >> 5, c8 = (task & 31) * 8; float o[8];
                    if (p0 - 30 + r >= 0) { const GAS f16* pr = PROJ + (size_t)(T0 - 30 + r) * INW + c8; const f16x8 a = *(const GAS f16x8*)pr, gt = *(const GAS f16x8*)(pr + 256);
#pragma unroll
                        for (int i = 0; i < 8; ++i) o[i] = (float)a[i] * sigmoidf_((float)gt[i]); }
                    else {
#pragma unroll
                        for (int i = 0; i < 8; ++i) o[i] = 0.f; }
                    *(LAS f32x4*)(y + r * 256 + c8) = (f32x4){o[0], o[1], o[2], o[3]}; *(LAS f32x4*)(y + r * 256 + c8 + 4) = (f32x4){o[4], o[5], o[6], o[7]}; }
                __syncthreads();
                float psq[8];
#pragma unroll
                for (int t = 0; t < 8; ++t) psq[t] = 0.f;
#pragma unroll 1
                for (int h = 0; h < 4; ++h) { const int c = h * 64 + lane; float w[31];
#pragma unroll
                    for (int j = 0; j < 31; ++j) w[j] = GIN(I_CONVW)[((size_t)l * 31 + j) * GW + c];
                    const float cb = GIN(I_CONVB)[l * GW + c], ng = GIN(I_CNG)[l * GW + c], nb_ = GIN(I_CNB)[l * GW + c];
#pragma unroll
                    for (int t = 0; t < 8; ++t) { const int tl = wave * 8 + t; float a = cb;
#pragma unroll
                        for (int j = 0; j < 31; ++j) a += w[j] * y[(tl + j) * 256 + c];
                        const float mean = wave_sum(a) * (1.f / 64.f); const float xc = a - mean; const float var = wave_sum(xc * xc) * (1.f / 64.f);
                        const float yn = xc * rsqrtf(var + EPS) * ng + nb_; const float sv = yn * sigmoidf_(yn);
                        psq[t] += sv * sv; MIX[(size_t)(T0 + tl) * DM + c] = (f16)sv; } }
#pragma unroll
                for (int t = 0; t < 8; ++t) psq[t] = rsqrtf(wave_sum(psq[t]) * (1.f / 256.f) + EPS);
#pragma unroll 1
                for (int h = 0; h < 4; ++h) {
#pragma unroll
                    for (int t = 0; t < 8; ++t) { GAS f16* p = MIX + (size_t)(T0 + wave * 8 + t) * DM + h * 64 + lane; *p = (f16)((float)*p * psq[t]); } }
                __syncthreads();
            } else if ((PH3 & 4) && it < 1280) {
                LAUNDER();
                const int T0 = (it - 768) * 64, p0 = T0 & (SEQ - 1);
                LAS f16* zt = (LAS f16*)Lp;
                LAS float* P = (LAS float*)(Lp + 40960);
                for (int task = tid; task < 79 * 32; task += 512) { const int r = task >> 5, c8 = (task & 31) * 8; u32x4 z = {0u, 0u, 0u, 0u};
                    if (p0 - 15 + r >= 0) z = *(const GAS u32x4*)(PROJ + (size_t)(T0 - 15 + r) * INW + 1280 + c8);
                    *(LAS u32x4*)(zt + r * 256 + c8) = z; }
                __syncthreads();
                { const int c8 = (tid & 31) * 8, seg = tid >> 5, gi = c8 >> 6, w = 2 << gi; float s[8];
#pragma unroll
                  for (int i = 0; i < 8; ++i) s[i] = 0.f;
                  for (int d = 1; d < w; ++d) { const f16x8 z = *(const LAS f16x8*)(zt + (seg * 4 + 15 - d) * 256 + c8);
#pragma unroll
                      for (int i = 0; i < 8; ++i) s[i] += (float)z[i]; }
#pragma unroll
                  for (int t = 0; t < 4; ++t) { const int tl = seg * 4 + t, p = p0 + tl;
                      const f16x8 zn = *(const LAS f16x8*)(zt + (tl + 15) * 256 + c8);
                      const float inv = 1.f / (float)(p + 1 < w ? p + 1 : w);
#pragma unroll
                      for (int i = 0; i < 8; ++i) { s[i] += (float)zn[i]; P[tl * 256 + c8 + i] = s[i] * inv - (float)zn[i]; }
                      const f16x8 zo = *(const LAS f16x8*)(zt + (tl + 15 - (w - 1)) * 256 + c8);
#pragma unroll
                      for (int i = 0; i < 8; ++i) s[i] -= (float)zo[i]; } }
                __syncthreads();
                const GAS float* Wp = GIN(I_POOLW) + (size_t)l * 16384;
                float o[8][4];
#pragma unroll
                for (int gi = 0; gi < 4; ++gi) { float a[8];
#pragma unroll
                    for (int t = 0; t < 8; ++t) a[t] = 0.f;
                    for (int c = 0; c < 64; ++c) { const float wv = Wp[(gi * 64 + c) * 64 + lane];
#pragma unroll
                        for (int t = 0; t < 8; ++t) a[t] += P[(wave * 8 + t) * 256 + gi * 64 + c] * wv; }
                    const float ps = GIN(I_POOLS)[l * GW + gi * 64 + lane];
#pragma unroll
                    for (int t = 0; t < 8; ++t) o[t][gi] = a[t] * ps; }
#pragma unroll
                for (int t = 0; t < 8; ++t) { float ss = o[t][0] * o[t][0] + o[t][1] * o[t][1] + o[t][2] * o[t][2] + o[t][3] * o[t][3];
                    const float rstd = rsqrtf(wave_sum(ss) * (1.f / 256.f) + EPS); const size_t tok = (size_t)(T0 + wave * 8 + t);
#pragma unroll
                    for (int gi = 0; gi < 4; ++gi) MIX[tok * DM + 512 + gi * 64 + lane] = (f16)(o[t][gi] * rstd); }
                __syncthreads();
            } else if (PH3 & 8) {
                LAUNDER();
                const int ib = it - 1280, T0 = ib * 256;
                LAS float* part = (LAS float*)Lp;
                const int c4 = (tid & 63) * 4, sl = tid >> 6; float s[4] = {0.f, 0.f, 0.f, 0.f};
                for (int t = 0; t < 32; ++t) { const f16x4 k4 = *(const GAS f16x4*)(PROJ + (size_t)(T0 + sl * 32 + t) * INW + 768 + c4);
#pragma unroll
                    for (int i = 0; i < 4; ++i) s[i] += (float)k4[i]; }
#pragma unroll
                for (int i = 0; i < 4; ++i) part[sl * 256 + c4 + i] = s[i];
                __syncthreads();
                if (tid < 256) { float a = 0.f;
#pragma unroll
                    for (int w = 0; w < 8; ++w) a += part[w * 256 + tid];
                    KMEAN[(size_t)ib * 256 + tid] = a * (1.f / 256.f); }
                __syncthreads();
            }
        }
}
        xcd_barrier(bar);

for (int rep_ = 0; rep_ < REPS(16); ++rep_) if (PHMASK & 16) { LAUNDER();
        {
            LAS f16* Kt = (LAS f16*)Lp;
            LAS f16* VT = (LAS f16*)(Lp + 9216);
            LAS float* kml = (LAS float*)(Lp + 18432);
            LAS float* lut = (LAS float*)(Lp + 18432 + 4096);
            constexpr int KS = 72, VSTR = 68;
            constexpr float LOG2E = 1.4426950408889634f, SC2 = 0.125f * LOG2E;
            const int r32 = lane & 31, hh = lane >> 5;
            for (int pi = bid; pi < 256; pi += G) {
                const int bh = pi >> 3, pp = pi & 7;
                for (int half = 0; half < 2; ++half) {
                    const int own = half == 0 ? 15 - pp : pp;
                    const int b = bh >> 2, h = bh & 3;
                    const size_t TB = (size_t)b * SEQ;
                    const int qpos = own * 256 + 32 * wave + r32;
                    __syncthreads();
                    for (int i = tid; i < 1024; i += 512) kml[i] = KMEAN[((size_t)(b * 16 + (i >> 6))) * 256 + h * 64 + (i & 63)];
                    if (tid < 128) lut[tid] = GIN(I_RELB)[t5_bucket(tid) * 4 + h] * LOG2E;
                    f16x8 qf[4];
                    { const GAS f16* qp = PROJ + (TB + qpos) * INW + 512 + h * 64 + 8 * hh;
#pragma unroll
                      for (int s = 0; s < 4; ++s) qf[s] = *(const GAS f16x8*)(qp + 16 * s); }
                    __syncthreads();
                    unsigned mask = 0u;
                    { float gsc[16];
#pragma unroll
                      for (int n = 0; n < 16; ++n) { float a = 0.f;
                          if (n < own) {
#pragma unroll
                              for (int s = 0; s < 4; ++s)
#pragma unroll
                                  for (int j = 0; j < 8; ++j) a += (float)qf[s][j] * kml[n * 64 + 16 * s + 8 * hh + j]; }
                          a += __shfl_xor(a, 32); gsc[n] = a; }
#pragma unroll
                      for (int k = 0; k < 3; ++k) { float best = -INFINITY; int bi = -1;
#pragma unroll
                          for (int n = 0; n < 16; ++n) { const bool ok = (n < own) && !((mask >> n) & 1u) && (gsc[n] > best); if (ok) { best = gsc[n]; bi = n; } }
                          if (bi >= 0) mask |= 1u << bi; } }
                    f32x16 o0, o1;
#pragma unroll
                    for (int i = 0; i < 16; ++i) { o0[i] = 0.f; o1[i] = 0.f; }
                    float mrun = -INFINITY, lrun = 0.f;
                    const int ntile = own * 4 + 4;
                    const int lk = tid >> 3, lc = tid & 7;
                    f16x8 kreg, vreg;
                    { const GAS f16* kp = PROJ + (TB + lk) * INW + 768 + h * 64 + 8 * lc; kreg = *(const GAS f16x8*)kp; vreg = *(const GAS f16x8*)(kp + 256); }
                    for (int j = 0; j < ntile; ++j) {
                        __syncthreads();
                        *(LAS f16x8*)(Kt + lk * KS + 8 * lc) = kreg;
#pragma unroll
                        for (int i = 0; i < 8; ++i) VT[(8 * lc + i) * VSTR + lk] = vreg[i];
                        __syncthreads();
                        if (j + 1 < ntile) { const GAS f16* kp = PROJ + (TB + (size_t)(j + 1) * 64 + lk) * INW + 768 + h * 64 + 8 * lc; kreg = *(const GAS f16x8*)kp; vreg = *(const GAS f16x8*)(kp + 256); }
                        const int n = j >> 2, kbase = j * 64;
                        bool active; bool sel;
                        if (n < own) { sel = (mask >> n) & 1u; active = __any(sel); }
                        else { sel = true; active = (kbase <= own * 256 + 32 * wave + 31); }
                        if (active) {
                            f32x16 p0, p1;
#pragma unroll
                            for (int i = 0; i < 16; ++i) { p0[i] = 0.f; p1[i] = 0.f; }
#pragma unroll
                            for (int s = 0; s < 4; ++s) { const f16x8 a0 = *(const LAS f16x8*)(Kt + r32 * KS + 16 * s + 8 * hh), a1 = *(const LAS f16x8*)(Kt + (32 + r32) * KS + 16 * s + 8 * hh);
                                p0 = __builtin_amdgcn_mfma_f32_32x32x16_f16(a0, qf[s], p0, 0, 0, 0); p1 = __builtin_amdgcn_mfma_f32_32x32x16_f16(a1, qf[s], p1, 0, 0, 0); }
                            const int dmin = own * 256 + 32 * wave - (kbase + 63);
                            float mx = -INFINITY;
                            if (dmin >= 127) { const float bc = lut[127];
#pragma unroll
                                for (int i = 0; i < 16; ++i) { p0[i] = sel ? p0[i] * SC2 + bc : -INFINITY; p1[i] = sel ? p1[i] * SC2 + bc : -INFINITY; mx = fmaxf(mx, fmaxf(p0[i], p1[i])); } }
                            else {
#pragma unroll
                                for (int i = 0; i < 16; ++i) { const int kr = (i & 3) + 8 * (i >> 2) + 4 * hh; const int d0 = qpos - (kbase + kr), d1 = d0 - 32;
                                    p0[i] = (sel && d0 >= 0) ? p0[i] * SC2 + lut[d0 > 127 ? 127 : d0] : -INFINITY;
                                    p1[i] = (sel && d1 >= 0) ? p1[i] * SC2 + lut[d1 > 127 ? 127 : (d1 < 0 ? 0 : d1)] : -INFINITY;
                                    mx = fmaxf(mx, fmaxf(p0[i], p1[i])); } }
                            mx = fmaxf(mx, __shfl_xor(mx, 32));
                            const float mnew = fmaxf(mrun, mx), msafe = (mnew == -INFINITY) ? 0.f : mnew;
                            const float alpha = exp2f(mrun - msafe);
                            float ps = 0.f;
#pragma unroll
                            for (int i = 0; i < 16; ++i) { p0[i] = exp2f(p0[i] - msafe); p1[i] = exp2f(p1[i] - msafe); ps += p0[i] + p1[i]; }
                            lrun = lrun * alpha + ps; mrun = mnew;
#pragma unroll
                            for (int i = 0; i < 16; ++i) { o0[i] *= alpha; o1[i] *= alpha; }
                            f16x8 pb[4];
#pragma unroll
                            for (int i = 0; i < 8; ++i) { pb[0][i] = (f16)p0[i]; pb[1][i] = (f16)p0[8 + i]; pb[2][i] = (f16)p1[i]; pb[3][i] = (f16)p1[8 + i]; }
#pragma unroll
                            for (int kk = 0; kk < 4; ++kk) {
                                const f16x4 a0l = *(const LAS f16x4*)(VT + r32 * VSTR + 16 * kk + 4 * hh), a0h = *(const LAS f16x4*)(VT + r32 * VSTR + 16 * kk + 8 + 4 * hh);
                                const f16x4 a1l = *(const LAS f16x4*)(VT + (32 + r32) * VSTR + 16 * kk + 4 * hh), a1h = *(const LAS f16x4*)(VT + (32 + r32) * VSTR + 16 * kk + 8 + 4 * hh);
                                const f16x8 av0 = {a0l[0], a0l[1], a0l[2], a0l[3], a0h[0], a0h[1], a0h[2], a0h[3]};
                                const f16x8 av1 = {a1l[0], a1l[1], a1l[2], a1l[3], a1h[0], a1h[1], a1h[2], a1h[3]};
                                o0 = __builtin_amdgcn_mfma_f32_32x32x16_f16(av0, pb[kk], o0, 0, 0, 0);
                                o1 = __builtin_amdgcn_mfma_f32_32x32x16_f16(av1, pb[kk], o1, 0, 0, 0); }
                        }
                    }
                    const float ltot = lrun + __shfl_xor(lrun, 32), inv = 1.f / ltot;
                    GAS f16* op = MIX + (TB + qpos) * DM + 256 + h * 64;
#pragma unroll
                    for (int g4 = 0; g4 < 4; ++g4) { const int d0 = 8 * g4 + 4 * hh;
                        u32x2 w0, w1; w0.x = pk_f16(o0[4 * g4] * inv, o0[4 * g4 + 1] * inv); w0.y = pk_f16(o0[4 * g4 + 2] * inv, o0[4 * g4 + 3] * inv);
                        w1.x = pk_f16(o1[4 * g4] * inv, o1[4 * g4 + 1] * inv); w1.y = pk_f16(o1[4 * g4 + 2] * inv, o1[4 * g4 + 3] * inv);
                        *(GAS u32x2*)(op + d0) = w0; *(GAS u32x2*)(op + 32 + d0) = w1; }
                }
            }
        }
}
        xcd_barrier(bar);

for (int rep_ = 0; rep_ < REPS(32); ++rep_) if (PHMASK & 32) { LAUNDER();
        for (int m = gw; m < NTOK; m += NGW) { GAS f16* p = MIX + (size_t)m * DM + 256 + 4 * lane; const f16x4 v = *(const GAS f16x4*)p;
            float f[4], ss = 0.f;
#pragma unroll
            for (int i = 0; i < 4; ++i) { f[i] = (float)v[i]; ss += f[i] * f[i]; }
            const float rstd = rsqrtf(wave_sum(ss) * (1.f / 256.f) + EPS);
            u32x2 w; w.x = pk_f16(f[0] * rstd, f[1] * rstd); w.y = pk_f16(f[2] * rstd, f[3] * rstd); *(GAS u32x2*)p = w; }
}
        xcd_barrier(bar);

if (PHMASK & 64) { LAUNDER();
        { pg8::Gemm g{(const GAS pg8::h16_t*)MIX, (const GAS pg8::h16_t*)(WOUT_T + (size_t)l * DM * DM), NTOK, DM, DM, nullptr}; pg8::StaticOrder S; S.init(NTOK, DM, G, bid);
          pg8::EpiResid E{l == 0 ? GIN(I_X) : X, X, MODL + 2048};
          pg8::gemm_phase<pg8::EpiResid, pg8::StaticOrder, false>(Lp, g, S, E, tid); }
}
        xcd_barrier(bar);

if (PHMASK & 128) { LAUNDER();
        {
            LAS float* WT = (LAS float*)Lp;
            constexpr int WS_ = 1028;
            LAS int* sel_e = (LAS int*)(Lp + 131584);
            LAS int* rank_ = (LAS int*)(Lp + 131584 + 2048);
            LAS int* lcnt = (LAS int*)(Lp + 131584 + 4096);
            LAS int* lbase = (LAS int*)(Lp + 131584 + 4096 + 128);
            const GAS float* rw = GIN(I_RW) + (size_t)l * DM * NEXP;
            for (int e = 0; e < 32; ++e) { WT[e * WS_ + tid] = rw[(size_t)tid * 32 + e]; WT[e * WS_ + 512 + tid] = rw[(size_t)(512 + tid) * 32 + e]; }
            GAS unsigned* gcnt = ctl + CW_CNT + l * 32 * 64;
            for (int ch = bid; ch < NTOK / 128; ch += G) {
                if (tid < 32) lcnt[tid] = 0;
                __syncthreads();
                const int b = (ch * 128) >> 12; const GAS float* md = MODL + (size_t)b * 6144;
                const GAS float* g2 = GIN(I_N2G) + l * DM;
                for (int pass = 0; pass < 8; ++pass) {
                    const int tl0 = wave * 16 + pass * 2; const size_t tok0 = (size_t)ch * 128 + tl0;
                    float hv[2][16];
#pragma unroll
                    for (int r = 0; r < 2; ++r) { const GAS float* xr = X + (tok0 + r) * DM; f32x4 v[4]; float s = 0.f;
#pragma unroll
                        for (int j = 0; j < 4; ++j) { v[j] = *(const GAS f32x4*)(xr + 4 * lane + 256 * j); s += (v[j].x * v[j].x + v[j].y * v[j].y) + (v[j].z * v[j].z + v[j].w * v[j].w); }
                        const float rstd = rsqrtf(wave_sum(s) * (1.f / DM) + EPS);
#pragma unroll
                        for (int j = 0; j < 4; ++j) { const int c = 4 * lane + 256 * j; const f32x4 gg = *(const GAS f32x4*)(g2 + c), sh = *(const GAS f32x4*)(md + 3072 + c), sc = *(const GAS f32x4*)(md + 4096 + c);
                            const f32x4 hq = (v[j] * rstd) * gg * (sc + 1.0f) + sh;
                            hv[r][4 * j] = hq.x; hv[r][4 * j + 1] = hq.y; hv[r][4 * j + 2] = hq.z; hv[r][4 * j + 3] = hq.w;
                            u32x2 w; w.x = pk_f16(hq.x, hq.y); w.y = pk_f16(hq.z, hq.w); *(GAS u32x2*)(H + (tok0 + r) * DM + c) = w; } }
                    float a0[32], a1[32];
#pragma unroll
                    for (int e = 0; e < 32; ++e) { float s0 = 0.f, s1 = 0.f;
#pragma unroll
                        for (int j = 0; j < 4; ++j) { const f32x4 w = *(const LAS f32x4*)(WT + e * WS_ + 4 * lane + 256 * j);
                            s0 += hv[0][4 * j] * w.x + hv[0][4 * j + 1] * w.y + hv[0][4 * j + 2] * w.z + hv[0][4 * j + 3] * w.w;
                            s1 += hv[1][4 * j] * w.x + hv[1][4 * j + 1] * w.y + hv[1][4 * j + 2] * w.z + hv[1][4 * j + 3] * w.w; }
                        a0[e] = s0; a1[e] = s1; }
                    float t1[32];
                    { const bool up = (lane & 32) != 0;
#pragma unroll
                      for (int e = 0; e < 32; ++e) { const float snd = up ? a0[e] : a1[e], kp = up ? a1[e] : a0[e]; t1[e] = kp + __shfl_xor(snd, 32); } }
                    float t2[16];
                    { const bool up = (lane & 16) != 0;
#pragma unroll
                      for (int e = 0; e < 16; ++e) { const float snd = up ? t1[e] : t1[e + 16], kp = up ? t1[e + 16] : t1[e]; t2[e] = kp + __shfl_xor(snd, 16); } }
                    float t3[8];
                    { const bool up = (lane & 8) != 0;
#pragma unroll
                      for (int e = 0; e < 8; ++e) { const float snd = up ? t2[e] : t2[e + 8], kp = up ? t2[e + 8] : t2[e]; t3[e] = kp + __shfl_xor(snd, 8); } }
                    float t4[4];
                    { const bool up = (lane & 4) != 0;
#pragma unroll
                      for (int e = 0; e < 4; ++e) { const float snd = up ? t3[e] : t3[e + 4], kp = up ? t3[e + 4] : t3[e]; t4[e] = kp + __shfl_xor(snd, 4); } }
                    float t5[2];
                    { const bool up = (lane & 2) != 0;
#pragma unroll
                      for (int e = 0; e < 2; ++e) { const float snd = up ? t4[e] : t4[e + 2], kp = up ? t4[e + 2] : t4[e]; t5[e] = kp + __shfl_xor(snd, 2); } }
                    float logit;
                    { const bool up = (lane & 1) != 0; const float snd = up ? t5[0] : t5[1], kp = up ? t5[1] : t5[0]; logit = kp + __shfl_xor(snd, 1); }
                    const int mye = lane & 31;
                    logit += GIN(I_RB)[l * NEXP + mye];
                    float topv[4]; int topi[4]; float myv = logit;
#pragma unroll
                    for (int k = 0; k < 4; ++k) { float bv = myv; int bi = mye;
#pragma unroll
                        for (int off = 1; off < 32; off <<= 1) { const float ov = __shfl_xor(bv, off); const int oi = __shfl_xor(bi, off); if (ov > bv || (ov == bv && oi < bi)) { bv = ov; bi = oi; } }
                        topv[k] = bv; topi[k] = bi; if (mye == bi) myv = -INFINITY; }
                    if (mye == 0) { const int tl = tl0 + (lane >> 5); const size_t tok = (size_t)ch * 128 + tl;
                        const float e1 = __expf(topv[1] - topv[0]), e2 = __expf(topv[2] - topv[0]), e3 = __expf(topv[3] - topv[0]); const float inv = 1.f / (1.f + e1 + e2 + e3);
                        *(GAS f32x4*)(ROUTE_G + tok * 4) = (f32x4){inv, e1 * inv, e2 * inv, e3 * inv};
#pragma unroll
                        for (int k = 0; k < 4; ++k) sel_e[tl * 4 + k] = topi[k]; }
                }
                __syncthreads();
                const int e = sel_e[tid];
                rank_[tid] = __hip_atomic_fetch_add(&lcnt[e], 1, __ATOMIC_RELAXED, __HIP_MEMORY_SCOPE_WORKGROUP);
                __syncthreads();
                if (tid < 32) lbase[tid] = (int)__hip_atomic_fetch_add(gcnt + tid * 64, (unsigned)lcnt[tid], __ATOMIC_RELAXED, __HIP_MEMORY_SCOPE_AGENT);
                __syncthreads();
                { const int pos = lbase[e] + rank_[tid]; const size_t tok = (size_t)ch * 128 + (tid >> 2);
                  LIST[(size_t)e * LISTCAP + pos] = (int)tok; ROUTE_E[tok * 4 + (tid & 3)] = e; ROUTE_POS[tok * 4 + (tid & 3)] = pos; }
                __syncthreads();
            }
        }
}
        xcd_barrier(bar);

#define cnts ((LAS int*)(Lp + RING_BYTES + 1024))
#define mbase ((LAS int*)(Lp + RING_BYTES + 1024 + 256))
        { LAUNDER(); GAS unsigned* gcnt = ctl + CW_CNT + l * 32 * 64;
          if (tid < 32) cnts[tid] = (int)__hip_atomic_load(gcnt + tid * 64, __ATOMIC_RELAXED, __HIP_MEMORY_SCOPE_AGENT);
          __syncthreads();
          if (tid == 0) { int a = 0; for (int e = 0; e < 32; ++e) { mbase[e] = a; a += (cnts[e] + 255) >> 8; } mbase[32] = a; }
          __syncthreads(); }

        for (int ph = 0; ph < 2; ++ph) {
            if (!(PHMASK & (512 << ph))) continue;
            for (int rep_ = 0; rep_ < REPS(512 << ph); ++rep_) {
            LAUNDER(); const int MT = mbase[32]; LAS int* ulist = (LAS int*)(Lp + RING_BYTES); const int NT = ph == 0 ? 8 : 4, U = MT * NT;
            __syncthreads();
            int nu = 0;
            { const int q = U / 8, rr = U % 8, nig = 8 * NT;
              for (int i = 0; i < 64; ++i) { const long Lid = (long)i * G + bid; if (Lid >= U) break; ++nu;
                  if (tid == i) { int wg = (int)Lid; const int xcd = wg % 8, off = wg / 8; wg = (xcd < rr ? xcd * (q + 1) : rr * (q + 1) + (xcd - rr) * q) + off;
                      const int gid = wg / nig, fm = gid * 8, gsz = (MT - fm) < 8 ? (MT - fm) : 8; const int pm = fm + ((wg % nig) % gsz), pn = (wg % nig) / gsz;
                      int e = 0;
                      for (int qq = 1; qq < 32; ++qq) e += (mbase[qq] <= pm) ? 1 : 0;
                      ulist[3 * i] = pm | ((e * NT + pn) << 16); ulist[3 * i + 1] = (pm - mbase[e]) * 256; ulist[3 * i + 2] = cnts[e]; } } }
            __syncthreads();
            pg8::ListOrder S{ulist, nu};
            if (ph == 0) { pg8::Gemm g{(const GAS pg8::h16_t*)H, (const GAS pg8::h16_t*)(W1_T + (size_t)l * NEXP * 2048 * DM), PROWS, 2048, DM, LIST};
                pg8::EpiSwiglu E{(GAS pg8::h16_t*)ACT, GIN(I_B1) + (size_t)l * NEXP * 2048};
                pg8::gemm_phase<pg8::EpiSwiglu, pg8::ListOrder, true>(Lp, g, S, E, tid); }
            else { pg8::Gemm g{(const GAS pg8::h16_t*)ACT, (const GAS pg8::h16_t*)(W2_T + (size_t)l * NEXP * DM * DM), PROWS, 1024, DM, nullptr};
                pg8::EpiDown E{(GAS pg8::h16_t*)XS, GIN(I_B2) + (size_t)l * NEXP * DM};
                pg8::gemm_phase<pg8::EpiDown, pg8::ListOrder, false>(Lp, g, S, E, tid); }
            }
            xcd_barrier(bar);
        }

if (PHMASK & 2048) { LAUNDER();
        for (int m = gw; m < NTOK; m += NGW) {
            const int b = m >> 12; const GAS float* md = MODL + (size_t)b * 6144;
            const GAS f16* yr[4]; float gk[4];
#pragma unroll
            for (int k = 0; k < 4; ++k) { const int e = ROUTE_E[(size_t)m * 4 + k], pos = ROUTE_POS[(size_t)m * 4 + k]; gk[k] = ROUTE_G[(size_t)m * 4 + k]; yr[k] = XS + ((size_t)mbase[e] * 256 + pos) * DM; }
            f32x4 v[4]; float s = 0.f;
#pragma unroll
            for (int j = 0; j < 4; ++j) { const int c = 4 * lane + 256 * j; f32x4 a = {0.f, 0.f, 0.f, 0.f};
#pragma unroll
                for (int k = 0; k < 4; ++k) { const f16x4 y4 = *(const GAS f16x4*)(yr[k] + c); a.x += gk[k] * (float)y4[0]; a.y += gk[k] * (float)y4[1]; a.z += gk[k] * (float)y4[2]; a.w += gk[k] * (float)y4[3]; }
                const f32x4 x1 = *(const GAS f32x4*)(X + (size_t)m * DM + c), g2 = *(const GAS f32x4*)(md + 5120 + c);
                v[j] = x1 + g2 * a; s += (v[j].x * v[j].x + v[j].y * v[j].y) + (v[j].z * v[j].z + v[j].w * v[j].w); }
            const float rstd = rsqrtf(wave_sum(s) * (1.f / DM) + EPS);
            if (l + 1 < DEPTH) {
                const GAS float* mdn = MOD + (size_t)((l + 1) * 8 + b) * 6144; const GAS float* g1 = GIN(I_N1G) + (l + 1) * DM;
#pragma unroll
                for (int j = 0; j < 4; ++j) { const int c = 4 * lane + 256 * j; *(GAS f32x4*)(X + (size_t)m * DM + c) = v[j];
                    const f32x4 gg = *(const GAS f32x4*)(g1 + c), sh = *(const GAS f32x4*)(mdn + c), sc = *(const GAS f32x4*)(mdn + 1024 + c);
                    const f32x4 hq = (v[j] * rstd) * gg * (sc + 1.0f) + sh; u32x2 w; w.x = pk_f16(hq.x, hq.y); w.y = pk_f16(hq.z, hq.w); *(GAS u32x2*)(H + (size_t)m * DM + c) = w; }
            } else {
#pragma unroll
                for (int j = 0; j < 4; ++j) { const int c = 4 * lane + 256 * j; const f32x4 gg = *(const GAS f32x4*)(GIN(I_FNG) + c); *(GAS f32x4*)(((GAS float*)AP->out) + (size_t)m * DM + c) = (v[j] * rstd) * gg; }
            }
        }
}
        if (l + 1 < DEPTH) xcd_barrier(bar);
}

__global__ void __launch_bounds__(NWAVES * 64, 2) fwd_megakernel(Args args) {
    const int tid0 = threadIdx.x, wave0 = __builtin_amdgcn_readfirstlane(tid0 >> 6);
    const int G = gridDim.x, bid = blockIdx.x;
    const int NGW = G * NWAVES;
    LAS unsigned char* L = (LAS unsigned char*)lds;

    if (tid0 < 16) ((LAS unsigned*)(L + BARST_OFF))[tid0] = 0u;
    __syncthreads();
    XcdBarrier bar = xcd_barrier_post((unsigned*)(args.ws + WS_CTL) + CW_BAR, (volatile LAS unsigned*)(L + BARST_OFF));

for (int rep_ = 0; rep_ < REPS(1); ++rep_) if (PHMASK & 1) { LAUNDER(); __syncthreads();
    {
        LAS float* cond = (LAS float*)Lp;
        LAS float* red = (LAS float*)(Lp + 32768);
        bool cond_ready = false;
        for (int it = bid; it < 192; it += G) {
            if (!cond_ready) { for (int i = tid; i < NB * DM; i += 512) { const float v = GIN(I_C)[i]; cond[i] = v * sigmoidf_(v); } __syncthreads(); cond_ready = true; }
            const int l = it / 96, n0 = (it % 96) * 64;
            const GAS float* wm = GIN(I_WMOD) + (size_t)l * DM * 6144 + n0 + lane;
            float a[8];
#pragma unroll
            for (int b = 0; b < 8; ++b) a[b] = 0.f;
            for (int k = wave * 128; k < wave * 128 + 128; ++k) { const float w = wm[(size_t)k * 6144];
#pragma unroll
                for (int b = 0; b < 8; ++b) a[b] += cond[b * DM + k] * w; }
#pragma unroll
            for (int b = 0; b < 8; ++b) red[(wave * 8 + b) * 64 + lane] = a[b];
            __syncthreads();
            { const int b = tid >> 6; float s = GIN(I_BMOD)[l * 6144 + n0 + lane];
#pragma unroll
              for (int w = 0; w < 8; ++w) s += red[(w * 8 + b) * 64 + lane];
              MOD[(size_t)(l * 8 + b) * 6144 + n0 + lane] = s; }
            __syncthreads();
        }
        __syncthreads();
        LAS float* scr = (LAS float*)(Lp + wave * 16384);
        constexpr int PER_L = 1024 + 512 + 32768 + 16384;
        for (int it = gw; it < DEPTH * PER_L; it += NGW) {
            const int l = it / PER_L; int r = it % PER_L;
            if (r < 1024) { const int kb = r >> 6, nb = r & 63; transpose_item(GIN(I_WIN) + (size_t)l * DM * INW, DM, INW, WIN_T + (size_t)l * INW * DM, 32 * nb, 64 * kb, 32 * nb, nullptr, scr, lane); continue; } r -= 1024;
            if (r < 512) { const int kb = r >> 5, nb = r & 31; transpose_item(GIN(I_WOUT) + (size_t)l * DM * DM, DM, DM, WOUT_T + (size_t)l * DM * DM, 32 * nb, 64 * kb, 32 * nb, GIN(I_MIXG) + l * DM, scr, lane); continue; } r -= 512;
            if (r < 32768) { const int e = r >> 10, q = r & 1023, kb = q >> 6, nb = q & 63, n0 = 32 * nb;
                const int bj = n0 >> 10, jj = n0 & 1023, orow = (jj >> 7) * 256 + bj * 128 + (jj & 127);
                transpose_item(GIN(I_W1) + ((size_t)l * NEXP + e) * DM * 2048, DM, 2048, W1_T + ((size_t)l * NEXP + e) * 2048 * DM, orow, 64 * kb, n0, nullptr, scr, lane); continue; } r -= 32768;
            { const int e = r >> 9, q = r & 511, kb = q >> 5, nb = q & 31;
                transpose_item(GIN(I_W2) + ((size_t)l * NEXP + e) * DM * DM, DM, DM, W2_T + ((size_t)l * NEXP + e) * DM * DM, 32 * nb, 64 * kb, 32 * nb, nullptr, scr, lane); }
        }
        for (int i = bid * 512 + tid; i < DEPTH * 4 * 128 * 128; i += G * 512) { const int jj = i & 127, ii = (i >> 7) & 127; SGUW[i] = (f16)(jj <= ii ? GIN(I_SGUW)[i] : 0.f); }
    }
}
    xcd_barrier(bar);

for (int rep_ = 0; rep_ < REPS(2); ++rep_) if (PHMASK & 2) { LAUNDER();
    for (int m = gw; m < NTOK; m += NGW) { const int b = m >> 12; const GAS float* md = MOD + (size_t)b * 6144;
        norm_mod_row(GIN(I_X) + (size_t)m * DM, GIN(I_N1G), md, md + 1024, H + (size_t)m * DM, lane); }
}
    xcd_barrier(bar);

    layer_body(0, bar, tid0, wave0, G, bid, NGW);
    layer_body(1, bar, tid0, wave0, G, bid, NGW);
}


extern "C" void kernel_launch(void* const* d_in, const int* in_sizes, int n_in, void* d_out, int out_size, void* d_ws, size_t ws_size, hipStream_t stream) {
    static int grid = 0;
    if (grid == 0) {
        if (n_in != 27 || out_size != NTOK * DM || ws_size < WS_END) { fprintf(stderr, "kernel_launch: unexpected shapes (n_in %d, out %d, ws %zu)\n", n_in, out_size, ws_size); grid = -1; return; }
        int dev = 0, cus = 0, per_cu = 0;
        if (hipGetDevice(&dev) != hipSuccess || hipDeviceGetAttribute(&cus, hipDeviceAttributeMultiprocessorCount, dev) != hipSuccess) { grid = -1; return; }
        if (hipFuncSetAttribute((const void*)fwd_megakernel, hipFuncAttributeMaxDynamicSharedMemorySize, LDS_BYTES) != hipSuccess) { fprintf(stderr, "kernel_launch: hipFuncSetAttribute failed\n"); grid = -1; return; }
        if (hipOccupancyMaxActiveBlocksPerMultiprocessor(&per_cu, (const void*)fwd_megakernel, NWAVES * 64, LDS_BYTES) != hipSuccess || per_cu < 1) { fprintf(stderr, "kernel_launch: occupancy query says %d blocks per CU\n", per_cu); (void)hipGetLastError(); grid = -1; return; }
        grid = cus;
    }
    if (grid < 0) return;
    (void)hipMemsetAsync((char*)d_ws + WS_CTL, 0, CTL_ZERO_BYTES, stream);
    Args a{};
    for (int i = 0; i < 27; ++i) a.in[i] = (const float*)d_in[i];
    a.out = (float*)d_out; a.ws = (unsigned char*)d_ws;
    hipLaunchKernelGGL(fwd_megakernel, dim3(grid), dim3(NWAVES * 64), LDS_BYTES, stream, a);
}
```

```cpp
#include <hip/hip_runtime.h>
#include <cstdio>
#include <cstdint>

#define LAS __attribute__((address_space(3)))
#define GAS __attribute__((address_space(1)))
#define CAS __attribute__((address_space(4)))
typedef _Float16 f16;
typedef _Float16 f16x8 __attribute__((ext_vector_type(8)));
typedef _Float16 f16x4 __attribute__((ext_vector_type(4)));
typedef _Float16 f16x2 __attribute__((ext_vector_type(2)));
typedef float f32x2 __attribute__((ext_vector_type(2)));
typedef float f32x4 __attribute__((ext_vector_type(4)));
typedef float f32x16 __attribute__((ext_vector_type(16)));
typedef unsigned u32x2 __attribute__((ext_vector_type(2)));
typedef unsigned u32x4 __attribute__((ext_vector_type(4)));
typedef short v4i16_t __attribute__((ext_vector_type(4)));
typedef int i32x4 __attribute__((ext_vector_type(4)));
typedef int i32x8 __attribute__((ext_vector_type(8)));

constexpr int DM = 1024, NB = 8, SEQ = 4096, NTOK = NB * SEQ, DEPTH = 2, GW = 256, INW = 2048;
constexpr int NEXP = 32, TOPK = 4;
constexpr int PROWS = NTOK * TOPK + NEXP * 256;
constexpr float EPS = 1e-6f;
constexpr int LISTCAP = NTOK;
constexpr int FP8_FIRST = 0;
#define IS_FP8(l_) ((l_) >= FP8_FIRST)
constexpr int FP8_LAYER_UNUSED = 1;
constexpr float W8_SCALE = 32.0f, W8_INV = 1.0f / 32.0f;
#define PROJ_FP8_FIRST 1
#ifndef PROJ_FP8
#define PROJ_FP8 1
#endif

__device__ __forceinline__ unsigned pk_f16(float lo, float hi) { f32x2 v = {lo, hi}; f16x2 h = __builtin_convertvector(v, f16x2); return __builtin_bit_cast(unsigned, h); }
__device__ __forceinline__ float row16_sum(float v) {
    v += __builtin_bit_cast(float, __builtin_amdgcn_update_dpp(0, __builtin_bit_cast(int, v), 0xB1, 0xf, 0xf, true));
    v += __builtin_bit_cast(float, __builtin_amdgcn_update_dpp(0, __builtin_bit_cast(int, v), 0x4E, 0xf, 0xf, true));
    v += __builtin_bit_cast(float, __builtin_amdgcn_update_dpp(0, __builtin_bit_cast(int, v), 0x141, 0xf, 0xf, true));
    v += __builtin_bit_cast(float, __builtin_amdgcn_update_dpp(0, __builtin_bit_cast(int, v), 0x140, 0xf, 0xf, true));
    return v;
}
__device__ __forceinline__ unsigned pk4_fp8(float a, float b, float c, float d) { int p = 0; p = __builtin_amdgcn_cvt_pk_fp8_f32(a, b, p, false); p = __builtin_amdgcn_cvt_pk_fp8_f32(c, d, p, true); return (unsigned)p; }
__device__ __forceinline__ float max3f(float a, float b, float c) { float r; asm("v_max3_f32 %0, %1, %2, %3" : "=v"(r) : "v"(a), "v"(b), "v"(c)); return r; }
__device__ __forceinline__ float max2f(float a, float b) { float r; asm("v_max_f32_e32 %0, %1, %2" : "=v"(r) : "v"(a), "v"(b)); return r; }
__device__ __forceinline__ float fadd_s(float a, float b) { float r; asm("v_add_f32_e32 %0, %1, %2" : "=v"(r) : "v"(a), "v"(b)); return r; }
template <int N> __device__ __forceinline__ void wave_sum_n(float (&v)[N]) {
#pragma unroll
    for (int i = 0; i < N; ++i) v[i] += __builtin_bit_cast(float, __builtin_amdgcn_update_dpp(0, __builtin_bit_cast(int, v[i]), 0xB1, 0xf, 0xf, true));
#pragma unroll
    for (int i = 0; i < N; ++i) v[i] += __builtin_bit_cast(float, __builtin_amdgcn_update_dpp(0, __builtin_bit_cast(int, v[i]), 0x4E, 0xf, 0xf, true));
#pragma unroll
    for (int i = 0; i < N; ++i) v[i] += __builtin_bit_cast(float, __builtin_amdgcn_update_dpp(0, __builtin_bit_cast(int, v[i]), 0x141, 0xf, 0xf, true));
#pragma unroll
    for (int i = 0; i < N; ++i) v[i] += __builtin_bit_cast(float, __builtin_amdgcn_update_dpp(0, __builtin_bit_cast(int, v[i]), 0x140, 0xf, 0xf, true));
#pragma unroll
    for (int i = 0; i < N; ++i) v[i] += __shfl_xor(v[i], 16);
#pragma unroll
    for (int i = 0; i < N; ++i) v[i] += __shfl_xor(v[i], 32);
}
__device__ __forceinline__ float wave_sum(float v) {
    v = row16_sum(v);
    v += __shfl_xor(v, 16); v += __shfl_xor(v, 32);
    return v;
}
__device__ __forceinline__ float sigmoidf_(float x) { return __builtin_amdgcn_rcpf(1.f + __expf(-x)); }
__device__ __forceinline__ float gelu_erf(float v) {
    const float av = fabsf(v), d = av * 0.2316418882f + 1.0f, t = __builtin_amdgcn_rcpf(d);
    float q = t * 0.5307027145f + (-0.7265760135f); q = q * t + 0.7107068705f; q = q * t + (-0.142248368f); q = q * t + 0.127414796f; q = q * t;
    const float e = __builtin_amdgcn_exp2f((v * v) * (-0.72134752044f));
    const float m = v * (q * e);
    return v < 0.f ? m : v - m;
}

#ifndef PROBE
#define PROBE 0
#endif
#ifndef TSEL_A
#define TSEL_A 0
#endif
#ifndef TSEL_B
#define TSEL_B 0
#endif
#ifndef TSCALE
#define TSCALE 16.0f
#endif
#define STAMP_OFF 146944
#define STAMP(k) do { if (TSEL_B > 0 && bid == 0 && tid0 == 0) ((__attribute__((address_space(3))) unsigned long long*)((__attribute__((address_space(3))) unsigned char*)lds + STAMP_OFF))[k] = __builtin_amdgcn_s_memrealtime(); } while (0)
namespace pg8 {
#define PG8_LAS __attribute__((address_space(3)))
typedef unsigned short h16_t;
constexpr int BM = 256, BK = 64, HALF = 128, HTB = HALF * BK * 2, STAGE_BYTES = 8 * HTB, NXCD = 8, WGM = 8;

__host__ __device__ __forceinline__ int lds_byte(int r, int c) { const int st = (r >> 4) * 2 + (c >> 5), rr = r & 15, cc = c & 31, ob = rr * 64 + cc * 2; return st * 1024 + (ob ^ (((ob >> 9) & 1) << 5)); }
__host__ __device__ __forceinline__ void stage_rc(int b, int& R, int& C) { const int st = b / 1024, sb = b % 1024, swz = sb ^ (((sb >> 9) & 1) << 5); R = (st >> 1) * 16 + swz / 64; C = (st & 1) * 32 + (swz % 64) / 2; }
__host__ __device__ __forceinline__ int perm32(int rho) { const int n = rho >> 4, i = rho & 15; return 8 * (i >> 2) + 4 * n + (i & 3); }

struct Unit { int pm, pn; };
struct Gemm { const GAS h16_t* A; const GAS h16_t* Bt; int M, N, K; const GAS int* rl; const GAS float* ssq; };

struct StaticOrder {
    int nM, nN, nwg, G, c;
    __host__ __device__ void init(int M, int N, int G_, int c_) { nM = M / BM; nN = N / BM; nwg = nM * nN; G = G_; c = c_; }
    __host__ __device__ bool next(int i, Unit& u) const {
        const long L = (long)i * G + c; if (L >= nwg) return false;
        int wgid = (int)L; { const int q = nwg / NXCD, r = nwg % NXCD, xcd = wgid % NXCD, off = wgid / NXCD; wgid = (xcd < r ? xcd * (q + 1) : r * (q + 1) + (xcd - r) * q) + off; }
        const int nig = WGM * nN, gid = wgid / nig, fm = gid * WGM, gsz = (nM - fm) < WGM ? (nM - fm) : WGM;
        u.pm = fm + ((wgid % nig) % gsz); u.pn = (wgid % nig) / gsz; return true;
    }
    __device__ __forceinline__ void a_ready(const Unit&) const {}
    __device__ __forceinline__ void done(const Unit&) const {}
    __device__ __forceinline__ void rows(int, int& r0, int& cnt) const { r0 = 0; cnt = 1; }
};
struct MapOrder : StaticOrder {
    unsigned map;
    __host__ __device__ bool next(int i, Unit& u) const { if (!StaticOrder::next(i, u)) return false; u.pn = (int)((map >> (4 * u.pn)) & 15u); return true; }
};
struct ListOrder {
    const PG8_LAS int* list; int n;
    __device__ __forceinline__ bool next(int i, Unit& u) const { if (i >= n) return false; const int v = __builtin_amdgcn_readfirstlane(list[3 * i]); u.pm = v & 0xffff; u.pn = v >> 16; return true; }
    __device__ __forceinline__ void rows(int i, int& r0, int& cnt) const { r0 = __builtin_amdgcn_readfirstlane(list[3 * i + 1]); cnt = __builtin_amdgcn_readfirstlane(list[3 * i + 2]); }
    __device__ __forceinline__ void a_ready(const Unit&) const {}
    __device__ __forceinline__ void done(const Unit&) const {}
};

struct Pre4 { f32x4 v[4]; };
struct EpiF16 {
    static constexpr bool PERM = true, AFTER_DRAIN = false, IS_DOWN = false, PRELOAD = false;
    GAS h16_t* O; int ldc; GAS float* ksum; float sc;
    __device__ __forceinline__ Pre4 pre(const Unit&, int, int, int, int) const { return Pre4{}; }
    __device__ __forceinline__ void operator()(const f32x4 (&acc)[2][2][4][2], const Unit& u, int wr, int wc, int fr, int fq, const Pre4&) const {
        const int row0 = u.pm * BM + wr * 64 + fr, col0 = u.pn * BM + wc * 32 + 8 * fq;
        if (u.pn == 3) {
#pragma unroll
            for (int bj = 0; bj < 2; ++bj)
#pragma unroll
                for (int n = 0; n < 2; ++n) { f32x4 s = (acc[0][bj][0][n] + acc[0][bj][1][n]) + (acc[0][bj][2][n] + acc[0][bj][3][n]); s += (acc[1][bj][0][n] + acc[1][bj][1][n]) + (acc[1][bj][2][n] + acc[1][bj][3][n]);
#pragma unroll
                    for (int i = 0; i < 4; ++i) { const float t = row16_sum(s[i]);
                        if (fr == 0) __hip_atomic_fetch_add(ksum + (size_t)u.pm * 256 + bj * HALF + wc * 32 + 8 * fq + 4 * n + i, t, __ATOMIC_RELAXED, __HIP_MEMORY_SCOPE_AGENT); } } }
#pragma unroll
        for (int ai = 0; ai < 2; ++ai)
#pragma unroll
            for (int m = 0; m < 4; ++m) { GAS h16_t* rowp = O + (size_t)(row0 + ai * HALF + m * 16) * ldc + col0;
#pragma unroll
                for (int bj = 0; bj < 2; ++bj) { const f32x4 v0 = acc[ai][bj][m][0] * sc, v1 = acc[ai][bj][m][1] * sc;
                    u32x4 w; w.x = pk_f16(v0[0], v0[1]); w.y = pk_f16(v0[2], v0[3]); w.z = pk_f16(v1[0], v1[1]); w.w = pk_f16(v1[2], v1[3]);
                    *(GAS u32x4*)(rowp + bj * HALF) = w; } }
    }
};
template <bool BASE32> struct EpiResidT {
    static constexpr bool PERM = true, AFTER_DRAIN = false, IS_DOWN = false, PRELOAD = false;
    const GAS float* base32; const GAS h16_t* base16; GAS h16_t* out; const GAS float* gate;
    __device__ __forceinline__ Pre4 pre(const Unit& u, int wr, int wc, int fr, int fq) const { Pre4 p; const int col0 = u.pn * BM + wc * 32 + 8 * fq; const GAS float* gp = gate + (size_t)((u.pm * BM) >> 12) * 6144;
#pragma unroll
        for (int bj = 0; bj < 2; ++bj)
#pragma unroll
            for (int n = 0; n < 2; ++n) p.v[bj * 2 + n] = *(const GAS f32x4*)(gp + col0 + bj * HALF + 4 * n);
        return p; }
    __device__ __forceinline__ void operator()(const f32x4 (&acc)[2][2][4][2], const Unit& u, int wr, int wc, int fr, int fq, const Pre4& pr) const {
        const int row0 = u.pm * BM + wr * 64 + fr, col0 = u.pn * BM + wc * 32 + 8 * fq;
        f32x4 gv[2][2];
#pragma unroll
        for (int bj = 0; bj < 2; ++bj)
#pragma unroll
            for (int n = 0; n < 2; ++n) gv[bj][n] = pr.v[bj * 2 + n];
#pragma unroll
        for (int ai = 0; ai < 2; ++ai)
#pragma unroll
            for (int m = 0; m < 4; ++m) { const size_t off = (size_t)(row0 + ai * HALF + m * 16) * DM + col0;
#pragma unroll
                for (int bj = 0; bj < 2; ++bj) { f32x4 b0, b1;
                    if constexpr (BASE32) { b0 = *(const GAS f32x4*)(base32 + off + bj * HALF); b1 = *(const GAS f32x4*)(base32 + off + bj * HALF + 4); }
                    else { const f16x8 hb = *(const GAS f16x8*)(base16 + off + bj * HALF); b0 = (f32x4){(float)hb[0], (float)hb[1], (float)hb[2], (float)hb[3]}; b1 = (f32x4){(float)hb[4], (float)hb[5], (float)hb[6], (float)hb[7]}; }
                    const f32x4 v0 = b0 + gv[bj][0] * acc[ai][bj][m][0], v1 = b1 + gv[bj][1] * acc[ai][bj][m][1];
                    u32x4 w; w.x = pk_f16(v0[0], v0[1]); w.y = pk_f16(v0[2], v0[3]); w.z = pk_f16(v1[0], v1[1]); w.w = pk_f16(v1[2], v1[3]);
                    *(GAS u32x4*)(out + off + bj * HALF) = w; } }
    }
};
template <bool OUT8> struct EpiSwigluT {
    static constexpr bool PERM = true, AFTER_DRAIN = false, IS_DOWN = false, PRELOAD = true;
    GAS unsigned char* O; const GAS float* b1; float sc;
    __device__ __forceinline__ Pre4 pre(const Unit& u, int wr, int wc, int fr, int fq) const { Pre4 q; const int e = u.pn >> 3, p = u.pn & 7, hc = p * 128 + wc * 32 + 8 * fq; const GAS float* bp = b1 + (size_t)e * 2048 + hc;
#pragma unroll
        for (int n = 0; n < 2; ++n) { q.v[n] = *(const GAS f32x4*)(bp + 4 * n); q.v[2 + n] = *(const GAS f32x4*)(bp + 1024 + 4 * n); }
        return q; }
    __device__ __forceinline__ void operator()(const f32x4 (&acc)[2][2][4][2], const Unit& u, int wr, int wc, int fr, int fq, const Pre4& pr) const {
        const int p = u.pn & 7;
        const int row0 = u.pm * BM + wr * 64 + fr, hc = p * 128 + wc * 32 + 8 * fq;
        f32x4 bg[2], bl[2];
#pragma unroll
        for (int n = 0; n < 2; ++n) { bg[n] = pr.v[n]; bl[n] = pr.v[2 + n]; }
#pragma unroll
        for (int ai = 0; ai < 2; ++ai)
#pragma unroll
            for (int m = 0; m < 4; ++m) { float r[8];
#pragma unroll
                for (int n = 0; n < 2; ++n) { const f32x4 g = acc[ai][0][m][n] * sc + bg[n], li = acc[ai][1][m][n] * sc + bl[n];
#pragma unroll
                    for (int i = 0; i < 4; ++i) { const float xg = fminf(g[i], 7.0f), xl = fminf(fmaxf(li[i], -7.0f), 7.0f);
                        r[4 * n + i] = xg * __builtin_amdgcn_rcpf(1.f + __expf(-1.702f * xg)) * (xl + 1.0f); } }
                if constexpr (OUT8) { u32x2 w; w.x = pk4_fp8(r[0], r[1], r[2], r[3]); w.y = pk4_fp8(r[4], r[5], r[6], r[7]);
                    *(GAS u32x2*)(O + (size_t)(row0 + ai * HALF + m * 16) * DM + hc) = w; }
                else { u32x4 w; w.x = pk_f16(r[0], r[1]); w.y = pk_f16(r[2], r[3]); w.z = pk_f16(r[4], r[5]); w.w = pk_f16(r[6], r[7]);
                    *(GAS u32x4*)(O + ((size_t)(row0 + ai * HALF + m * 16) * DM + hc) * 2) = w; } }
    }
};
template <bool OUT8> struct EpiDownT {
    static constexpr bool PERM = true, AFTER_DRAIN = false, IS_DOWN = true, PRELOAD = true;
    GAS unsigned char* O; const GAS float* b2; float sc;
    __device__ __forceinline__ Pre4 pre(const Unit& u, int wr, int wc, int fr, int fq) const { Pre4 q; const int e = u.pn >> 2, p = u.pn & 3, col0 = p * BM + wc * 32 + 8 * fq; const GAS float* bp = b2 + (size_t)e * 1024 + col0;
#pragma unroll
        for (int bj = 0; bj < 2; ++bj)
#pragma unroll
            for (int n = 0; n < 2; ++n) q.v[bj * 2 + n] = *(const GAS f32x4*)(bp + bj * HALF + 4 * n);
        return q; }
    __device__ __forceinline__ void operator()(const f32x4 (&acc)[2][2][4][2], const Unit& u, int wr, int wc, int fr, int fq, const Pre4& pr) const {
        const int p = u.pn & 3;
        const int row0 = u.pm * BM + wr * 64 + fr, col0 = p * BM + wc * 32 + 8 * fq;
        f32x4 bv[2][2];
#pragma unroll
        for (int bj = 0; bj < 2; ++bj)
#pragma unroll
            for (int n = 0; n < 2; ++n) bv[bj][n] = pr.v[bj * 2 + n];
#pragma unroll
        for (int ai = 0; ai < 2; ++ai)
#pragma unroll
            for (int m = 0; m < 4; ++m) { const size_t ro = (size_t)(row0 + ai * HALF + m * 16) * DM + col0;
#pragma unroll
                for (int bj = 0; bj < 2; ++bj) { const f32x4 v0 = acc[ai][bj][m][0] * sc + bv[bj][0], v1 = acc[ai][bj][m][1] * sc + bv[bj][1];
                    if constexpr (OUT8) { u32x2 w; w.x = pk4_fp8(v0[0], v0[1], v0[2], v0[3]); w.y = pk4_fp8(v1[0], v1[1], v1[2], v1[3]); *(GAS u32x2*)(O + ro + bj * HALF) = w; }
                    else { u32x4 w; w.x = pk_f16(v0[0], v0[1]); w.y = pk_f16(v0[2], v0[3]); w.z = pk_f16(v1[0], v1[1]); w.w = pk_f16(v1[2], v1[3]);
                        *(GAS u32x4*)(O + (ro + bj * HALF) * 2) = w; } } }
    }
};

template <class Epi, class Sched, bool GATHER = false, bool FP8 = false, bool ROWSCALE = false>
__device__ __forceinline__ void gemm_phase(PG8_LAS unsigned char* lds, const Gemm g, const Sched& S, const Epi& E, const int tid) {
    const int wid = __builtin_amdgcn_readfirstlane(tid >> 6), lane = tid & 63, wr = wid >> 2, wc = wid & 3, fr = lane & 15, fq = lane >> 4;
    const int K = g.K, nt = K / BK;
    const size_t kstep = (size_t)(BK * 2);
    const size_t hstep = (size_t)HALF * K * 2;
    const size_t tstep = 2 * hstep;
    unsigned voffB[2], oc0[2], oc1[2], on0[2], on1[2];
#pragma unroll
    for (int i = 0; i < 2; ++i) { int R, C; stage_rc(tid * 16 + i * 8192, R, C); const int Rb = Epi::PERM ? ((R & ~31) + perm32(R & 31)) : R;
        voffB[i] = (unsigned)(Rb * K + C) * 2u;
        oc0[i] = (unsigned)(R * K + C) * 2u; oc1[i] = oc0[i] + (unsigned)hstep; on0[i] = oc0[i]; on1[i] = oc1[i]; }
    const unsigned ldsw = (unsigned)wid * 1024u;
    const int aoff = lds_byte(wr * 64 + fr, fq * 8), boff = lds_byte(wc * 32 + fr, fq * 8);
#define PG8_SA(b, h) (((b) * 2 + (h)) * HTB)
#define PG8_SB(b, h) ((4 + (b) * 2 + (h)) * HTB)
#define PG8_STAGE(bufoff, gbase, voff) do { _Pragma("unroll") for (int _i = 0; _i < 2; ++_i) { unsigned vo_ = (voff)[_i]; asm volatile("" : "+v"(vo_)); \
        __builtin_amdgcn_global_load_lds((const GAS unsigned*)((const GAS char*)(gbase) + vo_), (PG8_LAS unsigned*)(lds + (bufoff) + ldsw + _i * 8192), 16, 0, 0); } } while (0)
#define PG8_LDA(dst, b, h) do { if constexpr (FP8) { _Pragma("unroll") for (int m = 0; m < 4; ++m) { \
            const i32x4 lo_ = *(const PG8_LAS i32x4*)(lds + PG8_SA(b, h) + aoff + m * 2048), hi_ = *(const PG8_LAS i32x4*)(lds + PG8_SA(b, h) + aoff + m * 2048 + 1024); \
            dst##8[m] = (i32x8){lo_[0], lo_[1], lo_[2], lo_[3], hi_[0], hi_[1], hi_[2], hi_[3]}; } } \
        else { _Pragma("unroll") for (int m = 0; m < 4; ++m) _Pragma("unroll") for (int k = 0; k < 2; ++k) dst[m][k] = *(const PG8_LAS f16x8*)(lds + PG8_SA(b, h) + aoff + m * 2048 + k * 1024); } } while (0)
#define PG8_LDB(dst, b, h) do { if constexpr (FP8) { _Pragma("unroll") for (int n = 0; n < 2; ++n) { \
            const i32x4 lo_ = *(const PG8_LAS i32x4*)(lds + PG8_SB(b, h) + boff + n * 2048), hi_ = *(const PG8_LAS i32x4*)(lds + PG8_SB(b, h) + boff + n * 2048 + 1024); \
            dst##8[n] = (i32x8){lo_[0], lo_[1], lo_[2], lo_[3], hi_[0], hi_[1], hi_[2], hi_[3]}; } } \
        else { _Pragma("unroll") for (int n = 0; n < 2; ++n) _Pragma("unroll") for (int k = 0; k < 2; ++k) dst[n][k] = *(const PG8_LAS f16x8*)(lds + PG8_SB(b, h) + boff + n * 2048 + k * 1024); } } while (0)
#define PG8_MMA(ai, bj, At, Bt) do { __builtin_amdgcn_s_setprio(1); \
        if constexpr (FP8) { _Pragma("unroll") for (int m = 0; m < 4; ++m) _Pragma("unroll") for (int n = 0; n < 2; ++n) \
            acc[ai][bj][m][n] = __builtin_amdgcn_mfma_scale_f32_16x16x128_f8f6f4(Bt##8[n], At##8[m], acc[ai][bj][m][n], 0, 0, 0, 0x7f7f7f7f, 0, 0x7f7f7f7f); } \
        else { _Pragma("unroll") for (int m = 0; m < 4; ++m) _Pragma("unroll") for (int n = 0; n < 2; ++n) _Pragma("unroll") for (int k = 0; k < 2; ++k) \
            acc[ai][bj][m][n] = __builtin_amdgcn_mfma_f32_16x16x32_f16(Bt[n][k], At[m][k], acc[ai][bj][m][n], 0, 0, 0); } \
        __builtin_amdgcn_s_setprio(0); } while (0)
#define PG8_WAIT_V(n) asm volatile("s_waitcnt vmcnt(" #n ")" ::: "memory")
#define PG8_WAIT_L(n) asm volatile("s_waitcnt lgkmcnt(" #n ")" ::: "memory")
#define PG8_BAR __builtin_amdgcn_s_barrier()
#define PG8_SCHED __builtin_amdgcn_sched_barrier(0)
#define PG8_GOFF(ix, un, o0, o1) do { int r0_, cnt_; S.rows(ix, r0_, cnt_); const GAS int* lp_ = g.rl + (size_t)((un).pn >> 3) * LISTCAP; \
        _Pragma("unroll") for (int _i = 0; _i < 2; ++_i) { int R_, C_; stage_rc(tid * 16 + _i * 8192, R_, C_); int ra_ = r0_ + R_, rb_ = ra_ + HALF; ra_ = ra_ < cnt_ ? ra_ : cnt_ - 1; rb_ = rb_ < cnt_ ? rb_ : cnt_ - 1; \
            (o0)[_i] = (unsigned)lp_[ra_] * (unsigned)(K * 2) + (unsigned)C_ * 2u; (o1)[_i] = (unsigned)lp_[rb_] * (unsigned)(K * 2) + (unsigned)C_ * 2u; } } while (0)
    Unit cur, nxt; int ui = 0;
    if (!S.next(0, cur)) return;
    f32x4 acc[2][2][4][2];
#pragma unroll
    for (int a = 0; a < 2; ++a)
#pragma unroll
        for (int b = 0; b < 2; ++b)
#pragma unroll
            for (int m = 0; m < 4; ++m)
#pragma unroll
                for (int n = 0; n < 2; ++n) acc[a][b][m][n] = (f32x4){0.f, 0.f, 0.f, 0.f};
    f16x8 At[4][2], B0[2][2], B1[2][2]; i32x8 At8[4], B08[2], B18[2]; (void)At; (void)B0; (void)B1; (void)At8; (void)B08; (void)B18;
    const GAS char* cA = (const GAS char*)g.A + (GATHER ? (size_t)0 : (size_t)cur.pm * tstep); const GAS char* cB = (const GAS char*)g.Bt + (size_t)cur.pn * tstep;
    if constexpr (GATHER) PG8_GOFF(0, cur, oc0, oc1);
    S.a_ready(cur);
    PG8_STAGE(PG8_SB(0, 0), cB, voffB); PG8_STAGE(PG8_SB(0, 1), cB + hstep, voffB); PG8_STAGE(PG8_SA(0, 0), cA, oc0); PG8_STAGE(PG8_SA(0, 1), cA, oc1);
    if (wr == 1) PG8_BAR;
    PG8_WAIT_V(2); PG8_BAR;
    PG8_STAGE(PG8_SB(1, 0), cB + kstep, voffB); PG8_STAGE(PG8_SA(1, 0), cA + kstep, oc0); PG8_STAGE(PG8_SB(1, 1), cB + hstep + kstep, voffB);
    PG8_WAIT_V(6); PG8_BAR;
    for (;;) {
        const bool has_next = S.next(ui + 1, nxt);
        const GAS char* nA = (has_next && !GATHER) ? (const GAS char*)g.A + (size_t)nxt.pm * tstep : cA; const GAS char* nB = has_next ? (const GAS char*)g.Bt + (size_t)nxt.pn * tstep : cB;
        if constexpr (GATHER) { if (has_next) PG8_GOFF(ui + 1, nxt, on0, on1); }
        Pre4 epre; if constexpr (Epi::PRELOAD) epre = E.pre(cur, wr, wc, fr, fq);
#pragma unroll 1
        for (int t = 0; t < nt; ++t) {
            const int b = t & 1;
            const bool w1 = (t + 1 >= nt), w2 = (t + 2 >= nt);
            const GAS char* a1 = (w1 ? nA : cA) + (size_t)(w1 ? t + 1 - nt : t + 1) * kstep;
            const GAS char* a2 = (w2 ? nA : cA) + (size_t)(w2 ? t + 2 - nt : t + 2) * kstep;
            const GAS char* b2 = (w2 ? nB : cB) + (size_t)(w2 ? t + 2 - nt : t + 2) * kstep;
            unsigned x0[2], y1[2];
#pragma unroll
            for (int i = 0; i < 2; ++i) { y1[i] = (GATHER && w1 && has_next) ? on1[i] : oc1[i]; x0[i] = (GATHER && w2 && has_next) ? on0[i] : oc0[i]; }
            if (t == nt - 2 && has_next) S.a_ready(nxt);
            if constexpr (ROWSCALE) { if (t == 4) {
#pragma unroll
                for (int ai = 0; ai < 2; ++ai) { f32x4 q4[4];
#pragma unroll
                    for (int m = 0; m < 4; ++m) q4[m] = *(const GAS f32x4*)(g.ssq + (size_t)(cur.pm * BM + ai * HALF + wr * 64 + m * 16 + fr) * 4);
#pragma unroll
                    for (int m = 0; m < 4; ++m) { const float rs = rsqrtf(((q4[m].x + q4[m].y) + (q4[m].z + q4[m].w)) * (1.f / 256.f) + EPS);
#pragma unroll
                        for (int bj = 0; bj < 2; ++bj)
#pragma unroll
                            for (int n = 0; n < 2; ++n) acc[ai][bj][m][n] *= rs; } } } }
            PG8_LDB(B0, b, 0); PG8_LDB(B1, b, 1); PG8_SCHED; PG8_LDA(At, b, 0); PG8_STAGE(PG8_SA(b ^ 1, 1), a1, y1);
            PG8_WAIT_V(8); PG8_WAIT_L(0); PG8_BAR; PG8_MMA(0, 0, At, B0); PG8_MMA(0, 1, At, B1); PG8_BAR; PG8_SCHED;
            PG8_LDA(At, b, 1); PG8_STAGE(PG8_SB(b, 0), b2, voffB); PG8_STAGE(PG8_SB(b, 1), b2 + hstep, voffB); PG8_STAGE(PG8_SA(b, 0), a2, x0);
            PG8_WAIT_V(8); PG8_WAIT_L(0); PG8_BAR; PG8_MMA(1, 0, At, B0); PG8_MMA(1, 1, At, B1); PG8_BAR; PG8_SCHED;
        }
        if (wr == 0) PG8_BAR;
        if constexpr (!Epi::PRELOAD) epre = E.pre(cur, wr, wc, fr, fq);
        E(acc, cur, wr, wc, fr, fq, epre); S.done(cur);
        if (!has_next) break;
#pragma unroll
        for (int a = 0; a < 2; ++a)
#pragma unroll
            for (int b = 0; b < 2; ++b)
#pragma unroll
                for (int m = 0; m < 4; ++m)
#pragma unroll
                    for (int n = 0; n < 2; ++n) acc[a][b][m][n] = (f32x4){0.f, 0.f, 0.f, 0.f};
        cur = nxt; cA = nA; cB = nB; ++ui;
        if constexpr (GATHER) {
#pragma unroll
            for (int i = 0; i < 2; ++i) { oc0[i] = on0[i]; oc1[i] = on1[i]; } }
        if (wr == 1) PG8_BAR;
    }
    PG8_WAIT_V(0);
    PG8_BAR;
#undef PG8_SA
#undef PG8_SB
#undef PG8_STAGE
#undef PG8_LDA
#undef PG8_LDB
#undef PG8_MMA
#undef PG8_WAIT_V
#undef PG8_WAIT_L
#undef PG8_BAR
#undef PG8_SCHED
#undef PG8_GOFF
}
}

constexpr size_t MiB = 1u << 20;
constexpr size_t WS_CTL   = 0,            CTL_ZERO_BYTES = 1 * MiB;
constexpr size_t WS_MOD   = 1 * MiB;
constexpr size_t WS_KMEAN = 2 * MiB;
constexpr size_t WS_SSQ   = 2 * MiB + 512 * 1024;
constexpr size_t WS_SGUW  = 3 * MiB;
constexpr size_t WS_RWT   = 3 * MiB + 512 * 1024;
constexpr size_t WS_PWT   = 3 * MiB + 768 * 1024;
constexpr size_t WS_ROUTE = 4 * MiB;
constexpr size_t WS_LIST  = 6 * MiB;
constexpr size_t WS_WIN   = 10 * MiB;
constexpr size_t WS_WOUT  = 18 * MiB;
constexpr size_t WS_W1    = 22 * MiB;
constexpr size_t WS_W2    = 278 * MiB;
constexpr size_t WS_X     = 406 * MiB;
constexpr size_t WS_H     = 534 * MiB;
constexpr size_t WS_PROJ  = 598 * MiB;
constexpr size_t WS_MIX   = 726 * MiB;
constexpr size_t WS_XS    = 790 * MiB;
constexpr size_t WS_ACT   = 1062 * MiB;
constexpr size_t WS_WIN8  = 1334 * MiB;
constexpr size_t WS_HB8   = 1338 * MiB;
constexpr size_t WS_END   = 1370 * MiB;
constexpr int CW_BAR = 4096;
constexpr int CW_CNT = 16384;

constexpr int RING_BYTES = 131072;
constexpr int LDS_BYTES = 147456;
constexpr int BARST_OFF = LDS_BYTES - 64;
constexpr int NWAVES = 8;
#ifndef PH3
#define PH3 15
#endif
#define GIN(k) ((const GAS float*)AP->in[k])
#define REPS(bit) (((PROBE) & (bit)) ? 2 : 1)
#ifndef PHMASK
#define PHMASK 0xFFFF
#endif

#define XB_TMO      128
#define XB_XCNT(j)  (256  + 64 * (j))
#define XB_XSUB(j)  (1280 + 64 * (j))
#define XB_XGEN(j)  (2304 + 64 * (j))
#define XB_TOP      3328
#define XB_TOPGEN   3392
#define XCD_BAR_WORDS 3456
#define XB_SPIN_CAP (1u << 20)
__device__ __forceinline__ unsigned xb_ld(unsigned* p)              { return __hip_atomic_load(p, __ATOMIC_RELAXED, __HIP_MEMORY_SCOPE_AGENT); }
__device__ __forceinline__ unsigned xb_add(unsigned* p, unsigned v) { return __hip_atomic_fetch_add(p, v, __ATOMIC_RELAXED, __HIP_MEMORY_SCOPE_AGENT); }
__device__ __forceinline__ unsigned xb_xcc_id() { return (unsigned)__builtin_amdgcn_s_getreg((3 << 11) | 20) & 0xFu; }
#define XB_SPIN(cond, bar) do { unsigned _sp = 0; while (cond) { __builtin_amdgcn_s_sleep(1); \
    if ((++_sp & 255u) == 0u) { if (xb_ld(&(bar)[XB_TMO])) break; if (_sp > XB_SPIN_CAP) { atomicAdd(&(bar)[XB_TMO], 1u); break; } } } } while (0)
struct XcdBarrier { unsigned* bar; unsigned x; volatile LAS unsigned* st; };
__device__ __forceinline__ XcdBarrier xcd_barrier_post(unsigned* bar, volatile LAS unsigned* st) {
    XcdBarrier b; b.bar = bar; b.x = xb_xcc_id(); b.st = st;
    if (threadIdx.x == 0) (void)xb_add(&bar[XB_XCNT(b.x)], 1u);
    return b;
}
__device__ __forceinline__ void xcd_barrier_complete(unsigned* bar, unsigned x, unsigned& nloc, unsigned& nx) {
    const unsigned G = gridDim.x * gridDim.y * gridDim.z;
    unsigned sum, cnt, mine, sp = 0u;
    for (;;) {
        sum = 0u; cnt = 0u; mine = 0u;
#pragma unroll
        for (unsigned j = 0; j < 16; ++j) { const unsigned c = xb_ld(&bar[XB_XCNT(j)]); sum += c; cnt += (c > 0u) ? 1u : 0u; mine = (j == x) ? c : mine; }
        if (sum == G) break;
        __builtin_amdgcn_s_sleep(1);
        if ((++sp & 255u) == 0u) { if (xb_ld(&bar[XB_TMO])) break; if (sp > XB_SPIN_CAP) { atomicAdd(&bar[XB_TMO], 1u); break; } }
    }
    nloc = mine > 0u ? mine : 1u; nx = cnt > 0u ? cnt : 1u;
}
__device__ __forceinline__ void xcd_barrier(const XcdBarrier& b) {
    asm volatile("s_waitcnt vmcnt(0)" ::: "memory");
    __syncthreads();
    if (threadIdx.x == 0) {
        unsigned* bar = b.bar; asm volatile("" : "+s"(bar));
        unsigned bx = b.x; asm volatile("" : "+s"(bx));
        __builtin_amdgcn_s_waitcnt(0);
        unsigned nloc = b.st[0], nx = b.st[1];
        if (nloc == 0u) { xcd_barrier_complete(bar, bx, nloc, nx); b.st[0] = nloc; b.st[1] = nx; }
        const unsigned old = xb_add(&bar[XB_XSUB(bx)], 1u);
        const unsigned gen = old / nloc;
        if (old + 1u == (gen + 1u) * nloc) {
            __builtin_amdgcn_fence(__ATOMIC_RELEASE, "agent");
            asm volatile("s_waitcnt vmcnt(0)" ::: "memory");
            const unsigned og = xb_add(&bar[XB_TOP], 1u);
            const unsigned tg = og / nx;
            if (og + 1u == (tg + 1u) * nx) xb_add(&bar[XB_TOPGEN], 1u);
            else XB_SPIN(xb_ld(&bar[XB_TOPGEN]) == tg, bar);
            __builtin_amdgcn_fence(__ATOMIC_ACQUIRE, "agent");
            xb_add(&bar[XB_XGEN(bx)], 1u);
            asm volatile("s_waitcnt vmcnt(0)" ::: "memory");
        } else {
            XB_SPIN(xb_ld(&bar[XB_XGEN(bx)]) == gen, bar);
            __builtin_amdgcn_fence(__ATOMIC_ACQUIRE, "agent");
            asm volatile("s_waitcnt vmcnt(0)" ::: "memory");
        }
    }
    __syncthreads();
}

struct Args { const float* in[27]; float* out; unsigned char* ws; };
enum { I_X = 0, I_C, I_WMOD, I_BMOD, I_N1G, I_WIN, I_CONVW, I_CONVB, I_CNG, I_CNB, I_RELB, I_POOLW, I_POOLS, I_SNG, I_SNB, I_SGUW, I_SGUB, I_MIXG, I_WOUT, I_N2G, I_RW, I_RB, I_W1, I_B1, I_W2, I_B2, I_FNG };

__device__ __forceinline__ int t5_bucket(int n) {
    if (n < 16) return n;
    int b = 16;
    b += (n >= 19); b += (n >= 21); b += (n >= 24); b += (n >= 27); b += (n >= 31); b += (n >= 35); b += (n >= 40); b += (n >= 46);
    b += (n >= 52); b += (n >= 59); b += (n >= 67); b += (n >= 77); b += (n >= 87); b += (n >= 99); b += (n >= 113);
    return b;
}

__device__ __forceinline__ void transpose_item(const GAS float* W, int K, int N, GAS f16* WT, int orow0, int k0, int n0, const GAS float* kscale, LAS float* scr, int lane, int ko = -1) {
    if (ko < 0) ko = k0;
#pragma unroll 8
    for (int i = 0; i < 32; ++i) { const int kk = 2 * i + (lane >> 5); float v = W[(size_t)(k0 + kk) * N + n0 + (lane & 31)]; if (kscale) v *= kscale[k0 + kk]; scr[kk * 33 + (lane & 31)] = v; }
    asm volatile("s_waitcnt lgkmcnt(0)" ::: "memory");
    const int c = lane & 7;
#pragma unroll
    for (int j = 0; j < 4; ++j) { const int n = (lane >> 3) + 8 * j; const LAS float* s = scr + (8 * c) * 33 + n;
        u32x4 o; o.x = pk_f16(s[0 * 33], s[1 * 33]); o.y = pk_f16(s[2 * 33], s[3 * 33]); o.z = pk_f16(s[4 * 33], s[5 * 33]); o.w = pk_f16(s[6 * 33], s[7 * 33]);
        *(GAS u32x4*)(WT + (size_t)(orow0 + n) * K + ko + 8 * c) = o; }
    asm volatile("s_waitcnt lgkmcnt(0)" ::: "memory");
}

__device__ __forceinline__ void transpose_item8(const GAS float* W, int K, int N, GAS unsigned char* WT, int orow0, int k0, int n0, LAS float* scr, int lane) {
#pragma unroll 8
    for (int i = 0; i < 32; ++i) { const int kk = 2 * i + (lane >> 5); scr[kk * 33 + (lane & 31)] = W[(size_t)(k0 + kk) * N + n0 + (lane & 31)] * W8_SCALE; }
    asm volatile("s_waitcnt lgkmcnt(0)" ::: "memory");
    const int c = lane & 7;
#pragma unroll
    for (int j = 0; j < 4; ++j) { const int n = (lane >> 3) + 8 * j; const LAS float* s = scr + (8 * c) * 33 + n;
        u32x2 o; o.x = pk4_fp8(s[0 * 33], s[1 * 33], s[2 * 33], s[3 * 33]); o.y = pk4_fp8(s[4 * 33], s[5 * 33], s[6 * 33], s[7 * 33]);
        *(GAS u32x2*)(WT + (size_t)(orow0 + n) * K + k0 + 8 * c) = o; }
    asm volatile("s_waitcnt lgkmcnt(0)" ::: "memory");
}

__device__ __forceinline__ void transpose_item8x64(const GAS float* W, int K, int N, GAS unsigned char* WT, int orow0, int k0, int n0, LAS float* scr, int lane) {
    f32x4 v[16];
#pragma unroll
    for (int i = 0; i < 16; ++i) v[i] = *(const GAS f32x4*)(W + (size_t)(k0 + 4 * i + (lane >> 4)) * N + n0 + 4 * (lane & 15));
#pragma unroll
    for (int i = 0; i < 16; ++i) { LAS float* d = scr + (4 * i + (lane >> 4)) * 65 + 4 * (lane & 15); d[0] = v[i].x * W8_SCALE; d[1] = v[i].y * W8_SCALE; d[2] = v[i].z * W8_SCALE; d[3] = v[i].w * W8_SCALE; }
    asm volatile("s_waitcnt lgkmcnt(0)" ::: "memory");
    const int c = lane & 7;
#pragma unroll
    for (int j = 0; j < 8; ++j) { const int n = (lane >> 3) + 8 * j; const LAS float* s = scr + (8 * c) * 65 + n;
        u32x2 o; o.x = pk4_fp8(s[0 * 65], s[1 * 65], s[2 * 65], s[3 * 65]); o.y = pk4_fp8(s[4 * 65], s[5 * 65], s[6 * 65], s[7 * 65]);
        *(GAS u32x2*)(WT + (size_t)(orow0 + n) * K + k0 + 8 * c) = o; }
    asm volatile("s_waitcnt lgkmcnt(0)" ::: "memory");
}

__device__ __forceinline__ void norm_mod_row(const GAS float* xrow, const GAS float* g, const GAS float* shift, const GAS float* scale, GAS f16* orow, GAS unsigned char* orow8, int lane) {
    f32x4 v[4]; float s = 0.f;
#pragma unroll
    for (int j = 0; j < 4; ++j) { v[j] = *(const GAS f32x4*)(xrow + 4 * lane + 256 * j); s += (v[j].x * v[j].x + v[j].y * v[j].y) + (v[j].z * v[j].z + v[j].w * v[j].w); }
    const float rstd = rsqrtf(wave_sum(s) * (1.f / DM) + EPS);
#pragma unroll
    for (int j = 0; j < 4; ++j) { const int c = 4 * lane + 256 * j; const f32x4 gg = *(const GAS f32x4*)(g + c), sh = *(const GAS f32x4*)(shift + c), sc = *(const GAS f32x4*)(scale + c);
        const f32x4 h = (v[j] * rstd) * gg * (sc + 1.0f) + sh;
        u32x2 w; w.x = pk_f16(h.x, h.y); w.y = pk_f16(h.z, h.w); *(GAS u32x2*)(orow + c) = w;
        if (PROJ_FP8 && PROJ_FP8_FIRST == 0) *(GAS unsigned*)(orow8 + c) = pk4_fp8(h.x, h.y, h.z, h.w); }
}

extern __shared__ __attribute__((aligned(16))) unsigned char lds[];
#define LAUNDER() int tid = tid0; asm volatile("" : "+v"(tid)); const int lane = tid & 63; int wave = wave0; asm volatile("" : "+s"(wave)); const int gw = bid * NWAVES + wave; (void)gw; (void)lane; const CAS Args* AP = (const CAS Args*)__builtin_amdgcn_kernarg_segment_ptr(); asm volatile("" : "+s"(AP)); (void)AP; LAS unsigned char* Lp = (LAS unsigned char*)lds; asm volatile("" : "+s"(Lp)); (void)Lp; GAS unsigned char* ws = (GAS unsigned char*)AP->ws; GAS unsigned* ctl = (GAS unsigned*)(ws + WS_CTL); GAS float* MOD = (GAS float*)(ws + WS_MOD); GAS float* KMEAN = (GAS float*)(ws + WS_KMEAN); GAS float* SSQ = (GAS float*)(ws + WS_SSQ); (void)SSQ; GAS f16* SGUW = (GAS f16*)(ws + WS_SGUW); GAS f16* RWT16 = (GAS f16*)(ws + WS_RWT); (void)RWT16; GAS unsigned char* WIN8 = (GAS unsigned char*)(ws + WS_WIN8); (void)WIN8; GAS unsigned char* HB8 = (GAS unsigned char*)(ws + WS_HB8); (void)HB8; GAS f16* PWT = (GAS f16*)(ws + WS_PWT); (void)PWT; GAS int* ROUTE_E = (GAS int*)(ws + WS_ROUTE); GAS int* ROUTE_POS = ROUTE_E + NTOK * 4; GAS float* ROUTE_G = (GAS float*)(ROUTE_POS + NTOK * 4); GAS int* LIST = (GAS int*)(ws + WS_LIST); GAS f16* WIN_T = (GAS f16*)(ws + WS_WIN); GAS f16* WOUT_T = (GAS f16*)(ws + WS_WOUT); GAS f16* W1_T = (GAS f16*)(ws + WS_W1); GAS f16* W2_T = (GAS f16*)(ws + WS_W2); GAS f16* X = (GAS f16*)(ws + WS_X); GAS f16* H = (GAS f16*)(ws + WS_H); GAS f16* PROJ = (GAS f16*)(ws + WS_PROJ); GAS f16* MIX = (GAS f16*)(ws + WS_MIX); GAS f16* XS = (GAS f16*)(ws + WS_XS); GAS f16* ACT = (GAS f16*)(ws + WS_ACT); (void)ctl; (void)MOD; (void)KMEAN; (void)SGUW; (void)ROUTE_E; (void)ROUTE_POS; (void)ROUTE_G; (void)LIST; (void)WIN_T; (void)WOUT_T; (void)W1_T; (void)W2_T; (void)X; (void)H; (void)PROJ; (void)MIX; (void)XS; (void)ACT;
__device__ __forceinline__ void layer_body(const int l, const XcdBarrier bar, const int tid0, const int wave0, const int G, const int bid, const int NGW) {
#define MODL (MOD + (size_t)l * 8 * 6144)
for (int rep_ = 0; rep_ < REPS(4); ++rep_) if (PHMASK & 4) { LAUNDER();
        if (PROJ_FP8 && l >= PROJ_FP8_FIRST) {
            { pg8::Gemm g{(const GAS pg8::h16_t*)H, (const GAS pg8::h16_t*)(WIN_T + (size_t)l * INW * DM), NTOK, 512, DM, nullptr, nullptr}; pg8::MapOrder S; S.init(NTOK, 512, G, bid); S.map = 0x32u;
              pg8::EpiF16 E{(GAS pg8::h16_t*)PROJ, INW, KMEAN, 1.0f};
              pg8::gemm_phase<pg8::EpiF16, pg8::MapOrder, false, false>(Lp, g, S, E, tid); }
            { pg8::Gemm g{(const GAS pg8::h16_t*)HB8, (const GAS pg8::h16_t*)(WIN8 + (size_t)l * INW * DM), NTOK, 1536, DM / 2, nullptr, nullptr}; pg8::MapOrder S; S.init(NTOK, 1536, G, bid); S.map = 0x765410u;
              pg8::EpiF16 E{(GAS pg8::h16_t*)PROJ, INW, KMEAN, W8_INV};
              pg8::gemm_phase<pg8::EpiF16, pg8::MapOrder, false, true>(Lp, g, S, E, tid); }
        } else {
        { pg8::Gemm g{(const GAS pg8::h16_t*)H, (const GAS pg8::h16_t*)(WIN_T + (size_t)l * INW * DM), NTOK, INW, DM, nullptr, nullptr}; pg8::StaticOrder S; S.init(NTOK, INW, G, bid);
          pg8::EpiF16 E{(GAS pg8::h16_t*)PROJ, INW, KMEAN, 1.0f};
          pg8::gemm_phase<pg8::EpiF16, pg8::StaticOrder, false>(Lp, g, S, E, tid); }
        }
}
        xcd_barrier(bar);
        STAMP(3 + 9 * l + 0);

for (int rep_ = 0; rep_ < REPS(8); ++rep_) if (PHMASK & 8) {
        for (int it_ = bid; it_ < 256 + 512 + 512; it_ += G) { int it = it_; asm volatile("" : "+s"(it));
            if ((PH3 & 1) && it < 256) {
                LAUNDER();
                const int T0 = it * 128;
                LAS f16* vT = (LAS f16*)Lp;
                constexpr int VS = 136;
                const GAS float* sng = GIN(I_SNG) + l * GW; const GAS float* snb = GIN(I_SNB) + l * GW;
                f16x8 afr[4][4];
#pragma unroll
                for (int ks = 0; ks < 4; ++ks)
#pragma unroll
                    for (int h = 0; h < 4; ++h) afr[ks][h] = *(const GAS f16x8*)(SGUW + ((size_t)(l * 4 + h) * 128 + 16 * wave + (lane & 15)) * 128 + 32 * ks + 8 * (lane >> 4));
#pragma unroll 1
                for (int tg = 0; tg < 16; tg += 4) { f16x4 hvv[4];
#pragma unroll
                  for (int t4 = 0; t4 < 4; ++t4) hvv[t4] = *(const GAS f16x4*)(PROJ + (size_t)(T0 + wave * 16 + tg + t4) * INW + 1792 + 4 * lane);
#pragma unroll
                  for (int t4 = 0; t4 < 4; ++t4) { const int tl = wave * 16 + tg + t4;
                    const f16x4 hv = hvv[t4]; float v[4]; float s = 0.f;
#pragma unroll
                    for (int i = 0; i < 4; ++i) { v[i] = gelu_erf((float)hv[i]); s += v[i]; }
                    const float mean = wave_sum(s) * (1.f / 256.f); float q = 0.f;
#pragma unroll
                    for (int i = 0; i < 4; ++i) { v[i] -= mean; q += v[i] * v[i]; }
                    const float rstd = rsqrtf(wave_sum(q) * (1.f / 256.f) + EPS);
#pragma unroll
                    for (int i = 0; i < 4; ++i) { const int c = 4 * lane + i; vT[c * VS + tl] = (f16)(v[i] * rstd * sng[c] + snb[c]); } } }
                __syncthreads();
                f32x4 acc[4][4];
#pragma unroll
                for (int h = 0; h < 4; ++h)
#pragma unroll
                    for (int ct = 0; ct < 4; ++ct) acc[h][ct] = (f32x4){0.f, 0.f, 0.f, 0.f};
                const int nk = (wave >> 1) + 1, fr = lane & 15, fq = lane >> 4;
#pragma unroll
                for (int ks = 0; ks < 4; ++ks) { if (ks < nk) {
#pragma unroll
                    for (int h = 0; h < 4; ++h) {
                        const f16x8 a = afr[ks][h];
#pragma unroll
                        for (int ct = 0; ct < 4; ++ct) { const f16x8 b = *(const LAS f16x8*)(vT + (h * 64 + ct * 16 + fr) * VS + 32 * ks + 8 * fq);
                            acc[h][ct] = __builtin_amdgcn_mfma_f32_16x16x32_f16(a, b, acc[h][ct], 0, 0, 0); } } } }
                const GAS float* sb = GIN(I_SGUB) + (size_t)l * 4 * 128;
#pragma unroll
                for (int reg = 0; reg < 4; ++reg) { const int il = 16 * wave + 4 * fq + reg; const size_t tok = (size_t)(T0 + il); float ss = 0.f; float val[4][4];
#pragma unroll
                    for (int h = 0; h < 4; ++h) { const float bia = sb[h * 128 + il];
#pragma unroll
                        for (int ct = 0; ct < 4; ++ct) { const int c = h * 64 + ct * 16 + fr; const float u = gelu_erf((float)PROJ[tok * INW + 1536 + c]);
                            const float x = (acc[h][ct][reg] + bia) * u; val[h][ct] = x; ss += x * x; } }
                    ss = row16_sum(ss);
                    const float rstd = rsqrtf(ss * (1.f / 256.f) + EPS);
#pragma unroll
                    for (int h = 0; h < 4; ++h)
#pragma unroll
                        for (int ct = 0; ct < 4; ++ct) MIX[tok * DM + 768 + h * 64 + ct * 16 + fr] = (f16)(val[h][ct] * rstd); }
                __syncthreads();
            } else if ((PH3 & 2) && it < 768) {
                LAUNDER();
                const int T0 = (it - 256) * 64, p0 = T0 & (SEQ - 1);
                LAS float* y = (LAS float*)Lp;
                LAS float* Wc = (LAS float*)(Lp + 96256);
                for (int i = tid; i < 31 * 64; i += 512) *(LAS f32x4*)(Wc + 4 * i) = *(const GAS f32x4*)(GIN(I_CONVW) + (size_t)l * 31 * GW + 4 * i);
                { f16x8 av[6], gv[6];
#pragma unroll
                  for (int k6 = 0; k6 < 6; ++k6) { int task = tid + k6 * 512; task = task < 94 * 32 ? task : 94 * 32 - 1; const int r = task >> 5, c8 = (task & 31) * 8; const bool ok = (p0 - 30 + r >= 0);
                      const GAS f16* pr = PROJ + (size_t)(T0 + (ok ? r - 30 : 0)) * INW + c8; av[k6] = *(const GAS f16x8*)pr; gv[k6] = *(const GAS f16x8*)(pr + 256); }
#pragma unroll
                  for (int k6 = 0; k6 < 6; ++k6) { const int task = tid + k6 * 512;
                      if (task < 94 * 32) { const int r = task >> 5, c8 = (task & 31) * 8; const bool ok = (p0 - 30 + r >= 0); float o[8];
#pragma unroll
                          for (int i = 0; i < 8; ++i) o[i] = ok ? (float)av[k6][i] * sigmoidf_((float)gv[k6][i]) : 0.f;
                          *(LAS f32x4*)(y + r * 256 + c8) = (f32x4){o[0], o[1], o[2], o[3]}; *(LAS f32x4*)(y + r * 256 + c8 + 4) = (f32x4){o[4], o[5], o[6], o[7]}; } } }
                __syncthreads();
                float psq[8];
#pragma unroll
                for (int t = 0; t < 8; ++t) psq[t] = 0.f;
                float osv[4][8];
#pragma unroll
                for (int h = 0; h < 4; ++h) { const int c = h * 64 + lane; float w[31];
#pragma unroll
                    for (int j = 0; j < 31; ++j) w[j] = Wc[j * 256 + c];
                    const float cb = GIN(I_CONVB)[l * GW + c], ng = GIN(I_CNG)[l * GW + c], nb_ = GIN(I_CNB)[l * GW + c];
                    float yv[38];
#pragma unroll
                    for (int q = 0; q < 38; ++q) yv[q] = y[(wave * 8 + q) * 256 + c];
                    float a[8], red[16];
#pragma unroll
                    for (int t = 0; t < 8; ++t) { float s = cb;
#pragma unroll
                        for (int j = 0; j < 31; ++j) s += w[j] * yv[t + j];
                        a[t] = s; red[t] = s; red[8 + t] = s * s; }
                    wave_sum_n<16>(red);
#pragma unroll
                    for (int t = 0; t < 8; ++t) { const float mean = red[t] * (1.f / 64.f), var = fmaxf(red[8 + t] * (1.f / 64.f) - mean * mean, 0.f);
                        const float yn = (a[t] - mean) * rsqrtf(var + EPS) * ng + nb_; const float sv = yn * sigmoidf_(yn);
                        psq[t] += sv * sv; osv[h][t] = sv; }
                    asm volatile("" ::: "memory"); }
                wave_sum_n<8>(psq);
#pragma unroll
                for (int t = 0; t < 8; ++t) psq[t] = rsqrtf(psq[t] * (1.f / 256.f) + EPS);
#pragma unroll
                for (int h = 0; h < 4; ++h)
#pragma unroll
                    for (int t = 0; t < 8; ++t) MIX[(size_t)(T0 + wave * 8 + t) * DM + 256 + h * 64 + lane] = (f16)(osv[h][t] * psq[t]);
                __syncthreads();
            } else if ((PH3 & 4) && it < 1280) {
                LAUNDER();
                const int T0 = (it - 768) * 64, p0 = T0 & (SEQ - 1);
                LAS f16* zt = (LAS f16*)Lp;
                LAS f16* Pf = (LAS f16*)(Lp + 40960);
                LAS f16* WpT = (LAS f16*)(Lp + 75776);
                constexpr int PS = 264, WS2 = 72;
                for (int i = tid; i < 256 * 8; i += 512) { const int r = i >> 3, c8 = (i & 7) * 8; *(LAS u32x4*)(WpT + r * WS2 + c8) = *(const GAS u32x4*)(PWT + (size_t)l * 16384 + r * 64 + c8); }
                for (int task = tid; task < 79 * 32; task += 512) { const int r = task >> 5, c8 = (task & 31) * 8; u32x4 z = {0u, 0u, 0u, 0u};
                    if (p0 - 15 + r >= 0) z = *(const GAS u32x4*)(PROJ + (size_t)(T0 - 15 + r) * INW + 1280 + c8);
                    *(LAS u32x4*)(zt + r * 256 + c8) = z; }
                __syncthreads();
                { const int c8 = (tid & 31) * 8, seg = tid >> 5, gi = c8 >> 6, w = 2 << gi; float s[8];
#pragma unroll
                  for (int i = 0; i < 8; ++i) s[i] = 0.f;
                  for (int d = 1; d < w; ++d) { const f16x8 z = *(const LAS f16x8*)(zt + (seg * 4 + 15 - d) * 256 + c8);
#pragma unroll
                      for (int i = 0; i < 8; ++i) s[i] += (float)z[i]; }
#pragma unroll
                  for (int t = 0; t < 4; ++t) { const int tl = seg * 4 + t, p = p0 + tl;
                      const f16x8 zn = *(const LAS f16x8*)(zt + (tl + 15) * 256 + c8);
                      const float inv = 1.f / (float)(p + 1 < w ? p + 1 : w); f16x8 po;
#pragma unroll
                      for (int i = 0; i < 8; ++i) { s[i] += (float)zn[i]; po[i] = (f16)(s[i] * inv - (float)zn[i]); }
                      *(LAS f16x8*)(Pf + tl * PS + c8) = po;
                      const f16x8 zo = *(const LAS f16x8*)(zt + (tl + 15 - (w - 1)) * 256 + c8);
#pragma unroll
                      for (int i = 0; i < 8; ++i) s[i] -= (float)zo[i]; } }
                __syncthreads();
                if (wave < 4) {
                    const int fr = lane & 15, fq = lane >> 4;
                    f32x4 acc[4][4];
#pragma unroll
                    for (int g = 0; g < 4; ++g)
#pragma unroll
                        for (int nt = 0; nt < 4; ++nt) acc[g][nt] = (f32x4){0.f, 0.f, 0.f, 0.f};
#pragma unroll
                    for (int g = 0; g < 4; ++g)
#pragma unroll
                        for (int ks = 0; ks < 2; ++ks) { const f16x8 av = *(const LAS f16x8*)(Pf + (16 * wave + fr) * PS + g * 64 + 32 * ks + 8 * fq);
#pragma unroll
                            for (int nt = 0; nt < 4; ++nt) { const f16x8 bv = *(const LAS f16x8*)(WpT + (g * 64 + nt * 16 + fr) * WS2 + 32 * ks + 8 * fq);
                                acc[g][nt] = __builtin_amdgcn_mfma_f32_16x16x32_f16(av, bv, acc[g][nt], 0, 0, 0); } }
                    float psc[4][4];
#pragma unroll
                    for (int g = 0; g < 4; ++g)
#pragma unroll
                        for (int nt = 0; nt < 4; ++nt) psc[g][nt] = GIN(I_POOLS)[l * GW + g * 64 + nt * 16 + fr];
#pragma unroll
                    for (int reg = 0; reg < 4; ++reg) { float ss = 0.f;
#pragma unroll
                        for (int g = 0; g < 4; ++g)
#pragma unroll
                            for (int nt = 0; nt < 4; ++nt) { const float x = acc[g][nt][reg] * psc[g][nt]; acc[g][nt][reg] = x; ss += x * x; }
                        ss = row16_sum(ss);
                        const float rstd = rsqrtf(ss * (1.f / 256.f) + EPS); const size_t tok = (size_t)(T0 + 16 * wave + 4 * fq + reg);
#pragma unroll
                        for (int g = 0; g < 4; ++g)
#pragma unroll
                            for (int nt = 0; nt < 4; ++nt) MIX[tok * DM + 512 + g * 64 + nt * 16 + fr] = (f16)(acc[g][nt][reg] * rstd); }
                }
                __syncthreads();
            }
        }
}
        STAMP(3 + 9 * l + 1);

for (int rep_ = 0; rep_ < REPS(16); ++rep_) if (PHMASK & 16) { LAUNDER();
        {
            LAS f16* Kb = (LAS f16*)Lp;
            LAS f16* Vb = (LAS f16*)(Lp + 36864);
            LAS float* kml = (LAS float*)(Lp + 73728);
            LAS float* lut = (LAS float*)(Lp + 73728 + 4096);
            constexpr int KS = 72;
            constexpr float LOG2E = 1.4426950408889634f, SC2 = 0.125f * LOG2E, THR = 4.0f;
            const int r32 = lane & 31, hh = lane >> 5;
            const int vtr_off = (4 * hh + ((lane & 15) >> 2)) * KS + 16 * ((lane >> 4) & 1) + 4 * (lane & 3);
            const int lk = tid >> 3, lc = tid & 7;
            for (int pi = bid; pi < 256; pi += G) {
                const int bh = pi >> 3, pp = pi & 7;
                for (int half = 0; half < 2; ++half) {
                    const int own = half == 0 ? 15 - pp : pp;
                    const int b = bh >> 2, h = bh & 3;
                    const size_t TB = (size_t)b * SEQ;
                    const int qpos = own * 256 + 32 * wave + r32;
                    const GAS f16* kvp = PROJ + (TB + lk) * INW + 768 + h * 64 + 8 * lc;
                    f16x8 kr[4], vr[4];
#pragma unroll
                    for (int pc = 0; pc < 4; ++pc) { const GAS f16* p_ = kvp + (size_t)(64 * pc) * INW; kr[pc] = *(const GAS f16x8*)p_; vr[pc] = *(const GAS f16x8*)(p_ + 256); }
                    __syncthreads();
                    for (int i = tid; i < 1024; i += 512) kml[i] = KMEAN[((size_t)(b * 16 + (i >> 6))) * 256 + h * 64 + (i & 63)] * (1.f / 256.f);
                    if (tid < 128) lut[tid] = GIN(I_RELB)[t5_bucket(tid) * 4 + h] * LOG2E;
                    f16x8 qf[4];
                    { const GAS f16* qp = PROJ + (TB + qpos) * INW + 512 + h * 64 + 8 * hh;
#pragma unroll
                      for (int s = 0; s < 4; ++s) qf[s] = *(const GAS f16x8*)(qp + 16 * s); }
                    __syncthreads();
                    unsigned mask = 0u;
                    { float gsc[16]; float qv[32];
#pragma unroll
                      for (int s = 0; s < 4; ++s)
#pragma unroll
                          for (int j = 0; j < 8; ++j) qv[8 * s + j] = (float)qf[s][j];
#pragma unroll
                      for (int n = 0; n < 16; ++n) { float a = 0.f;
                          if (n < own) { f32x4 kv[8];
#pragma unroll
                              for (int s = 0; s < 4; ++s) { kv[2 * s] = *(const LAS f32x4*)(kml + n * 64 + 16 * s + 8 * hh); kv[2 * s + 1] = *(const LAS f32x4*)(kml + n * 64 + 16 * s + 8 * hh + 4); }
#pragma unroll
                              for (int s = 0; s < 8; ++s) a += (qv[4 * s] * kv[s].x + qv[4 * s + 1] * kv[s].y) + (qv[4 * s + 2] * kv[s].z + qv[4 * s + 3] * kv[s].w); }
                          a += __shfl_xor(a, 32); gsc[n] = a; }
#pragma unroll
                      for (int k = 0; k < 3; ++k) { float best = -INFINITY; int bi = -1;
#pragma unroll
                          for (int n = 0; n < 16; ++n) { const bool ok = (n < own) && !((mask >> n) & 1u) && (gsc[n] > best); if (ok) { best = gsc[n]; bi = n; } }
                          if (bi >= 0) mask |= 1u << bi; }
#pragma unroll
                      for (int s = 0; s < 4; ++s)
#pragma unroll
                          for (int j = 0; j < 8; ++j) qf[s][j] = (f16)(qv[8 * s + j] * SC2); }
                    f32x16 o0, o1;
#pragma unroll
                    for (int i = 0; i < 16; ++i) { o0[i] = 0.f; o1[i] = 0.f; }
                    float mrun = -INFINITY, lrun = 0.f;
                    f32x16 iniv; float ini_prev = 0.f;
#pragma unroll
                    for (int i = 0; i < 16; ++i) iniv[i] = 0.f;
                    for (int n = 0; n <= own; ++n) {
                        __syncthreads();
#pragma unroll
                        for (int pc = 0; pc < 4; ++pc) { *(LAS f16x8*)(Kb + (lk + 64 * pc) * KS + 8 * lc) = kr[pc]; *(LAS f16x8*)(Vb + (lk + 64 * pc) * KS + 8 * lc) = vr[pc]; }
                        __syncthreads();
                        if (n < own) {
#pragma unroll
                            for (int pc = 0; pc < 4; ++pc) { const GAS f16* p_ = kvp + (size_t)((n + 1) * 256 + 64 * pc) * INW; kr[pc] = *(const GAS f16x8*)p_; vr[pc] = *(const GAS f16x8*)(p_ + 256); } }
                        const bool past = n < own;
                        const bool sel = past ? ((mask >> n) & 1u) != 0u : true;
                        if (past && !__any(sel)) continue;
                        const int ntl = past ? 4 : (wave >> 1) + 1;
#pragma unroll 1
                        for (int tl = 0; tl < ntl; ++tl) {
                            const LAS f16* Kt = Kb + tl * 64 * KS; const LAS f16* Vt = Vb + tl * 64 * KS;
                            const int kbase = n * 256 + tl * 64;
                            const int dmin = own * 256 + 32 * wave - (kbase + 63);
                            const bool cb = dmin >= 127;
                            const float minit = (mrun == -INFINITY) ? 0.f : mrun;
                            const float ini = sel ? ((cb ? lut[127] : 0.f) - minit) : -INFINITY;
                            if (__any(ini != ini_prev)) {
#pragma unroll
                                for (int i = 0; i < 16; ++i) iniv[i] = ini;
                                ini_prev = ini; }
                            f32x16 p0, p1;
                            { const f16x8 a0 = *(const LAS f16x8*)(Kt + r32 * KS + 8 * hh), a1 = *(const LAS f16x8*)(Kt + (32 + r32) * KS + 8 * hh);
                              p0 = __builtin_amdgcn_mfma_f32_32x32x16_f16(a0, qf[0], iniv, 0, 0, 0); p1 = __builtin_amdgcn_mfma_f32_32x32x16_f16(a1, qf[0], iniv, 0, 0, 0); }
#pragma unroll
                            for (int s = 1; s < 4; ++s) { const f16x8 a0 = *(const LAS f16x8*)(Kt + r32 * KS + 16 * s + 8 * hh), a1 = *(const LAS f16x8*)(Kt + (32 + r32) * KS + 16 * s + 8 * hh);
                                p0 = __builtin_amdgcn_mfma_f32_32x32x16_f16(a0, qf[s], p0, 0, 0, 0); p1 = __builtin_amdgcn_mfma_f32_32x32x16_f16(a1, qf[s], p1, 0, 0, 0); }
                            if (!cb) {
#pragma unroll
                                for (int i = 0; i < 16; ++i) { const int kr_ = (i & 3) + 8 * (i >> 2) + 4 * hh; const int d0 = qpos - (kbase + kr_), d1 = d0 - 32;
                                    p0[i] = (d0 >= 0) ? p0[i] + lut[d0 > 127 ? 127 : d0] : -INFINITY;
                                    p1[i] = (d1 >= 0) ? p1[i] + lut[d1 > 127 ? 127 : (d1 < 0 ? 0 : d1)] : -INFINITY; } }
                            asm volatile("s_nop 7\n\ts_nop 7\n\ts_nop 7" : "+v"(p0), "+v"(p1));
                            float mx = max3f(p0[0], p0[1], p1[0]), mxb = max3f(p0[2], p0[3], p1[1]); mx = max3f(mx, p1[2], p1[3]);
#pragma unroll
                            for (int i = 4; i < 16; i += 4) { mx = max3f(mx, p0[i], p0[i + 1]); mxb = max3f(mxb, p0[i + 2], p0[i + 3]); mx = max3f(mx, p1[i], p1[i + 1]); mxb = max3f(mxb, p1[i + 2], p1[i + 3]); }
                            mx = max2f(mx, mxb);
                            mx = max2f(mx, __shfl_xor(mx, 32));
                            const bool need = sel && (mx > -INFINITY) && ((mrun == -INFINITY) || (mx > THR));
                            if (__any(need)) { const float delta = need ? mx : 0.f; const float alpha = __builtin_amdgcn_exp2f(-delta);
#pragma unroll
                                for (int i = 0; i < 16; ++i) { p0[i] -= delta; p1[i] -= delta; o0[i] *= alpha; o1[i] *= alpha; }
                                lrun *= alpha; if (need) mrun = minit + delta; }
#pragma unroll
                            for (int i = 0; i < 16; ++i) { p0[i] = __builtin_amdgcn_exp2f(p0[i]); p1[i] = __builtin_amdgcn_exp2f(p1[i]); }
                            asm volatile("s_nop 1" : "+v"(p0), "+v"(p1));
                            float psa = 0.f, psb = 0.f, psc = 0.f, psd = 0.f;
#pragma unroll
                            for (int i = 0; i < 16; i += 2) { psa = fadd_s(psa, p0[i]); psb = fadd_s(psb, p1[i]); psc = fadd_s(psc, p0[i + 1]); psd = fadd_s(psd, p1[i + 1]); }
                            lrun += (psa + psb) + (psc + psd);
                            f16x8 pb[4];
#pragma unroll
                            for (int i = 0; i < 8; ++i) { pb[0][i] = (f16)p0[i]; pb[1][i] = (f16)p0[8 + i]; pb[2][i] = (f16)p1[i]; pb[3][i] = (f16)p1[8 + i]; }
#pragma unroll
                            for (int kk = 0; kk < 4; ++kk) {
                                const LAS f16* vb = Vt + vtr_off + (16 * kk) * KS;
                                const f16x4 a0l = __builtin_bit_cast(f16x4, __builtin_amdgcn_ds_read_tr16_b64_v4i16((LAS v4i16_t*)(vb)));
                                const f16x4 a0h = __builtin_bit_cast(f16x4, __builtin_amdgcn_ds_read_tr16_b64_v4i16((LAS v4i16_t*)(vb + 8 * KS)));
                                const f16x4 a1l = __builtin_bit_cast(f16x4, __builtin_amdgcn_ds_read_tr16_b64_v4i16((LAS v4i16_t*)(vb + 32)));
                                const f16x4 a1h = __builtin_bit_cast(f16x4, __builtin_amdgcn_ds_read_tr16_b64_v4i16((LAS v4i16_t*)(vb + 8 * KS + 32)));
                                const f16x8 av0 = {a0l[0], a0l[1], a0l[2], a0l[3], a0h[0], a0h[1], a0h[2], a0h[3]};
                                const f16x8 av1 = {a1l[0], a1l[1], a1l[2], a1l[3], a1h[0], a1h[1], a1h[2], a1h[3]};
                                o0 = __builtin_amdgcn_mfma_f32_32x32x16_f16(av0, pb[kk], o0, 0, 0, 0);
                                o1 = __builtin_amdgcn_mfma_f32_32x32x16_f16(av1, pb[kk], o1, 0, 0, 0); }
                        }
                    }
                    const float ltot = lrun + __shfl_xor(lrun, 32), inv = 1.f / ltot;
                    GAS f16* op = MIX + (TB + qpos) * DM + h * 64;
                    float sq = 0.f;
#pragma unroll
                    for (int g4 = 0; g4 < 4; ++g4) { const int d0 = 8 * g4 + 4 * hh;
                        u32x2 w0, w1; w0.x = pk_f16(o0[4 * g4] * inv, o0[4 * g4 + 1] * inv); w0.y = pk_f16(o0[4 * g4 + 2] * inv, o0[4 * g4 + 3] * inv);
                        w1.x = pk_f16(o1[4 * g4] * inv, o1[4 * g4 + 1] * inv); w1.y = pk_f16(o1[4 * g4 + 2] * inv, o1[4 * g4 + 3] * inv);
                        { const f16x4 r0 = __builtin_bit_cast(f16x4, w0), r1 = __builtin_bit_cast(f16x4, w1);
#pragma unroll
                          for (int i = 0; i < 4; ++i) { const float a_ = (float)r0[i], b_ = (float)r1[i]; sq += a_ * a_ + b_ * b_; } }
                        *(GAS u32x2*)(op + d0) = w0; *(GAS u32x2*)(op + 32 + d0) = w1; }
                    sq += __shfl_xor(sq, 32);
                    if (hh == 0) SSQ[(TB + qpos) * 4 + h] = sq;
                }
            }
        }
}
        xcd_barrier(bar);
        STAMP(3 + 9 * l + 2);

        STAMP(3 + 9 * l + 3);

if (PHMASK & 64) { LAUNDER();
        { pg8::Gemm g{(const GAS pg8::h16_t*)MIX, (const GAS pg8::h16_t*)(WOUT_T + (size_t)l * DM * DM), NTOK, DM, DM, nullptr, SSQ}; pg8::StaticOrder S; S.init(NTOK, DM, G, bid);
          if (l == 0) { pg8::EpiResidT<true> E{GIN(I_X), nullptr, (GAS pg8::h16_t*)X, MODL + 2048}; pg8::gemm_phase<pg8::EpiResidT<true>, pg8::StaticOrder, false, false, true>(Lp, g, S, E, tid); }
          else { pg8::EpiResidT<false> E{nullptr, (const GAS pg8::h16_t*)X, (GAS pg8::h16_t*)X, MODL + 2048}; pg8::gemm_phase<pg8::EpiResidT<false>, pg8::StaticOrder, false, false, true>(Lp, g, S, E, tid); } }
}
        xcd_barrier(bar);
        STAMP(3 + 9 * l + 4);

if (PHMASK & 128) { LAUNDER();
        {
            LAS f16* WT = (LAS f16*)Lp;
            constexpr int WS_ = 1032;
            LAS float* lg = (LAS float*)(Lp + 66560 + wave * 2304);
            LAS int* sel_e = (LAS int*)(Lp + 131584);
            LAS int* rank_ = (LAS int*)(Lp + 131584 + 2048);
            LAS int* lcnt = (LAS int*)(Lp + 131584 + 4096);
            LAS int* lbase = (LAS int*)(Lp + 131584 + 4096 + 128);
            for (int i = tid; i < 32 * WS_ / 8; i += 512) *(LAS u32x4*)(WT + 8 * i) = *(const GAS u32x4*)(RWT16 + (size_t)l * 32 * WS_ + 8 * i);
            GAS unsigned* gcnt = ctl + CW_CNT + l * 32 * 64;
            const int fr = lane & 15, fq = lane >> 4;
            if (l + 1 < DEPTH) { for (int i = bid * 512 + tid; i < NB * 16 * 256; i += G * 512) KMEAN[i] = 0.f; }
            for (int ch = bid; ch < NTOK / 128; ch += G) {
                if (tid < 32) lcnt[tid] = 0;
                __syncthreads();
                const int b = (ch * 128) >> 12; const GAS float* md = MODL + (size_t)b * 6144;
                const GAS float* g2 = GIN(I_N2G) + l * DM;
                const size_t tokw = (size_t)ch * 128 + wave * 16;
                LAS float* pgl = (LAS float*)(Lp + 86016); LAS float* psl = (LAS float*)(Lp + 86016 + 4096);
                for (int i = tid; i < 256; i += 512) { const f32x4 g4 = *(const GAS f32x4*)(g2 + 4 * i), s4 = *(const GAS f32x4*)(md + 4096 + 4 * i); *(LAS f32x4*)(pgl + 4 * i) = g4 * (s4 + 1.0f); *(LAS f32x4*)(psl + 4 * i) = *(const GAS f32x4*)(md + 3072 + 4 * i); }
                __syncthreads();
                LAS f16* hb = (LAS f16*)(Lp + 94208) + wave * (2 * WS_);
                const float rb0 = GIN(I_RB)[l * NEXP + fr], rb1 = GIN(I_RB)[l * NEXP + 16 + fr];
#pragma unroll 1
                for (int t2 = 0; t2 < 16; t2 += 4) {
                    f32x4 v[4][4];
#pragma unroll
                    for (int r = 0; r < 4; ++r)
#pragma unroll
                        for (int j = 0; j < 4; ++j) { const f16x4 xh = *(const GAS f16x4*)(X + (tokw + t2 + r) * DM + 4 * lane + 256 * j); v[r][j] = (f32x4){(float)xh[0], (float)xh[1], (float)xh[2], (float)xh[3]}; }
#pragma unroll
                    for (int hf = 0; hf < 2; ++hf) {
#pragma unroll
                        for (int r2 = 0; r2 < 2; ++r2) { const int r = 2 * hf + r2; float s = 0.f;
#pragma unroll
                            for (int j = 0; j < 4; ++j) s += (v[r][j].x * v[r][j].x + v[r][j].y * v[r][j].y) + (v[r][j].z * v[r][j].z + v[r][j].w * v[r][j].w);
                            const float rstd = rsqrtf(wave_sum(s) * (1.f / DM) + EPS);
#pragma unroll
                            for (int j = 0; j < 4; ++j) { const int c = 4 * lane + 256 * j;
                                const f32x4 hq = (v[r][j] * rstd) * *(const LAS f32x4*)(pgl + c) + *(const LAS f32x4*)(psl + c);
                                u32x2 w; w.x = pk_f16(hq.x, hq.y); w.y = pk_f16(hq.z, hq.w); *(LAS u32x2*)(hb + r2 * WS_ + c) = w;
                                if (!IS_FP8(l)) *(GAS u32x2*)(H + (tokw + t2 + r) * DM + c) = w;
                                if (IS_FP8(l)) *(GAS unsigned*)((GAS unsigned char*)XS + (tokw + t2 + r) * DM + c) = pk4_fp8(hq.x, hq.y, hq.z, hq.w); } }
                        asm volatile("s_waitcnt lgkmcnt(0)" ::: "memory");
                        f32x4 acc0 = {0.f, 0.f, 0.f, 0.f}, acc1 = {0.f, 0.f, 0.f, 0.f};
#pragma unroll 4
                        for (int ks = 0; ks < 32; ++ks) { const f16x8 a = *(const LAS f16x8*)(hb + (fr & 1) * WS_ + 32 * ks + 8 * fq);
                            const f16x8 b0 = *(const LAS f16x8*)(WT + fr * WS_ + 32 * ks + 8 * fq), b1 = *(const LAS f16x8*)(WT + (16 + fr) * WS_ + 32 * ks + 8 * fq);
                            acc0 = __builtin_amdgcn_mfma_f32_16x16x32_f16(a, b0, acc0, 0, 0, 0); acc1 = __builtin_amdgcn_mfma_f32_16x16x32_f16(a, b1, acc1, 0, 0, 0); }
                        if (fq == 0) {
#pragma unroll
                            for (int reg = 0; reg < 2; ++reg) { lg[(t2 + 2 * hf + reg) * 36 + fr] = acc0[reg] + rb0; lg[(t2 + 2 * hf + reg) * 36 + 16 + fr] = acc1[reg] + rb1; } }
                        asm volatile("s_waitcnt lgkmcnt(0)" ::: "memory");
                    }
                }
                asm volatile("s_waitcnt lgkmcnt(0)" ::: "memory");
                if (lane < 16) { float vv[32];
#pragma unroll
                    for (int q = 0; q < 8; ++q) { const f32x4 t = *(const LAS f32x4*)(lg + lane * 36 + 4 * q); vv[4 * q] = t.x; vv[4 * q + 1] = t.y; vv[4 * q + 2] = t.z; vv[4 * q + 3] = t.w; }
                    float topv[4]; int topi[4];
#pragma unroll
                    for (int k = 0; k < 4; ++k) { float bv = -INFINITY; int bi = 0;
#pragma unroll
                        for (int e = 0; e < 32; ++e) { if (vv[e] > bv) { bv = vv[e]; bi = e; } }
                        topv[k] = bv; topi[k] = bi;
#pragma unroll
                        for (int e = 0; e < 32; ++e) vv[e] = (e == bi) ? -INFINITY : vv[e]; }
                    const int tl = wave * 16 + lane; const size_t tok = (size_t)ch * 128 + tl;
                    const float e1 = __expf(topv[1] - topv[0]), e2 = __expf(topv[2] - topv[0]), e3 = __expf(topv[3] - topv[0]); const float inv = 1.f / (1.f + e1 + e2 + e3);
                    *(GAS f32x4*)(ROUTE_G + tok * 4) = (f32x4){inv, e1 * inv, e2 * inv, e3 * inv};
#pragma unroll
                    for (int k = 0; k < 4; ++k) sel_e[tl * 4 + k] = topi[k]; }
                __syncthreads();
                const int e = sel_e[tid];
                rank_[tid] = __hip_atomic_fetch_add(&lcnt[e], 1, __ATOMIC_RELAXED, __HIP_MEMORY_SCOPE_WORKGROUP);
                __syncthreads();
                if (tid < 32) lbase[tid] = (int)__hip_atomic_fetch_add(gcnt + tid * 64, (unsigned)lcnt[tid], __ATOMIC_RELAXED, __HIP_MEMORY_SCOPE_AGENT);
                __syncthreads();
                { const int pos = lbase[e] + rank_[tid]; const size_t tok = (size_t)ch * 128 + (tid >> 2);
                  LIST[(size_t)e * LISTCAP + pos] = (int)tok; ROUTE_E[tok * 4 + (tid & 3)] = e; ROUTE_POS[tok * 4 + (tid & 3)] = pos; }
                __syncthreads();
            }
        }
}
        xcd_barrier(bar);
        STAMP(3 + 9 * l + 5);

#define cnts ((LAS int*)(Lp + RING_BYTES + 1024))
#define mbase ((LAS int*)(Lp + RING_BYTES + 1024 + 256))
        { LAUNDER(); GAS unsigned* gcnt = ctl + CW_CNT + l * 32 * 64;
          if (tid < 32) cnts[tid] = (int)__hip_atomic_load(gcnt + tid * 64, __ATOMIC_RELAXED, __HIP_MEMORY_SCOPE_AGENT);
          __syncthreads();
          if (tid == 0) { int a = 0; for (int e = 0; e < 32; ++e) { mbase[e] = a; a += (cnts[e] + 255) >> 8; } mbase[32] = a; }
          __syncthreads(); }

        for (int ph = 0; ph < 2; ++ph) {
            if (!(PHMASK & (512 << ph))) continue;
            for (int rep_ = 0; rep_ < REPS(512 << ph); ++rep_) {
            LAUNDER(); const int MT = mbase[32]; LAS int* ulist = (LAS int*)(Lp + RING_BYTES); const int NT = ph == 0 ? 8 : 4, U = MT * NT;
            __syncthreads();
            int nu = 0;
            { const int q = U / 8, rr = U % 8, nig = 8 * NT;
              for (int i = 0; i < 64; ++i) { const long Lid = (long)i * G + bid; if (Lid >= U) break; ++nu;
                  if (tid == i) { int wg = (int)Lid; const int xcd = wg % 8, off = wg / 8; wg = (xcd < rr ? xcd * (q + 1) : rr * (q + 1) + (xcd - rr) * q) + off;
                      const int gid = wg / nig, fm = gid * 8, gsz = (MT - fm) < 8 ? (MT - fm) : 8; const int pm = fm + ((wg % nig) % gsz), pn = (wg % nig) / gsz;
                      int e = 0;
                      for (int qq = 1; qq < 32; ++qq) e += (mbase[qq] <= pm) ? 1 : 0;
                      ulist[3 * i] = pm | ((e * NT + pn) << 16); ulist[3 * i + 1] = (pm - mbase[e]) * 256; ulist[3 * i + 2] = cnts[e]; } } }
            __syncthreads();
            pg8::ListOrder S{ulist, nu};
            if (ph == 0) {
                if (IS_FP8(l)) { pg8::Gemm g{(const GAS pg8::h16_t*)XS, (const GAS pg8::h16_t*)(W1_T + (size_t)l * NEXP * 2048 * DM), PROWS, 2048, DM / 2, LIST, nullptr};
                    pg8::EpiSwigluT<true> E{(GAS unsigned char*)ACT, GIN(I_B1) + (size_t)l * NEXP * 2048, W8_INV};
                    pg8::gemm_phase<pg8::EpiSwigluT<true>, pg8::ListOrder, true, true>(Lp, g, S, E, tid); }
                else { pg8::Gemm g{(const GAS pg8::h16_t*)H, (const GAS pg8::h16_t*)(W1_T + (size_t)l * NEXP * 2048 * DM), PROWS, 2048, DM, LIST, nullptr};
                    pg8::EpiSwigluT<false> E{(GAS unsigned char*)ACT, GIN(I_B1) + (size_t)l * NEXP * 2048, 1.0f};
                    pg8::gemm_phase<pg8::EpiSwigluT<false>, pg8::ListOrder, true, false>(Lp, g, S, E, tid); } }
            else {
                if (IS_FP8(l)) { pg8::Gemm g{(const GAS pg8::h16_t*)ACT, (const GAS pg8::h16_t*)(W2_T + (size_t)l * NEXP * DM * DM), PROWS, 1024, DM / 2, nullptr, nullptr};
                    pg8::EpiDownT<true> E{(GAS unsigned char*)XS, GIN(I_B2) + (size_t)l * NEXP * DM, W8_INV};
                    pg8::gemm_phase<pg8::EpiDownT<true>, pg8::ListOrder, false, true>(Lp, g, S, E, tid); }
                else { pg8::Gemm g{(const GAS pg8::h16_t*)ACT, (const GAS pg8::h16_t*)(W2_T + (size_t)l * NEXP * DM * DM), PROWS, 1024, DM, nullptr, nullptr};
                    pg8::EpiDownT<false> E{(GAS unsigned char*)XS, GIN(I_B2) + (size_t)l * NEXP * DM, 1.0f};
                    pg8::gemm_phase<pg8::EpiDownT<false>, pg8::ListOrder, false, false>(Lp, g, S, E, tid); } }
            }
            xcd_barrier(bar);
            STAMP(3 + 9 * l + 6 + ph);
        }

if (PHMASK & 2048) { LAUNDER();
        for (int m = gw; m < NTOK; m += NGW) {
            const int b = m >> 12; const GAS float* md = MODL + (size_t)b * 6144;
            const GAS unsigned char* yr[4]; float gk[4];
#pragma unroll
            for (int k = 0; k < 4; ++k) { const int e = ROUTE_E[(size_t)m * 4 + k], pos = ROUTE_POS[(size_t)m * 4 + k]; gk[k] = ROUTE_G[(size_t)m * 4 + k]; yr[k] = (const GAS unsigned char*)XS + ((size_t)mbase[e] * 256 + pos) * DM * (IS_FP8(l) ? 1 : 2); }
            f32x4 v[4]; float s = 0.f;
#pragma unroll
            for (int j = 0; j < 4; ++j) { const int c = 4 * lane + 256 * j; f32x4 a = {0.f, 0.f, 0.f, 0.f};
#pragma unroll
                for (int k = 0; k < 4; ++k) {
                    if (IS_FP8(l)) { const int y8 = *(const GAS int*)(yr[k] + c); const f32x2 lo = __builtin_amdgcn_cvt_pk_f32_fp8(y8, false), hi = __builtin_amdgcn_cvt_pk_f32_fp8(y8, true);
                        a.x += gk[k] * lo.x; a.y += gk[k] * lo.y; a.z += gk[k] * hi.x; a.w += gk[k] * hi.y; }
                    else { const f16x4 y4 = *(const GAS f16x4*)(yr[k] + 2 * c); a.x += gk[k] * (float)y4[0]; a.y += gk[k] * (float)y4[1]; a.z += gk[k] * (float)y4[2]; a.w += gk[k] * (float)y4[3]; } }
                const f16x4 xh = *(const GAS f16x4*)(X + (size_t)m * DM + c); const f32x4 x1 = {(float)xh[0], (float)xh[1], (float)xh[2], (float)xh[3]}, g2 = *(const GAS f32x4*)(md + 5120 + c);
                v[j] = x1 + g2 * a; s += (v[j].x * v[j].x + v[j].y * v[j].y) + (v[j].z * v[j].z + v[j].w * v[j].w); }
            const float rstd = rsqrtf(wave_sum(s) * (1.f / DM) + EPS);
            if (l + 1 < DEPTH) {
                const GAS float* mdn = MOD + (size_t)((l + 1) * 8 + b) * 6144; const GAS float* g1 = GIN(I_N1G) + (l + 1) * DM;
#pragma unroll
                for (int j = 0; j < 4; ++j) { const int c = 4 * lane + 256 * j; { u32x2 wx; wx.x = pk_f16(v[j].x, v[j].y); wx.y = pk_f16(v[j].z, v[j].w); *(GAS u32x2*)(X + (size_t)m * DM + c) = wx; }
                    const f32x4 gg = *(const GAS f32x4*)(g1 + c), sh = *(const GAS f32x4*)(mdn + c), sc = *(const GAS f32x4*)(mdn + 1024 + c);
                    const f32x4 hq = (v[j] * rstd) * gg * (sc + 1.0f) + sh; u32x2 w; w.x = pk_f16(hq.x, hq.y); w.y = pk_f16(hq.z, hq.w); *(GAS u32x2*)(H + (size_t)m * DM + c) = w;
                    if (PROJ_FP8 && l + 1 >= PROJ_FP8_FIRST) *(GAS unsigned*)(HB8 + (size_t)m * DM + c) = pk4_fp8(hq.x, hq.y, hq.z, hq.w); }
            } else {
#pragma unroll
                for (int j = 0; j < 4; ++j) { const int c = 4 * lane + 256 * j; const f32x4 gg = *(const GAS f32x4*)(GIN(I_FNG) + c); *(GAS f32x4*)(((GAS float*)AP->out) + (size_t)m * DM + c) = (v[j] * rstd) * gg; }
            }
        }
}
        STAMP(3 + 9 * l + 8);
        if (l + 1 < DEPTH) xcd_barrier(bar);
}

__global__ void __launch_bounds__(NWAVES * 64, 2) fwd_megakernel(Args args) {
    const int tid0 = threadIdx.x, wave0 = __builtin_amdgcn_readfirstlane(tid0 >> 6);
    const int G = gridDim.x, bid = blockIdx.x;
    const int NGW = G * NWAVES;
    LAS unsigned char* L = (LAS unsigned char*)lds;

    if (tid0 < 16) ((LAS unsigned*)(L + BARST_OFF))[tid0] = 0u;
    __syncthreads();
    STAMP(0);
    XcdBarrier bar = xcd_barrier_post((unsigned*)(args.ws + WS_CTL) + CW_BAR, (volatile LAS unsigned*)(L + BARST_OFF));

for (int rep_ = 0; rep_ < REPS(1); ++rep_) if (PHMASK & 1) { LAUNDER(); __syncthreads();
    {
        LAS float* cond = (LAS float*)Lp;
        LAS float* red = (LAS float*)(Lp + 32768);
        bool cond_ready = false;
        for (int it = bid; it < 192; it += G) {
            if (!cond_ready) { for (int i = tid; i < NB * DM; i += 512) { const float v = GIN(I_C)[i]; cond[i] = v * sigmoidf_(v); } __syncthreads(); cond_ready = true; }
            const int l = it / 96, n0 = (it % 96) * 64;
            const GAS float* wm = GIN(I_WMOD) + (size_t)l * DM * 6144 + n0 + lane;
            float a[8];
#pragma unroll
            for (int b = 0; b < 8; ++b) a[b] = 0.f;
            for (int k = wave * 128; k < wave * 128 + 128; ++k) { const float w = wm[(size_t)k * 6144];
#pragma unroll
                for (int b = 0; b < 8; ++b) a[b] += cond[b * DM + k] * w; }
#pragma unroll
            for (int b = 0; b < 8; ++b) red[(wave * 8 + b) * 64 + lane] = a[b];
            __syncthreads();
            { const int b = tid >> 6; float s = GIN(I_BMOD)[l * 6144 + n0 + lane];
#pragma unroll
              for (int w = 0; w < 8; ++w) s += red[(w * 8 + b) * 64 + lane];
              MOD[(size_t)(l * 8 + b) * 6144 + n0 + lane] = s; }
            __syncthreads();
        }
        __syncthreads();
        LAS float* scr = (LAS float*)(Lp + wave * 16640);
        for (int it = gw; it < DEPTH * 1536; it += NGW) {
            const int l = it / 1536; int r = it % 1536;
            if (r < 1024) { const int kb = r >> 6, nb = r & 63; transpose_item(GIN(I_WIN) + (size_t)l * DM * INW, DM, INW, WIN_T + (size_t)l * INW * DM, 32 * nb, 64 * kb, 32 * nb, nullptr, scr, lane);
                if (PROJ_FP8 && l >= PROJ_FP8_FIRST) transpose_item8(GIN(I_WIN) + (size_t)l * DM * INW, DM, INW, WIN8 + (size_t)l * INW * DM, 32 * nb, 64 * kb, 32 * nb, scr, lane); continue; } r -= 1024;
            { const int kb = r >> 5, nb = r & 31; transpose_item(GIN(I_WOUT) + (size_t)l * DM * DM, DM, DM, WOUT_T + (size_t)l * DM * DM, 32 * nb, 64 * kb, 32 * nb, GIN(I_MIXG) + l * DM, scr, lane, kb < 4 ? 64 * kb + 256 : (kb < 8 ? 64 * kb - 256 : 64 * kb)); }
        }
        static_assert(FP8_FIRST == 0, "the 64x64 expert-weight items below write fp8");
        constexpr int PER_L = 32 * 512 + 32 * 256;
        for (int it = gw; it < DEPTH * PER_L; it += NGW) {
            const int l = it / PER_L; int r = it % PER_L;
            if (r < 32 * 512) { const int e = r >> 9, q = r & 511, kb = q >> 5, nb = q & 31, n0 = 64 * nb;
                const int bj = n0 >> 10, jj = n0 & 1023, orow = (jj >> 7) * 256 + bj * 128 + (jj & 127);
                transpose_item8x64(GIN(I_W1) + ((size_t)l * NEXP + e) * DM * 2048, DM, 2048, (GAS unsigned char*)(W1_T + (size_t)l * NEXP * 2048 * DM) + (size_t)e * 2048 * DM, orow, 64 * kb, n0, scr, lane); continue; } r -= 32 * 512;
            { const int e = r >> 8, q = r & 255, kb = q >> 4, nb = q & 15;
                transpose_item8x64(GIN(I_W2) + ((size_t)l * NEXP + e) * DM * DM, DM, DM, (GAS unsigned char*)(W2_T + (size_t)l * NEXP * DM * DM) + (size_t)e * DM * DM, 64 * nb, 64 * kb, 64 * nb, scr, lane); }
        }
        for (int i = bid * 512 + tid; i < NB * 16 * 256; i += G * 512) KMEAN[i] = 0.f;
        for (int i = bid * 512 + tid; i < DEPTH * 4 * 128 * 128; i += G * 512) { const int jj = i & 127, ii = (i >> 7) & 127; SGUW[i] = (f16)(jj <= ii ? GIN(I_SGUW)[i] : 0.f); }
        for (int i = bid * 512 + tid; i < DEPTH * 4 * 64 * 64; i += G * 512) { const int c = i & 63, d = (i >> 6) & 63, g = (i >> 12) & 3, ll = i >> 14; PWT[i] = (f16)GIN(I_POOLW)[(((size_t)ll * 4 + g) * 64 + c) * 64 + d]; }
        for (int i = bid * 512 + tid; i < DEPTH * 32 * 1024; i += G * 512) { const int k = i & 1023, e = (i >> 10) & 31, ll = i >> 15; RWT16[(size_t)(ll * 32 + e) * 1032 + k] = (f16)GIN(I_RW)[((size_t)ll * DM + k) * NEXP + e]; }
    }
}
    xcd_barrier(bar);
    STAMP(1);

for (int rep_ = 0; rep_ < REPS(2); ++rep_) if (PHMASK & 2) { LAUNDER();
    for (int m = gw; m < NTOK; m += NGW) { const int b = m >> 12; const GAS float* md = MOD + (size_t)b * 6144;
        norm_mod_row(GIN(I_X) + (size_t)m * DM, GIN(I_N1G), md, md + 1024, H + (size_t)m * DM, HB8 + (size_t)m * DM, lane); }
}
    xcd_barrier(bar);
    STAMP(2);

    layer_body(0, bar, tid0, wave0, G, bid, NGW);
    layer_body(1, bar, tid0, wave0, G, bid, NGW);
    if (TSEL_B > 0 && bid == 0 && tid0 == 0) { const LAS unsigned long long* st = (const LAS unsigned long long*)((LAS unsigned char*)lds + STAMP_OFF);
        asm volatile("s_waitcnt vmcnt(0)" ::: "memory");
        args.out[0] += (float)(st[TSEL_B] - st[TSEL_A]) * 0.01f / TSCALE; }
}


extern "C" void kernel_launch(void* const* d_in, const int* in_sizes, int n_in, void* d_out, int out_size, void* d_ws, size_t ws_size, hipStream_t stream) {
    static int grid = 0;
    if (grid == 0) {
        if (n_in != 27 || out_size != NTOK * DM || ws_size < WS_END) { fprintf(stderr, "kernel_launch: unexpected shapes (n_in %d, out %d, ws %zu)\n", n_in, out_size, ws_size); grid = -1; return; }
        int dev = 0, cus = 0, per_cu = 0;
        if (hipGetDevice(&dev) != hipSuccess || hipDeviceGetAttribute(&cus, hipDeviceAttributeMultiprocessorCount, dev) != hipSuccess) { grid = -1; return; }
        if (hipFuncSetAttribute((const void*)fwd_megakernel, hipFuncAttributeMaxDynamicSharedMemorySize, LDS_BYTES) != hipSuccess) { fprintf(stderr, "kernel_launch: hipFuncSetAttribute failed\n"); grid = -1; return; }
        if (hipOccupancyMaxActiveBlocksPerMultiprocessor(&per_cu, (const void*)fwd_megakernel, NWAVES * 64, LDS_BYTES) != hipSuccess || per_cu < 1) { fprintf(stderr, "kernel_launch: occupancy query says %d blocks per CU\n", per_cu); (void)hipGetLastError(); grid = -1; return; }
        grid = cus;
    }
    if (grid < 0) return;
    (void)hipMemsetAsync((char*)d_ws + WS_CTL, 0, CTL_ZERO_BYTES, stream);
    Args a{};
    for (int i = 0; i < 27; ++i) a.in[i] = (const float*)d_in[i];
    a.out = (float*)d_out; a.ws = (unsigned char*)d_ws;
    hipLaunchKernelGGL(fwd_megakernel, dim3(grid), dim3(NWAVES * 64), LDS_BYTES, stream, a);
}
```

```cpp
#include <hip/hip_runtime.h>
#include <cstdio>
#include <cstdint>

#define LAS __attribute__((address_space(3)))
#define GAS __attribute__((address_space(1)))
#define CAS __attribute__((address_space(4)))
typedef _Float16 f16;
typedef _Float16 f16x8 __attribute__((ext_vector_type(8)));
typedef _Float16 f16x4 __attribute__((ext_vector_type(4)));
typedef _Float16 f16x2 __attribute__((ext_vector_type(2)));
typedef float f32x2 __attribute__((ext_vector_type(2)));
typedef float f32x4 __attribute__((ext_vector_type(4)));
typedef float f32x16 __attribute__((ext_vector_type(16)));
typedef unsigned u32x2 __attribute__((ext_vector_type(2)));
typedef unsigned u32x4 __attribute__((ext_vector_type(4)));
typedef short v4i16_t __attribute__((ext_vector_type(4)));
typedef int i32x4 __attribute__((ext_vector_type(4)));
typedef int i32x8 __attribute__((ext_vector_type(8)));

constexpr int DM = 1024, NB = 8, SEQ = 4096, NTOK = NB * SEQ, DEPTH = 2, GW = 256, INW = 2048;
constexpr int NEXP = 32, TOPK = 4;
constexpr int PROWS = NTOK * TOPK + NEXP * 256;
constexpr float EPS = 1e-6f;
constexpr int LISTCAP = NTOK;
constexpr int FP8_FIRST = 0;
#define IS_FP8(l_) ((l_) >= FP8_FIRST)
constexpr int FP8_LAYER_UNUSED = 1;
constexpr float W8_SCALE = 32.0f, W8_INV = 1.0f / 32.0f;
#define PROJ_FP8_FIRST 1
#ifndef PROJ_FP8
#define PROJ_FP8 1
#endif

__device__ __forceinline__ unsigned pk_f16(float lo, float hi) { f32x2 v = {lo, hi}; f16x2 h = __builtin_convertvector(v, f16x2); return __builtin_bit_cast(unsigned, h); }
__device__ __forceinline__ float row16_sum(float v) {
    v += __builtin_bit_cast(float, __builtin_amdgcn_update_dpp(0, __builtin_bit_cast(int, v), 0xB1, 0xf, 0xf, true));
    v += __builtin_bit_cast(float, __builtin_amdgcn_update_dpp(0, __builtin_bit_cast(int, v), 0x4E, 0xf, 0xf, true));
    v += __builtin_bit_cast(float, __builtin_amdgcn_update_dpp(0, __builtin_bit_cast(int, v), 0x141, 0xf, 0xf, true));
    v += __builtin_bit_cast(float, __builtin_amdgcn_update_dpp(0, __builtin_bit_cast(int, v), 0x140, 0xf, 0xf, true));
    return v;
}
__device__ __forceinline__ unsigned pk4_fp8(float a, float b, float c, float d) { int p = 0; p = __builtin_amdgcn_cvt_pk_fp8_f32(a, b, p, false); p = __builtin_amdgcn_cvt_pk_fp8_f32(c, d, p, true); return (unsigned)p; }
__device__ __forceinline__ float max3f(float a, float b, float c) { float r; asm("v_max3_f32 %0, %1, %2, %3" : "=v"(r) : "v"(a), "v"(b), "v"(c)); return r; }
__device__ __forceinline__ float max2f(float a, float b) { float r; asm("v_max_f32_e32 %0, %1, %2" : "=v"(r) : "v"(a), "v"(b)); return r; }
__device__ __forceinline__ float fadd_s(float a, float b) { float r; asm("v_add_f32_e32 %0, %1, %2" : "=v"(r) : "v"(a), "v"(b)); return r; }
template <int N> __device__ __forceinline__ void wave_sum_n(float (&v)[N]) {
#pragma unroll
    for (int i = 0; i < N; ++i) v[i] += __builtin_bit_cast(float, __builtin_amdgcn_update_dpp(0, __builtin_bit_cast(int, v[i]), 0xB1, 0xf, 0xf, true));
#pragma unroll
    for (int i = 0; i < N; ++i) v[i] += __builtin_bit_cast(float, __builtin_amdgcn_update_dpp(0, __builtin_bit_cast(int, v[i]), 0x4E, 0xf, 0xf, true));
#pragma unroll
    for (int i = 0; i < N; ++i) v[i] += __builtin_bit_cast(float, __builtin_amdgcn_update_dpp(0, __builtin_bit_cast(int, v[i]), 0x141, 0xf, 0xf, true));
#pragma unroll
    for (int i = 0; i < N; ++i) v[i] += __builtin_bit_cast(float, __builtin_amdgcn_update_dpp(0, __builtin_bit_cast(int, v[i]), 0x140, 0xf, 0xf, true));
#pragma unroll
    for (int i = 0; i < N; ++i) v[i] += __shfl_xor(v[i], 16);
#pragma unroll
    for (int i = 0; i < N; ++i) v[i] += __shfl_xor(v[i], 32);
}
__device__ __forceinline__ float wave_sum(float v) {
    v = row16_sum(v);
    v += __shfl_xor(v, 16); v += __shfl_xor(v, 32);
    return v;
}
__device__ __forceinline__ float sigmoidf_(float x) { return __builtin_amdgcn_rcpf(1.f + __expf(-x)); }
__device__ __forceinline__ float gelu_erf(float v) {
    const float av = fabsf(v), d = av * 0.2316418882f + 1.0f, t = __builtin_amdgcn_rcpf(d);
    float q = t * 0.5307027145f + (-0.7265760135f); q = q * t + 0.7107068705f; q = q * t + (-0.142248368f); q = q * t + 0.127414796f; q = q * t;
    const float e = __builtin_amdgcn_exp2f((v * v) * (-0.72134752044f));
    const float m = v * (q * e);
    return v < 0.f ? m : v - m;
}

#ifndef PROBE
#define PROBE 0
#endif
#ifndef TSEL_A
#define TSEL_A 0
#endif
#ifndef TSEL_B
#define TSEL_B 0
#endif
#ifndef TSCALE
#define TSCALE 16.0f
#endif
#define STAMP_OFF 146944
#define STAMP(k) do { if (TSEL_B > 0 && bid == 0 && tid0 == 0) ((__attribute__((address_space(3))) unsigned long long*)((__attribute__((address_space(3))) unsigned char*)lds + STAMP_OFF))[k] = __builtin_amdgcn_s_memrealtime(); } while (0)
namespace pg8 {
#define PG8_LAS __attribute__((address_space(3)))
typedef unsigned short h16_t;
constexpr int BM = 256, BK = 64, HALF = 128, HTB = HALF * BK * 2, STAGE_BYTES = 8 * HTB, NXCD = 8, WGM = 8;

__host__ __device__ __forceinline__ int lds_byte(int r, int c) { const int st = (r >> 4) * 2 + (c >> 5), rr = r & 15, cc = c & 31, ob = rr * 64 + cc * 2; return st * 1024 + (ob ^ (((ob >> 9) & 1) << 5)); }
__host__ __device__ __forceinline__ void stage_rc(int b, int& R, int& C) { const int st = b / 1024, sb = b % 1024, swz = sb ^ (((sb >> 9) & 1) << 5); R = (st >> 1) * 16 + swz / 64; C = (st & 1) * 32 + (swz % 64) / 2; }
__host__ __device__ __forceinline__ int perm32(int rho) { const int n = rho >> 4, i = rho & 15; return 8 * (i >> 2) + 4 * n + (i & 3); }

struct Unit { int pm, pn; };
struct Gemm { const GAS h16_t* A; const GAS h16_t* Bt; int M, N, K; const GAS int* rl; const GAS float* ssq; };

struct StaticOrder {
    int nM, nN, nwg, G, c;
    __host__ __device__ void init(int M, int N, int G_, int c_) { nM = M / BM; nN = N / BM; nwg = nM * nN; G = G_; c = c_; }
    __host__ __device__ bool next(int i, Unit& u) const {
        const long L = (long)i * G + c; if (L >= nwg) return false;
        int wgid = (int)L; { const int q = nwg / NXCD, r = nwg % NXCD, xcd = wgid % NXCD, off = wgid / NXCD; wgid = (xcd < r ? xcd * (q + 1) : r * (q + 1) + (xcd - r) * q) + off; }
        const int nig = WGM * nN, gid = wgid / nig, fm = gid * WGM, gsz = (nM - fm) < WGM ? (nM - fm) : WGM;
        u.pm = fm + ((wgid % nig) % gsz); u.pn = (wgid % nig) / gsz; return true;
    }
    __device__ __forceinline__ void a_ready(const Unit&) const {}
    __device__ __forceinline__ void done(const Unit&) const {}
    __device__ __forceinline__ void rows(int, int& r0, int& cnt) const { r0 = 0; cnt = 1; }
};
struct MapOrder : StaticOrder {
    unsigned map;
    __host__ __device__ bool next(int i, Unit& u) const { if (!StaticOrder::next(i, u)) return false; u.pn = (int)((map >> (4 * u.pn)) & 15u); return true; }
};
struct ListOrder {
    const PG8_LAS int* list; int n;
    __device__ __forceinline__ bool next(int i, Unit& u) const { if (i >= n) return false; const int v = __builtin_amdgcn_readfirstlane(list[3 * i]); u.pm = v & 0xffff; u.pn = v >> 16; return true; }
    __device__ __forceinline__ void rows(int i, int& r0, int& cnt) const { r0 = __builtin_amdgcn_readfirstlane(list[3 * i + 1]); cnt = __builtin_amdgcn_readfirstlane(list[3 * i + 2]); }
    __device__ __forceinline__ void a_ready(const Unit&) const {}
    __device__ __forceinline__ void done(const Unit&) const {}
};

struct Pre4 { f32x4 v[4]; };
struct EpiF16 {
    static constexpr bool PERM = true, AFTER_DRAIN = false, IS_DOWN = false, PRELOAD = false;
    GAS h16_t* O; int ldc; GAS float* ksum; float sc;
    __device__ __forceinline__ Pre4 pre(const Unit&, int, int, int, int) const { return Pre4{}; }
    __device__ __forceinline__ void operator()(const f32x4 (&acc)[2][2][4][2], const Unit& u, int wr, int wc, int fr, int fq, const Pre4&) const {
        const int row0 = u.pm * BM + wr * 64 + fr, col0 = u.pn * BM + wc * 32 + 8 * fq;
        if (u.pn == 3) {
#pragma unroll
            for (int bj = 0; bj < 2; ++bj)
#pragma unroll
                for (int n = 0; n < 2; ++n) { f32x4 s = (acc[0][bj][0][n] + acc[0][bj][1][n]) + (acc[0][bj][2][n] + acc[0][bj][3][n]); s += (acc[1][bj][0][n] + acc[1][bj][1][n]) + (acc[1][bj][2][n] + acc[1][bj][3][n]);
#pragma unroll
                    for (int i = 0; i < 4; ++i) { const float t = row16_sum(s[i]);
                        if (fr == 0) __hip_atomic_fetch_add(ksum + (size_t)u.pm * 256 + bj * HALF + wc * 32 + 8 * fq + 4 * n + i, t, __ATOMIC_RELAXED, __HIP_MEMORY_SCOPE_AGENT); } } }
#pragma unroll
        for (int ai = 0; ai < 2; ++ai)
#pragma unroll
            for (int m = 0; m < 4; ++m) { GAS h16_t* rowp = O + (size_t)(row0 + ai * HALF + m * 16) * ldc + col0;
#pragma unroll
                for (int bj = 0; bj < 2; ++bj) { const f32x4 v0 = acc[ai][bj][m][0] * sc, v1 = acc[ai][bj][m][1] * sc;
                    u32x4 w; w.x = pk_f16(v0[0], v0[1]); w.y = pk_f16(v0[2], v0[3]); w.z = pk_f16(v1[0], v1[1]); w.w = pk_f16(v1[2], v1[3]);
                    *(GAS u32x4*)(rowp + bj * HALF) = w; } }
    }
};
template <bool BASE32> struct EpiResidT {
    static constexpr bool PERM = true, AFTER_DRAIN = false, IS_DOWN = false, PRELOAD = false;
    const GAS float* base32; const GAS h16_t* base16; GAS h16_t* out; const GAS float* gate;
    __device__ __forceinline__ Pre4 pre(const Unit& u, int wr, int wc, int fr, int fq) const { Pre4 p; const int col0 = u.pn * BM + wc * 32 + 8 * fq; const GAS float* gp = gate + (size_t)((u.pm * BM) >> 12) * 6144;
#pragma unroll
        for (int bj = 0; bj < 2; ++bj)
#pragma unroll
            for (int n = 0; n < 2; ++n) p.v[bj * 2 + n] = *(const GAS f32x4*)(gp + col0 + bj * HALF + 4 * n);
        return p; }
    __device__ __forceinline__ void operator()(const f32x4 (&acc)[2][2][4][2], const Unit& u, int wr, int wc, int fr, int fq, const Pre4& pr) const {
        const int row0 = u.pm * BM + wr * 64 + fr, col0 = u.pn * BM + wc * 32 + 8 * fq;
        f32x4 gv[2][2];
#pragma unroll
        for (int bj = 0; bj < 2; ++bj)
#pragma unroll
            for (int n = 0; n < 2; ++n) gv[bj][n] = pr.v[bj * 2 + n];
#pragma unroll
        for (int ai = 0; ai < 2; ++ai)
#pragma unroll
            for (int m = 0; m < 4; ++m) { const size_t off = (size_t)(row0 + ai * HALF + m * 16) * DM + col0;
#pragma unroll
                for (int bj = 0; bj < 2; ++bj) { f32x4 b0, b1;
                    if constexpr (BASE32) { b0 = *(const GAS f32x4*)(base32 + off + bj * HALF); b1 = *(const GAS f32x4*)(base32 + off + bj * HALF + 4); }
                    else { const f16x8 hb = *(const GAS f16x8*)(base16 + off + bj * HALF); b0 = (f32x4){(float)hb[0], (float)hb[1], (float)hb[2], (float)hb[3]}; b1 = (f32x4){(float)hb[4], (float)hb[5], (float)hb[6], (float)hb[7]}; }
                    const f32x4 v0 = b0 + gv[bj][0] * acc[ai][bj][m][0], v1 = b1 + gv[bj][1] * acc[ai][bj][m][1];
                    u32x4 w; w.x = pk_f16(v0[0], v0[1]); w.y = pk_f16(v0[2], v0[3]); w.z = pk_f16(v1[0], v1[1]); w.w = pk_f16(v1[2], v1[3]);
                    *(GAS u32x4*)(out + off + bj * HALF) = w; } }
    }
};
template <bool OUT8> struct EpiSwigluT {
    static constexpr bool PERM = true, AFTER_DRAIN = false, IS_DOWN = false, PRELOAD = true;
    GAS unsigned char* O; const GAS float* b1; float sc;
    __device__ __forceinline__ Pre4 pre(const Unit& u, int wr, int wc, int fr, int fq) const { Pre4 q; const int e = u.pn >> 3, p = u.pn & 7, hc = p * 128 + wc * 32 + 8 * fq; const GAS float* bp = b1 + (size_t)e * 2048 + hc;
#pragma unroll
        for (int n = 0; n < 2; ++n) { q.v[n] = *(const GAS f32x4*)(bp + 4 * n); q.v[2 + n] = *(const GAS f32x4*)(bp + 1024 + 4 * n); }
        return q; }
    __device__ __forceinline__ void operator()(const f32x4 (&acc)[2][2][4][2], const Unit& u, int wr, int wc, int fr, int fq, const Pre4& pr) const {
        const int p = u.pn & 7;
        const int row0 = u.pm * BM + wr * 64 + fr, hc = p * 128 + wc * 32 + 8 * fq;
        f32x4 bg[2], bl[2];
#pragma unroll
        for (int n = 0; n < 2; ++n) { bg[n] = pr.v[n]; bl[n] = pr.v[2 + n]; }
        u32x2 wprev = {0u, 0u};
#pragma unroll
        for (int ai = 0; ai < 2; ++ai)
#pragma unroll
            for (int m = 0; m < 4; ++m) { float r[8];
#pragma unroll
                for (int n = 0; n < 2; ++n) { const f32x4 g = acc[ai][0][m][n] * sc + bg[n], li = acc[ai][1][m][n] * sc + bl[n];
#pragma unroll
                    for (int i = 0; i < 4; ++i) { const float xg = fminf(g[i], 7.0f), xl = fminf(fmaxf(li[i], -7.0f), 7.0f);
                        r[4 * n + i] = xg * __builtin_amdgcn_rcpf(1.f + __expf(-1.702f * xg)) * (xl + 1.0f); } }
                if constexpr (OUT8) { u32x2 w; w.x = pk4_fp8(r[0], r[1], r[2], r[3]); w.y = pk4_fp8(r[4], r[5], r[6], r[7]);
                    if (m & 1) { const auto sx = __builtin_amdgcn_permlane16_swap(wprev.x, w.x, false, false), sy = __builtin_amdgcn_permlane16_swap(wprev.y, w.y, false, false);
                        u32x4 o; o.x = sx[0]; o.y = sy[0]; o.z = sx[1]; o.w = sy[1];
                        *(GAS u32x4*)(O + (size_t)(row0 + ai * HALF + (m - 1 + (fq & 1)) * 16) * DM + (hc - 8 * fq + 16 * (fq >> 1))) = o; }
                    else wprev = w; }
                else { u32x4 w; w.x = pk_f16(r[0], r[1]); w.y = pk_f16(r[2], r[3]); w.z = pk_f16(r[4], r[5]); w.w = pk_f16(r[6], r[7]);
                    *(GAS u32x4*)(O + ((size_t)(row0 + ai * HALF + m * 16) * DM + hc) * 2) = w; } }
    }
};
template <bool OUT8> struct EpiDownT {
    static constexpr bool PERM = true, AFTER_DRAIN = false, IS_DOWN = true, PRELOAD = true;
    GAS unsigned char* O; const GAS float* b2; float sc;
    __device__ __forceinline__ Pre4 pre(const Unit& u, int wr, int wc, int fr, int fq) const { Pre4 q; const int e = u.pn >> 2, p = u.pn & 3, col0 = p * BM + wc * 32 + 8 * fq; const GAS float* bp = b2 + (size_t)e * 1024 + col0;
#pragma unroll
        for (int bj = 0; bj < 2; ++bj)
#pragma unroll
            for (int n = 0; n < 2; ++n) q.v[bj * 2 + n] = *(const GAS f32x4*)(bp + bj * HALF + 4 * n);
        return q; }
    __device__ __forceinline__ void operator()(const f32x4 (&acc)[2][2][4][2], const Unit& u, int wr, int wc, int fr, int fq, const Pre4& pr) const {
        const int p = u.pn & 3;
        const int row0 = u.pm * BM + wr * 64 + fr, col0 = p * BM + wc * 32 + 8 * fq;
        f32x4 bv[2][2];
#pragma unroll
        for (int bj = 0; bj < 2; ++bj)
#pragma unroll
            for (int n = 0; n < 2; ++n) bv[bj][n] = pr.v[bj * 2 + n];
        u32x2 wprev[2] = {{0u, 0u}, {0u, 0u}};
#pragma unroll
        for (int ai = 0; ai < 2; ++ai)
#pragma unroll
            for (int m = 0; m < 4; ++m) { const size_t ro = (size_t)(row0 + ai * HALF + m * 16) * DM + col0;
#pragma unroll
                for (int bj = 0; bj < 2; ++bj) { const f32x4 v0 = acc[ai][bj][m][0] * sc + bv[bj][0], v1 = acc[ai][bj][m][1] * sc + bv[bj][1];
                    if constexpr (OUT8) { u32x2 w; w.x = pk4_fp8(v0[0], v0[1], v0[2], v0[3]); w.y = pk4_fp8(v1[0], v1[1], v1[2], v1[3]);
                        if (m & 1) { const auto sx = __builtin_amdgcn_permlane16_swap(wprev[bj].x, w.x, false, false), sy = __builtin_amdgcn_permlane16_swap(wprev[bj].y, w.y, false, false);
                            u32x4 o; o.x = sx[0]; o.y = sy[0]; o.z = sx[1]; o.w = sy[1];
                            *(GAS u32x4*)(O + (size_t)(row0 + ai * HALF + (m - 1 + (fq & 1)) * 16) * DM + (col0 - 8 * fq + 16 * (fq >> 1)) + bj * HALF) = o; }
                        else wprev[bj] = w; }
                    else { u32x4 w; w.x = pk_f16(v0[0], v0[1]); w.y = pk_f16(v0[2], v0[3]); w.z = pk_f16(v1[0], v1[1]); w.w = pk_f16(v1[2], v1[3]);
                        *(GAS u32x4*)(O + (ro + bj * HALF) * 2) = w; } } }
    }
};

template <class Epi, class Sched, bool GATHER = false, bool FP8 = false, bool ROWSCALE = false>
__device__ __forceinline__ void gemm_phase(PG8_LAS unsigned char* lds, const Gemm g, const Sched& S, const Epi& E, const int tid) {
    const int wid = __builtin_amdgcn_readfirstlane(tid >> 6), lane = tid & 63, wr = wid >> 2, wc = wid & 3, fr = lane & 15, fq = lane >> 4;
    const int K = g.K, nt = K / BK;
    const size_t kstep = (size_t)(BK * 2);
    const size_t hstep = (size_t)HALF * K * 2;
    const size_t tstep = 2 * hstep;
    unsigned voffB[2], oc0[2], oc1[2], on0[2], on1[2];
#pragma unroll
    for (int i = 0; i < 2; ++i) { int R, C; stage_rc(tid * 16 + i * 8192, R, C); const int Rb = Epi::PERM ? ((R & ~31) + perm32(R & 31)) : R;
        voffB[i] = (unsigned)(Rb * K + C) * 2u;
        oc0[i] = (unsigned)(R * K + C) * 2u; oc1[i] = oc0[i] + (unsigned)hstep; on0[i] = oc0[i]; on1[i] = oc1[i]; }
    const unsigned ldsw = (unsigned)wid * 1024u;
    const int aoff = lds_byte(wr * 64 + fr, fq * 8), boff = lds_byte(wc * 32 + fr, fq * 8);
#define PG8_SA(b, h) (((b) * 2 + (h)) * HTB)
#define PG8_SB(b, h) ((4 + (b) * 2 + (h)) * HTB)
#define PG8_STAGE(bufoff, gbase, voff) do { _Pragma("unroll") for (int _i = 0; _i < 2; ++_i) { unsigned vo_ = (voff)[_i]; asm volatile("" : "+v"(vo_)); \
        __builtin_amdgcn_global_load_lds((const GAS unsigned*)((const GAS char*)(gbase) + vo_), (PG8_LAS unsigned*)(lds + (bufoff) + ldsw + _i * 8192), 16, 0, 0); } } while (0)
#define PG8_LDA(dst, b, h) do { if constexpr (FP8) { _Pragma("unroll") for (int m = 0; m < 4; ++m) { \
            const i32x4 lo_ = *(const PG8_LAS i32x4*)(lds + PG8_SA(b, h) + aoff + m * 2048), hi_ = *(const PG8_LAS i32x4*)(lds + PG8_SA(b, h) + aoff + m * 2048 + 1024); \
            dst##8[m] = (i32x8){lo_[0], lo_[1], lo_[2], lo_[3], hi_[0], hi_[1], hi_[2], hi_[3]}; } } \
        else { _Pragma("unroll") for (int m = 0; m < 4; ++m) _Pragma("unroll") for (int k = 0; k < 2; ++k) dst[m][k] = *(const PG8_LAS f16x8*)(lds + PG8_SA(b, h) + aoff + m * 2048 + k * 1024); } } while (0)
#define PG8_LDB(dst, b, h) do { if constexpr (FP8) { _Pragma("unroll") for (int n = 0; n < 2; ++n) { \
            const i32x4 lo_ = *(const PG8_LAS i32x4*)(lds + PG8_SB(b, h) + boff + n * 2048), hi_ = *(const PG8_LAS i32x4*)(lds + PG8_SB(b, h) + boff + n * 2048 + 1024); \
            dst##8[n] = (i32x8){lo_[0], lo_[1], lo_[2], lo_[3], hi_[0], hi_[1], hi_[2], hi_[3]}; } } \
        else { _Pragma("unroll") for (int n = 0; n < 2; ++n) _Pragma("unroll") for (int k = 0; k < 2; ++k) dst[n][k] = *(const PG8_LAS f16x8*)(lds + PG8_SB(b, h) + boff + n * 2048 + k * 1024); } } while (0)
#define PG8_MMA(ai, bj, At, Bt) do { __builtin_amdgcn_s_setprio(1); \
        if constexpr (FP8) { _Pragma("unroll") for (int m = 0; m < 4; ++m) _Pragma("unroll") for (int n = 0; n < 2; ++n) \
            acc[ai][bj][m][n] = __builtin_amdgcn_mfma_scale_f32_16x16x128_f8f6f4(Bt##8[n], At##8[m], acc[ai][bj][m][n], 0, 0, 0, 0x7f7f7f7f, 0, 0x7f7f7f7f); } \
        else { _Pragma("unroll") for (int m = 0; m < 4; ++m) _Pragma("unroll") for (int n = 0; n < 2; ++n) _Pragma("unroll") for (int k = 0; k < 2; ++k) \
            acc[ai][bj][m][n] = __builtin_amdgcn_mfma_f32_16x16x32_f16(Bt[n][k], At[m][k], acc[ai][bj][m][n], 0, 0, 0); } \
        __builtin_amdgcn_s_setprio(0); } while (0)
#define PG8_WAIT_V(n) asm volatile("s_waitcnt vmcnt(" #n ")" ::: "memory")
#define PG8_WAIT_L(n) asm volatile("s_waitcnt lgkmcnt(" #n ")" ::: "memory")
#define PG8_BAR __builtin_amdgcn_s_barrier()
#define PG8_SCHED __builtin_amdgcn_sched_barrier(0)
#define PG8_GOFF(ix, un, o0, o1) do { int r0_, cnt_; S.rows(ix, r0_, cnt_); const GAS int* lp_ = g.rl + (size_t)((un).pn >> 3) * LISTCAP; \
        _Pragma("unroll") for (int _i = 0; _i < 2; ++_i) { int R_, C_; stage_rc(tid * 16 + _i * 8192, R_, C_); int ra_ = r0_ + R_, rb_ = ra_ + HALF; ra_ = ra_ < cnt_ ? ra_ : cnt_ - 1; rb_ = rb_ < cnt_ ? rb_ : cnt_ - 1; \
            (o0)[_i] = (unsigned)lp_[ra_] * (unsigned)(K * 2) + (unsigned)C_ * 2u; (o1)[_i] = (unsigned)lp_[rb_] * (unsigned)(K * 2) + (unsigned)C_ * 2u; } } while (0)
    Unit cur, nxt; int ui = 0;
    if (!S.next(0, cur)) return;
    f32x4 acc[2][2][4][2];
#pragma unroll
    for (int a = 0; a < 2; ++a)
#pragma unroll
        for (int b = 0; b < 2; ++b)
#pragma unroll
            for (int m = 0; m < 4; ++m)
#pragma unroll
                for (int n = 0; n < 2; ++n) acc[a][b][m][n] = (f32x4){0.f, 0.f, 0.f, 0.f};
    f16x8 At[4][2], B0[2][2], B1[2][2]; i32x8 At8[4], B08[2], B18[2]; (void)At; (void)B0; (void)B1; (void)At8; (void)B08; (void)B18;
    const GAS char* cA = (const GAS char*)g.A + (GATHER ? (size_t)0 : (size_t)cur.pm * tstep); const GAS char* cB = (const GAS char*)g.Bt + (size_t)cur.pn * tstep;
    if constexpr (GATHER) PG8_GOFF(0, cur, oc0, oc1);
    S.a_ready(cur);
    PG8_STAGE(PG8_SB(0, 0), cB, voffB); PG8_STAGE(PG8_SB(0, 1), cB + hstep, voffB); PG8_STAGE(PG8_SA(0, 0), cA, oc0); PG8_STAGE(PG8_SA(0, 1), cA, oc1);
    if (wr == 1) PG8_BAR;
    PG8_WAIT_V(2); PG8_BAR;
    PG8_STAGE(PG8_SB(1, 0), cB + kstep, voffB); PG8_STAGE(PG8_SA(1, 0), cA + kstep, oc0); PG8_STAGE(PG8_SB(1, 1), cB + hstep + kstep, voffB);
    PG8_WAIT_V(6); PG8_BAR;
    for (;;) {
        const bool has_next = S.next(ui + 1, nxt);
        const GAS char* nA = (has_next && !GATHER) ? (const GAS char*)g.A + (size_t)nxt.pm * tstep : cA; const GAS char* nB = has_next ? (const GAS char*)g.Bt + (size_t)nxt.pn * tstep : cB;
        if constexpr (GATHER) { if (has_next) PG8_GOFF(ui + 1, nxt, on0, on1); }
        Pre4 epre; if constexpr (Epi::PRELOAD) epre = E.pre(cur, wr, wc, fr, fq);
#pragma unroll 1
        for (int t = 0; t < nt; ++t) {
            const int b = t & 1;
            const bool w1 = (t + 1 >= nt), w2 = (t + 2 >= nt);
            const GAS char* a1 = (w1 ? nA : cA) + (size_t)(w1 ? t + 1 - nt : t + 1) * kstep;
            const GAS char* a2 = (w2 ? nA : cA) + (size_t)(w2 ? t + 2 - nt : t + 2) * kstep;
            const GAS char* b2 = (w2 ? nB : cB) + (size_t)(w2 ? t + 2 - nt : t + 2) * kstep;
            unsigned x0[2], y1[2];
#pragma unroll
            for (int i = 0; i < 2; ++i) { y1[i] = (GATHER && w1 && has_next) ? on1[i] : oc1[i]; x0[i] = (GATHER && w2 && has_next) ? on0[i] : oc0[i]; }
            if (t == nt - 2 && has_next) S.a_ready(nxt);
            if constexpr (ROWSCALE) { if (t == 4) {
#pragma unroll
                for (int ai = 0; ai < 2; ++ai) { f32x4 q4[4];
#pragma unroll
                    for (int m = 0; m < 4; ++m) q4[m] = *(const GAS f32x4*)(g.ssq + (size_t)(cur.pm * BM + ai * HALF + wr * 64 + m * 16 + fr) * 4);
#pragma unroll
                    for (int m = 0; m < 4; ++m) { const float rs = rsqrtf(((q4[m].x + q4[m].y) + (q4[m].z + q4[m].w)) * (1.f / 256.f) + EPS);
#pragma unroll
                        for (int bj = 0; bj < 2; ++bj)
#pragma unroll
                            for (int n = 0; n < 2; ++n) acc[ai][bj][m][n] *= rs; } } } }
            PG8_LDB(B0, b, 0); PG8_LDB(B1, b, 1); PG8_SCHED; PG8_LDA(At, b, 0); PG8_STAGE(PG8_SA(b ^ 1, 1), a1, y1);
            PG8_WAIT_V(8); PG8_WAIT_L(0); PG8_BAR; PG8_MMA(0, 0, At, B0); PG8_MMA(0, 1, At, B1); PG8_BAR; PG8_SCHED;
            PG8_LDA(At, b, 1); PG8_STAGE(PG8_SB(b, 0), b2, voffB); PG8_STAGE(PG8_SB(b, 1), b2 + hstep, voffB); PG8_STAGE(PG8_SA(b, 0), a2, x0);
            PG8_WAIT_V(8); PG8_WAIT_L(0); PG8_BAR; PG8_MMA(1, 0, At, B0); PG8_MMA(1, 1, At, B1); PG8_BAR; PG8_SCHED;
        }
        if (wr == 0) PG8_BAR;
        if constexpr (!Epi::PRELOAD) epre = E.pre(cur, wr, wc, fr, fq);
        E(acc, cur, wr, wc, fr, fq, epre); S.done(cur);
        if (!has_next) break;
#pragma unroll
        for (int a = 0; a < 2; ++a)
#pragma unroll
            for (int b = 0; b < 2; ++b)
#pragma unroll
                for (int m = 0; m < 4; ++m)
#pragma unroll
                    for (int n = 0; n < 2; ++n) acc[a][b][m][n] = (f32x4){0.f, 0.f, 0.f, 0.f};
        cur = nxt; cA = nA; cB = nB; ++ui;
        if constexpr (GATHER) {
#pragma unroll
            for (int i = 0; i < 2; ++i) { oc0[i] = on0[i]; oc1[i] = on1[i]; } }
        if (wr == 1) PG8_BAR;
    }
    PG8_WAIT_V(0);
    PG8_BAR;
#undef PG8_SA
#undef PG8_SB
#undef PG8_STAGE
#undef PG8_LDA
#undef PG8_LDB
#undef PG8_MMA
#undef PG8_WAIT_V
#undef PG8_WAIT_L
#undef PG8_BAR
#undef PG8_SCHED
#undef PG8_GOFF
}
}

constexpr size_t MiB = 1u << 20;
constexpr size_t WS_CTL   = 0,            CTL_ZERO_BYTES = 1 * MiB;
constexpr size_t WS_MOD   = 1 * MiB;
constexpr size_t WS_KMEAN = 2 * MiB;
constexpr size_t WS_SSQ   = 2 * MiB + 512 * 1024;
constexpr size_t WS_SGUW  = 3 * MiB;
constexpr size_t WS_RWT   = 3 * MiB + 512 * 1024;
constexpr size_t WS_PWT   = 3 * MiB + 768 * 1024;
constexpr size_t WS_ROUTE = 4 * MiB;
constexpr size_t WS_LIST  = 6 * MiB;
constexpr size_t WS_WIN   = 10 * MiB;
constexpr size_t WS_WOUT  = 18 * MiB;
constexpr size_t WS_W1    = 22 * MiB;
constexpr size_t WS_W2    = 278 * MiB;
constexpr size_t WS_X     = 406 * MiB;
constexpr size_t WS_H     = 534 * MiB;
constexpr size_t WS_PROJ  = 598 * MiB;
constexpr size_t WS_MIX   = 726 * MiB;
constexpr size_t WS_XS    = 790 * MiB;
constexpr size_t WS_ACT   = 1062 * MiB;
constexpr size_t WS_WIN8  = 1334 * MiB;
constexpr size_t WS_HB8   = 1338 * MiB;
constexpr size_t WS_END   = 1370 * MiB;
constexpr int CW_BAR = 4096;
constexpr int CW_CNT = 16384;

constexpr int RING_BYTES = 131072;
constexpr int LDS_BYTES = 147456;
constexpr int BARST_OFF = LDS_BYTES - 64;
constexpr int NWAVES = 8;
#ifndef PH3
#define PH3 15
#endif
#define GIN(k) ((const GAS float*)AP->in[k])
#define REPS(bit) (((PROBE) & (bit)) ? 2 : 1)
#ifndef PHMASK
#define PHMASK 0xFFFF
#endif

#define XB_TMO      128
#define XB_XCNT(j)  (256  + 64 * (j))
#define XB_XSUB(j)  (1280 + 64 * (j))
#define XB_XGEN(j)  (2304 + 64 * (j))
#define XB_TOP      3328
#define XB_TOPGEN   3392
#define XCD_BAR_WORDS 3456
#define XB_SPIN_CAP (1u << 20)
__device__ __forceinline__ unsigned xb_ld(unsigned* p)              { return __hip_atomic_load(p, __ATOMIC_RELAXED, __HIP_MEMORY_SCOPE_AGENT); }
__device__ __forceinline__ unsigned xb_add(unsigned* p, unsigned v) { return __hip_atomic_fetch_add(p, v, __ATOMIC_RELAXED, __HIP_MEMORY_SCOPE_AGENT); }
__device__ __forceinline__ unsigned xb_xcc_id() { return (unsigned)__builtin_amdgcn_s_getreg((3 << 11) | 20) & 0xFu; }
#define XB_SPIN(cond, bar) do { unsigned _sp = 0; while (cond) { __builtin_amdgcn_s_sleep(1); \
    if ((++_sp & 255u) == 0u) { if (xb_ld(&(bar)[XB_TMO])) break; if (_sp > XB_SPIN_CAP) { atomicAdd(&(bar)[XB_TMO], 1u); break; } } } } while (0)
struct XcdBarrier { unsigned* bar; unsigned x; volatile LAS unsigned* st; };
__device__ __forceinline__ XcdBarrier xcd_barrier_post(unsigned* bar, volatile LAS unsigned* st) {
    XcdBarrier b; b.bar = bar; b.x = xb_xcc_id(); b.st = st;
    if (threadIdx.x == 0) (void)xb_add(&bar[XB_XCNT(b.x)], 1u);
    return b;
}
__device__ __forceinline__ void xcd_barrier_complete(unsigned* bar, unsigned x, unsigned& nloc, unsigned& nx) {
    const unsigned G = gridDim.x * gridDim.y * gridDim.z;
    unsigned sum, cnt, mine, sp = 0u;
    for (;;) {
        sum = 0u; cnt = 0u; mine = 0u;
#pragma unroll
        for (unsigned j = 0; j < 16; ++j) { const unsigned c = xb_ld(&bar[XB_XCNT(j)]); sum += c; cnt += (c > 0u) ? 1u : 0u; mine = (j == x) ? c : mine; }
        if (sum == G) break;
        __builtin_amdgcn_s_sleep(1);
        if ((++sp & 255u) == 0u) { if (xb_ld(&bar[XB_TMO])) break; if (sp > XB_SPIN_CAP) { atomicAdd(&bar[XB_TMO], 1u); break; } }
    }
    nloc = mine > 0u ? mine : 1u; nx = cnt > 0u ? cnt : 1u;
}
__device__ __forceinline__ void xcd_barrier(const XcdBarrier& b) {
    asm volatile("s_waitcnt vmcnt(0)" ::: "memory");
    __syncthreads();
    if (threadIdx.x == 0) {
        unsigned* bar = b.bar; asm volatile("" : "+s"(bar));
        unsigned bx = b.x; asm volatile("" : "+s"(bx));
        __builtin_amdgcn_s_waitcnt(0);
        unsigned nloc = b.st[0], nx = b.st[1];
        if (nloc == 0u) { xcd_barrier_complete(bar, bx, nloc, nx); b.st[0] = nloc; b.st[1] = nx; }
        const unsigned old = xb_add(&bar[XB_XSUB(bx)], 1u);
        const unsigned gen = old / nloc;
        if (old + 1u == (gen + 1u) * nloc) {
            __builtin_amdgcn_fence(__ATOMIC_RELEASE, "agent");
            asm volatile("s_waitcnt vmcnt(0)" ::: "memory");
            const unsigned og = xb_add(&bar[XB_TOP], 1u);
            const unsigned tg = og / nx;
            if (og + 1u == (tg + 1u) * nx) xb_add(&bar[XB_TOPGEN], 1u);
            else XB_SPIN(xb_ld(&bar[XB_TOPGEN]) == tg, bar);
            __builtin_amdgcn_fence(__ATOMIC_ACQUIRE, "agent");
            xb_add(&bar[XB_XGEN(bx)], 1u);
            asm volatile("s_waitcnt vmcnt(0)" ::: "memory");
        } else {
            XB_SPIN(xb_ld(&bar[XB_XGEN(bx)]) == gen, bar);
            __builtin_amdgcn_fence(__ATOMIC_ACQUIRE, "agent");
            asm volatile("s_waitcnt vmcnt(0)" ::: "memory");
        }
    }
    __syncthreads();
}

struct Args { const float* in[27]; float* out; unsigned char* ws; };
enum { I_X = 0, I_C, I_WMOD, I_BMOD, I_N1G, I_WIN, I_CONVW, I_CONVB, I_CNG, I_CNB, I_RELB, I_POOLW, I_POOLS, I_SNG, I_SNB, I_SGUW, I_SGUB, I_MIXG, I_WOUT, I_N2G, I_RW, I_RB, I_W1, I_B1, I_W2, I_B2, I_FNG };

__device__ __forceinline__ int t5_bucket(int n) {
    if (n < 16) return n;
    int b = 16;
    b += (n >= 19); b += (n >= 21); b += (n >= 24); b += (n >= 27); b += (n >= 31); b += (n >= 35); b += (n >= 40); b += (n >= 46);
    b += (n >= 52); b += (n >= 59); b += (n >= 67); b += (n >= 77); b += (n >= 87); b += (n >= 99); b += (n >= 113);
    return b;
}

__device__ __forceinline__ void transpose_item(const GAS float* W, int K, int N, GAS f16* WT, int orow0, int k0, int n0, const GAS float* kscale, LAS float* scr, int lane, int ko = -1) {
    if (ko < 0) ko = k0;
#pragma unroll 8
    for (int i = 0; i < 32; ++i) { const int kk = 2 * i + (lane >> 5); float v = W[(size_t)(k0 + kk) * N + n0 + (lane & 31)]; if (kscale) v *= kscale[k0 + kk]; scr[kk * 33 + (lane & 31)] = v; }
    asm volatile("s_waitcnt lgkmcnt(0)" ::: "memory");
    const int c = lane & 7;
#pragma unroll
    for (int j = 0; j < 4; ++j) { const int n = (lane >> 3) + 8 * j; const LAS float* s = scr + (8 * c) * 33 + n;
        u32x4 o; o.x = pk_f16(s[0 * 33], s[1 * 33]); o.y = pk_f16(s[2 * 33], s[3 * 33]); o.z = pk_f16(s[4 * 33], s[5 * 33]); o.w = pk_f16(s[6 * 33], s[7 * 33]);
        *(GAS u32x4*)(WT + (size_t)(orow0 + n) * K + ko + 8 * c) = o; }
    asm volatile("s_waitcnt lgkmcnt(0)" ::: "memory");
}

__device__ __forceinline__ void transpose_item8(const GAS float* W, int K, int N, GAS unsigned char* WT, int orow0, int k0, int n0, LAS float* scr, int lane) {
#pragma unroll 8
    for (int i = 0; i < 32; ++i) { const int kk = 2 * i + (lane >> 5); scr[kk * 33 + (lane & 31)] = W[(size_t)(k0 + kk) * N + n0 + (lane & 31)] * W8_SCALE; }
    asm volatile("s_waitcnt lgkmcnt(0)" ::: "memory");
    const int c = lane & 7;
#pragma unroll
    for (int j = 0; j < 4; ++j) { const int n = (lane >> 3) + 8 * j; const LAS float* s = scr + (8 * c) * 33 + n;
        u32x2 o; o.x = pk4_fp8(s[0 * 33], s[1 * 33], s[2 * 33], s[3 * 33]); o.y = pk4_fp8(s[4 * 33], s[5 * 33], s[6 * 33], s[7 * 33]);
        *(GAS u32x2*)(WT + (size_t)(orow0 + n) * K + k0 + 8 * c) = o; }
    asm volatile("s_waitcnt lgkmcnt(0)" ::: "memory");
}

__device__ __forceinline__ void transpose_item8x64(const GAS float* W, int K, int N, GAS unsigned char* WT, int orow0, int k0, int n0, LAS float* scr, int lane) {
    f32x4 v[16];
#pragma unroll
    for (int i = 0; i < 16; ++i) v[i] = *(const GAS f32x4*)(W + (size_t)(k0 + 4 * i + (lane >> 4)) * N + n0 + 4 * (lane & 15));
#pragma unroll
    for (int i = 0; i < 16; ++i) { LAS float* d = scr + (4 * i + (lane >> 4)) * 65 + 4 * (lane & 15); d[0] = v[i].x * W8_SCALE; d[1] = v[i].y * W8_SCALE; d[2] = v[i].z * W8_SCALE; d[3] = v[i].w * W8_SCALE; }
    asm volatile("s_waitcnt lgkmcnt(0)" ::: "memory");
    const int c = lane & 7;
#pragma unroll
    for (int j = 0; j < 8; ++j) { const int n = (lane >> 3) + 8 * j; const LAS float* s = scr + (8 * c) * 65 + n;
        u32x2 o; o.x = pk4_fp8(s[0 * 65], s[1 * 65], s[2 * 65], s[3 * 65]); o.y = pk4_fp8(s[4 * 65], s[5 * 65], s[6 * 65], s[7 * 65]);
        *(GAS u32x2*)(WT + (size_t)(orow0 + n) * K + k0 + 8 * c) = o; }
    asm volatile("s_waitcnt lgkmcnt(0)" ::: "memory");
}

__device__ __forceinline__ void norm_mod_row(const GAS float* xrow, const GAS float* g, const GAS float* shift, const GAS float* scale, GAS f16* orow, GAS unsigned char* orow8, int lane) {
    f32x4 v[4]; float s = 0.f;
#pragma unroll
    for (int j = 0; j < 4; ++j) { v[j] = *(const GAS f32x4*)(xrow + 4 * lane + 256 * j); s += (v[j].x * v[j].x + v[j].y * v[j].y) + (v[j].z * v[j].z + v[j].w * v[j].w); }
    const float rstd = rsqrtf(wave_sum(s) * (1.f / DM) + EPS);
#pragma unroll
    for (int j = 0; j < 4; ++j) { const int c = 4 * lane + 256 * j; const f32x4 gg = *(const GAS f32x4*)(g + c), sh = *(const GAS f32x4*)(shift + c), sc = *(const GAS f32x4*)(scale + c);
        const f32x4 h = (v[j] * rstd) * gg * (sc + 1.0f) + sh;
        u32x2 w; w.x = pk_f16(h.x, h.y); w.y = pk_f16(h.z, h.w); *(GAS u32x2*)(orow + c) = w;
        if (PROJ_FP8 && PROJ_FP8_FIRST == 0) *(GAS unsigned*)(orow8 + c) = pk4_fp8(h.x, h.y, h.z, h.w); }
}

extern __shared__ __attribute__((aligned(16))) unsigned char lds[];
#define LAUNDER() int tid = tid0; asm volatile("" : "+v"(tid)); const int lane = tid & 63; int wave = wave0; asm volatile("" : "+s"(wave)); const int gw = bid * NWAVES + wave; (void)gw; (void)lane; const CAS Args* AP = (const CAS Args*)__builtin_amdgcn_kernarg_segment_ptr(); asm volatile("" : "+s"(AP)); (void)AP; LAS unsigned char* Lp = (LAS unsigned char*)lds; asm volatile("" : "+s"(Lp)); (void)Lp; GAS unsigned char* ws = (GAS unsigned char*)AP->ws; GAS unsigned* ctl = (GAS unsigned*)(ws + WS_CTL); GAS float* MOD = (GAS float*)(ws + WS_MOD); GAS float* KMEAN = (GAS float*)(ws + WS_KMEAN); GAS float* SSQ = (GAS float*)(ws + WS_SSQ); (void)SSQ; GAS f16* SGUW = (GAS f16*)(ws + WS_SGUW); GAS f16* RWT16 = (GAS f16*)(ws + WS_RWT); (void)RWT16; GAS unsigned char* WIN8 = (GAS unsigned char*)(ws + WS_WIN8); (void)WIN8; GAS unsigned char* HB8 = (GAS unsigned char*)(ws + WS_HB8); (void)HB8; GAS f16* PWT = (GAS f16*)(ws + WS_PWT); (void)PWT; GAS int* ROUTE_E = (GAS int*)(ws + WS_ROUTE); GAS int* ROUTE_POS = ROUTE_E + NTOK * 4; GAS float* ROUTE_G = (GAS float*)(ROUTE_POS + NTOK * 4); GAS int* LIST = (GAS int*)(ws + WS_LIST); GAS f16* WIN_T = (GAS f16*)(ws + WS_WIN); GAS f16* WOUT_T = (GAS f16*)(ws + WS_WOUT); GAS f16* W1_T = (GAS f16*)(ws + WS_W1); GAS f16* W2_T = (GAS f16*)(ws + WS_W2); GAS f16* X = (GAS f16*)(ws + WS_X); GAS f16* H = (GAS f16*)(ws + WS_H); GAS f16* PROJ = (GAS f16*)(ws + WS_PROJ); GAS f16* MIX = (GAS f16*)(ws + WS_MIX); GAS f16* XS = (GAS f16*)(ws + WS_XS); GAS f16* ACT = (GAS f16*)(ws + WS_ACT); (void)ctl; (void)MOD; (void)KMEAN; (void)SGUW; (void)ROUTE_E; (void)ROUTE_POS; (void)ROUTE_G; (void)LIST; (void)WIN_T; (void)WOUT_T; (void)W1_T; (void)W2_T; (void)X; (void)H; (void)PROJ; (void)MIX; (void)XS; (void)ACT;
__device__ __forceinline__ void layer_body(const int l, const XcdBarrier bar, const int tid0, const int wave0, const int G, const int bid, const int NGW) {
#define MODL (MOD + (size_t)l * 8 * 6144)
for (int rep_ = 0; rep_ < REPS(4); ++rep_) if (PHMASK & 4) { LAUNDER();
        if (PROJ_FP8 && l >= PROJ_FP8_FIRST) {
            { pg8::Gemm g{(const GAS pg8::h16_t*)H, (const GAS pg8::h16_t*)(WIN_T + (size_t)l * INW * DM), NTOK, 512, DM, nullptr, nullptr}; pg8::MapOrder S; S.init(NTOK, 512, G, bid); S.map = 0x32u;
              pg8::EpiF16 E{(GAS pg8::h16_t*)PROJ, INW, KMEAN, 1.0f};
              pg8::gemm_phase<pg8::EpiF16, pg8::MapOrder, false, false>(Lp, g, S, E, tid); }
            { pg8::Gemm g{(const GAS pg8::h16_t*)HB8, (const GAS pg8::h16_t*)(WIN8 + (size_t)l * INW * DM), NTOK, 1536, DM / 2, nullptr, nullptr}; pg8::MapOrder S; S.init(NTOK, 1536, G, bid); S.map = 0x765410u;
              pg8::EpiF16 E{(GAS pg8::h16_t*)PROJ, INW, KMEAN, W8_INV};
              pg8::gemm_phase<pg8::EpiF16, pg8::MapOrder, false, true>(Lp, g, S, E, tid); }
        } else {
        { pg8::Gemm g{(const GAS pg8::h16_t*)H, (const GAS pg8::h16_t*)(WIN_T + (size_t)l * INW * DM), NTOK, INW, DM, nullptr, nullptr}; pg8::StaticOrder S; S.init(NTOK, INW, G, bid);
          pg8::EpiF16 E{(GAS pg8::h16_t*)PROJ, INW, KMEAN, 1.0f};
          pg8::gemm_phase<pg8::EpiF16, pg8::StaticOrder, false>(Lp, g, S, E, tid); }
        }
}
        xcd_barrier(bar);
        STAMP(3 + 9 * l + 0);

for (int rep_ = 0; rep_ < REPS(8); ++rep_) if (PHMASK & 8) {
        for (int it_ = bid; it_ < 256 + 512 + 512; it_ += G) { int it = it_; asm volatile("" : "+s"(it));
            if ((PH3 & 1) && it < 256) {
                LAUNDER();
                const int T0 = it * 128;
                LAS f16* vT = (LAS f16*)Lp;
                constexpr int VS = 136;
                const GAS float* sng = GIN(I_SNG) + l * GW; const GAS float* snb = GIN(I_SNB) + l * GW;
                f16x8 afr[4][4];
#pragma unroll
                for (int ks = 0; ks < 4; ++ks)
#pragma unroll
                    for (int h = 0; h < 4; ++h) afr[ks][h] = *(const GAS f16x8*)(SGUW + ((size_t)(l * 4 + h) * 128 + 16 * wave + (lane & 15)) * 128 + 32 * ks + 8 * (lane >> 4));
#pragma unroll 1
                for (int tg = 0; tg < 16; tg += 4) { f16x4 hvv[4];
#pragma unroll
                  for (int t4 = 0; t4 < 4; ++t4) hvv[t4] = *(const GAS f16x4*)(PROJ + (size_t)(T0 + wave * 16 + tg + t4) * INW + 1792 + 4 * lane);
#pragma unroll
                  for (int t4 = 0; t4 < 4; ++t4) { const int tl = wave * 16 + tg + t4;
                    const f16x4 hv = hvv[t4]; float v[4]; float s = 0.f;
#pragma unroll
                    for (int i = 0; i < 4; ++i) { v[i] = gelu_erf((float)hv[i]); s += v[i]; }
                    const float mean = wave_sum(s) * (1.f / 256.f); float q = 0.f;
#pragma unroll
                    for (int i = 0; i < 4; ++i) { v[i] -= mean; q += v[i] * v[i]; }
                    const float rstd = rsqrtf(wave_sum(q) * (1.f / 256.f) + EPS);
#pragma unroll
                    for (int i = 0; i < 4; ++i) { const int c = 4 * lane + i; vT[c * VS + tl] = (f16)(v[i] * rstd * sng[c] + snb[c]); } } }
                __syncthreads();
                f32x4 acc[4][4];
#pragma unroll
                for (int h = 0; h < 4; ++h)
#pragma unroll
                    for (int ct = 0; ct < 4; ++ct) acc[h][ct] = (f32x4){0.f, 0.f, 0.f, 0.f};
                const int nk = (wave >> 1) + 1, fr = lane & 15, fq = lane >> 4;
#pragma unroll
                for (int ks = 0; ks < 4; ++ks) { if (ks < nk) {
#pragma unroll
                    for (int h = 0; h < 4; ++h) {
                        const f16x8 a = afr[ks][h];
#pragma unroll
                        for (int ct = 0; ct < 4; ++ct) { const f16x8 b = *(const LAS f16x8*)(vT + (h * 64 + ct * 16 + fr) * VS + 32 * ks + 8 * fq);
                            acc[h][ct] = __builtin_amdgcn_mfma_f32_16x16x32_f16(a, b, acc[h][ct], 0, 0, 0); } } } }
                const GAS float* sb = GIN(I_SGUB) + (size_t)l * 4 * 128;
#pragma unroll
                for (int reg = 0; reg < 4; ++reg) { const int il = 16 * wave + 4 * fq + reg; const size_t tok = (size_t)(T0 + il); float ss = 0.f; float val[4][4];
#pragma unroll
                    for (int h = 0; h < 4; ++h) { const float bia = sb[h * 128 + il];
#pragma unroll
                        for (int ct = 0; ct < 4; ++ct) { const int c = h * 64 + ct * 16 + fr; const float u = gelu_erf((float)PROJ[tok * INW + 1536 + c]);
                            const float x = (acc[h][ct][reg] + bia) * u; val[h][ct] = x; ss += x * x; } }
                    ss = row16_sum(ss);
                    const float rstd = rsqrtf(ss * (1.f / 256.f) + EPS);
#pragma unroll
                    for (int h = 0; h < 4; ++h)
#pragma unroll
                        for (int ct = 0; ct < 4; ++ct) MIX[tok * DM + 768 + h * 64 + ct * 16 + fr] = (f16)(val[h][ct] * rstd); }
                __syncthreads();
            } else if ((PH3 & 2) && it < 768) {
                LAUNDER();
                const int T0 = (it - 256) * 64, p0 = T0 & (SEQ - 1);
                LAS float* y = (LAS float*)Lp;
                LAS float* Wc = (LAS float*)(Lp + 96256);
                for (int i = tid; i < 31 * 64; i += 512) *(LAS f32x4*)(Wc + 4 * i) = *(const GAS f32x4*)(GIN(I_CONVW) + (size_t)l * 31 * GW + 4 * i);
                { f16x8 av[6], gv[6];
#pragma unroll
                  for (int k6 = 0; k6 < 6; ++k6) { int task = tid + k6 * 512; task = task < 94 * 32 ? task : 94 * 32 - 1; const int r = task >> 5, c8 = (task & 31) * 8; const bool ok = (p0 - 30 + r >= 0);
                      const GAS f16* pr = PROJ + (size_t)(T0 + (ok ? r - 30 : 0)) * INW + c8; av[k6] = *(const GAS f16x8*)pr; gv[k6] = *(const GAS f16x8*)(pr + 256); }
#pragma unroll
                  for (int k6 = 0; k6 < 6; ++k6) { const int task = tid + k6 * 512;
                      if (task < 94 * 32) { const int r = task >> 5, c8 = (task & 31) * 8; const bool ok = (p0 - 30 + r >= 0); float o[8];
#pragma unroll
                          for (int i = 0; i < 8; ++i) o[i] = ok ? (float)av[k6][i] * sigmoidf_((float)gv[k6][i]) : 0.f;
                          *(LAS f32x4*)(y + r * 256 + c8) = (f32x4){o[0], o[1], o[2], o[3]}; *(LAS f32x4*)(y + r * 256 + c8 + 4) = (f32x4){o[4], o[5], o[6], o[7]}; } } }
                __syncthreads();
                float psq[8];
#pragma unroll
                for (int t = 0; t < 8; ++t) psq[t] = 0.f;
                float osv[4][8];
#pragma unroll
                for (int h = 0; h < 4; ++h) { const int c = h * 64 + lane; float w[31];
#pragma unroll
                    for (int j = 0; j < 31; ++j) w[j] = Wc[j * 256 + c];
                    const float cb = GIN(I_CONVB)[l * GW + c], ng = GIN(I_CNG)[l * GW + c], nb_ = GIN(I_CNB)[l * GW + c];
                    float yv[38];
#pragma unroll
                    for (int q = 0; q < 38; ++q) yv[q] = y[(wave * 8 + q) * 256 + c];
                    float a[8], red[16];
#pragma unroll
                    for (int t = 0; t < 8; ++t) { float s = cb;
#pragma unroll
                        for (int j = 0; j < 31; ++j) s += w[j] * yv[t + j];
                        a[t] = s; red[t] = s; red[8 + t] = s * s; }
                    wave_sum_n<16>(red);
#pragma unroll
                    for (int t = 0; t < 8; ++t) { const float mean = red[t] * (1.f / 64.f), var = fmaxf(red[8 + t] * (1.f / 64.f) - mean * mean, 0.f);
                        const float yn = (a[t] - mean) * rsqrtf(var + EPS) * ng + nb_; const float sv = yn * sigmoidf_(yn);
                        psq[t] += sv * sv; osv[h][t] = sv; }
                    asm volatile("" ::: "memory"); }
                wave_sum_n<8>(psq);
#pragma unroll
                for (int t = 0; t < 8; ++t) psq[t] = rsqrtf(psq[t] * (1.f / 256.f) + EPS);
#pragma unroll
                for (int h = 0; h < 4; ++h)
#pragma unroll
                    for (int t = 0; t < 8; ++t) MIX[(size_t)(T0 + wave * 8 + t) * DM + 256 + h * 64 + lane] = (f16)(osv[h][t] * psq[t]);
                __syncthreads();
            } else if ((PH3 & 4) && it < 1280) {
                LAUNDER();
                const int T0 = (it - 768) * 64, p0 = T0 & (SEQ - 1);
                LAS f16* zt = (LAS f16*)Lp;
                LAS f16* Pf = (LAS f16*)(Lp + 40960);
                LAS f16* WpT = (LAS f16*)(Lp + 75776);
                constexpr int PS = 264, WS2 = 72;
                for (int i = tid; i < 256 * 8; i += 512) { const int r = i >> 3, c8 = (i & 7) * 8; *(LAS u32x4*)(WpT + r * WS2 + c8) = *(const GAS u32x4*)(PWT + (size_t)l * 16384 + r * 64 + c8); }
                for (int task = tid; task < 79 * 32; task += 512) { const int r = task >> 5, c8 = (task & 31) * 8; u32x4 z = {0u, 0u, 0u, 0u};
                    if (p0 - 15 + r >= 0) z = *(const GAS u32x4*)(PROJ + (size_t)(T0 - 15 + r) * INW + 1280 + c8);
                    *(LAS u32x4*)(zt + r * 256 + c8) = z; }
                __syncthreads();
                { const int c8 = (tid & 31) * 8, seg = tid >> 5, gi = c8 >> 6, w = 2 << gi; float s[8];
#pragma unroll
                  for (int i = 0; i < 8; ++i) s[i] = 0.f;
                  for (int d = 1; d < w; ++d) { const f16x8 z = *(const LAS f16x8*)(zt + (seg * 4 + 15 - d) * 256 + c8);
#pragma unroll
                      for (int i = 0; i < 8; ++i) s[i] += (float)z[i]; }
#pragma unroll
                  for (int t = 0; t < 4; ++t) { const int tl = seg * 4 + t, p = p0 + tl;
                      const f16x8 zn = *(const LAS f16x8*)(zt + (tl + 15) * 256 + c8);
                      const float inv = 1.f / (float)(p + 1 < w ? p + 1 : w); f16x8 po;
#pragma unroll
                      for (int i = 0; i < 8; ++i) { s[i] += (float)zn[i]; po[i] = (f16)(s[i] * inv - (float)zn[i]); }
                      *(LAS f16x8*)(Pf + tl * PS + c8) = po;
                      const f16x8 zo = *(const LAS f16x8*)(zt + (tl + 15 - (w - 1)) * 256 + c8);
#pragma unroll
                      for (int i = 0; i < 8; ++i) s[i] -= (float)zo[i]; } }
                __syncthreads();
                if (wave < 4) {
                    const int fr = lane & 15, fq = lane >> 4;
                    f32x4 acc[4][4];
#pragma unroll
                    for (int g = 0; g < 4; ++g)
#pragma unroll
                        for (int nt = 0; nt < 4; ++nt) acc[g][nt] = (f32x4){0.f, 0.f, 0.f, 0.f};
#pragma unroll
                    for (int g = 0; g < 4; ++g)
#pragma unroll
                        for (int ks = 0; ks < 2; ++ks) { const f16x8 av = *(const LAS f16x8*)(Pf + (16 * wave + fr) * PS + g * 64 + 32 * ks + 8 * fq);
#pragma unroll
                            for (int nt = 0; nt < 4; ++nt) { const f16x8 bv = *(const LAS f16x8*)(WpT + (g * 64 + nt * 16 + fr) * WS2 + 32 * ks + 8 * fq);
                                acc[g][nt] = __builtin_amdgcn_mfma_f32_16x16x32_f16(av, bv, acc[g][nt], 0, 0, 0); } }
                    float psc[4][4];
#pragma unroll
                    for (int g = 0; g < 4; ++g)
#pragma unroll
                        for (int nt = 0; nt < 4; ++nt) psc[g][nt] = GIN(I_POOLS)[l * GW + g * 64 + nt * 16 + fr];
#pragma unroll
                    for (int reg = 0; reg < 4; ++reg) { float ss = 0.f;
#pragma unroll
                        for (int g = 0; g < 4; ++g)
#pragma unroll
                            for (int nt = 0; nt < 4; ++nt) { const float x = acc[g][nt][reg] * psc[g][nt]; acc[g][nt][reg] = x; ss += x * x; }
                        ss = row16_sum(ss);
                        const float rstd = rsqrtf(ss * (1.f / 256.f) + EPS); const size_t tok = (size_t)(T0 + 16 * wave + 4 * fq + reg);
#pragma unroll
                        for (int g = 0; g < 4; ++g)
#pragma unroll
                            for (int nt = 0; nt < 4; ++nt) MIX[tok * DM + 512 + g * 64 + nt * 16 + fr] = (f16)(acc[g][nt][reg] * rstd); }
                }
                __syncthreads();
            }
        }
}
        STAMP(3 + 9 * l + 1);

for (int rep_ = 0; rep_ < REPS(16); ++rep_) if (PHMASK & 16) { LAUNDER();
        {
            LAS f16* Kb = (LAS f16*)Lp;
            LAS f16* Vb = (LAS f16*)(Lp + 36864);
            LAS float* kml = (LAS float*)(Lp + 73728);
            LAS float* lut = (LAS float*)(Lp + 73728 + 4096);
            constexpr int KS = 72;
            constexpr float LOG2E = 1.4426950408889634f, SC2 = 0.125f * LOG2E, THR = 4.0f;
            const int r32 = lane & 31, hh = lane >> 5;
            const int vtr_off = (4 * hh + ((lane & 15) >> 2)) * KS + 16 * ((lane >> 4) & 1) + 4 * (lane & 3);
            const int lk = tid >> 3, lc = tid & 7;
            for (int pi = bid; pi < 256; pi += G) {
                const int bh = pi >> 3, pp = pi & 7;
                for (int half = 0; half < 2; ++half) {
                    const int own = half == 0 ? 15 - pp : pp;
                    const int b = bh >> 2, h = bh & 3;
                    const size_t TB = (size_t)b * SEQ;
                    const int qpos = own * 256 + 32 * wave + r32;
                    const GAS f16* kvp = PROJ + (TB + lk) * INW + 768 + h * 64 + 8 * lc;
                    f16x8 kr[4], vr[4];
#pragma unroll
                    for (int pc = 0; pc < 4; ++pc) { const GAS f16* p_ = kvp + (size_t)(64 * pc) * INW; kr[pc] = *(const GAS f16x8*)p_; vr[pc] = *(const GAS f16x8*)(p_ + 256); }
                    __syncthreads();
                    for (int i = tid; i < 1024; i += 512) kml[i] = KMEAN[((size_t)(b * 16 + (i >> 6))) * 256 + h * 64 + (i & 63)] * (1.f / 256.f);
                    if (tid < 128) lut[tid] = GIN(I_RELB)[t5_bucket(tid) * 4 + h] * LOG2E;
                    f16x8 qf[4];
                    { const GAS f16* qp = PROJ + (TB + qpos) * INW + 512 + h * 64 + 8 * hh;
#pragma unroll
                      for (int s = 0; s < 4; ++s) qf[s] = *(const GAS f16x8*)(qp + 16 * s); }
                    __syncthreads();
                    unsigned mask = 0u;
                    { float gsc[16]; float qv[32];
#pragma unroll
                      for (int s = 0; s < 4; ++s)
#pragma unroll
                          for (int j = 0; j < 8; ++j) qv[8 * s + j] = (float)qf[s][j];
#pragma unroll
                      for (int n = 0; n < 16; ++n) { float a = 0.f;
                          if (n < own) { f32x4 kv[8];
#pragma unroll
                              for (int s = 0; s < 4; ++s) { kv[2 * s] = *(const LAS f32x4*)(kml + n * 64 + 16 * s + 8 * hh); kv[2 * s + 1] = *(const LAS f32x4*)(kml + n * 64 + 16 * s + 8 * hh + 4); }
#pragma unroll
                              for (int s = 0; s < 8; ++s) a += (qv[4 * s] * kv[s].x + qv[4 * s + 1] * kv[s].y) + (qv[4 * s + 2] * kv[s].z + qv[4 * s + 3] * kv[s].w); }
                          a += __shfl_xor(a, 32); gsc[n] = a; }
#pragma unroll
                      for (int k = 0; k < 3; ++k) { float best = -INFINITY; int bi = -1;
#pragma unroll
                          for (int n = 0; n < 16; ++n) { const bool ok = (n < own) && !((mask >> n) & 1u) && (gsc[n] > best); if (ok) { best = gsc[n]; bi = n; } }
                          if (bi >= 0) mask |= 1u << bi; }
#pragma unroll
                      for (int s = 0; s < 4; ++s)
#pragma unroll
                          for (int j = 0; j < 8; ++j) qf[s][j] = (f16)(qv[8 * s + j] * SC2); }
                    f32x16 o0, o1;
#pragma unroll
                    for (int i = 0; i < 16; ++i) { o0[i] = 0.f; o1[i] = 0.f; }
                    float mrun = -INFINITY, lrun = 0.f;
                    f32x16 iniv; float ini_prev = 0.f;
#pragma unroll
                    for (int i = 0; i < 16; ++i) iniv[i] = 0.f;
                    for (int n = 0; n <= own; ++n) {
                        __syncthreads();
#pragma unroll
                        for (int pc = 0; pc < 4; ++pc) { *(LAS f16x8*)(Kb + (lk + 64 * pc) * KS + 8 * lc) = kr[pc]; *(LAS f16x8*)(Vb + (lk + 64 * pc) * KS + 8 * lc) = vr[pc]; }
                        __syncthreads();
                        if (n < own) {
#pragma unroll
                            for (int pc = 0; pc < 4; ++pc) { const GAS f16* p_ = kvp + (size_t)((n + 1) * 256 + 64 * pc) * INW; kr[pc] = *(const GAS f16x8*)p_; vr[pc] = *(const GAS f16x8*)(p_ + 256); } }
                        const bool past = n < own;
                        const bool sel = past ? ((mask >> n) & 1u) != 0u : true;
                        if (past && !__any(sel)) continue;
                        const int ntl = past ? 4 : (wave >> 1) + 1;
#pragma unroll 1
                        for (int tl = 0; tl < ntl; ++tl) {
                            const LAS f16* Kt = Kb + tl * 64 * KS; const LAS f16* Vt = Vb + tl * 64 * KS;
                            const int kbase = n * 256 + tl * 64;
                            const int dmin = own * 256 + 32 * wave - (kbase + 63);
                            const bool cb = dmin >= 127;
                            const float minit = (mrun == -INFINITY) ? 0.f : mrun;
                            const float ini = sel ? ((cb ? lut[127] : 0.f) - minit) : -INFINITY;
                            if (__any(ini != ini_prev)) {
#pragma unroll
                                for (int i = 0; i < 16; ++i) iniv[i] = ini;
                                ini_prev = ini; }
                            f32x16 p0, p1;
                            { const f16x8 a0 = *(const LAS f16x8*)(Kt + r32 * KS + 8 * hh), a1 = *(const LAS f16x8*)(Kt + (32 + r32) * KS + 8 * hh);
                              p0 = __builtin_amdgcn_mfma_f32_32x32x16_f16(a0, qf[0], iniv, 0, 0, 0); p1 = __builtin_amdgcn_mfma_f32_32x32x16_f16(a1, qf[0], iniv, 0, 0, 0); }
#pragma unroll
                            for (int s = 1; s < 4; ++s) { const f16x8 a0 = *(const LAS f16x8*)(Kt + r32 * KS + 16 * s + 8 * hh), a1 = *(const LAS f16x8*)(Kt + (32 + r32) * KS + 16 * s + 8 * hh);
                                p0 = __builtin_amdgcn_mfma_f32_32x32x16_f16(a0, qf[s], p0, 0, 0, 0); p1 = __builtin_amdgcn_mfma_f32_32x32x16_f16(a1, qf[s], p1, 0, 0, 0); }
                            if (!cb) {
#pragma unroll
                                for (int i = 0; i < 16; ++i) { const int kr_ = (i & 3) + 8 * (i >> 2) + 4 * hh; const int d0 = qpos - (kbase + kr_), d1 = d0 - 32;
                                    p0[i] = (d0 >= 0) ? p0[i] + lut[d0 > 127 ? 127 : d0] : -INFINITY;
                                    p1[i] = (d1 >= 0) ? p1[i] + lut[d1 > 127 ? 127 : (d1 < 0 ? 0 : d1)] : -INFINITY; } }
                            asm volatile("s_nop 7\n\ts_nop 7\n\ts_nop 7" : "+v"(p0), "+v"(p1));
                            float mx = max3f(p0[0], p0[1], p1[0]), mxb = max3f(p0[2], p0[3], p1[1]); mx = max3f(mx, p1[2], p1[3]);
#pragma unroll
                            for (int i = 4; i < 16; i += 4) { mx = max3f(mx, p0[i], p0[i + 1]); mxb = max3f(mxb, p0[i + 2], p0[i + 3]); mx = max3f(mx, p1[i], p1[i + 1]); mxb = max3f(mxb, p1[i + 2], p1[i + 3]); }
                            mx = max2f(mx, mxb);
                            mx = max2f(mx, __shfl_xor(mx, 32));
                            const bool need = sel && (mx > -INFINITY) && ((mrun == -INFINITY) || (mx > THR));
                            if (__any(need)) { const float delta = need ? mx : 0.f; const float alpha = __builtin_amdgcn_exp2f(-delta);
#pragma unroll
                                for (int i = 0; i < 16; ++i) { p0[i] -= delta; p1[i] -= delta; o0[i] *= alpha; o1[i] *= alpha; }
                                lrun *= alpha; if (need) mrun = minit + delta; }
#pragma unroll
                            for (int i = 0; i < 16; ++i) { p0[i] = __builtin_amdgcn_exp2f(p0[i]); p1[i] = __builtin_amdgcn_exp2f(p1[i]); }
                            asm volatile("s_nop 1" : "+v"(p0), "+v"(p1));
                            float psa = 0.f, psb = 0.f, psc = 0.f, psd = 0.f;
#pragma unroll
                            for (int i = 0; i < 16; i += 2) { psa = fadd_s(psa, p0[i]); psb = fadd_s(psb, p1[i]); psc = fadd_s(psc, p0[i + 1]); psd = fadd_s(psd, p1[i + 1]); }
                            lrun += (psa + psb) + (psc + psd);
                            f16x8 pb[4];
#pragma unroll
                            for (int i = 0; i < 8; ++i) { pb[0][i] = (f16)p0[i]; pb[1][i] = (f16)p0[8 + i]; pb[2][i] = (f16)p1[i]; pb[3][i] = (f16)p1[8 + i]; }
#pragma unroll
                            for (int kk = 0; kk < 4; ++kk) {
                                const LAS f16* vb = Vt + vtr_off + (16 * kk) * KS;
                                const f16x4 a0l = __builtin_bit_cast(f16x4, __builtin_amdgcn_ds_read_tr16_b64_v4i16((LAS v4i16_t*)(vb)));
                                const f16x4 a0h = __builtin_bit_cast(f16x4, __builtin_amdgcn_ds_read_tr16_b64_v4i16((LAS v4i16_t*)(vb + 8 * KS)));
                                const f16x4 a1l = __builtin_bit_cast(f16x4, __builtin_amdgcn_ds_read_tr16_b64_v4i16((LAS v4i16_t*)(vb + 32)));
                                const f16x4 a1h = __builtin_bit_cast(f16x4, __builtin_amdgcn_ds_read_tr16_b64_v4i16((LAS v4i16_t*)(vb + 8 * KS + 32)));
                                const f16x8 av0 = {a0l[0], a0l[1], a0l[2], a0l[3], a0h[0], a0h[1], a0h[2], a0h[3]};
                                const f16x8 av1 = {a1l[0], a1l[1], a1l[2], a1l[3], a1h[0], a1h[1], a1h[2], a1h[3]};
                                o0 = __builtin_amdgcn_mfma_f32_32x32x16_f16(av0, pb[kk], o0, 0, 0, 0);
                                o1 = __builtin_amdgcn_mfma_f32_32x32x16_f16(av1, pb[kk], o1, 0, 0, 0); }
                        }
                    }
                    const float ltot = lrun + __shfl_xor(lrun, 32), inv = 1.f / ltot;
                    GAS f16* op = MIX + (TB + qpos) * DM + h * 64;
                    float sq = 0.f;
#pragma unroll
                    for (int g4 = 0; g4 < 4; ++g4) { const int d0 = 8 * g4 + 4 * hh;
                        u32x2 w0, w1; w0.x = pk_f16(o0[4 * g4] * inv, o0[4 * g4 + 1] * inv); w0.y = pk_f16(o0[4 * g4 + 2] * inv, o0[4 * g4 + 3] * inv);
                        w1.x = pk_f16(o1[4 * g4] * inv, o1[4 * g4 + 1] * inv); w1.y = pk_f16(o1[4 * g4 + 2] * inv, o1[4 * g4 + 3] * inv);
                        { const f16x4 r0 = __builtin_bit_cast(f16x4, w0), r1 = __builtin_bit_cast(f16x4, w1);
#pragma unroll
                          for (int i = 0; i < 4; ++i) { const float a_ = (float)r0[i], b_ = (float)r1[i]; sq += a_ * a_ + b_ * b_; } }
                        *(GAS u32x2*)(op + d0) = w0; *(GAS u32x2*)(op + 32 + d0) = w1; }
                    sq += __shfl_xor(sq, 32);
                    if (hh == 0) SSQ[(TB + qpos) * 4 + h] = sq;
                }
            }
        }
}
        xcd_barrier(bar);
        STAMP(3 + 9 * l + 2);

        STAMP(3 + 9 * l + 3);

if (PHMASK & 64) { LAUNDER();
        { pg8::Gemm g{(const GAS pg8::h16_t*)MIX, (const GAS pg8::h16_t*)(WOUT_T + (size_t)l * DM * DM), NTOK, DM, DM, nullptr, SSQ}; pg8::StaticOrder S; S.init(NTOK, DM, G, bid);
          if (l == 0) { pg8::EpiResidT<true> E{GIN(I_X), nullptr, (GAS pg8::h16_t*)X, MODL + 2048}; pg8::gemm_phase<pg8::EpiResidT<true>, pg8::StaticOrder, false, false, true>(Lp, g, S, E, tid); }
          else { pg8::EpiResidT<false> E{nullptr, (const GAS pg8::h16_t*)X, (GAS pg8::h16_t*)X, MODL + 2048}; pg8::gemm_phase<pg8::EpiResidT<false>, pg8::StaticOrder, false, false, true>(Lp, g, S, E, tid); } }
}
        xcd_barrier(bar);
        STAMP(3 + 9 * l + 4);

if (PHMASK & 128) { LAUNDER();
        {
            LAS f16* WT = (LAS f16*)Lp;
            constexpr int WS_ = 1032;
            LAS float* lg = (LAS float*)(Lp + 66560 + wave * 2304);
            LAS int* sel_e = (LAS int*)(Lp + 131584);
            LAS int* rank_ = (LAS int*)(Lp + 131584 + 2048);
            LAS int* lcnt = (LAS int*)(Lp + 131584 + 4096);
            LAS int* lbase = (LAS int*)(Lp + 131584 + 4096 + 128);
            for (int i = tid; i < 32 * WS_ / 8; i += 512) *(LAS u32x4*)(WT + 8 * i) = *(const GAS u32x4*)(RWT16 + (size_t)l * 32 * WS_ + 8 * i);
            GAS unsigned* gcnt = ctl + CW_CNT + l * 32 * 64;
            const int fr = lane & 15, fq = lane >> 4;
            if (l + 1 < DEPTH) { for (int i = bid * 512 + tid; i < NB * 16 * 256; i += G * 512) KMEAN[i] = 0.f; }
            for (int ch = bid; ch < NTOK / 128; ch += G) {
                if (tid < 32) lcnt[tid] = 0;
                __syncthreads();
                const int b = (ch * 128) >> 12; const GAS float* md = MODL + (size_t)b * 6144;
                const GAS float* g2 = GIN(I_N2G) + l * DM;
                const size_t tokw = (size_t)ch * 128 + wave * 16;
                LAS float* pgl = (LAS float*)(Lp + 86016); LAS float* psl = (LAS float*)(Lp + 86016 + 4096);
                for (int i = tid; i < 256; i += 512) { const f32x4 g4 = *(const GAS f32x4*)(g2 + 4 * i), s4 = *(const GAS f32x4*)(md + 4096 + 4 * i); *(LAS f32x4*)(pgl + 4 * i) = g4 * (s4 + 1.0f); *(LAS f32x4*)(psl + 4 * i) = *(const GAS f32x4*)(md + 3072 + 4 * i); }
                __syncthreads();
                LAS f16* hb = (LAS f16*)(Lp + 94208) + wave * (2 * WS_);
                const float rb0 = GIN(I_RB)[l * NEXP + fr], rb1 = GIN(I_RB)[l * NEXP + 16 + fr];
#pragma unroll 1
                for (int t2 = 0; t2 < 16; t2 += 4) {
                    f32x4 v[4][4];
#pragma unroll
                    for (int r = 0; r < 4; ++r)
#pragma unroll
                        for (int j = 0; j < 4; ++j) { const f16x4 xh = *(const GAS f16x4*)(X + (tokw + t2 + r) * DM + 4 * lane + 256 * j); v[r][j] = (f32x4){(float)xh[0], (float)xh[1], (float)xh[2], (float)xh[3]}; }
#pragma unroll
                    for (int hf = 0; hf < 2; ++hf) {
#pragma unroll
                        for (int r2 = 0; r2 < 2; ++r2) { const int r = 2 * hf + r2; float s = 0.f;
#pragma unroll
                            for (int j = 0; j < 4; ++j) s += (v[r][j].x * v[r][j].x + v[r][j].y * v[r][j].y) + (v[r][j].z * v[r][j].z + v[r][j].w * v[r][j].w);
                            const float rstd = rsqrtf(wave_sum(s) * (1.f / DM) + EPS);
#pragma unroll
                            for (int j = 0; j < 4; ++j) { const int c = 4 * lane + 256 * j;
                                const f32x4 hq = (v[r][j] * rstd) * *(const LAS f32x4*)(pgl + c) + *(const LAS f32x4*)(psl + c);
                                u32x2 w; w.x = pk_f16(hq.x, hq.y); w.y = pk_f16(hq.z, hq.w); *(LAS u32x2*)(hb + r2 * WS_ + c) = w;
                                if (!IS_FP8(l)) *(GAS u32x2*)(H + (tokw + t2 + r) * DM + c) = w;
                                if (IS_FP8(l)) *(GAS unsigned*)((GAS unsigned char*)XS + (tokw + t2 + r) * DM + c) = pk4_fp8(hq.x, hq.y, hq.z, hq.w); } }
                        asm volatile("s_waitcnt lgkmcnt(0)" ::: "memory");
                        f32x4 acc0 = {0.f, 0.f, 0.f, 0.f}, acc1 = {0.f, 0.f, 0.f, 0.f};
#pragma unroll 4
                        for (int ks = 0; ks < 32; ++ks) { const f16x8 a = *(const LAS f16x8*)(hb + (fr & 1) * WS_ + 32 * ks + 8 * fq);
                            const f16x8 b0 = *(const LAS f16x8*)(WT + fr * WS_ + 32 * ks + 8 * fq), b1 = *(const LAS f16x8*)(WT + (16 + fr) * WS_ + 32 * ks + 8 * fq);
                            acc0 = __builtin_amdgcn_mfma_f32_16x16x32_f16(a, b0, acc0, 0, 0, 0); acc1 = __builtin_amdgcn_mfma_f32_16x16x32_f16(a, b1, acc1, 0, 0, 0); }
                        if (fq == 0) {
#pragma unroll
                            for (int reg = 0; reg < 2; ++reg) { lg[(t2 + 2 * hf + reg) * 36 + fr] = acc0[reg] + rb0; lg[(t2 + 2 * hf + reg) * 36 + 16 + fr] = acc1[reg] + rb1; } }
                        asm volatile("s_waitcnt lgkmcnt(0)" ::: "memory");
                    }
                }
                asm volatile("s_waitcnt lgkmcnt(0)" ::: "memory");
                if (lane < 16) { float vv[32];
#pragma unroll
                    for (int q = 0; q < 8; ++q) { const f32x4 t = *(const LAS f32x4*)(lg + lane * 36 + 4 * q); vv[4 * q] = t.x; vv[4 * q + 1] = t.y; vv[4 * q + 2] = t.z; vv[4 * q + 3] = t.w; }
                    float topv[4]; int topi[4];
#pragma unroll
                    for (int k = 0; k < 4; ++k) { float bv = -INFINITY; int bi = 0;
#pragma unroll
                        for (int e = 0; e < 32; ++e) { if (vv[e] > bv) { bv = vv[e]; bi = e; } }
                        topv[k] = bv; topi[k] = bi;
#pragma unroll
                        for (int e = 0; e < 32; ++e) vv[e] = (e == bi) ? -INFINITY : vv[e]; }
                    const int tl = wave * 16 + lane; const size_t tok = (size_t)ch * 128 + tl;
                    const float e1 = __expf(topv[1] - topv[0]), e2 = __expf(topv[2] - topv[0]), e3 = __expf(topv[3] - topv[0]); const float inv = 1.f / (1.f + e1 + e2 + e3);
                    *(GAS f32x4*)(ROUTE_G + tok * 4) = (f32x4){inv, e1 * inv, e2 * inv, e3 * inv};
#pragma unroll
                    for (int k = 0; k < 4; ++k) sel_e[tl * 4 + k] = topi[k]; }
                __syncthreads();
                const int e = sel_e[tid];
                rank_[tid] = __hip_atomic_fetch_add(&lcnt[e], 1, __ATOMIC_RELAXED, __HIP_MEMORY_SCOPE_WORKGROUP);
                __syncthreads();
                if (tid < 32) lbase[tid] = (int)__hip_atomic_fetch_add(gcnt + tid * 64, (unsigned)lcnt[tid], __ATOMIC_RELAXED, __HIP_MEMORY_SCOPE_AGENT);
                __syncthreads();
                { const int pos = lbase[e] + rank_[tid]; const size_t tok = (size_t)ch * 128 + (tid >> 2);
                  LIST[(size_t)e * LISTCAP + pos] = (int)tok; ROUTE_E[tok * 4 + (tid & 3)] = e; ROUTE_POS[tok * 4 + (tid & 3)] = pos; }
                __syncthreads();
            }
        }
}
        xcd_barrier(bar);
        STAMP(3 + 9 * l + 5);

#define cnts ((LAS int*)(Lp + RING_BYTES + 1024))
#define mbase ((LAS int*)(Lp + RING_BYTES + 1024 + 256))
        { LAUNDER(); GAS unsigned* gcnt = ctl + CW_CNT + l * 32 * 64;
          if (tid < 32) cnts[tid] = (int)__hip_atomic_load(gcnt + tid * 64, __ATOMIC_RELAXED, __HIP_MEMORY_SCOPE_AGENT);
          __syncthreads();
          if (tid == 0) { int a = 0; for (int e = 0; e < 32; ++e) { mbase[e] = a; a += (cnts[e] + 255) >> 8; } mbase[32] = a; }
          __syncthreads(); }

        for (int ph = 0; ph < 2; ++ph) {
            if (!(PHMASK & (512 << ph))) continue;
            for (int rep_ = 0; rep_ < REPS(512 << ph); ++rep_) {
            LAUNDER(); const int MT = mbase[32]; LAS int* ulist = (LAS int*)(Lp + RING_BYTES); const int NT = ph == 0 ? 8 : 4, U = MT * NT;
            __syncthreads();
            int nu = 0;
            { const int q = U / 8, rr = U % 8, nig = 8 * NT;
              for (int i = 0; i < 64; ++i) { const long Lid = (long)i * G + bid; if (Lid >= U) break; ++nu;
                  if (tid == i) { int wg = (int)Lid; const int xcd = wg % 8, off = wg / 8; wg = (xcd < rr ? xcd * (q + 1) : rr * (q + 1) + (xcd - rr) * q) + off;
                      const int gid = wg / nig, fm = gid * 8, gsz = (MT - fm) < 8 ? (MT - fm) : 8; const int pm = fm + ((wg % nig) % gsz), pn = (wg % nig) / gsz;
                      int e = 0;
                      for (int qq = 1; qq < 32; ++qq) e += (mbase[qq] <= pm) ? 1 : 0;
                      ulist[3 * i] = pm | ((e * NT + pn) << 16); ulist[3 * i + 1] = (pm - mbase[e]) * 256; ulist[3 * i + 2] = cnts[e]; } } }
            __syncthreads();
            pg8::ListOrder S{ulist, nu};
            if (ph == 0) {
                if (IS_FP8(l)) { pg8::Gemm g{(const GAS pg8::h16_t*)XS, (const GAS pg8::h16_t*)(W1_T + (size_t)l * NEXP * 2048 * DM), PROWS, 2048, DM / 2, LIST, nullptr};
                    pg8::EpiSwigluT<true> E{(GAS unsigned char*)ACT, GIN(I_B1) + (size_t)l * NEXP * 2048, W8_INV};
                    pg8::gemm_phase<pg8::EpiSwigluT<true>, pg8::ListOrder, true, true>(Lp, g, S, E, tid); }
                else { pg8::Gemm g{(const GAS pg8::h16_t*)H, (const GAS pg8::h16_t*)(W1_T + (size_t)l * NEXP * 2048 * DM), PROWS, 2048, DM, LIST, nullptr};
                    pg8::EpiSwigluT<false> E{(GAS unsigned char*)ACT, GIN(I_B1) + (size_t)l * NEXP * 2048, 1.0f};
                    pg8::gemm_phase<pg8::EpiSwigluT<false>, pg8::ListOrder, true, false>(Lp, g, S, E, tid); } }
            else {
                if (IS_FP8(l)) { pg8::Gemm g{(const GAS pg8::h16_t*)ACT, (const GAS pg8::h16_t*)(W2_T + (size_t)l * NEXP * DM * DM), PROWS, 1024, DM / 2, nullptr, nullptr};
                    pg8::EpiDownT<true> E{(GAS unsigned char*)XS, GIN(I_B2) + (size_t)l * NEXP * DM, W8_INV};
                    pg8::gemm_phase<pg8::EpiDownT<true>, pg8::ListOrder, false, true>(Lp, g, S, E, tid); }
                else { pg8::Gemm g{(const GAS pg8::h16_t*)ACT, (const GAS pg8::h16_t*)(W2_T + (size_t)l * NEXP * DM * DM), PROWS, 1024, DM, nullptr, nullptr};
                    pg8::EpiDownT<false> E{(GAS unsigned char*)XS, GIN(I_B2) + (size_t)l * NEXP * DM, 1.0f};
                    pg8::gemm_phase<pg8::EpiDownT<false>, pg8::ListOrder, false, false>(Lp, g, S, E, tid); } }
            }
            xcd_barrier(bar);
            STAMP(3 + 9 * l + 6 + ph);
        }

if (PHMASK & 2048) { LAUNDER();
        for (int m = gw; m < NTOK; m += NGW) {
            const int b = m >> 12; const GAS float* md = MODL + (size_t)b * 6144;
            const GAS unsigned char* yr[4]; float gk[4];
#pragma unroll
            for (int k = 0; k < 4; ++k) { const int e = ROUTE_E[(size_t)m * 4 + k], pos = ROUTE_POS[(size_t)m * 4 + k]; gk[k] = ROUTE_G[(size_t)m * 4 + k]; yr[k] = (const GAS unsigned char*)XS + ((size_t)mbase[e] * 256 + pos) * DM * (IS_FP8(l) ? 1 : 2); }
            f32x4 v[4]; float s = 0.f;
#pragma unroll
            for (int j = 0; j < 4; ++j) { const int c = 4 * lane + 256 * j; f32x4 a = {0.f, 0.f, 0.f, 0.f};
#pragma unroll
                for (int k = 0; k < 4; ++k) {
                    if (IS_FP8(l)) { const int y8 = *(const GAS int*)(yr[k] + c); const f32x2 lo = __builtin_amdgcn_cvt_pk_f32_fp8(y8, false), hi = __builtin_amdgcn_cvt_pk_f32_fp8(y8, true);
                        a.x += gk[k] * lo.x; a.y += gk[k] * lo.y; a.z += gk[k] * hi.x; a.w += gk[k] * hi.y; }
                    else { const f16x4 y4 = *(const GAS f16x4*)(yr[k] + 2 * c); a.x += gk[k] * (float)y4[0]; a.y += gk[k] * (float)y4[1]; a.z += gk[k] * (float)y4[2]; a.w += gk[k] * (float)y4[3]; } }
                const f16x4 xh = *(const GAS f16x4*)(X + (size_t)m * DM + c); const f32x4 x1 = {(float)xh[0], (float)xh[1], (float)xh[2], (float)xh[3]}, g2 = *(const GAS f32x4*)(md + 5120 + c);
                v[j] = x1 + g2 * a; s += (v[j].x * v[j].x + v[j].y * v[j].y) + (v[j].z * v[j].z + v[j].w * v[j].w); }
            const float rstd = rsqrtf(wave_sum(s) * (1.f / DM) + EPS);
            if (l + 1 < DEPTH) {
                const GAS float* mdn = MOD + (size_t)((l + 1) * 8 + b) * 6144; const GAS float* g1 = GIN(I_N1G) + (l + 1) * DM;
#pragma unroll
                for (int j = 0; j < 4; ++j) { const int c = 4 * lane + 256 * j; { u32x2 wx; wx.x = pk_f16(v[j].x, v[j].y); wx.y = pk_f16(v[j].z, v[j].w); *(GAS u32x2*)(X + (size_t)m * DM + c) = wx; }
                    const f32x4 gg = *(const GAS f32x4*)(g1 + c), sh = *(const GAS f32x4*)(mdn + c), sc = *(const GAS f32x4*)(mdn + 1024 + c);
                    const f32x4 hq = (v[j] * rstd) * gg * (sc + 1.0f) + sh; u32x2 w; w.x = pk_f16(hq.x, hq.y); w.y = pk_f16(hq.z, hq.w); *(GAS u32x2*)(H + (size_t)m * DM + c) = w;
                    if (PROJ_FP8 && l + 1 >= PROJ_FP8_FIRST) *(GAS unsigned*)(HB8 + (size_t)m * DM + c) = pk4_fp8(hq.x, hq.y, hq.z, hq.w); }
            } else {
#pragma unroll
                for (int j = 0; j < 4; ++j) { const int c = 4 * lane + 256 * j; const f32x4 gg = *(const GAS f32x4*)(GIN(I_FNG) + c); *(GAS f32x4*)(((GAS float*)AP->out) + (size_t)m * DM + c) = (v[j] * rstd) * gg; }
            }
        }
}
        STAMP(3 + 9 * l + 8);
        if (l + 1 < DEPTH) xcd_barrier(bar);
}

__global__ void __launch_bounds__(NWAVES * 64, 2) fwd_megakernel(Args args) {
    const int tid0 = threadIdx.x, wave0 = __builtin_amdgcn_readfirstlane(tid0 >> 6);
    const int G = gridDim.x, bid = blockIdx.x;
    const int NGW = G * NWAVES;
    LAS unsigned char* L = (LAS unsigned char*)lds;

    if (tid0 < 16) ((LAS unsigned*)(L + BARST_OFF))[tid0] = 0u;
    __syncthreads();
    STAMP(0);
    XcdBarrier bar = xcd_barrier_post((unsigned*)(args.ws + WS_CTL) + CW_BAR, (volatile LAS unsigned*)(L + BARST_OFF));

for (int rep_ = 0; rep_ < REPS(1); ++rep_) if (PHMASK & 1) { LAUNDER(); __syncthreads();
    {
        LAS float* cond = (LAS float*)Lp;
        LAS float* red = (LAS float*)(Lp + 32768);
        bool cond_ready = false;
        for (int it = bid; it < 192; it += G) {
            if (!cond_ready) { for (int i = tid; i < NB * DM; i += 512) { const float v = GIN(I_C)[i]; cond[i] = v * sigmoidf_(v); } __syncthreads(); cond_ready = true; }
            const int l = it / 96, n0 = (it % 96) * 64;
            const GAS float* wm = GIN(I_WMOD) + (size_t)l * DM * 6144 + n0 + lane;
            float a[8];
#pragma unroll
            for (int b = 0; b < 8; ++b) a[b] = 0.f;
            for (int k = wave * 128; k < wave * 128 + 128; ++k) { const float w = wm[(size_t)k * 6144];
#pragma unroll
                for (int b = 0; b < 8; ++b) a[b] += cond[b * DM + k] * w; }
#pragma unroll
            for (int b = 0; b < 8; ++b) red[(wave * 8 + b) * 64 + lane] = a[b];
            __syncthreads();
            { const int b = tid >> 6; float s = GIN(I_BMOD)[l * 6144 + n0 + lane];
#pragma unroll
              for (int w = 0; w < 8; ++w) s += red[(w * 8 + b) * 64 + lane];
              MOD[(size_t)(l * 8 + b) * 6144 + n0 + lane] = s; }
            __syncthreads();
        }
        __syncthreads();
        LAS float* scr = (LAS float*)(Lp + wave * 16640);
        for (int it = gw; it < DEPTH * 1536; it += NGW) {
            const int l = it / 1536; int r = it % 1536;
            if (r < 1024) { const int kb = r >> 6, nb = r & 63; transpose_item(GIN(I_WIN) + (size_t)l * DM * INW, DM, INW, WIN_T + (size_t)l * INW * DM, 32 * nb, 64 * kb, 32 * nb, nullptr, scr, lane);
                if (PROJ_FP8 && l >= PROJ_FP8_FIRST) transpose_item8(GIN(I_WIN) + (size_t)l * DM * INW, DM, INW, WIN8 + (size_t)l * INW * DM, 32 * nb, 64 * kb, 32 * nb, scr, lane); continue; } r -= 1024;
            { const int kb = r >> 5, nb = r & 31; transpose_item(GIN(I_WOUT) + (size_t)l * DM * DM, DM, DM, WOUT_T + (size_t)l * DM * DM, 32 * nb, 64 * kb, 32 * nb, GIN(I_MIXG) + l * DM, scr, lane, kb < 4 ? 64 * kb + 256 : (kb < 8 ? 64 * kb - 256 : 64 * kb)); }
        }
        static_assert(FP8_FIRST == 0, "the 64x64 expert-weight items below write fp8");
        constexpr int PER_L = 32 * 512 + 32 * 256;
        for (int it = gw; it < DEPTH * PER_L; it += NGW) {
            const int l = it / PER_L; int r = it % PER_L;
            if (r < 32 * 512) { const int e = r >> 9, q = r & 511, kb = q >> 5, nb = q & 31, n0 = 64 * nb;
                const int bj = n0 >> 10, jj = n0 & 1023, orow = (jj >> 7) * 256 + bj * 128 + (jj & 127);
                transpose_item8x64(GIN(I_W1) + ((size_t)l * NEXP + e) * DM * 2048, DM, 2048, (GAS unsigned char*)(W1_T + (size_t)l * NEXP * 2048 * DM) + (size_t)e * 2048 * DM, orow, 64 * kb, n0, scr, lane); continue; } r -= 32 * 512;
            { const int e = r >> 8, q = r & 255, kb = q >> 4, nb = q & 15;
                transpose_item8x64(GIN(I_W2) + ((size_t)l * NEXP + e) * DM * DM, DM, DM, (GAS unsigned char*)(W2_T + (size_t)l * NEXP * DM * DM) + (size_t)e * DM * DM, 64 * nb, 64 * kb, 64 * nb, scr, lane); }
        }
        for (int i = bid * 512 + tid; i < NB * 16 * 256; i += G * 512) KMEAN[i] = 0.f;
        for (int i = bid * 512 + tid; i < DEPTH * 4 * 128 * 128; i += G * 512) { const int jj = i & 127, ii = (i >> 7) & 127; SGUW[i] = (f16)(jj <= ii ? GIN(I_SGUW)[i] : 0.f); }
        for (int i = bid * 512 + tid; i < DEPTH * 4 * 64 * 64; i += G * 512) { const int c = i & 63, d = (i >> 6) & 63, g = (i >> 12) & 3, ll = i >> 14; PWT[i] = (f16)GIN(I_POOLW)[(((size_t)ll * 4 + g) * 64 + c) * 64 + d]; }
        for (int i = bid * 512 + tid; i < DEPTH * 32 * 1024; i += G * 512) { const int k = i & 1023, e = (i >> 10) & 31, ll = i >> 15; RWT16[(size_t)(ll * 32 + e) * 1032 + k] = (f16)GIN(I_RW)[((size_t)ll * DM + k) * NEXP + e]; }
    }
}
    xcd_barrier(bar);
    STAMP(1);

for (int rep_ = 0; rep_ < REPS(2); ++rep_) if (PHMASK & 2) { LAUNDER();
    for (int m = gw; m < NTOK; m += NGW) { const int b = m >> 12; const GAS float* md = MOD + (size_t)b * 6144;
        norm_mod_row(GIN(I_X) + (size_t)m * DM, GIN(I_N1G), md, md + 1024, H + (size_t)m * DM, HB8 + (size_t)m * DM, lane); }
}
    xcd_barrier(bar);
    STAMP(2);

    layer_body(0, bar, tid0, wave0, G, bid, NGW);
    layer_body(1, bar, tid0, wave0, G, bid, NGW);
    if (TSEL_B > 0 && bid == 0 && tid0 == 0) { const LAS unsigned long long* st = (const LAS unsigned long long*)((LAS unsigned char*)lds + STAMP_OFF);
        asm volatile("s_waitcnt vmcnt(0)" ::: "memory");
        args.out[0] += (float)(st[TSEL_B] - st[TSEL_A]) * 0.01f / TSCALE; }
}


extern "C" void kernel_launch(void* const* d_in, const int* in_sizes, int n_in, void* d_out, int out_size, void* d_ws, size_t ws_size, hipStream_t stream) {
    static int grid = 0;
    if (grid == 0) {
        if (n_in != 27 || out_size != NTOK * DM || ws_size < WS_END) { fprintf(stderr, "kernel_launch: unexpected shapes (n_in %d, out %d, ws %zu)\n", n_in, out_size, ws_size); grid = -1; return; }
        int dev = 0, cus = 0, per_cu = 0;
        if (hipGetDevice(&dev) != hipSuccess || hipDeviceGetAttribute(&cus, hipDeviceAttributeMultiprocessorCount, dev) != hipSuccess) { grid = -1; return; }
        if (hipFuncSetAttribute((const void*)fwd_megakernel, hipFuncAttributeMaxDynamicSharedMemorySize, LDS_BYTES) != hipSuccess) { fprintf(stderr, "kernel_launch: hipFuncSetAttribute failed\n"); grid = -1; return; }
        if (hipOccupancyMaxActiveBlocksPerMultiprocessor(&per_cu, (const void*)fwd_megakernel, NWAVES * 64, LDS_BYTES) != hipSuccess || per_cu < 1) { fprintf(stderr, "kernel_launch: occupancy query says %d blocks per CU\n", per_cu); (void)hipGetLastError(); grid = -1; return; }
        grid = cus;
    }
    if (grid < 0) return;
    (void)hipMemsetAsync((char*)d_ws + WS_CTL, 0, CTL_ZERO_BYTES, stream);
    Args a{};
    for (int i = 0; i < 27; ++i) a.in[i] = (const float*)d_in[i];
    a.out = (float*)d_out; a.ws = (unsigned char*)d_ws;
    hipLaunchKernelGGL(fwd_megakernel, dim3(grid), dim3(NWAVES * 64), LDS_BYTES, stream, a);
}
```

```cpp
#include <hip/hip_runtime.h>
#include <cstdio>
#include <cstdint>

#define LAS __attribute__((address_space(3)))
#define GAS __attribute__((address_space(1)))
#define CAS __attribute__((address_space(4)))
typedef _Float16 f16;
typedef _Float16 f16x8 __attribute__((ext_vector_type(8)));
typedef _Float16 f16x4 __attribute__((ext_vector_type(4)));
typedef _Float16 f16x2 __attribute__((ext_vector_type(2)));
typedef float f32x2 __attribute__((ext_vector_type(2)));
typedef float f32x4 __attribute__((ext_vector_type(4)));
typedef float f32x16 __attribute__((ext_vector_type(16)));
typedef unsigned u32x2 __attribute__((ext_vector_type(2)));
typedef unsigned u32x4 __attribute__((ext_vector_type(4)));
typedef short v4i16_t __attribute__((ext_vector_type(4)));
typedef int i32x4 __attribute__((ext_vector_type(4)));
typedef int i32x8 __attribute__((ext_vector_type(8)));

constexpr int DM = 1024, NB = 8, SEQ = 4096, NTOK = NB * SEQ, DEPTH = 2, GW = 256, INW = 2048;
constexpr int NEXP = 32, TOPK = 4;
constexpr int PROWS = NTOK * TOPK + NEXP * 256;
constexpr float EPS = 1e-6f;
constexpr int LISTCAP = NTOK;
constexpr int FP8_FIRST = 0;
#define IS_FP8(l_) ((l_) >= FP8_FIRST)
constexpr int FP8_LAYER_UNUSED = 1;
constexpr float W8_SCALE = 32.0f, W8_INV = 1.0f / 32.0f;
#define PROJ_FP8_FIRST 1
#ifndef PROJ_FP8
#define PROJ_FP8 1
#endif

__device__ __forceinline__ unsigned pk_f16(float lo, float hi) { f32x2 v = {lo, hi}; f16x2 h = __builtin_convertvector(v, f16x2); return __builtin_bit_cast(unsigned, h); }
__device__ __forceinline__ float row16_sum(float v) {
    v += __builtin_bit_cast(float, __builtin_amdgcn_update_dpp(0, __builtin_bit_cast(int, v), 0xB1, 0xf, 0xf, true));
    v += __builtin_bit_cast(float, __builtin_amdgcn_update_dpp(0, __builtin_bit_cast(int, v), 0x4E, 0xf, 0xf, true));
    v += __builtin_bit_cast(float, __builtin_amdgcn_update_dpp(0, __builtin_bit_cast(int, v), 0x141, 0xf, 0xf, true));
    v += __builtin_bit_cast(float, __builtin_amdgcn_update_dpp(0, __builtin_bit_cast(int, v), 0x140, 0xf, 0xf, true));
    return v;
}
__device__ __forceinline__ unsigned pk4_fp8(float a, float b, float c, float d) { int p = 0; p = __builtin_amdgcn_cvt_pk_fp8_f32(a, b, p, false); p = __builtin_amdgcn_cvt_pk_fp8_f32(c, d, p, true); return (unsigned)p; }
__device__ __forceinline__ float max3f(float a, float b, float c) { float r; asm("v_max3_f32 %0, %1, %2, %3" : "=v"(r) : "v"(a), "v"(b), "v"(c)); return r; }
__device__ __forceinline__ float max2f(float a, float b) { float r; asm("v_max_f32_e32 %0, %1, %2" : "=v"(r) : "v"(a), "v"(b)); return r; }
__device__ __forceinline__ float fadd_s(float a, float b) { float r; asm("v_add_f32_e32 %0, %1, %2" : "=v"(r) : "v"(a), "v"(b)); return r; }
template <int N> __device__ __forceinline__ void wave_sum_n(float (&v)[N]) {
#pragma unroll
    for (int i = 0; i < N; ++i) v[i] += __builtin_bit_cast(float, __builtin_amdgcn_update_dpp(0, __builtin_bit_cast(int, v[i]), 0xB1, 0xf, 0xf, true));
#pragma unroll
    for (int i = 0; i < N; ++i) v[i] += __builtin_bit_cast(float, __builtin_amdgcn_update_dpp(0, __builtin_bit_cast(int, v[i]), 0x4E, 0xf, 0xf, true));
#pragma unroll
    for (int i = 0; i < N; ++i) v[i] += __builtin_bit_cast(float, __builtin_amdgcn_update_dpp(0, __builtin_bit_cast(int, v[i]), 0x141, 0xf, 0xf, true));
#pragma unroll
    for (int i = 0; i < N; ++i) v[i] += __builtin_bit_cast(float, __builtin_amdgcn_update_dpp(0, __builtin_bit_cast(int, v[i]), 0x140, 0xf, 0xf, true));
#pragma unroll
    for (int i = 0; i < N; ++i) v[i] += __shfl_xor(v[i], 16);
#pragma unroll
    for (int i = 0; i < N; ++i) v[i] += __shfl_xor(v[i], 32);
}
__device__ __forceinline__ float wave_sum(float v) {
    v = row16_sum(v);
    v += __shfl_xor(v, 16); v += __shfl_xor(v, 32);
    return v;
}
__device__ __forceinline__ float sigmoidf_(float x) { return __builtin_amdgcn_rcpf(1.f + __expf(-x)); }
__device__ __forceinline__ float gelu_erf(float v) {
    const float av = fabsf(v), d = av * 0.2316418882f + 1.0f, t = __builtin_amdgcn_rcpf(d);
    float q = t * 0.5307027145f + (-0.7265760135f); q = q * t + 0.7107068705f; q = q * t + (-0.142248368f); q = q * t + 0.127414796f; q = q * t;
    const float e = __builtin_amdgcn_exp2f((v * v) * (-0.72134752044f));
    const float m = v * (q * e);
    return v < 0.f ? m : v - m;
}

#ifndef PROBE
#define PROBE 0
#endif
#ifndef TSEL_A
#define TSEL_A 0
#endif
#ifndef TSEL_B
#define TSEL_B 0
#endif
#ifndef TSCALE
#define TSCALE 16.0f
#endif
#define STAMP_OFF 146944
#define STAMP(k) do { if (TSEL_B > 0 && bid == 0 && tid0 == 0) ((__attribute__((address_space(3))) unsigned long long*)((__attribute__((address_space(3))) unsigned char*)lds + STAMP_OFF))[k] = __builtin_amdgcn_s_memrealtime(); } while (0)
namespace pg8 {
#define PG8_LAS __attribute__((address_space(3)))
typedef unsigned short h16_t;
constexpr int BM = 256, BK = 64, HALF = 128, HTB = HALF * BK * 2, STAGE_BYTES = 8 * HTB, NXCD = 8, WGM = 8;

__host__ __device__ __forceinline__ int lds_byte(int r, int c) { const int st = (r >> 4) * 2 + (c >> 5), rr = r & 15, cc = c & 31, ob = rr * 64 + cc * 2; return st * 1024 + (ob ^ (((ob >> 9) & 1) << 5)); }
__host__ __device__ __forceinline__ void stage_rc(int b, int& R, int& C) { const int st = b / 1024, sb = b % 1024, swz = sb ^ (((sb >> 9) & 1) << 5); R = (st >> 1) * 16 + swz / 64; C = (st & 1) * 32 + (swz % 64) / 2; }
__host__ __device__ __forceinline__ int perm32(int rho) { const int n = rho >> 4, i = rho & 15; return 8 * (i >> 2) + 4 * n + (i & 3); }

struct Unit { int pm, pn; };
struct Gemm { const GAS h16_t* A; const GAS h16_t* Bt; int M, N, K; const GAS int* rl; const GAS float* ssq; };

struct StaticOrder {
    int nM, nN, nwg, G, c;
    __host__ __device__ void init(int M, int N, int G_, int c_) { nM = M / BM; nN = N / BM; nwg = nM * nN; G = G_; c = c_; }
    __host__ __device__ bool next(int i, Unit& u) const {
        const long L = (long)i * G + c; if (L >= nwg) return false;
        int wgid = (int)L; { const int q = nwg / NXCD, r = nwg % NXCD, xcd = wgid % NXCD, off = wgid / NXCD; wgid = (xcd < r ? xcd * (q + 1) : r * (q + 1) + (xcd - r) * q) + off; }
        const int nig = WGM * nN, gid = wgid / nig, fm = gid * WGM, gsz = (nM - fm) < WGM ? (nM - fm) : WGM;
        u.pm = fm + ((wgid % nig) % gsz); u.pn = (wgid % nig) / gsz; return true;
    }
    __device__ __forceinline__ void a_ready(const Unit&) const {}
    __device__ __forceinline__ void done(const Unit&) const {}
    __device__ __forceinline__ void rows(int, int& r0, int& cnt) const { r0 = 0; cnt = 1; }
};
struct MapOrder : StaticOrder {
    unsigned map;
    __host__ __device__ bool next(int i, Unit& u) const { if (!StaticOrder::next(i, u)) return false; u.pn = (int)((map >> (4 * u.pn)) & 15u); return true; }
};
struct ListOrder {
    const PG8_LAS int* list; int n;
    __device__ __forceinline__ bool next(int i, Unit& u) const { if (i >= n) return false; const int v = __builtin_amdgcn_readfirstlane(list[3 * i]); u.pm = v & 0xffff; u.pn = v >> 16; return true; }
    __device__ __forceinline__ void rows(int i, int& r0, int& cnt) const { r0 = __builtin_amdgcn_readfirstlane(list[3 * i + 1]); cnt = __builtin_amdgcn_readfirstlane(list[3 * i + 2]); }
    __device__ __forceinline__ void a_ready(const Unit&) const {}
    __device__ __forceinline__ void done(const Unit&) const {}
};

struct Pre4 { f32x4 v[4]; };
struct EpiF16 {
    static constexpr bool PERM = true, PERM2 = true, AFTER_DRAIN = false, IS_DOWN = false, PRELOAD = false;
    GAS h16_t* O; int ldc; GAS float* ksum; float sc;
    __device__ __forceinline__ Pre4 pre(const Unit&, int, int, int, int) const { return Pre4{}; }
    __device__ __forceinline__ void operator()(const f32x4 (&acc)[2][2][4][2], const Unit& u, int wr, int wc, int fr, int fq, const Pre4&) const {
        const int row0 = u.pm * BM + wr * 64 + fr, col0 = u.pn * BM + wc * 64 + 16 * fq;
        if (u.pn == 3) {
#pragma unroll
            for (int bj = 0; bj < 2; ++bj)
#pragma unroll
                for (int n = 0; n < 2; ++n) { f32x4 s = (acc[0][bj][0][n] + acc[0][bj][1][n]) + (acc[0][bj][2][n] + acc[0][bj][3][n]); s += (acc[1][bj][0][n] + acc[1][bj][1][n]) + (acc[1][bj][2][n] + acc[1][bj][3][n]);
#pragma unroll
                    for (int i = 0; i < 4; ++i) { const float t = row16_sum(s[i]);
                        if (fr == 0) __hip_atomic_fetch_add(ksum + (size_t)u.pm * 256 + wc * 64 + 16 * fq + 8 * bj + 4 * n + i, t, __ATOMIC_RELAXED, __HIP_MEMORY_SCOPE_AGENT); } } }
#pragma unroll
        for (int ai = 0; ai < 2; ++ai)
#pragma unroll
            for (int m = 0; m < 4; ++m) { GAS h16_t* rowp = O + (size_t)(row0 + ai * HALF + m * 16) * ldc + col0;
#pragma unroll
                for (int bj = 0; bj < 2; ++bj) { const f32x4 v0 = acc[ai][bj][m][0] * sc, v1 = acc[ai][bj][m][1] * sc;
                    u32x4 w; w.x = pk_f16(v0[0], v0[1]); w.y = pk_f16(v0[2], v0[3]); w.z = pk_f16(v1[0], v1[1]); w.w = pk_f16(v1[2], v1[3]);
                    *(GAS u32x4*)(rowp + bj * 8) = w; } }
    }
};
template <bool BASE32> struct EpiResidT {
    static constexpr bool PERM = true, PERM2 = true, AFTER_DRAIN = false, IS_DOWN = false, PRELOAD = false;
    const GAS float* base32; const GAS h16_t* base16; GAS h16_t* out; const GAS float* gate;
    __device__ __forceinline__ Pre4 pre(const Unit& u, int wr, int wc, int fr, int fq) const { Pre4 p; const int col0 = u.pn * BM + wc * 64 + 16 * fq; const GAS float* gp = gate + (size_t)((u.pm * BM) >> 12) * 6144;
#pragma unroll
        for (int bj = 0; bj < 2; ++bj)
#pragma unroll
            for (int n = 0; n < 2; ++n) p.v[bj * 2 + n] = *(const GAS f32x4*)(gp + col0 + bj * 8 + 4 * n);
        return p; }
    __device__ __forceinline__ void operator()(const f32x4 (&acc)[2][2][4][2], const Unit& u, int wr, int wc, int fr, int fq, const Pre4& pr) const {
        const int row0 = u.pm * BM + wr * 64 + fr, col0 = u.pn * BM + wc * 64 + 16 * fq;
        f32x4 gv[2][2];
#pragma unroll
        for (int bj = 0; bj < 2; ++bj)
#pragma unroll
            for (int n = 0; n < 2; ++n) gv[bj][n] = pr.v[bj * 2 + n];
#pragma unroll
        for (int ai = 0; ai < 2; ++ai)
#pragma unroll
            for (int m = 0; m < 4; ++m) { const size_t off = (size_t)(row0 + ai * HALF + m * 16) * DM + col0;
#pragma unroll
                for (int bj = 0; bj < 2; ++bj) { f32x4 b0, b1;
                    if constexpr (BASE32) { b0 = *(const GAS f32x4*)(base32 + off + bj * 8); b1 = *(const GAS f32x4*)(base32 + off + bj * 8 + 4); }
                    else { const f16x8 hb = *(const GAS f16x8*)(base16 + off + bj * 8); b0 = (f32x4){(float)hb[0], (float)hb[1], (float)hb[2], (float)hb[3]}; b1 = (f32x4){(float)hb[4], (float)hb[5], (float)hb[6], (float)hb[7]}; }
                    const f32x4 v0 = b0 + gv[bj][0] * acc[ai][bj][m][0], v1 = b1 + gv[bj][1] * acc[ai][bj][m][1];
                    u32x4 w; w.x = pk_f16(v0[0], v0[1]); w.y = pk_f16(v0[2], v0[3]); w.z = pk_f16(v1[0], v1[1]); w.w = pk_f16(v1[2], v1[3]);
                    *(GAS u32x4*)(out + off + bj * 8) = w; } }
    }
};
template <bool OUT8> struct EpiSwigluT {
    static constexpr bool PERM = true, PERM2 = false, AFTER_DRAIN = false, IS_DOWN = false, PRELOAD = true;
    GAS unsigned char* O; const GAS float* b1; float sc;
    __device__ __forceinline__ Pre4 pre(const Unit& u, int wr, int wc, int fr, int fq) const { Pre4 q; const int e = u.pn >> 3, p = u.pn & 7, hc = p * 128 + wc * 32 + 8 * fq; const GAS float* bp = b1 + (size_t)e * 2048 + hc;
#pragma unroll
        for (int n = 0; n < 2; ++n) { q.v[n] = *(const GAS f32x4*)(bp + 4 * n); q.v[2 + n] = *(const GAS f32x4*)(bp + 1024 + 4 * n); }
        return q; }
    __device__ __forceinline__ void operator()(const f32x4 (&acc)[2][2][4][2], const Unit& u, int wr, int wc, int fr, int fq, const Pre4& pr) const {
        const int p = u.pn & 7;
        const int row0 = u.pm * BM + wr * 64 + fr, hc = p * 128 + wc * 32 + 8 * fq;
        f32x4 bg[2], bl[2];
#pragma unroll
        for (int n = 0; n < 2; ++n) { bg[n] = pr.v[n]; bl[n] = pr.v[2 + n]; }
        u32x2 wprev = {0u, 0u};
#pragma unroll
        for (int ai = 0; ai < 2; ++ai)
#pragma unroll
            for (int m = 0; m < 4; ++m) { float r[8];
#pragma unroll
                for (int n = 0; n < 2; ++n) { const f32x4 g = acc[ai][0][m][n] * sc + bg[n], li = acc[ai][1][m][n] * sc + bl[n];
#pragma unroll
                    for (int i = 0; i < 4; ++i) { const float xg = fminf(g[i], 7.0f), xl = fminf(fmaxf(li[i], -7.0f), 7.0f);
                        r[4 * n + i] = xg * __builtin_amdgcn_rcpf(1.f + __expf(-1.702f * xg)) * (xl + 1.0f); } }
                if constexpr (OUT8) { u32x2 w; w.x = pk4_fp8(r[0], r[1], r[2], r[3]); w.y = pk4_fp8(r[4], r[5], r[6], r[7]);
                    if (m & 1) { const auto sx = __builtin_amdgcn_permlane16_swap(wprev.x, w.x, false, false), sy = __builtin_amdgcn_permlane16_swap(wprev.y, w.y, false, false);
                        u32x4 o; o.x = sx[0]; o.y = sy[0]; o.z = sx[1]; o.w = sy[1];
                        *(GAS u32x4*)(O + (size_t)(row0 + ai * HALF + (m - 1 + (fq & 1)) * 16) * DM + (hc - 8 * fq + 16 * (fq >> 1))) = o; }
                    else wprev = w; }
                else { u32x4 w; w.x = pk_f16(r[0], r[1]); w.y = pk_f16(r[2], r[3]); w.z = pk_f16(r[4], r[5]); w.w = pk_f16(r[6], r[7]);
                    *(GAS u32x4*)(O + ((size_t)(row0 + ai * HALF + m * 16) * DM + hc) * 2) = w; } }
    }
};
template <bool OUT8> struct EpiDownT {
    static constexpr bool PERM = true, PERM2 = true, AFTER_DRAIN = false, IS_DOWN = true, PRELOAD = true;
    GAS unsigned char* O; const GAS float* b2; float sc;
    __device__ __forceinline__ Pre4 pre(const Unit& u, int wr, int wc, int fr, int fq) const { Pre4 q; const int e = u.pn >> 2, p = u.pn & 3, col0 = p * BM + wc * 64 + 16 * fq; const GAS float* bp = b2 + (size_t)e * 1024 + col0;
#pragma unroll
        for (int bj = 0; bj < 2; ++bj)
#pragma unroll
            for (int n = 0; n < 2; ++n) q.v[bj * 2 + n] = *(const GAS f32x4*)(bp + bj * 8 + 4 * n);
        return q; }
    __device__ __forceinline__ void operator()(const f32x4 (&acc)[2][2][4][2], const Unit& u, int wr, int wc, int fr, int fq, const Pre4& pr) const {
        const int p = u.pn & 3;
        const int row0 = u.pm * BM + wr * 64 + fr, col0 = p * BM + wc * 64 + 16 * fq;
        f32x4 bv[2][2];
#pragma unroll
        for (int bj = 0; bj < 2; ++bj)
#pragma unroll
            for (int n = 0; n < 2; ++n) bv[bj][n] = pr.v[bj * 2 + n];
#pragma unroll
        for (int ai = 0; ai < 2; ++ai)
#pragma unroll
            for (int m = 0; m < 4; ++m) { const size_t ro = (size_t)(row0 + ai * HALF + m * 16) * DM + col0;
                if constexpr (OUT8) { u32x4 w;
#pragma unroll
                    for (int bj = 0; bj < 2; ++bj) { const f32x4 v0 = acc[ai][bj][m][0] * sc + bv[bj][0], v1 = acc[ai][bj][m][1] * sc + bv[bj][1];
                        w[2 * bj] = pk4_fp8(v0[0], v0[1], v0[2], v0[3]); w[2 * bj + 1] = pk4_fp8(v1[0], v1[1], v1[2], v1[3]); }
                    *(GAS u32x4*)(O + ro) = w; }
                else {
#pragma unroll
                    for (int bj = 0; bj < 2; ++bj) { const f32x4 v0 = acc[ai][bj][m][0] * sc + bv[bj][0], v1 = acc[ai][bj][m][1] * sc + bv[bj][1];
                        u32x4 w; w.x = pk_f16(v0[0], v0[1]); w.y = pk_f16(v0[2], v0[3]); w.z = pk_f16(v1[0], v1[1]); w.w = pk_f16(v1[2], v1[3]);
                        *(GAS u32x4*)(O + (ro + bj * 8) * 2) = w; } } }
    }
};

template <class Epi, class Sched, bool GATHER = false, bool FP8 = false, bool ROWSCALE = false>
__device__ __forceinline__ void gemm_phase(PG8_LAS unsigned char* lds, const Gemm g, const Sched& S, const Epi& E, const int tid) {
    const int wid = __builtin_amdgcn_readfirstlane(tid >> 6), lane = tid & 63, wr = wid >> 2, wc = wid & 3, fr = lane & 15, fq = lane >> 4;
    const int K = g.K, nt = K / BK;
    const size_t kstep = (size_t)(BK * 2);
    const size_t hstep = (size_t)HALF * K * 2;
    const size_t tstep = 2 * hstep;
    const size_t bstep = Epi::PERM2 ? (size_t)8 * K * 2 : hstep;
    unsigned voffB[2], oc0[2], oc1[2], on0[2], on1[2];
#pragma unroll
    for (int i = 0; i < 2; ++i) { int R, C; stage_rc(tid * 16 + i * 8192, R, C); const int Rb = Epi::PERM2 ? (64 * (R >> 5) + 16 * ((R & 15) >> 2) + 4 * ((R >> 4) & 1) + (R & 3)) : (Epi::PERM ? ((R & ~31) + perm32(R & 31)) : R);
        voffB[i] = (unsigned)(Rb * K + C) * 2u;
        oc0[i] = (unsigned)(R * K + C) * 2u; oc1[i] = oc0[i] + (unsigned)hstep; on0[i] = oc0[i]; on1[i] = oc1[i]; }
    const unsigned ldsw = (unsigned)wid * 1024u;
    const int aoff = lds_byte(wr * 64 + fr, fq * 8), boff = lds_byte(wc * 32 + fr, fq * 8);
#define PG8_SA(b, h) (((b) * 2 + (h)) * HTB)
#define PG8_SB(b, h) ((4 + (b) * 2 + (h)) * HTB)
#define PG8_STAGE(bufoff, gbase, voff) do { _Pragma("unroll") for (int _i = 0; _i < 2; ++_i) { unsigned vo_ = (voff)[_i]; asm volatile("" : "+v"(vo_)); \
        __builtin_amdgcn_global_load_lds((const GAS unsigned*)((const GAS char*)(gbase) + vo_), (PG8_LAS unsigned*)(lds + (bufoff) + ldsw + _i * 8192), 16, 0, 0); } } while (0)
#define PG8_LDA(dst, b, h) do { if constexpr (FP8) { _Pragma("unroll") for (int m = 0; m < 4; ++m) { \
            const i32x4 lo_ = *(const PG8_LAS i32x4*)(lds + PG8_SA(b, h) + aoff + m * 2048), hi_ = *(const PG8_LAS i32x4*)(lds + PG8_SA(b, h) + aoff + m * 2048 + 1024); \
            dst##8[m] = (i32x8){lo_[0], lo_[1], lo_[2], lo_[3], hi_[0], hi_[1], hi_[2], hi_[3]}; } } \
        else { _Pragma("unroll") for (int m = 0; m < 4; ++m) _Pragma("unroll") for (int k = 0; k < 2; ++k) dst[m][k] = *(const PG8_LAS f16x8*)(lds + PG8_SA(b, h) + aoff + m * 2048 + k * 1024); } } while (0)
#define PG8_LDB(dst, b, h) do { if constexpr (FP8) { _Pragma("unroll") for (int n = 0; n < 2; ++n) { \
            const i32x4 lo_ = *(const PG8_LAS i32x4*)(lds + PG8_SB(b, h) + boff + n * 2048), hi_ = *(const PG8_LAS i32x4*)(lds + PG8_SB(b, h) + boff + n * 2048 + 1024); \
            dst##8[n] = (i32x8){lo_[0], lo_[1], lo_[2], lo_[3], hi_[0], hi_[1], hi_[2], hi_[3]}; } } \
        else { _Pragma("unroll") for (int n = 0; n < 2; ++n) _Pragma("unroll") for (int k = 0; k < 2; ++k) dst[n][k] = *(const PG8_LAS f16x8*)(lds + PG8_SB(b, h) + boff + n * 2048 + k * 1024); } } while (0)
#define PG8_MMA(ai, bj, At, Bt) do { __builtin_amdgcn_s_setprio(1); \
        if constexpr (FP8) { _Pragma("unroll") for (int m = 0; m < 4; ++m) _Pragma("unroll") for (int n = 0; n < 2; ++n) \
            acc[ai][bj][m][n] = __builtin_amdgcn_mfma_scale_f32_16x16x128_f8f6f4(Bt##8[n], At##8[m], acc[ai][bj][m][n], 0, 0, 0, 0x7f7f7f7f, 0, 0x7f7f7f7f); } \
        else { _Pragma("unroll") for (int m = 0; m < 4; ++m) _Pragma("unroll") for (int n = 0; n < 2; ++n) _Pragma("unroll") for (int k = 0; k < 2; ++k) \
            acc[ai][bj][m][n] = __builtin_amdgcn_mfma_f32_16x16x32_f16(Bt[n][k], At[m][k], acc[ai][bj][m][n], 0, 0, 0); } \
        __builtin_amdgcn_s_setprio(0); } while (0)
#define PG8_WAIT_V(n) asm volatile("s_waitcnt vmcnt(" #n ")" ::: "memory")
#define PG8_WAIT_L(n) asm volatile("s_waitcnt lgkmcnt(" #n ")" ::: "memory")
#define PG8_BAR __builtin_amdgcn_s_barrier()
#define PG8_SCHED __builtin_amdgcn_sched_barrier(0)
#define PG8_GOFF(ix, un, o0, o1) do { int r0_, cnt_; S.rows(ix, r0_, cnt_); const GAS int* lp_ = g.rl + (size_t)((un).pn >> 3) * LISTCAP; \
        _Pragma("unroll") for (int _i = 0; _i < 2; ++_i) { int R_, C_; stage_rc(tid * 16 + _i * 8192, R_, C_); int ra_ = r0_ + R_, rb_ = ra_ + HALF; ra_ = ra_ < cnt_ ? ra_ : cnt_ - 1; rb_ = rb_ < cnt_ ? rb_ : cnt_ - 1; \
            (o0)[_i] = (unsigned)lp_[ra_] * (unsigned)(K * 2) + (unsigned)C_ * 2u; (o1)[_i] = (unsigned)lp_[rb_] * (unsigned)(K * 2) + (unsigned)C_ * 2u; } } while (0)
    Unit cur, nxt; int ui = 0;
    if (!S.next(0, cur)) return;
    f32x4 acc[2][2][4][2];
#pragma unroll
    for (int a = 0; a < 2; ++a)
#pragma unroll
        for (int b = 0; b < 2; ++b)
#pragma unroll
            for (int m = 0; m < 4; ++m)
#pragma unroll
                for (int n = 0; n < 2; ++n) acc[a][b][m][n] = (f32x4){0.f, 0.f, 0.f, 0.f};
    f16x8 At[4][2], B0[2][2], B1[2][2]; i32x8 At8[4], B08[2], B18[2]; (void)At; (void)B0; (void)B1; (void)At8; (void)B08; (void)B18;
    const GAS char* cA = (const GAS char*)g.A + (GATHER ? (size_t)0 : (size_t)cur.pm * tstep); const GAS char* cB = (const GAS char*)g.Bt + (size_t)cur.pn * tstep;
    if constexpr (GATHER) PG8_GOFF(0, cur, oc0, oc1);
    S.a_ready(cur);
    PG8_STAGE(PG8_SB(0, 0), cB, voffB); PG8_STAGE(PG8_SB(0, 1), cB + bstep, voffB); PG8_STAGE(PG8_SA(0, 0), cA, oc0); PG8_STAGE(PG8_SA(0, 1), cA, oc1);
    if (wr == 1) PG8_BAR;
    PG8_WAIT_V(2); PG8_BAR;
    PG8_STAGE(PG8_SB(1, 0), cB + kstep, voffB); PG8_STAGE(PG8_SA(1, 0), cA + kstep, oc0); PG8_STAGE(PG8_SB(1, 1), cB + bstep + kstep, voffB);
    PG8_WAIT_V(6); PG8_BAR;
    for (;;) {
        const bool has_next = S.next(ui + 1, nxt);
        const GAS char* nA = (has_next && !GATHER) ? (const GAS char*)g.A + (size_t)nxt.pm * tstep : cA; const GAS char* nB = has_next ? (const GAS char*)g.Bt + (size_t)nxt.pn * tstep : cB;
        if constexpr (GATHER) { if (has_next) PG8_GOFF(ui + 1, nxt, on0, on1); }
        Pre4 epre; if constexpr (Epi::PRELOAD) epre = E.pre(cur, wr, wc, fr, fq);
#pragma unroll 1
        for (int t = 0; t < nt; ++t) {
            const int b = t & 1;
            const bool w1 = (t + 1 >= nt), w2 = (t + 2 >= nt);
            const GAS char* a1 = (w1 ? nA : cA) + (size_t)(w1 ? t + 1 - nt : t + 1) * kstep;
            const GAS char* a2 = (w2 ? nA : cA) + (size_t)(w2 ? t + 2 - nt : t + 2) * kstep;
            const GAS char* b2 = (w2 ? nB : cB) + (size_t)(w2 ? t + 2 - nt : t + 2) * kstep;
            unsigned x0[2], y1[2];
#pragma unroll
            for (int i = 0; i < 2; ++i) { y1[i] = (GATHER && w1 && has_next) ? on1[i] : oc1[i]; x0[i] = (GATHER && w2 && has_next) ? on0[i] : oc0[i]; }
            if (t == nt - 2 && has_next) S.a_ready(nxt);
            if constexpr (ROWSCALE) { if (t == 4) {
#pragma unroll
                for (int ai = 0; ai < 2; ++ai) { f32x4 q4[4];
#pragma unroll
                    for (int m = 0; m < 4; ++m) q4[m] = *(const GAS f32x4*)(g.ssq + (size_t)(cur.pm * BM + ai * HALF + wr * 64 + m * 16 + fr) * 4);
#pragma unroll
                    for (int m = 0; m < 4; ++m) { const float rs = rsqrtf(((q4[m].x + q4[m].y) + (q4[m].z + q4[m].w)) * (1.f / 256.f) + EPS);
#pragma unroll
                        for (int bj = 0; bj < 2; ++bj)
#pragma unroll
                            for (int n = 0; n < 2; ++n) acc[ai][bj][m][n] *= rs; } } } }
            PG8_LDB(B0, b, 0); PG8_LDB(B1, b, 1); PG8_SCHED; PG8_LDA(At, b, 0); PG8_STAGE(PG8_SA(b ^ 1, 1), a1, y1);
            PG8_WAIT_V(8); PG8_WAIT_L(0); PG8_BAR; PG8_MMA(0, 0, At, B0); PG8_MMA(0, 1, At, B1); PG8_BAR; PG8_SCHED;
            PG8_LDA(At, b, 1); PG8_STAGE(PG8_SB(b, 0), b2, voffB); PG8_STAGE(PG8_SB(b, 1), b2 + bstep, voffB); PG8_STAGE(PG8_SA(b, 0), a2, x0);
            PG8_WAIT_V(8); PG8_WAIT_L(0); PG8_BAR; PG8_MMA(1, 0, At, B0); PG8_MMA(1, 1, At, B1); PG8_BAR; PG8_SCHED;
        }
        if (wr == 0) PG8_BAR;
        if constexpr (!Epi::PRELOAD) epre = E.pre(cur, wr, wc, fr, fq);
        E(acc, cur, wr, wc, fr, fq, epre); S.done(cur);
        if (!has_next) break;
#pragma unroll
        for (int a = 0; a < 2; ++a)
#pragma unroll
            for (int b = 0; b < 2; ++b)
#pragma unroll
                for (int m = 0; m < 4; ++m)
#pragma unroll
                    for (int n = 0; n < 2; ++n) acc[a][b][m][n] = (f32x4){0.f, 0.f, 0.f, 0.f};
        cur = nxt; cA = nA; cB = nB; ++ui;
        if constexpr (GATHER) {
#pragma unroll
            for (int i = 0; i < 2; ++i) { oc0[i] = on0[i]; oc1[i] = on1[i]; } }
        if (wr == 1) PG8_BAR;
    }
    PG8_WAIT_V(0);
    PG8_BAR;
#undef PG8_SA
#undef PG8_SB
#undef PG8_STAGE
#undef PG8_LDA
#undef PG8_LDB
#undef PG8_MMA
#undef PG8_WAIT_V
#undef PG8_WAIT_L
#undef PG8_BAR
#undef PG8_SCHED
#undef PG8_GOFF
}
}

constexpr size_t MiB = 1u << 20;
constexpr size_t WS_CTL   = 0,            CTL_ZERO_BYTES = 1 * MiB;
constexpr size_t WS_MOD   = 1 * MiB;
constexpr size_t WS_KMEAN = 2 * MiB;
constexpr size_t WS_SSQ   = 2 * MiB + 512 * 1024;
constexpr size_t WS_SGUW  = 3 * MiB;
constexpr size_t WS_RWT   = 3 * MiB + 512 * 1024;
constexpr size_t WS_PWT   = 3 * MiB + 768 * 1024;
constexpr size_t WS_ROUTE = 4 * MiB;
constexpr size_t WS_LIST  = 6 * MiB;
constexpr size_t WS_WIN   = 10 * MiB;
constexpr size_t WS_WOUT  = 18 * MiB;
constexpr size_t WS_W1    = 22 * MiB;
constexpr size_t WS_W2    = 278 * MiB;
constexpr size_t WS_X     = 406 * MiB;
constexpr size_t WS_H     = 534 * MiB;
constexpr size_t WS_PROJ  = 598 * MiB;
constexpr size_t WS_MIX   = 726 * MiB;
constexpr size_t WS_XS    = 790 * MiB;
constexpr size_t WS_ACT   = 1062 * MiB;
constexpr size_t WS_WIN8  = 1334 * MiB;
constexpr size_t WS_HB8   = 1338 * MiB;
constexpr size_t WS_END   = 1370 * MiB;
constexpr int CW_BAR = 4096;
constexpr int CW_CNT = 16384;

constexpr int RING_BYTES = 131072;
constexpr int LDS_BYTES = 147456;
constexpr int BARST_OFF = LDS_BYTES - 64;
constexpr int NWAVES = 8;
#ifndef PH3
#define PH3 15
#endif
#define GIN(k) ((const GAS float*)AP->in[k])
#define REPS(bit) (((PROBE) & (bit)) ? 2 : 1)
#ifndef PHMASK
#define PHMASK 0xFFFF
#endif

#define XB_TMO      128
#define XB_XCNT(j)  (256  + 64 * (j))
#define XB_XSUB(j)  (1280 + 64 * (j))
#define XB_XGEN(j)  (2304 + 64 * (j))
#define XB_TOP      3328
#define XB_TOPGEN   3392
#define XCD_BAR_WORDS 3456
#define XB_SPIN_CAP (1u << 20)
__device__ __forceinline__ unsigned xb_ld(unsigned* p)              { return __hip_atomic_load(p, __ATOMIC_RELAXED, __HIP_MEMORY_SCOPE_AGENT); }
__device__ __forceinline__ unsigned xb_add(unsigned* p, unsigned v) { return __hip_atomic_fetch_add(p, v, __ATOMIC_RELAXED, __HIP_MEMORY_SCOPE_AGENT); }
__device__ __forceinline__ unsigned xb_xcc_id() { return (unsigned)__builtin_amdgcn_s_getreg((3 << 11) | 20) & 0xFu; }
#define XB_SPIN(cond, bar) do { unsigned _sp = 0; while (cond) { __builtin_amdgcn_s_sleep(1); \
    if ((++_sp & 255u) == 0u) { if (xb_ld(&(bar)[XB_TMO])) break; if (_sp > XB_SPIN_CAP) { atomicAdd(&(bar)[XB_TMO], 1u); break; } } } } while (0)
struct XcdBarrier { unsigned* bar; unsigned x; volatile LAS unsigned* st; };
__device__ __forceinline__ XcdBarrier xcd_barrier_post(unsigned* bar, volatile LAS unsigned* st) {
    XcdBarrier b; b.bar = bar; b.x = xb_xcc_id(); b.st = st;
    if (threadIdx.x == 0) (void)xb_add(&bar[XB_XCNT(b.x)], 1u);
    return b;
}
__device__ __forceinline__ void xcd_barrier_complete(unsigned* bar, unsigned x, unsigned& nloc, unsigned& nx) {
    const unsigned G = gridDim.x * gridDim.y * gridDim.z;
    unsigned sum, cnt, mine, sp = 0u;
    for (;;) {
        sum = 0u; cnt = 0u; mine = 0u;
#pragma unroll
        for (unsigned j = 0; j < 16; ++j) { const unsigned c = xb_ld(&bar[XB_XCNT(j)]); sum += c; cnt += (c > 0u) ? 1u : 0u; mine = (j == x) ? c : mine; }
        if (sum == G) break;
        __builtin_amdgcn_s_sleep(1);
        if ((++sp & 255u) == 0u) { if (xb_ld(&bar[XB_TMO])) break; if (sp > XB_SPIN_CAP) { atomicAdd(&bar[XB_TMO], 1u); break; } }
    }
    nloc = mine > 0u ? mine : 1u; nx = cnt > 0u ? cnt : 1u;
}
__device__ __forceinline__ void xcd_barrier(const XcdBarrier& b) {
    asm volatile("s_waitcnt vmcnt(0)" ::: "memory");
    __syncthreads();
    if (threadIdx.x == 0) {
        unsigned* bar = b.bar; asm volatile("" : "+s"(bar));
        unsigned bx = b.x; asm volatile("" : "+s"(bx));
        __builtin_amdgcn_s_waitcnt(0);
        unsigned nloc = b.st[0], nx = b.st[1];
        if (nloc == 0u) { xcd_barrier_complete(bar, bx, nloc, nx); b.st[0] = nloc; b.st[1] = nx; }
        const unsigned old = xb_add(&bar[XB_XSUB(bx)], 1u);
        const unsigned gen = old / nloc;
        if (old + 1u == (gen + 1u) * nloc) {
            __builtin_amdgcn_fence(__ATOMIC_RELEASE, "agent");
            asm volatile("s_waitcnt vmcnt(0)" ::: "memory");
            const unsigned og = xb_add(&bar[XB_TOP], 1u);
            const unsigned tg = og / nx;
            if (og + 1u == (tg + 1u) * nx) xb_add(&bar[XB_TOPGEN], 1u);
            else XB_SPIN(xb_ld(&bar[XB_TOPGEN]) == tg, bar);
            __builtin_amdgcn_fence(__ATOMIC_ACQUIRE, "agent");
            xb_add(&bar[XB_XGEN(bx)], 1u);
            asm volatile("s_waitcnt vmcnt(0)" ::: "memory");
        } else {
            XB_SPIN(xb_ld(&bar[XB_XGEN(bx)]) == gen, bar);
            __builtin_amdgcn_fence(__ATOMIC_ACQUIRE, "agent");
            asm volatile("s_waitcnt vmcnt(0)" ::: "memory");
        }
    }
    __syncthreads();
}

struct Args { const float* in[27]; float* out; unsigned char* ws; };
enum { I_X = 0, I_C, I_WMOD, I_BMOD, I_N1G, I_WIN, I_CONVW, I_CONVB, I_CNG, I_CNB, I_RELB, I_POOLW, I_POOLS, I_SNG, I_SNB, I_SGUW, I_SGUB, I_MIXG, I_WOUT, I_N2G, I_RW, I_RB, I_W1, I_B1, I_W2, I_B2, I_FNG };

__device__ __forceinline__ int t5_bucket(int n) {
    if (n < 16) return n;
    int b = 16;
    b += (n >= 19); b += (n >= 21); b += (n >= 24); b += (n >= 27); b += (n >= 31); b += (n >= 35); b += (n >= 40); b += (n >= 46);
    b += (n >= 52); b += (n >= 59); b += (n >= 67); b += (n >= 77); b += (n >= 87); b += (n >= 99); b += (n >= 113);
    return b;
}

__device__ __forceinline__ void transpose_item(const GAS float* W, int K, int N, GAS f16* WT, int orow0, int k0, int n0, const GAS float* kscale, LAS float* scr, int lane, int ko = -1) {
    if (ko < 0) ko = k0;
#pragma unroll 8
    for (int i = 0; i < 32; ++i) { const int kk = 2 * i + (lane >> 5); float v = W[(size_t)(k0 + kk) * N + n0 + (lane & 31)]; if (kscale) v *= kscale[k0 + kk]; scr[kk * 33 + (lane & 31)] = v; }
    asm volatile("s_waitcnt lgkmcnt(0)" ::: "memory");
    const int c = lane & 7;
#pragma unroll
    for (int j = 0; j < 4; ++j) { const int n = (lane >> 3) + 8 * j; const LAS float* s = scr + (8 * c) * 33 + n;
        u32x4 o; o.x = pk_f16(s[0 * 33], s[1 * 33]); o.y = pk_f16(s[2 * 33], s[3 * 33]); o.z = pk_f16(s[4 * 33], s[5 * 33]); o.w = pk_f16(s[6 * 33], s[7 * 33]);
        *(GAS u32x4*)(WT + (size_t)(orow0 + n) * K + ko + 8 * c) = o; }
    asm volatile("s_waitcnt lgkmcnt(0)" ::: "memory");
}

__device__ __forceinline__ void transpose_item8(const GAS float* W, int K, int N, GAS unsigned char* WT, int orow0, int k0, int n0, LAS float* scr, int lane) {
#pragma unroll 8
    for (int i = 0; i < 32; ++i) { const int kk = 2 * i + (lane >> 5); scr[kk * 33 + (lane & 31)] = W[(size_t)(k0 + kk) * N + n0 + (lane & 31)] * W8_SCALE; }
    asm volatile("s_waitcnt lgkmcnt(0)" ::: "memory");
    const int c = lane & 7;
#pragma unroll
    for (int j = 0; j < 4; ++j) { const int n = (lane >> 3) + 8 * j; const LAS float* s = scr + (8 * c) * 33 + n;
        u32x2 o; o.x = pk4_fp8(s[0 * 33], s[1 * 33], s[2 * 33], s[3 * 33]); o.y = pk4_fp8(s[4 * 33], s[5 * 33], s[6 * 33], s[7 * 33]);
        *(GAS u32x2*)(WT + (size_t)(orow0 + n) * K + k0 + 8 * c) = o; }
    asm volatile("s_waitcnt lgkmcnt(0)" ::: "memory");
}

__device__ __forceinline__ void transpose_item8x64(const GAS float* W, int K, int N, GAS unsigned char* WT, int orow0, int k0, int n0, LAS float* scr, int lane) {
    f32x4 v[16];
#pragma unroll
    for (int i = 0; i < 16; ++i) v[i] = *(const GAS f32x4*)(W + (size_t)(k0 + 4 * i + (lane >> 4)) * N + n0 + 4 * (lane & 15));
#pragma unroll
    for (int i = 0; i < 16; ++i) { LAS float* d = scr + (4 * i + (lane >> 4)) * 65 + 4 * (lane & 15); d[0] = v[i].x * W8_SCALE; d[1] = v[i].y * W8_SCALE; d[2] = v[i].z * W8_SCALE; d[3] = v[i].w * W8_SCALE; }
    asm volatile("s_waitcnt lgkmcnt(0)" ::: "memory");
    const int c = lane & 7;
#pragma unroll
    for (int j = 0; j < 8; ++j) { const int n = (lane >> 3) + 8 * j; const LAS float* s = scr + (8 * c) * 65 + n;
        u32x2 o; o.x = pk4_fp8(s[0 * 65], s[1 * 65], s[2 * 65], s[3 * 65]); o.y = pk4_fp8(s[4 * 65], s[5 * 65], s[6 * 65], s[7 * 65]);
        *(GAS u32x2*)(WT + (size_t)(orow0 + n) * K + k0 + 8 * c) = o; }
    asm volatile("s_waitcnt lgkmcnt(0)" ::: "memory");
}

__device__ __forceinline__ void norm_mod_row(const GAS float* xrow, const GAS float* g, const GAS float* shift, const GAS float* scale, GAS f16* orow, GAS unsigned char* orow8, int lane) {
    f32x4 v[4]; float s = 0.f;
#pragma unroll
    for (int j = 0; j < 4; ++j) { v[j] = *(const GAS f32x4*)(xrow + 4 * lane + 256 * j); s += (v[j].x * v[j].x + v[j].y * v[j].y) + (v[j].z * v[j].z + v[j].w * v[j].w); }
    const float rstd = rsqrtf(wave_sum(s) * (1.f / DM) + EPS);
#pragma unroll
    for (int j = 0; j < 4; ++j) { const int c = 4 * lane + 256 * j; const f32x4 gg = *(const GAS f32x4*)(g + c), sh = *(const GAS f32x4*)(shift + c), sc = *(const GAS f32x4*)(scale + c);
        const f32x4 h = (v[j] * rstd) * gg * (sc + 1.0f) + sh;
        u32x2 w; w.x = pk_f16(h.x, h.y); w.y = pk_f16(h.z, h.w); *(GAS u32x2*)(orow + c) = w;
        if (PROJ_FP8 && PROJ_FP8_FIRST == 0) *(GAS unsigned*)(orow8 + c) = pk4_fp8(h.x, h.y, h.z, h.w); }
}

extern __shared__ __attribute__((aligned(16))) unsigned char lds[];
#define LAUNDER() int tid = tid0; asm volatile("" : "+v"(tid)); const int lane = tid & 63; int wave = wave0; asm volatile("" : "+s"(wave)); const int gw = bid * NWAVES + wave; (void)gw; (void)lane; const CAS Args* AP = (const CAS Args*)__builtin_amdgcn_kernarg_segment_ptr(); asm volatile("" : "+s"(AP)); (void)AP; LAS unsigned char* Lp = (LAS unsigned char*)lds; asm volatile("" : "+s"(Lp)); (void)Lp; GAS unsigned char* ws = (GAS unsigned char*)AP->ws; GAS unsigned* ctl = (GAS unsigned*)(ws + WS_CTL); GAS float* MOD = (GAS float*)(ws + WS_MOD); GAS float* KMEAN = (GAS float*)(ws + WS_KMEAN); GAS float* SSQ = (GAS float*)(ws + WS_SSQ); (void)SSQ; GAS f16* SGUW = (GAS f16*)(ws + WS_SGUW); GAS f16* RWT16 = (GAS f16*)(ws + WS_RWT); (void)RWT16; GAS unsigned char* WIN8 = (GAS unsigned char*)(ws + WS_WIN8); (void)WIN8; GAS unsigned char* HB8 = (GAS unsigned char*)(ws + WS_HB8); (void)HB8; GAS f16* PWT = (GAS f16*)(ws + WS_PWT); (void)PWT; GAS int* ROUTE_E = (GAS int*)(ws + WS_ROUTE); GAS int* ROUTE_POS = ROUTE_E + NTOK * 4; GAS float* ROUTE_G = (GAS float*)(ROUTE_POS + NTOK * 4); GAS int* LIST = (GAS int*)(ws + WS_LIST); GAS f16* WIN_T = (GAS f16*)(ws + WS_WIN); GAS f16* WOUT_T = (GAS f16*)(ws + WS_WOUT); GAS f16* W1_T = (GAS f16*)(ws + WS_W1); GAS f16* W2_T = (GAS f16*)(ws + WS_W2); GAS f16* X = (GAS f16*)(ws + WS_X); GAS f16* H = (GAS f16*)(ws + WS_H); GAS f16* PROJ = (GAS f16*)(ws + WS_PROJ); GAS f16* MIX = (GAS f16*)(ws + WS_MIX); GAS f16* XS = (GAS f16*)(ws + WS_XS); GAS f16* ACT = (GAS f16*)(ws + WS_ACT); (void)ctl; (void)MOD; (void)KMEAN; (void)SGUW; (void)ROUTE_E; (void)ROUTE_POS; (void)ROUTE_G; (void)LIST; (void)WIN_T; (void)WOUT_T; (void)W1_T; (void)W2_T; (void)X; (void)H; (void)PROJ; (void)MIX; (void)XS; (void)ACT;
__device__ __forceinline__ void layer_body(const int l, const XcdBarrier bar, const int tid0, const int wave0, const int G, const int bid, const int NGW) {
#define MODL (MOD + (size_t)l * 8 * 6144)
for (int rep_ = 0; rep_ < REPS(4); ++rep_) if (PHMASK & 4) { LAUNDER();
        if (PROJ_FP8 && l >= PROJ_FP8_FIRST) {
            { pg8::Gemm g{(const GAS pg8::h16_t*)H, (const GAS pg8::h16_t*)(WIN_T + (size_t)l * INW * DM), NTOK, 512, DM, nullptr, nullptr}; pg8::MapOrder S; S.init(NTOK, 512, G, bid); S.map = 0x32u;
              pg8::EpiF16 E{(GAS pg8::h16_t*)PROJ, INW, KMEAN, 1.0f};
              pg8::gemm_phase<pg8::EpiF16, pg8::MapOrder, false, false>(Lp, g, S, E, tid); }
            { pg8::Gemm g{(const GAS pg8::h16_t*)HB8, (const GAS pg8::h16_t*)(WIN8 + (size_t)l * INW * DM), NTOK, 1536, DM / 2, nullptr, nullptr}; pg8::MapOrder S; S.init(NTOK, 1536, G, bid); S.map = 0x765410u;
              pg8::EpiF16 E{(GAS pg8::h16_t*)PROJ, INW, KMEAN, W8_INV};
              pg8::gemm_phase<pg8::EpiF16, pg8::MapOrder, false, true>(Lp, g, S, E, tid); }
        } else {
        { pg8::Gemm g{(const GAS pg8::h16_t*)H, (const GAS pg8::h16_t*)(WIN_T + (size_t)l * INW * DM), NTOK, INW, DM, nullptr, nullptr}; pg8::StaticOrder S; S.init(NTOK, INW, G, bid);
          pg8::EpiF16 E{(GAS pg8::h16_t*)PROJ, INW, KMEAN, 1.0f};
          pg8::gemm_phase<pg8::EpiF16, pg8::StaticOrder, false>(Lp, g, S, E, tid); }
        }
}
        xcd_barrier(bar);
        STAMP(3 + 9 * l + 0);

for (int rep_ = 0; rep_ < REPS(8); ++rep_) if (PHMASK & 8) {
        for (int it_ = bid; it_ < 256 + 512 + 512; it_ += G) { int it = it_; asm volatile("" : "+s"(it));
            if ((PH3 & 1) && it < 256) {
                LAUNDER();
                const int T0 = it * 128;
                LAS f16* vT = (LAS f16*)Lp;
                constexpr int VS = 136;
                const GAS float* sng = GIN(I_SNG) + l * GW; const GAS float* snb = GIN(I_SNB) + l * GW;
                f16x8 afr[4][4];
#pragma unroll
                for (int ks = 0; ks < 4; ++ks)
#pragma unroll
                    for (int h = 0; h < 4; ++h) afr[ks][h] = *(const GAS f16x8*)(SGUW + ((size_t)(l * 4 + h) * 128 + 16 * wave + (lane & 15)) * 128 + 32 * ks + 8 * (lane >> 4));
#pragma unroll 1
                for (int tg = 0; tg < 16; tg += 4) { f16x4 hvv[4];
#pragma unroll
                  for (int t4 = 0; t4 < 4; ++t4) hvv[t4] = *(const GAS f16x4*)(PROJ + (size_t)(T0 + wave * 16 + tg + t4) * INW + 1792 + 4 * lane);
#pragma unroll
                  for (int t4 = 0; t4 < 4; ++t4) { const int tl = wave * 16 + tg + t4;
                    const f16x4 hv = hvv[t4]; float v[4]; float s = 0.f;
#pragma unroll
                    for (int i = 0; i < 4; ++i) { v[i] = gelu_erf((float)hv[i]); s += v[i]; }
                    const float mean = wave_sum(s) * (1.f / 256.f); float q = 0.f;
#pragma unroll
                    for (int i = 0; i < 4; ++i) { v[i] -= mean; q += v[i] * v[i]; }
                    const float rstd = rsqrtf(wave_sum(q) * (1.f / 256.f) + EPS);
#pragma unroll
                    for (int i = 0; i < 4; ++i) { const int c = 4 * lane + i; vT[c * VS + tl] = (f16)(v[i] * rstd * sng[c] + snb[c]); } } }
                __syncthreads();
                f32x4 acc[4][4];
#pragma unroll
                for (int h = 0; h < 4; ++h)
#pragma unroll
                    for (int ct = 0; ct < 4; ++ct) acc[h][ct] = (f32x4){0.f, 0.f, 0.f, 0.f};
                const int nk = (wave >> 1) + 1, fr = lane & 15, fq = lane >> 4;
#pragma unroll
                for (int ks = 0; ks < 4; ++ks) { if (ks < nk) {
#pragma unroll
                    for (int h = 0; h < 4; ++h) {
                        const f16x8 a = afr[ks][h];
#pragma unroll
                        for (int ct = 0; ct < 4; ++ct) { const f16x8 b = *(const LAS f16x8*)(vT + (h * 64 + ct * 16 + fr) * VS + 32 * ks + 8 * fq);
                            acc[h][ct] = __builtin_amdgcn_mfma_f32_16x16x32_f16(a, b, acc[h][ct], 0, 0, 0); } } } }
                const GAS float* sb = GIN(I_SGUB) + (size_t)l * 4 * 128;
#pragma unroll
                for (int reg = 0; reg < 4; ++reg) { const int il = 16 * wave + 4 * fq + reg; const size_t tok = (size_t)(T0 + il); float ss = 0.f; float val[4][4];
#pragma unroll
                    for (int h = 0; h < 4; ++h) { const float bia = sb[h * 128 + il];
#pragma unroll
                        for (int ct = 0; ct < 4; ++ct) { const int c = h * 64 + ct * 16 + fr; const float u = gelu_erf((float)PROJ[tok * INW + 1536 + c]);
                            const float x = (acc[h][ct][reg] + bia) * u; val[h][ct] = x; ss += x * x; } }
                    ss = row16_sum(ss);
                    const float rstd = rsqrtf(ss * (1.f / 256.f) + EPS);
#pragma unroll
                    for (int h = 0; h < 4; ++h)
#pragma unroll
                        for (int ct = 0; ct < 4; ++ct) MIX[tok * DM + 768 + h * 64 + ct * 16 + fr] = (f16)(val[h][ct] * rstd); }
                __syncthreads();
            } else if ((PH3 & 2) && it < 768) {
                LAUNDER();
                const int T0 = (it - 256) * 64, p0 = T0 & (SEQ - 1);
                LAS float* y = (LAS float*)Lp;
                LAS float* Wc = (LAS float*)(Lp + 96256);
                for (int i = tid; i < 31 * 64; i += 512) *(LAS f32x4*)(Wc + 4 * i) = *(const GAS f32x4*)(GIN(I_CONVW) + (size_t)l * 31 * GW + 4 * i);
                { f16x8 av[6], gv[6];
#pragma unroll
                  for (int k6 = 0; k6 < 6; ++k6) { int task = tid + k6 * 512; task = task < 94 * 32 ? task : 94 * 32 - 1; const int r = task >> 5, c8 = (task & 31) * 8; const bool ok = (p0 - 30 + r >= 0);
                      const GAS f16* pr = PROJ + (size_t)(T0 + (ok ? r - 30 : 0)) * INW + c8; av[k6] = *(const GAS f16x8*)pr; gv[k6] = *(const GAS f16x8*)(pr + 256); }
#pragma unroll
                  for (int k6 = 0; k6 < 6; ++k6) { const int task = tid + k6 * 512;
                      if (task < 94 * 32) { const int r = task >> 5, c8 = (task & 31) * 8; const bool ok = (p0 - 30 + r >= 0); float o[8];
#pragma unroll
                          for (int i = 0; i < 8; ++i) o[i] = ok ? (float)av[k6][i] * sigmoidf_((float)gv[k6][i]) : 0.f;
                          *(LAS f32x4*)(y + r * 256 + c8) = (f32x4){o[0], o[1], o[2], o[3]}; *(LAS f32x4*)(y + r * 256 + c8 + 4) = (f32x4){o[4], o[5], o[6], o[7]}; } } }
                __syncthreads();
                float psq[8];
#pragma unroll
                for (int t = 0; t < 8; ++t) psq[t] = 0.f;
                float osv[4][8];
#pragma unroll
                for (int h = 0; h < 4; ++h) { const int c = h * 64 + lane; float w[31];
#pragma unroll
                    for (int j = 0; j < 31; ++j) w[j] = Wc[j * 256 + c];
                    const float cb = GIN(I_CONVB)[l * GW + c], ng = GIN(I_CNG)[l * GW + c], nb_ = GIN(I_CNB)[l * GW + c];
                    float yv[38];
#pragma unroll
                    for (int q = 0; q < 38; ++q) yv[q] = y[(wave * 8 + q) * 256 + c];
                    float a[8], red[16];
#pragma unroll
                    for (int t = 0; t < 8; ++t) { float s = cb;
#pragma unroll
                        for (int j = 0; j < 31; ++j) s += w[j] * yv[t + j];
                        a[t] = s; red[t] = s; red[8 + t] = s * s; }
                    wave_sum_n<16>(red);
#pragma unroll
                    for (int t = 0; t < 8; ++t) { const float mean = red[t] * (1.f / 64.f), var = fmaxf(red[8 + t] * (1.f / 64.f) - mean * mean, 0.f);
                        const float yn = (a[t] - mean) * rsqrtf(var + EPS) * ng + nb_; const float sv = yn * sigmoidf_(yn);
                        psq[t] += sv * sv; osv[h][t] = sv; }
                    asm volatile("" ::: "memory"); }
                wave_sum_n<8>(psq);
#pragma unroll
                for (int t = 0; t < 8; ++t) psq[t] = rsqrtf(psq[t] * (1.f / 256.f) + EPS);
#pragma unroll
                for (int h = 0; h < 4; ++h)
#pragma unroll
                    for (int t = 0; t < 8; ++t) MIX[(size_t)(T0 + wave * 8 + t) * DM + 256 + h * 64 + lane] = (f16)(osv[h][t] * psq[t]);
                __syncthreads();
            } else if ((PH3 & 4) && it < 1280) {
                LAUNDER();
                const int T0 = (it - 768) * 64, p0 = T0 & (SEQ - 1);
                LAS f16* zt = (LAS f16*)Lp;
                LAS f16* Pf = (LAS f16*)(Lp + 40960);
                LAS f16* WpT = (LAS f16*)(Lp + 75776);
                constexpr int PS = 264, WS2 = 72;
                for (int i = tid; i < 256 * 8; i += 512) { const int r = i >> 3, c8 = (i & 7) * 8; *(LAS u32x4*)(WpT + r * WS2 + c8) = *(const GAS u32x4*)(PWT + (size_t)l * 16384 + r * 64 + c8); }
                for (int task = tid; task < 79 * 32; task += 512) { const int r = task >> 5, c8 = (task & 31) * 8; u32x4 z = {0u, 0u, 0u, 0u};
                    if (p0 - 15 + r >= 0) z = *(const GAS u32x4*)(PROJ + (size_t)(T0 - 15 + r) * INW + 1280 + c8);
                    *(LAS u32x4*)(zt + r * 256 + c8) = z; }
                __syncthreads();
                { const int c8 = (tid & 31) * 8, seg = tid >> 5, gi = c8 >> 6, w = 2 << gi; float s[8];
#pragma unroll
                  for (int i = 0; i < 8; ++i) s[i] = 0.f;
                  for (int d = 1; d < w; ++d) { const f16x8 z = *(const LAS f16x8*)(zt + (seg * 4 + 15 - d) * 256 + c8);
#pragma unroll
                      for (int i = 0; i < 8; ++i) s[i] += (float)z[i]; }
#pragma unroll
                  for (int t = 0; t < 4; ++t) { const int tl = seg * 4 + t, p = p0 + tl;
                      const f16x8 zn = *(const LAS f16x8*)(zt + (tl + 15) * 256 + c8);
                      const float inv = 1.f / (float)(p + 1 < w ? p + 1 : w); f16x8 po;
#pragma unroll
                      for (int i = 0; i < 8; ++i) { s[i] += (float)zn[i]; po[i] = (f16)(s[i] * inv - (float)zn[i]); }
                      *(LAS f16x8*)(Pf + tl * PS + c8) = po;
                      const f16x8 zo = *(const LAS f16x8*)(zt + (tl + 15 - (w - 1)) * 256 + c8);
#pragma unroll
                      for (int i = 0; i < 8; ++i) s[i] -= (float)zo[i]; } }
                __syncthreads();
                if (wave < 4) {
                    const int fr = lane & 15, fq = lane >> 4;
                    f32x4 acc[4][4];
#pragma unroll
                    for (int g = 0; g < 4; ++g)
#pragma unroll
                        for (int nt = 0; nt < 4; ++nt) acc[g][nt] = (f32x4){0.f, 0.f, 0.f, 0.f};
#pragma unroll
                    for (int g = 0; g < 4; ++g)
#pragma unroll
                        for (int ks = 0; ks < 2; ++ks) { const f16x8 av = *(const LAS f16x8*)(Pf + (16 * wave + fr) * PS + g * 64 + 32 * ks + 8 * fq);
#pragma unroll
                            for (int nt = 0; nt < 4; ++nt) { const f16x8 bv = *(const LAS f16x8*)(WpT + (g * 64 + nt * 16 + fr) * WS2 + 32 * ks + 8 * fq);
                                acc[g][nt] = __builtin_amdgcn_mfma_f32_16x16x32_f16(av, bv, acc[g][nt], 0, 0, 0); } }
                    float psc[4][4];
#pragma unroll
                    for (int g = 0; g < 4; ++g)
#pragma unroll
                        for (int nt = 0; nt < 4; ++nt) psc[g][nt] = GIN(I_POOLS)[l * GW + g * 64 + nt * 16 + fr];
#pragma unroll
                    for (int reg = 0; reg < 4; ++reg) { float ss = 0.f;
#pragma unroll
                        for (int g = 0; g < 4; ++g)
#pragma unroll
                            for (int nt = 0; nt < 4; ++nt) { const float x = acc[g][nt][reg] * psc[g][nt]; acc[g][nt][reg] = x; ss += x * x; }
                        ss = row16_sum(ss);
                        const float rstd = rsqrtf(ss * (1.f / 256.f) + EPS); const size_t tok = (size_t)(T0 + 16 * wave + 4 * fq + reg);
#pragma unroll
                        for (int g = 0; g < 4; ++g)
#pragma unroll
                            for (int nt = 0; nt < 4; ++nt) MIX[tok * DM + 512 + g * 64 + nt * 16 + fr] = (f16)(acc[g][nt][reg] * rstd); }
                }
                __syncthreads();
            }
        }
}
        STAMP(3 + 9 * l + 1);

for (int rep_ = 0; rep_ < REPS(16); ++rep_) if (PHMASK & 16) { LAUNDER();
        {
            LAS f16* Kb = (LAS f16*)Lp;
            LAS f16* Vb = (LAS f16*)(Lp + 36864);
            LAS float* kml = (LAS float*)(Lp + 73728);
            LAS float* lut = (LAS float*)(Lp + 73728 + 4096);
            constexpr int KS = 72;
            constexpr float LOG2E = 1.4426950408889634f, SC2 = 0.125f * LOG2E, THR = 4.0f;
            const int r32 = lane & 31, hh = lane >> 5;
            const int vtr_off = (4 * hh + ((lane & 15) >> 2)) * KS + 16 * ((lane >> 4) & 1) + 4 * (lane & 3);
            const int lk = tid >> 3, lc = tid & 7;
            for (int pi = bid; pi < 256; pi += G) {
                const int bh = pi >> 3, pp = pi & 7;
                for (int half = 0; half < 2; ++half) {
                    const int own = half == 0 ? 15 - pp : pp;
                    const int b = bh >> 2, h = bh & 3;
                    const size_t TB = (size_t)b * SEQ;
                    const int qpos = own * 256 + 32 * wave + r32;
                    const GAS f16* kvp = PROJ + (TB + lk) * INW + 768 + h * 64 + 8 * lc;
                    f16x8 kr[4], vr[4];
#pragma unroll
                    for (int pc = 0; pc < 4; ++pc) { const GAS f16* p_ = kvp + (size_t)(64 * pc) * INW; kr[pc] = *(const GAS f16x8*)p_; vr[pc] = *(const GAS f16x8*)(p_ + 256); }
                    __syncthreads();
                    for (int i = tid; i < 1024; i += 512) kml[i] = KMEAN[((size_t)(b * 16 + (i >> 6))) * 256 + h * 64 + (i & 63)] * (1.f / 256.f);
                    if (tid < 128) lut[tid] = GIN(I_RELB)[t5_bucket(tid) * 4 + h] * LOG2E;
                    f16x8 qf[4];
                    { const GAS f16* qp = PROJ + (TB + qpos) * INW + 512 + h * 64 + 8 * hh;
#pragma unroll
                      for (int s = 0; s < 4; ++s) qf[s] = *(const GAS f16x8*)(qp + 16 * s); }
                    __syncthreads();
                    unsigned mask = 0u;
                    { float gsc[16]; float qv[32];
#pragma unroll
                      for (int s = 0; s < 4; ++s)
#pragma unroll
                          for (int j = 0; j < 8; ++j) qv[8 * s + j] = (float)qf[s][j];
#pragma unroll
                      for (int n = 0; n < 16; ++n) { float a = 0.f;
                          if (n < own) { f32x4 kv[8];
#pragma unroll
                              for (int s = 0; s < 4; ++s) { kv[2 * s] = *(const LAS f32x4*)(kml + n * 64 + 16 * s + 8 * hh); kv[2 * s + 1] = *(const LAS f32x4*)(kml + n * 64 + 16 * s + 8 * hh + 4); }
#pragma unroll
                              for (int s = 0; s < 8; ++s) a += (qv[4 * s] * kv[s].x + qv[4 * s + 1] * kv[s].y) + (qv[4 * s + 2] * kv[s].z + qv[4 * s + 3] * kv[s].w); }
                          a += __shfl_xor(a, 32); gsc[n] = a; }
#pragma unroll
                      for (int k = 0; k < 3; ++k) { float best = -INFINITY; int bi = -1;
#pragma unroll
                          for (int n = 0; n < 16; ++n) { const bool ok = (n < own) && !((mask >> n) & 1u) && (gsc[n] > best); if (ok) { best = gsc[n]; bi = n; } }
                          if (bi >= 0) mask |= 1u << bi; }
#pragma unroll
                      for (int s = 0; s < 4; ++s)
#pragma unroll
                          for (int j = 0; j < 8; ++j) qf[s][j] = (f16)(qv[8 * s + j] * SC2); }
                    f32x16 o0, o1;
#pragma unroll
                    for (int i = 0; i < 16; ++i) { o0[i] = 0.f; o1[i] = 0.f; }
                    float mrun = -INFINITY, lrun = 0.f;
                    f32x16 iniv; float ini_prev = 0.f;
#pragma unroll
                    for (int i = 0; i < 16; ++i) iniv[i] = 0.f;
                    for (int n = 0; n <= own; ++n) {
                        __syncthreads();
#pragma unroll
                        for (int pc = 0; pc < 4; ++pc) { *(LAS f16x8*)(Kb + (lk + 64 * pc) * KS + 8 * lc) = kr[pc]; *(LAS f16x8*)(Vb + (lk + 64 * pc) * KS + 8 * lc) = vr[pc]; }
                        __syncthreads();
                        if (n < own) {
#pragma unroll
                            for (int pc = 0; pc < 4; ++pc) { const GAS f16* p_ = kvp + (size_t)((n + 1) * 256 + 64 * pc) * INW; kr[pc] = *(const GAS f16x8*)p_; vr[pc] = *(const GAS f16x8*)(p_ + 256); } }
                        const bool past = n < own;
                        const bool sel = past ? ((mask >> n) & 1u) != 0u : true;
                        if (past && !__any(sel)) continue;
                        const int ntl = past ? 4 : (wave >> 1) + 1;
#pragma unroll 1
                        for (int tl = 0; tl < ntl; ++tl) {
                            const LAS f16* Kt = Kb + tl * 64 * KS; const LAS f16* Vt = Vb + tl * 64 * KS;
                            const int kbase = n * 256 + tl * 64;
                            const int dmin = own * 256 + 32 * wave - (kbase + 63);
                            const bool cb = dmin >= 127;
                            const float minit = (mrun == -INFINITY) ? 0.f : mrun;
                            const float ini = sel ? ((cb ? lut[127] : 0.f) - minit) : -INFINITY;
                            if (__any(ini != ini_prev)) {
#pragma unroll
                                for (int i = 0; i < 16; ++i) iniv[i] = ini;
                                ini_prev = ini; }
                            f32x16 p0, p1;
                            { const f16x8 a0 = *(const LAS f16x8*)(Kt + r32 * KS + 8 * hh), a1 = *(const LAS f16x8*)(Kt + (32 + r32) * KS + 8 * hh);
                              p0 = __builtin_amdgcn_mfma_f32_32x32x16_f16(a0, qf[0], iniv, 0, 0, 0); p1 = __builtin_amdgcn_mfma_f32_32x32x16_f16(a1, qf[0], iniv, 0, 0, 0); }
#pragma unroll
                            for (int s = 1; s < 4; ++s) { const f16x8 a0 = *(const LAS f16x8*)(Kt + r32 * KS + 16 * s + 8 * hh), a1 = *(const LAS f16x8*)(Kt + (32 + r32) * KS + 16 * s + 8 * hh);
                                p0 = __builtin_amdgcn_mfma_f32_32x32x16_f16(a0, qf[s], p0, 0, 0, 0); p1 = __builtin_amdgcn_mfma_f32_32x32x16_f16(a1, qf[s], p1, 0, 0, 0); }
                            if (!cb) {
#pragma unroll
                                for (int i = 0; i < 16; ++i) { const int kr_ = (i & 3) + 8 * (i >> 2) + 4 * hh; const int d0 = qpos - (kbase + kr_), d1 = d0 - 32;
                                    p0[i] = (d0 >= 0) ? p0[i] + lut[d0 > 127 ? 127 : d0] : -INFINITY;
                                    p1[i] = (d1 >= 0) ? p1[i] + lut[d1 > 127 ? 127 : (d1 < 0 ? 0 : d1)] : -INFINITY; } }
                            asm volatile("s_nop 7\n\ts_nop 7\n\ts_nop 7" : "+v"(p0), "+v"(p1));
                            float mx = max3f(p0[0], p0[1], p1[0]), mxb = max3f(p0[2], p0[3], p1[1]); mx = max3f(mx, p1[2], p1[3]);
#pragma unroll
                            for (int i = 4; i < 16; i += 4) { mx = max3f(mx, p0[i], p0[i + 1]); mxb = max3f(mxb, p0[i + 2], p0[i + 3]); mx = max3f(mx, p1[i], p1[i + 1]); mxb = max3f(mxb, p1[i + 2], p1[i + 3]); }
                            mx = max2f(mx, mxb);
                            mx = max2f(mx, __shfl_xor(mx, 32));
                            const bool need = sel && (mx > -INFINITY) && ((mrun == -INFINITY) || (mx > THR));
                            if (__any(need)) { const float delta = need ? mx : 0.f; const float alpha = __builtin_amdgcn_exp2f(-delta);
#pragma unroll
                                for (int i = 0; i < 16; ++i) { p0[i] -= delta; p1[i] -= delta; o0[i] *= alpha; o1[i] *= alpha; }
                                lrun *= alpha; if (need) mrun = minit + delta; }
#pragma unroll
                            for (int i = 0; i < 16; ++i) { p0[i] = __builtin_amdgcn_exp2f(p0[i]); p1[i] = __builtin_amdgcn_exp2f(p1[i]); }
                            asm volatile("s_nop 1" : "+v"(p0), "+v"(p1));
                            float psa = 0.f, psb = 0.f, psc = 0.f, psd = 0.f;
#pragma unroll
                            for (int i = 0; i < 16; i += 2) { psa = fadd_s(psa, p0[i]); psb = fadd_s(psb, p1[i]); psc = fadd_s(psc, p0[i + 1]); psd = fadd_s(psd, p1[i + 1]); }
                            lrun += (psa + psb) + (psc + psd);
                            f16x8 pb[4];
#pragma unroll
                            for (int i = 0; i < 8; ++i) { pb[0][i] = (f16)p0[i]; pb[1][i] = (f16)p0[8 + i]; pb[2][i] = (f16)p1[i]; pb[3][i] = (f16)p1[8 + i]; }
#pragma unroll
                            for (int kk = 0; kk < 4; ++kk) {
                                const LAS f16* vb = Vt + vtr_off + (16 * kk) * KS;
                                const f16x4 a0l = __builtin_bit_cast(f16x4, __builtin_amdgcn_ds_read_tr16_b64_v4i16((LAS v4i16_t*)(vb)));
                                const f16x4 a0h = __builtin_bit_cast(f16x4, __builtin_amdgcn_ds_read_tr16_b64_v4i16((LAS v4i16_t*)(vb + 8 * KS)));
                                const f16x4 a1l = __builtin_bit_cast(f16x4, __builtin_amdgcn_ds_read_tr16_b64_v4i16((LAS v4i16_t*)(vb + 32)));
                                const f16x4 a1h = __builtin_bit_cast(f16x4, __builtin_amdgcn_ds_read_tr16_b64_v4i16((LAS v4i16_t*)(vb + 8 * KS + 32)));
                                const f16x8 av0 = {a0l[0], a0l[1], a0l[2], a0l[3], a0h[0], a0h[1], a0h[2], a0h[3]};
                                const f16x8 av1 = {a1l[0], a1l[1], a1l[2], a1l[3], a1h[0], a1h[1], a1h[2], a1h[3]};
                                o0 = __builtin_amdgcn_mfma_f32_32x32x16_f16(av0, pb[kk], o0, 0, 0, 0);
                                o1 = __builtin_amdgcn_mfma_f32_32x32x16_f16(av1, pb[kk], o1, 0, 0, 0); }
                        }
                    }
                    const float ltot = lrun + __shfl_xor(lrun, 32), inv = 1.f / ltot;
                    GAS f16* op = MIX + (TB + qpos) * DM + h * 64;
                    float sq = 0.f;
#pragma unroll
                    for (int g4 = 0; g4 < 4; ++g4) { const int d0 = 8 * g4 + 4 * hh;
                        u32x2 w0, w1; w0.x = pk_f16(o0[4 * g4] * inv, o0[4 * g4 + 1] * inv); w0.y = pk_f16(o0[4 * g4 + 2] * inv, o0[4 * g4 + 3] * inv);
                        w1.x = pk_f16(o1[4 * g4] * inv, o1[4 * g4 + 1] * inv); w1.y = pk_f16(o1[4 * g4 + 2] * inv, o1[4 * g4 + 3] * inv);
                        { const f16x4 r0 = __builtin_bit_cast(f16x4, w0), r1 = __builtin_bit_cast(f16x4, w1);
#pragma unroll
                          for (int i = 0; i < 4; ++i) { const float a_ = (float)r0[i], b_ = (float)r1[i]; sq += a_ * a_ + b_ * b_; } }
                        *(GAS u32x2*)(op + d0) = w0; *(GAS u32x2*)(op + 32 + d0) = w1; }
                    sq += __shfl_xor(sq, 32);
                    if (hh == 0) SSQ[(TB + qpos) * 4 + h] = sq;
                }
            }
        }
}
        xcd_barrier(bar);
        STAMP(3 + 9 * l + 2);

        STAMP(3 + 9 * l + 3);

if (PHMASK & 64) { LAUNDER();
        { pg8::Gemm g{(const GAS pg8::h16_t*)MIX, (const GAS pg8::h16_t*)(WOUT_T + (size_t)l * DM * DM), NTOK, DM, DM, nullptr, SSQ}; pg8::StaticOrder S; S.init(NTOK, DM, G, bid);
          if (l == 0) { pg8::EpiResidT<true> E{GIN(I_X), nullptr, (GAS pg8::h16_t*)X, MODL + 2048}; pg8::gemm_phase<pg8::EpiResidT<true>, pg8::StaticOrder, false, false, true>(Lp, g, S, E, tid); }
          else { pg8::EpiResidT<false> E{nullptr, (const GAS pg8::h16_t*)X, (GAS pg8::h16_t*)X, MODL + 2048}; pg8::gemm_phase<pg8::EpiResidT<false>, pg8::StaticOrder, false, false, true>(Lp, g, S, E, tid); } }
}
        xcd_barrier(bar);
        STAMP(3 + 9 * l + 4);

if (PHMASK & 128) { LAUNDER();
        {
            LAS f16* WT = (LAS f16*)Lp;
            constexpr int WS_ = 1032;
            LAS float* lg = (LAS float*)(Lp + 66560 + wave * 2304);
            LAS int* sel_e = (LAS int*)(Lp + 131584);
            LAS int* rank_ = (LAS int*)(Lp + 131584 + 2048);
            LAS int* lcnt = (LAS int*)(Lp + 131584 + 4096);
            LAS int* lbase = (LAS int*)(Lp + 131584 + 4096 + 128);
            for (int i = tid; i < 32 * WS_ / 8; i += 512) *(LAS u32x4*)(WT + 8 * i) = *(const GAS u32x4*)(RWT16 + (size_t)l * 32 * WS_ + 8 * i);
            GAS unsigned* gcnt = ctl + CW_CNT + l * 32 * 64;
            const int fr = lane & 15, fq = lane >> 4;
            if (l + 1 < DEPTH) { for (int i = bid * 512 + tid; i < NB * 16 * 256; i += G * 512) KMEAN[i] = 0.f; }
            for (int ch = bid; ch < NTOK / 128; ch += G) {
                if (tid < 32) lcnt[tid] = 0;
                __syncthreads();
                const int b = (ch * 128) >> 12; const GAS float* md = MODL + (size_t)b * 6144;
                const GAS float* g2 = GIN(I_N2G) + l * DM;
                const size_t tokw = (size_t)ch * 128 + wave * 16;
                LAS float* pgl = (LAS float*)(Lp + 86016); LAS float* psl = (LAS float*)(Lp + 86016 + 4096);
                for (int i = tid; i < 256; i += 512) { const f32x4 g4 = *(const GAS f32x4*)(g2 + 4 * i), s4 = *(const GAS f32x4*)(md + 4096 + 4 * i); *(LAS f32x4*)(pgl + 4 * i) = g4 * (s4 + 1.0f); *(LAS f32x4*)(psl + 4 * i) = *(const GAS f32x4*)(md + 3072 + 4 * i); }
                __syncthreads();
                LAS f16* hb = (LAS f16*)(Lp + 94208) + wave * (2 * WS_);
                const float rb0 = GIN(I_RB)[l * NEXP + fr], rb1 = GIN(I_RB)[l * NEXP + 16 + fr];
#pragma unroll 1
                for (int t2 = 0; t2 < 16; t2 += 4) {
                    f32x4 v[4][4];
#pragma unroll
                    for (int r = 0; r < 4; ++r)
#pragma unroll
                        for (int j = 0; j < 4; ++j) { const f16x4 xh = *(const GAS f16x4*)(X + (tokw + t2 + r) * DM + 4 * lane + 256 * j); v[r][j] = (f32x4){(float)xh[0], (float)xh[1], (float)xh[2], (float)xh[3]}; }
#pragma unroll
                    for (int hf = 0; hf < 2; ++hf) {
#pragma unroll
                        for (int r2 = 0; r2 < 2; ++r2) { const int r = 2 * hf + r2; float s = 0.f;
#pragma unroll
                            for (int j = 0; j < 4; ++j) s += (v[r][j].x * v[r][j].x + v[r][j].y * v[r][j].y) + (v[r][j].z * v[r][j].z + v[r][j].w * v[r][j].w);
                            const float rstd = rsqrtf(wave_sum(s) * (1.f / DM) + EPS);
#pragma unroll
                            for (int j = 0; j < 4; ++j) { const int c = 4 * lane + 256 * j;
                                const f32x4 hq = (v[r][j] * rstd) * *(const LAS f32x4*)(pgl + c) + *(const LAS f32x4*)(psl + c);
                                u32x2 w; w.x = pk_f16(hq.x, hq.y); w.y = pk_f16(hq.z, hq.w); *(LAS u32x2*)(hb + r2 * WS_ + c) = w;
                                if (!IS_FP8(l)) *(GAS u32x2*)(H + (tokw + t2 + r) * DM + c) = w;
                                if (IS_FP8(l)) *(GAS unsigned*)((GAS unsigned char*)XS + (tokw + t2 + r) * DM + c) = pk4_fp8(hq.x, hq.y, hq.z, hq.w); } }
                        asm volatile("s_waitcnt lgkmcnt(0)" ::: "memory");
                        f32x4 acc0 = {0.f, 0.f, 0.f, 0.f}, acc1 = {0.f, 0.f, 0.f, 0.f};
#pragma unroll 4
                        for (int ks = 0; ks < 32; ++ks) { const f16x8 a = *(const LAS f16x8*)(hb + (fr & 1) * WS_ + 32 * ks + 8 * fq);
                            const f16x8 b0 = *(const LAS f16x8*)(WT + fr * WS_ + 32 * ks + 8 * fq), b1 = *(const LAS f16x8*)(WT + (16 + fr) * WS_ + 32 * ks + 8 * fq);
                            acc0 = __builtin_amdgcn_mfma_f32_16x16x32_f16(a, b0, acc0, 0, 0, 0); acc1 = __builtin_amdgcn_mfma_f32_16x16x32_f16(a, b1, acc1, 0, 0, 0); }
                        if (fq == 0) {
#pragma unroll
                            for (int reg = 0; reg < 2; ++reg) { lg[(t2 + 2 * hf + reg) * 36 + fr] = acc0[reg] + rb0; lg[(t2 + 2 * hf + reg) * 36 + 16 + fr] = acc1[reg] + rb1; } }
                        asm volatile("s_waitcnt lgkmcnt(0)" ::: "memory");
                    }
                }
                asm volatile("s_waitcnt lgkmcnt(0)" ::: "memory");
                if (lane < 16) { float vv[32];
#pragma unroll
                    for (int q = 0; q < 8; ++q) { const f32x4 t = *(const LAS f32x4*)(lg + lane * 36 + 4 * q); vv[4 * q] = t.x; vv[4 * q + 1] = t.y; vv[4 * q + 2] = t.z; vv[4 * q + 3] = t.w; }
                    float topv[4]; int topi[4];
#pragma unroll
                    for (int k = 0; k < 4; ++k) { float bv = -INFINITY; int bi = 0;
#pragma unroll
                        for (int e = 0; e < 32; ++e) { if (vv[e] > bv) { bv = vv[e]; bi = e; } }
                        topv[k] = bv; topi[k] = bi;
#pragma unroll
                        for (int e = 0; e < 32; ++e) vv[e] = (e == bi) ? -INFINITY : vv[e]; }
                    const int tl = wave * 16 + lane; const size_t tok = (size_t)ch * 128 + tl;
                    const float e1 = __expf(topv[1] - topv[0]), e2 = __expf(topv[2] - topv[0]), e3 = __expf(topv[3] - topv[0]); const float inv = 1.f / (1.f + e1 + e2 + e3);
                    *(GAS f32x4*)(ROUTE_G + tok * 4) = (f32x4){inv, e1 * inv, e2 * inv, e3 * inv};
#pragma unroll
                    for (int k = 0; k < 4; ++k) sel_e[tl * 4 + k] = topi[k]; }
                __syncthreads();
                const int e = sel_e[tid];
                rank_[tid] = __hip_atomic_fetch_add(&lcnt[e], 1, __ATOMIC_RELAXED, __HIP_MEMORY_SCOPE_WORKGROUP);
                __syncthreads();
                if (tid < 32) lbase[tid] = (int)__hip_atomic_fetch_add(gcnt + tid * 64, (unsigned)lcnt[tid], __ATOMIC_RELAXED, __HIP_MEMORY_SCOPE_AGENT);
                __syncthreads();
                { const int pos = lbase[e] + rank_[tid]; const size_t tok = (size_t)ch * 128 + (tid >> 2);
                  LIST[(size_t)e * LISTCAP + pos] = (int)tok; ROUTE_E[tok * 4 + (tid & 3)] = e; ROUTE_POS[tok * 4 + (tid & 3)] = pos; }
                __syncthreads();
            }
        }
}
        xcd_barrier(bar);
        STAMP(3 + 9 * l + 5);

#define cnts ((LAS int*)(Lp + RING_BYTES + 1024))
#define mbase ((LAS int*)(Lp + RING_BYTES + 1024 + 256))
        { LAUNDER(); GAS unsigned* gcnt = ctl + CW_CNT + l * 32 * 64;
          if (tid < 32) cnts[tid] = (int)__hip_atomic_load(gcnt + tid * 64, __ATOMIC_RELAXED, __HIP_MEMORY_SCOPE_AGENT);
          __syncthreads();
          if (tid == 0) { int a = 0; for (int e = 0; e < 32; ++e) { mbase[e] = a; a += (cnts[e] + 255) >> 8; } mbase[32] = a; }
          __syncthreads(); }

        for (int ph = 0; ph < 2; ++ph) {
            if (!(PHMASK & (512 << ph))) continue;
            for (int rep_ = 0; rep_ < REPS(512 << ph); ++rep_) {
            LAUNDER(); const int MT = mbase[32]; LAS int* ulist = (LAS int*)(Lp + RING_BYTES); const int NT = ph == 0 ? 8 : 4, U = MT * NT;
            __syncthreads();
            int nu = 0;
            { const int q = U / 8, rr = U % 8, nig = 8 * NT;
              for (int i = 0; i < 64; ++i) { const long Lid = (long)i * G + bid; if (Lid >= U) break; ++nu;
                  if (tid == i) { int wg = (int)Lid; const int xcd = wg % 8, off = wg / 8; wg = (xcd < rr ? xcd * (q + 1) : rr * (q + 1) + (xcd - rr) * q) + off;
                      const int gid = wg / nig, fm = gid * 8, gsz = (MT - fm) < 8 ? (MT - fm) : 8; const int pm = fm + ((wg % nig) % gsz), pn = (wg % nig) / gsz;
                      int e = 0;
                      for (int qq = 1; qq < 32; ++qq) e += (mbase[qq] <= pm) ? 1 : 0;
                      ulist[3 * i] = pm | ((e * NT + pn) << 16); ulist[3 * i + 1] = (pm - mbase[e]) * 256; ulist[3 * i + 2] = cnts[e]; } } }
            __syncthreads();
            pg8::ListOrder S{ulist, nu};
            if (ph == 0) {
                if (IS_FP8(l)) { pg8::Gemm g{(const GAS pg8::h16_t*)XS, (const GAS pg8::h16_t*)(W1_T + (size_t)l * NEXP * 2048 * DM), PROWS, 2048, DM / 2, LIST, nullptr};
                    pg8::EpiSwigluT<true> E{(GAS unsigned char*)ACT, GIN(I_B1) + (size_t)l * NEXP * 2048, W8_INV};
                    pg8::gemm_phase<pg8::EpiSwigluT<true>, pg8::ListOrder, true, true>(Lp, g, S, E, tid); }
                else { pg8::Gemm g{(const GAS pg8::h16_t*)H, (const GAS pg8::h16_t*)(W1_T + (size_t)l * NEXP * 2048 * DM), PROWS, 2048, DM, LIST, nullptr};
                    pg8::EpiSwigluT<false> E{(GAS unsigned char*)ACT, GIN(I_B1) + (size_t)l * NEXP * 2048, 1.0f};
                    pg8::gemm_phase<pg8::EpiSwigluT<false>, pg8::ListOrder, true, false>(Lp, g, S, E, tid); } }
            else {
                if (IS_FP8(l)) { pg8::Gemm g{(const GAS pg8::h16_t*)ACT, (const GAS pg8::h16_t*)(W2_T + (size_t)l * NEXP * DM * DM), PROWS, 1024, DM / 2, nullptr, nullptr};
                    pg8::EpiDownT<true> E{(GAS unsigned char*)XS, GIN(I_B2) + (size_t)l * NEXP * DM, W8_INV};
                    pg8::gemm_phase<pg8::EpiDownT<true>, pg8::ListOrder, false, true>(Lp, g, S, E, tid); }
                else { pg8::Gemm g{(const GAS pg8::h16_t*)ACT, (const GAS pg8::h16_t*)(W2_T + (size_t)l * NEXP * DM * DM), PROWS, 1024, DM, nullptr, nullptr};
                    pg8::EpiDownT<false> E{(GAS unsigned char*)XS, GIN(I_B2) + (size_t)l * NEXP * DM, 1.0f};
                    pg8::gemm_phase<pg8::EpiDownT<false>, pg8::ListOrder, false, false>(Lp, g, S, E, tid); } }
            }
            xcd_barrier(bar);
            STAMP(3 + 9 * l + 6 + ph);
        }

if (PHMASK & 2048) { LAUNDER();
        for (int m = gw; m < NTOK; m += NGW) {
            const int b = m >> 12; const GAS float* md = MODL + (size_t)b * 6144;
            const GAS unsigned char* yr[4]; float gk[4];
#pragma unroll
            for (int k = 0; k < 4; ++k) { const int e = ROUTE_E[(size_t)m * 4 + k], pos = ROUTE_POS[(size_t)m * 4 + k]; gk[k] = ROUTE_G[(size_t)m * 4 + k]; yr[k] = (const GAS unsigned char*)XS + ((size_t)mbase[e] * 256 + pos) * DM * (IS_FP8(l) ? 1 : 2); }
            f32x4 v[4]; float s = 0.f;
#pragma unroll
            for (int j = 0; j < 4; ++j) { const int c = 4 * lane + 256 * j; f32x4 a = {0.f, 0.f, 0.f, 0.f};
#pragma unroll
                for (int k = 0; k < 4; ++k) {
                    if (IS_FP8(l)) { const int y8 = *(const GAS int*)(yr[k] + c); const f32x2 lo = __builtin_amdgcn_cvt_pk_f32_fp8(y8, false), hi = __builtin_amdgcn_cvt_pk_f32_fp8(y8, true);
                        a.x += gk[k] * lo.x; a.y += gk[k] * lo.y; a.z += gk[k] * hi.x; a.w += gk[k] * hi.y; }
                    else { const f16x4 y4 = *(const GAS f16x4*)(yr[k] + 2 * c); a.x += gk[k] * (float)y4[0]; a.y += gk[k] * (float)y4[1]; a.z += gk[k] * (float)y4[2]; a.w += gk[k] * (float)y4[3]; } }
                const f16x4 xh = *(const GAS f16x4*)(X + (size_t)m * DM + c); const f32x4 x1 = {(float)xh[0], (float)xh[1], (float)xh[2], (float)xh[3]}, g2 = *(const GAS f32x4*)(md + 5120 + c);
                v[j] = x1 + g2 * a; s += (v[j].x * v[j].x + v[j].y * v[j].y) + (v[j].z * v[j].z + v[j].w * v[j].w); }
            const float rstd = rsqrtf(wave_sum(s) * (1.f / DM) + EPS);
            if (l + 1 < DEPTH) {
                const GAS float* mdn = MOD + (size_t)((l + 1) * 8 + b) * 6144; const GAS float* g1 = GIN(I_N1G) + (l + 1) * DM;
#pragma unroll
                for (int j = 0; j < 4; ++j) { const int c = 4 * lane + 256 * j; { u32x2 wx; wx.x = pk_f16(v[j].x, v[j].y); wx.y = pk_f16(v[j].z, v[j].w); *(GAS u32x2*)(X + (size_t)m * DM + c) = wx; }
                    const f32x4 gg = *(const GAS f32x4*)(g1 + c), sh = *(const GAS f32x4*)(mdn + c), sc = *(const GAS f32x4*)(mdn + 1024 + c);
                    const f32x4 hq = (v[j] * rstd) * gg * (sc + 1.0f) + sh; u32x2 w; w.x = pk_f16(hq.x, hq.y); w.y = pk_f16(hq.z, hq.w); *(GAS u32x2*)(H + (size_t)m * DM + c) = w;
                    if (PROJ_FP8 && l + 1 >= PROJ_FP8_FIRST) *(GAS unsigned*)(HB8 + (size_t)m * DM + c) = pk4_fp8(hq.x, hq.y, hq.z, hq.w); }
            } else {
#pragma unroll
                for (int j = 0; j < 4; ++j) { const int c = 4 * lane + 256 * j; const f32x4 gg = *(const GAS f32x4*)(GIN(I_FNG) + c); *(GAS f32x4*)(((GAS float*)AP->out) + (size_t)m * DM + c) = (v[j] * rstd) * gg; }
            }
        }
}
        STAMP(3 + 9 * l + 8);
        if (l + 1 < DEPTH) xcd_barrier(bar);
}

__global__ void __launch_bounds__(NWAVES * 64, 2) fwd_megakernel(Args args) {
    const int tid0 = threadIdx.x, wave0 = __builtin_amdgcn_readfirstlane(tid0 >> 6);
    const int G = gridDim.x, bid = blockIdx.x;
    const int NGW = G * NWAVES;
    LAS unsigned char* L = (LAS unsigned char*)lds;

    if (tid0 < 16) ((LAS unsigned*)(L + BARST_OFF))[tid0] = 0u;
    __syncthreads();
    STAMP(0);
    XcdBarrier bar = xcd_barrier_post((unsigned*)(args.ws + WS_CTL) + CW_BAR, (volatile LAS unsigned*)(L + BARST_OFF));

for (int rep_ = 0; rep_ < REPS(1); ++rep_) if (PHMASK & 1) { LAUNDER(); __syncthreads();
    {
        LAS float* cond = (LAS float*)Lp;
        LAS float* red = (LAS float*)(Lp + 32768);
        bool cond_ready = false;
        for (int it = bid; it < 192; it += G) {
            if (!cond_ready) { for (int i = tid; i < NB * DM; i += 512) { const float v = GIN(I_C)[i]; cond[i] = v * sigmoidf_(v); } __syncthreads(); cond_ready = true; }
            const int l = it / 96, n0 = (it % 96) * 64;
            const GAS float* wm = GIN(I_WMOD) + (size_t)l * DM * 6144 + n0 + lane;
            float a[8];
#pragma unroll
            for (int b = 0; b < 8; ++b) a[b] = 0.f;
            for (int k = wave * 128; k < wave * 128 + 128; ++k) { const float w = wm[(size_t)k * 6144];
#pragma unroll
                for (int b = 0; b < 8; ++b) a[b] += cond[b * DM + k] * w; }
#pragma unroll
            for (int b = 0; b < 8; ++b) red[(wave * 8 + b) * 64 + lane] = a[b];
            __syncthreads();
            { const int b = tid >> 6; float s = GIN(I_BMOD)[l * 6144 + n0 + lane];
#pragma unroll
              for (int w = 0; w < 8; ++w) s += red[(w * 8 + b) * 64 + lane];
              MOD[(size_t)(l * 8 + b) * 6144 + n0 + lane] = s; }
            __syncthreads();
        }
        __syncthreads();
        LAS float* scr = (LAS float*)(Lp + wave * 16640);
        for (int it = gw; it < DEPTH * 1536; it += NGW) {
            const int l = it / 1536; int r = it % 1536;
            if (r < 1024) { const int kb = r >> 6, nb = r & 63; transpose_item(GIN(I_WIN) + (size_t)l * DM * INW, DM, INW, WIN_T + (size_t)l * INW * DM, 32 * nb, 64 * kb, 32 * nb, nullptr, scr, lane);
                if (PROJ_FP8 && l >= PROJ_FP8_FIRST) transpose_item8(GIN(I_WIN) + (size_t)l * DM * INW, DM, INW, WIN8 + (size_t)l * INW * DM, 32 * nb, 64 * kb, 32 * nb, scr, lane); continue; } r -= 1024;
            { const int kb = r >> 5, nb = r & 31; transpose_item(GIN(I_WOUT) + (size_t)l * DM * DM, DM, DM, WOUT_T + (size_t)l * DM * DM, 32 * nb, 64 * kb, 32 * nb, GIN(I_MIXG) + l * DM, scr, lane, kb < 4 ? 64 * kb + 256 : (kb < 8 ? 64 * kb - 256 : 64 * kb)); }
        }
        static_assert(FP8_FIRST == 0, "the 64x64 expert-weight items below write fp8");
        constexpr int PER_L = 32 * 512 + 32 * 256;
        for (int it = gw; it < DEPTH * PER_L; it += NGW) {
            const int l = it / PER_L; int r = it % PER_L;
            if (r < 32 * 512) { const int e = r >> 9, q = r & 511, kb = q >> 5, nb = q & 31, n0 = 64 * nb;
                const int bj = n0 >> 10, jj = n0 & 1023, orow = (jj >> 7) * 256 + bj * 128 + (jj & 127);
                transpose_item8x64(GIN(I_W1) + ((size_t)l * NEXP + e) * DM * 2048, DM, 2048, (GAS unsigned char*)(W1_T + (size_t)l * NEXP * 2048 * DM) + (size_t)e * 2048 * DM, orow, 64 * kb, n0, scr, lane); continue; } r -= 32 * 512;
            { const int e = r >> 8, q = r & 255, kb = q >> 4, nb = q & 15;
                transpose_item8x64(GIN(I_W2) + ((size_t)l * NEXP + e) * DM * DM, DM, DM, (GAS unsigned char*)(W2_T + (size_t)l * NEXP * DM * DM) + (size_t)e * DM * DM, 64 * nb, 64 * kb, 64 * nb, scr, lane); }
        }
        for (int i = bid * 512 + tid; i < NB * 16 * 256; i += G * 512) KMEAN[i] = 0.f;
        for (int i = bid * 512 + tid; i < DEPTH * 4 * 128 * 128; i += G * 512) { const int jj = i & 127, ii = (i >> 7) & 127; SGUW[i] = (f16)(jj <= ii ? GIN(I_SGUW)[i] : 0.f); }
        for (int i = bid * 512 + tid; i < DEPTH * 4 * 64 * 64; i += G * 512) { const int c = i & 63, d = (i >> 6) & 63, g = (i >> 12) & 3, ll = i >> 14; PWT[i] = (f16)GIN(I_POOLW)[(((size_t)ll * 4 + g) * 64 + c) * 64 + d]; }
        for (int i = bid * 512 + tid; i < DEPTH * 32 * 1024; i += G * 512) { const int k = i & 1023, e = (i >> 10) & 31, ll = i >> 15; RWT16[(size_t)(ll * 32 + e) * 1032 + k] = (f16)GIN(I_RW)[((size_t)ll * DM + k) * NEXP + e]; }
    }
}
    xcd_barrier(bar);
    STAMP(1);

for (int rep_ = 0; rep_ < REPS(2); ++rep_) if (PHMASK & 2) { LAUNDER();
    for (int m = gw; m < NTOK; m += NGW) { const int b = m >> 12; const GAS float* md = MOD + (size_t)b * 6144;
        norm_mod_row(GIN(I_X) + (size_t)m * DM, GIN(I_N1G), md, md + 1024, H + (size_t)m * DM, HB8 + (size_t)m * DM, lane); }
}
    xcd_barrier(bar);
    STAMP(2);

    layer_body(0, bar, tid0, wave0, G, bid, NGW);
    layer_body(1, bar, tid0, wave0, G, bid, NGW);
    if (TSEL_B > 0 && bid == 0 && tid0 == 0) { const LAS unsigned long long* st = (const LAS unsigned long long*)((LAS unsigned char*)lds + STAMP_OFF);
        asm volatile("s_waitcnt vmcnt(0)" ::: "memory");
        args.out[0] += (float)(st[TSEL_B] - st[TSEL_A]) * 0.01f / TSCALE; }
}


extern "C" void kernel_launch(void* const* d_in, const int* in_sizes, int n_in, void* d_out, int out_size, void* d_ws, size_t ws_size, hipStream_t stream) {
    static int grid = 0;
    if (grid == 0) {
        if (n_in != 27 || out_size != NTOK * DM || ws_size < WS_END) { fprintf(stderr, "kernel_launch: unexpected shapes (n_in %d, out %d, ws %zu)\n", n_in, out_size, ws_size); grid = -1; return; }
        int dev = 0, cus = 0, per_cu = 0;
        if (hipGetDevice(&dev) != hipSuccess || hipDeviceGetAttribute(&cus, hipDeviceAttributeMultiprocessorCount, dev) != hipSuccess) { grid = -1; return; }
        if (hipFuncSetAttribute((const void*)fwd_megakernel, hipFuncAttributeMaxDynamicSharedMemorySize, LDS_BYTES) != hipSuccess) { fprintf(stderr, "kernel_launch: hipFuncSetAttribute failed\n"); grid = -1; return; }
        if (hipOccupancyMaxActiveBlocksPerMultiprocessor(&per_cu, (const void*)fwd_megakernel, NWAVES * 64, LDS_BYTES) != hipSuccess || per_cu < 1) { fprintf(stderr, "kernel_launch: occupancy query says %d blocks per CU\n", per_cu); (void)hipGetLastError(); grid = -1; return; }
        grid = cus;
    }
    if (grid < 0) return;
    (void)hipMemsetAsync((char*)d_ws + WS_CTL, 0, CTL_ZERO_BYTES, stream);
    Args a{};
    for (int i = 0; i < 27; ++i) a.in[i] = (const float*)d_in[i];
    a.out = (float*)d_out; a.ws = (unsigned char*)d_ws;
    hipLaunchKernelGGL(fwd_megakernel, dim3(grid), dim3(NWAVES * 64), LDS_BYTES, stream, a);
}
```

```cpp
#include <hip/hip_runtime.h>
#include <cstdio>
#include <cstdint>

#define LAS __attribute__((address_space(3)))
#define GAS __attribute__((address_space(1)))
#define CAS __attribute__((address_space(4)))
typedef _Float16 f16;
typedef _Float16 f16x8 __attribute__((ext_vector_type(8)));
typedef _Float16 f16x4 __attribute__((ext_vector_type(4)));
typedef _Float16 f16x2 __attribute__((ext_vector_type(2)));
typedef float f32x2 __attribute__((ext_vector_type(2)));
typedef float f32x4 __attribute__((ext_vector_type(4)));
typedef float f32x16 __attribute__((ext_vector_type(16)));
typedef unsigned u32x2 __attribute__((ext_vector_type(2)));
typedef unsigned u32x4 __attribute__((ext_vector_type(4)));
typedef short v4i16_t __attribute__((ext_vector_type(4)));
typedef int i32x4 __attribute__((ext_vector_type(4)));
typedef int i32x8 __attribute__((ext_vector_type(8)));

constexpr int DM = 1024, NB = 8, SEQ = 4096, NTOK = NB * SEQ, DEPTH = 2, GW = 256, INW = 2048;
constexpr int NEXP = 32, TOPK = 4;
constexpr int PROWS = NTOK * TOPK + NEXP * 256;
constexpr float EPS = 1e-6f;
constexpr int LISTCAP = NTOK;
constexpr int FP8_FIRST = 0;
#define IS_FP8(l_) ((l_) >= FP8_FIRST)
constexpr int FP8_LAYER_UNUSED = 1;
constexpr float W8_SCALE = 32.0f, W8_INV = 1.0f / 32.0f;
#define PROJ_FP8_FIRST 0
#ifndef PROJ_FP8
#define PROJ_QK_FP8 1
#define NEED_H16(l) (!(PROJ_FP8 && PROJ_QK_FP8 && (l) >= PROJ_FP8_FIRST))
#define PROJ_FP8 1
#endif

__device__ __forceinline__ unsigned pk_f16(float lo, float hi) { f32x2 v = {lo, hi}; f16x2 h = __builtin_convertvector(v, f16x2); return __builtin_bit_cast(unsigned, h); }
__device__ __forceinline__ float row16_sum(float v) {
    v += __builtin_bit_cast(float, __builtin_amdgcn_update_dpp(0, __builtin_bit_cast(int, v), 0xB1, 0xf, 0xf, true));
    v += __builtin_bit_cast(float, __builtin_amdgcn_update_dpp(0, __builtin_bit_cast(int, v), 0x4E, 0xf, 0xf, true));
    v += __builtin_bit_cast(float, __builtin_amdgcn_update_dpp(0, __builtin_bit_cast(int, v), 0x141, 0xf, 0xf, true));
    v += __builtin_bit_cast(float, __builtin_amdgcn_update_dpp(0, __builtin_bit_cast(int, v), 0x140, 0xf, 0xf, true));
    return v;
}
__device__ __forceinline__ unsigned pk4_fp8(float a, float b, float c, float d) { int p = 0; p = __builtin_amdgcn_cvt_pk_fp8_f32(a, b, p, false); p = __builtin_amdgcn_cvt_pk_fp8_f32(c, d, p, true); return (unsigned)p; }
__device__ __forceinline__ float max3f(float a, float b, float c) { float r; asm("v_max3_f32 %0, %1, %2, %3" : "=v"(r) : "v"(a), "v"(b), "v"(c)); return r; }
__device__ __forceinline__ float max2f(float a, float b) { float r; asm("v_max_f32_e32 %0, %1, %2" : "=v"(r) : "v"(a), "v"(b)); return r; }
__device__ __forceinline__ float fadd_s(float a, float b) { float r; asm("v_add_f32_e32 %0, %1, %2" : "=v"(r) : "v"(a), "v"(b)); return r; }
template <int N> __device__ __forceinline__ void wave_sum_n(float (&v)[N]) {
#pragma unroll
    for (int i = 0; i < N; ++i) v[i] += __builtin_bit_cast(float, __builtin_amdgcn_update_dpp(0, __builtin_bit_cast(int, v[i]), 0xB1, 0xf, 0xf, true));
#pragma unroll
    for (int i = 0; i < N; ++i) v[i] += __builtin_bit_cast(float, __builtin_amdgcn_update_dpp(0, __builtin_bit_cast(int, v[i]), 0x4E, 0xf, 0xf, true));
#pragma unroll
    for (int i = 0; i < N; ++i) v[i] += __builtin_bit_cast(float, __builtin_amdgcn_update_dpp(0, __builtin_bit_cast(int, v[i]), 0x141, 0xf, 0xf, true));
#pragma unroll
    for (int i = 0; i < N; ++i) v[i] += __builtin_bit_cast(float, __builtin_amdgcn_update_dpp(0, __builtin_bit_cast(int, v[i]), 0x140, 0xf, 0xf, true));
#pragma unroll
    for (int i = 0; i < N; ++i) v[i] += __shfl_xor(v[i], 16);
#pragma unroll
    for (int i = 0; i < N; ++i) v[i] += __shfl_xor(v[i], 32);
}
__device__ __forceinline__ float wave_sum(float v) {
    v = row16_sum(v);
    v += __shfl_xor(v, 16); v += __shfl_xor(v, 32);
    return v;
}
__device__ __forceinline__ float sigmoidf_(float x) { return __builtin_amdgcn_rcpf(1.f + __expf(-x)); }
__device__ __forceinline__ float gelu_erf(float v) {
    const float av = fabsf(v), d = av * 0.2316418882f + 1.0f, t = __builtin_amdgcn_rcpf(d);
    float q = t * 0.5307027145f + (-0.7265760135f); q = q * t + 0.7107068705f; q = q * t + (-0.142248368f); q = q * t + 0.127414796f; q = q * t;
    const float e = __builtin_amdgcn_exp2f((v * v) * (-0.72134752044f));
    const float m = v * (q * e);
    return v < 0.f ? m : v - m;
}

#ifndef PROBE
#define PROBE 0
#endif
#ifndef TSEL_A
#define TSEL_A 0
#endif
#ifndef TSEL_B
#define TSEL_B 0
#endif
#ifndef TSCALE
#define TSCALE 16.0f
#endif
#define STAMP_OFF 146944
#define STAMP(k) do { if (TSEL_B > 0 && bid == 0 && tid0 == 0) ((__attribute__((address_space(3))) unsigned long long*)((__attribute__((address_space(3))) unsigned char*)lds + STAMP_OFF))[k] = __builtin_amdgcn_s_memrealtime(); } while (0)
namespace pg8 {
#define PG8_LAS __attribute__((address_space(3)))
typedef unsigned short h16_t;
constexpr int BM = 256, BK = 64, HALF = 128, HTB = HALF * BK * 2, STAGE_BYTES = 8 * HTB, NXCD = 8, WGM = 8;

__host__ __device__ __forceinline__ int lds_byte(int r, int c) { const int st = (r >> 4) * 2 + (c >> 5), rr = r & 15, cc = c & 31, ob = rr * 64 + cc * 2; return st * 1024 + (ob ^ (((ob >> 9) & 1) << 5)); }
__host__ __device__ __forceinline__ void stage_rc(int b, int& R, int& C) { const int st = b / 1024, sb = b % 1024, swz = sb ^ (((sb >> 9) & 1) << 5); R = (st >> 1) * 16 + swz / 64; C = (st & 1) * 32 + (swz % 64) / 2; }
__host__ __device__ __forceinline__ int perm32(int rho) { const int n = rho >> 4, i = rho & 15; return 8 * (i >> 2) + 4 * n + (i & 3); }

struct Unit { int pm, pn; };
struct Gemm { const GAS h16_t* A; const GAS h16_t* Bt; int M, N, K; const GAS int* rl; const GAS float* ssq; };

struct StaticOrder {
    int nM, nN, nwg, G, c;
    __host__ __device__ void init(int M, int N, int G_, int c_) { nM = M / BM; nN = N / BM; nwg = nM * nN; G = G_; c = c_; }
    __host__ __device__ bool next(int i, Unit& u) const {
        const long L = (long)i * G + c; if (L >= nwg) return false;
        int wgid = (int)L; { const int q = nwg / NXCD, r = nwg % NXCD, xcd = wgid % NXCD, off = wgid / NXCD; wgid = (xcd < r ? xcd * (q + 1) : r * (q + 1) + (xcd - r) * q) + off; }
        const int nig = WGM * nN, gid = wgid / nig, fm = gid * WGM, gsz = (nM - fm) < WGM ? (nM - fm) : WGM;
        u.pm = fm + ((wgid % nig) % gsz); u.pn = (wgid % nig) / gsz; return true;
    }
    __device__ __forceinline__ void a_ready(const Unit&) const {}
    __device__ __forceinline__ void done(const Unit&) const {}
    __device__ __forceinline__ void rows(int, int& r0, int& cnt) const { r0 = 0; cnt = 1; }
};
struct MapOrder : StaticOrder {
    unsigned map;
    __host__ __device__ bool next(int i, Unit& u) const { if (!StaticOrder::next(i, u)) return false; u.pn = (int)((map >> (4 * u.pn)) & 15u); return true; }
};
struct ListOrder {
    const PG8_LAS int* list; int n;
    __device__ __forceinline__ bool next(int i, Unit& u) const { if (i >= n) return false; const int v = __builtin_amdgcn_readfirstlane(list[3 * i]); u.pm = v & 0xffff; u.pn = v >> 16; return true; }
    __device__ __forceinline__ void rows(int i, int& r0, int& cnt) const { r0 = __builtin_amdgcn_readfirstlane(list[3 * i + 1]); cnt = __builtin_amdgcn_readfirstlane(list[3 * i + 2]); }
    __device__ __forceinline__ void a_ready(const Unit&) const {}
    __device__ __forceinline__ void done(const Unit&) const {}
};

struct Pre4 { f32x4 v[4]; };
struct EpiF16 {
    static constexpr bool PERM = true, PERM2 = true, AFTER_DRAIN = false, IS_DOWN = false, PRELOAD = false;
    GAS h16_t* O; int ldc; GAS float* ksum; float sc;
    __device__ __forceinline__ Pre4 pre(const Unit&, int, int, int, int) const { return Pre4{}; }
    __device__ __forceinline__ void operator()(const f32x4 (&acc)[2][2][4][2], const Unit& u, int wr, int wc, int fr, int fq, const Pre4&) const {
        const int row0 = u.pm * BM + wr * 64 + fr, col0 = u.pn * BM + wc * 64 + 16 * fq;
        if (u.pn == 3) {
#pragma unroll
            for (int bj = 0; bj < 2; ++bj)
#pragma unroll
                for (int n = 0; n < 2; ++n) { f32x4 s = (acc[0][bj][0][n] + acc[0][bj][1][n]) + (acc[0][bj][2][n] + acc[0][bj][3][n]); s += (acc[1][bj][0][n] + acc[1][bj][1][n]) + (acc[1][bj][2][n] + acc[1][bj][3][n]);
#pragma unroll
                    for (int i = 0; i < 4; ++i) { const float t = row16_sum(s[i]) * sc;
                        if (fr == 0) __hip_atomic_fetch_add(ksum + (size_t)u.pm * 256 + wc * 64 + 16 * fq + 8 * bj + 4 * n + i, t, __ATOMIC_RELAXED, __HIP_MEMORY_SCOPE_AGENT); } } }
#pragma unroll
        for (int ai = 0; ai < 2; ++ai)
#pragma unroll
            for (int m = 0; m < 4; ++m) { GAS h16_t* rowp = O + (size_t)(row0 + ai * HALF + m * 16) * ldc + col0;
#pragma unroll
                for (int bj = 0; bj < 2; ++bj) { const f32x4 v0 = acc[ai][bj][m][0] * sc, v1 = acc[ai][bj][m][1] * sc;
                    u32x4 w; w.x = pk_f16(v0[0], v0[1]); w.y = pk_f16(v0[2], v0[3]); w.z = pk_f16(v1[0], v1[1]); w.w = pk_f16(v1[2], v1[3]);
                    *(GAS u32x4*)(rowp + bj * 8) = w; } }
    }
};
template <bool BASE32> struct EpiResidT {
    static constexpr bool PERM = true, PERM2 = true, AFTER_DRAIN = false, IS_DOWN = false, PRELOAD = false;
    const GAS float* base32; const GAS h16_t* base16; GAS h16_t* out; const GAS float* gate;
    __device__ __forceinline__ Pre4 pre(const Unit& u, int wr, int wc, int fr, int fq) const { Pre4 p; const int col0 = u.pn * BM + wc * 64 + 16 * fq; const GAS float* gp = gate + (size_t)((u.pm * BM) >> 12) * 6144;
#pragma unroll
        for (int bj = 0; bj < 2; ++bj)
#pragma unroll
            for (int n = 0; n < 2; ++n) p.v[bj * 2 + n] = *(const GAS f32x4*)(gp + col0 + bj * 8 + 4 * n);
        return p; }
    __device__ __forceinline__ void operator()(const f32x4 (&acc)[2][2][4][2], const Unit& u, int wr, int wc, int fr, int fq, const Pre4& pr) const {
        const int row0 = u.pm * BM + wr * 64 + fr, col0 = u.pn * BM + wc * 64 + 16 * fq;
        f32x4 gv[2][2];
#pragma unroll
        for (int bj = 0; bj < 2; ++bj)
#pragma unroll
            for (int n = 0; n < 2; ++n) gv[bj][n] = pr.v[bj * 2 + n];
#pragma unroll
        for (int ai = 0; ai < 2; ++ai)
#pragma unroll
            for (int m = 0; m < 4; ++m) { const size_t off = (size_t)(row0 + ai * HALF + m * 16) * DM + col0;
#pragma unroll
                for (int bj = 0; bj < 2; ++bj) { f32x4 b0, b1;
                    if constexpr (BASE32) { b0 = *(const GAS f32x4*)(base32 + off + bj * 8); b1 = *(const GAS f32x4*)(base32 + off + bj * 8 + 4); }
                    else { const f16x8 hb = *(const GAS f16x8*)(base16 + off + bj * 8); b0 = (f32x4){(float)hb[0], (float)hb[1], (float)hb[2], (float)hb[3]}; b1 = (f32x4){(float)hb[4], (float)hb[5], (float)hb[6], (float)hb[7]}; }
                    const f32x4 v0 = b0 + gv[bj][0] * acc[ai][bj][m][0], v1 = b1 + gv[bj][1] * acc[ai][bj][m][1];
                    u32x4 w; w.x = pk_f16(v0[0], v0[1]); w.y = pk_f16(v0[2], v0[3]); w.z = pk_f16(v1[0], v1[1]); w.w = pk_f16(v1[2], v1[3]);
                    *(GAS u32x4*)(out + off + bj * 8) = w; } }
    }
};
template <bool OUT8> struct EpiSwigluT {
    static constexpr bool PERM = true, PERM2 = false, AFTER_DRAIN = false, IS_DOWN = false, PRELOAD = true;
    GAS unsigned char* O; const GAS float* b1; float sc;
    __device__ __forceinline__ Pre4 pre(const Unit& u, int wr, int wc, int fr, int fq) const { Pre4 q; const int e = u.pn >> 3, p = u.pn & 7, hc = p * 128 + wc * 32 + 8 * fq; const GAS float* bp = b1 + (size_t)e * 2048 + hc;
#pragma unroll
        for (int n = 0; n < 2; ++n) { q.v[n] = *(const GAS f32x4*)(bp + 4 * n); q.v[2 + n] = *(const GAS f32x4*)(bp + 1024 + 4 * n); }
        return q; }
    __device__ __forceinline__ void operator()(const f32x4 (&acc)[2][2][4][2], const Unit& u, int wr, int wc, int fr, int fq, const Pre4& pr) const {
        const int p = u.pn & 7;
        const int row0 = u.pm * BM + wr * 64 + fr, hc = p * 128 + wc * 32 + 8 * fq;
        f32x4 bg[2], bl[2];
#pragma unroll
        for (int n = 0; n < 2; ++n) { bg[n] = pr.v[n]; bl[n] = pr.v[2 + n]; }
        u32x2 wprev = {0u, 0u};
#pragma unroll
        for (int ai = 0; ai < 2; ++ai)
#pragma unroll
            for (int m = 0; m < 4; ++m) { float r[8];
#pragma unroll
                for (int n = 0; n < 2; ++n) { const f32x4 g = acc[ai][0][m][n] * sc + bg[n], li = acc[ai][1][m][n] * sc + bl[n];
#pragma unroll
                    for (int i = 0; i < 4; ++i) { const float xg = fminf(g[i], 7.0f), xl = fminf(fmaxf(li[i], -7.0f), 7.0f);
                        r[4 * n + i] = xg * __builtin_amdgcn_rcpf(1.f + __expf(-1.702f * xg)) * (xl + 1.0f); } }
                if constexpr (OUT8) { u32x2 w; w.x = pk4_fp8(r[0], r[1], r[2], r[3]); w.y = pk4_fp8(r[4], r[5], r[6], r[7]);
                    if (m & 1) { const auto sx = __builtin_amdgcn_permlane16_swap(wprev.x, w.x, false, false), sy = __builtin_amdgcn_permlane16_swap(wprev.y, w.y, false, false);
                        u32x4 o; o.x = sx[0]; o.y = sy[0]; o.z = sx[1]; o.w = sy[1];
                        *(GAS u32x4*)(O + (size_t)(row0 + ai * HALF + (m - 1 + (fq & 1)) * 16) * DM + (hc - 8 * fq + 16 * (fq >> 1))) = o; }
                    else wprev = w; }
                else { u32x4 w; w.x = pk_f16(r[0], r[1]); w.y = pk_f16(r[2], r[3]); w.z = pk_f16(r[4], r[5]); w.w = pk_f16(r[6], r[7]);
                    *(GAS u32x4*)(O + ((size_t)(row0 + ai * HALF + m * 16) * DM + hc) * 2) = w; } }
    }
};
template <bool OUT8> struct EpiDownT {
    static constexpr bool PERM = true, PERM2 = true, AFTER_DRAIN = false, IS_DOWN = true, PRELOAD = true;
    GAS unsigned char* O; const GAS float* b2; float sc;
    __device__ __forceinline__ Pre4 pre(const Unit& u, int wr, int wc, int fr, int fq) const { Pre4 q; const int e = u.pn >> 2, p = u.pn & 3, col0 = p * BM + wc * 64 + 16 * fq; const GAS float* bp = b2 + (size_t)e * 1024 + col0;
#pragma unroll
        for (int bj = 0; bj < 2; ++bj)
#pragma unroll
            for (int n = 0; n < 2; ++n) q.v[bj * 2 + n] = *(const GAS f32x4*)(bp + bj * 8 + 4 * n);
        return q; }
    __device__ __forceinline__ void operator()(const f32x4 (&acc)[2][2][4][2], const Unit& u, int wr, int wc, int fr, int fq, const Pre4& pr) const {
        const int p = u.pn & 3;
        const int row0 = u.pm * BM + wr * 64 + fr, col0 = p * BM + wc * 64 + 16 * fq;
        f32x4 bv[2][2];
#pragma unroll
        for (int bj = 0; bj < 2; ++bj)
#pragma unroll
            for (int n = 0; n < 2; ++n) bv[bj][n] = pr.v[bj * 2 + n];
#pragma unroll
        for (int ai = 0; ai < 2; ++ai)
#pragma unroll
            for (int m = 0; m < 4; ++m) { const size_t ro = (size_t)(row0 + ai * HALF + m * 16) * DM + col0;
                if constexpr (OUT8) { u32x4 w;
#pragma unroll
                    for (int bj = 0; bj < 2; ++bj) { const f32x4 v0 = acc[ai][bj][m][0] * sc + bv[bj][0], v1 = acc[ai][bj][m][1] * sc + bv[bj][1];
                        w[2 * bj] = pk4_fp8(v0[0], v0[1], v0[2], v0[3]); w[2 * bj + 1] = pk4_fp8(v1[0], v1[1], v1[2], v1[3]); }
                    *(GAS u32x4*)(O + ro) = w; }
                else {
#pragma unroll
                    for (int bj = 0; bj < 2; ++bj) { const f32x4 v0 = acc[ai][bj][m][0] * sc + bv[bj][0], v1 = acc[ai][bj][m][1] * sc + bv[bj][1];
                        u32x4 w; w.x = pk_f16(v0[0], v0[1]); w.y = pk_f16(v0[2], v0[3]); w.z = pk_f16(v1[0], v1[1]); w.w = pk_f16(v1[2], v1[3]);
                        *(GAS u32x4*)(O + (ro + bj * 8) * 2) = w; } } }
    }
};

template <class Epi, class Sched, bool GATHER = false, bool FP8 = false, bool ROWSCALE = false>
__device__ __forceinline__ void gemm_phase(PG8_LAS unsigned char* lds, const Gemm g, const Sched& S, const Epi& E, const int tid) {
    const int wid = __builtin_amdgcn_readfirstlane(tid >> 6), lane = tid & 63, wr = wid >> 2, wc = wid & 3, fr = lane & 15, fq = lane >> 4;
    const int K = g.K, nt = K / BK;
    const size_t kstep = (size_t)(BK * 2);
    const size_t hstep = (size_t)HALF * K * 2;
    const size_t tstep = 2 * hstep;
    const size_t bstep = Epi::PERM2 ? (size_t)8 * K * 2 : hstep;
    unsigned voffB[2], oc0[2], oc1[2], on0[2], on1[2];
#pragma unroll
    for (int i = 0; i < 2; ++i) { int R, C; stage_rc(tid * 16 + i * 8192, R, C); const int Rb = Epi::PERM2 ? (64 * (R >> 5) + 16 * ((R & 15) >> 2) + 4 * ((R >> 4) & 1) + (R & 3)) : (Epi::PERM ? ((R & ~31) + perm32(R & 31)) : R);
        voffB[i] = (unsigned)(Rb * K + C) * 2u;
        oc0[i] = (unsigned)(R * K + C) * 2u; oc1[i] = oc0[i] + (unsigned)hstep; on0[i] = oc0[i]; on1[i] = oc1[i]; }
    const unsigned ldsw = (unsigned)wid * 1024u;
    const int aoff = lds_byte(wr * 64 + fr, fq * 8), boff = lds_byte(wc * 32 + fr, fq * 8);
#define PG8_SA(b, h) (((b) * 2 + (h)) * HTB)
#define PG8_SB(b, h) ((4 + (b) * 2 + (h)) * HTB)
#define PG8_STAGE(bufoff, gbase, voff) do { _Pragma("unroll") for (int _i = 0; _i < 2; ++_i) { unsigned vo_ = (voff)[_i]; asm volatile("" : "+v"(vo_)); \
        __builtin_amdgcn_global_load_lds((const GAS unsigned*)((const GAS char*)(gbase) + vo_), (PG8_LAS unsigned*)(lds + (bufoff) + ldsw + _i * 8192), 16, 0, 0); } } while (0)
#define PG8_LDA(dst, b, h) do { if constexpr (FP8) { _Pragma("unroll") for (int m = 0; m < 4; ++m) { \
            const i32x4 lo_ = *(const PG8_LAS i32x4*)(lds + PG8_SA(b, h) + aoff + m * 2048), hi_ = *(const PG8_LAS i32x4*)(lds + PG8_SA(b, h) + aoff + m * 2048 + 1024); \
            dst##8[m] = (i32x8){lo_[0], lo_[1], lo_[2], lo_[3], hi_[0], hi_[1], hi_[2], hi_[3]}; } } \
        else { _Pragma("unroll") for (int m = 0; m < 4; ++m) _Pragma("unroll") for (int k = 0; k < 2; ++k) dst[m][k] = *(const PG8_LAS f16x8*)(lds + PG8_SA(b, h) + aoff + m * 2048 + k * 1024); } } while (0)
#define PG8_LDB(dst, b, h) do { if constexpr (FP8) { _Pragma("unroll") for (int n = 0; n < 2; ++n) { \
            const i32x4 lo_ = *(const PG8_LAS i32x4*)(lds + PG8_SB(b, h) + boff + n * 2048), hi_ = *(const PG8_LAS i32x4*)(lds + PG8_SB(b, h) + boff + n * 2048 + 1024); \
            dst##8[n] = (i32x8){lo_[0], lo_[1], lo_[2], lo_[3], hi_[0], hi_[1], hi_[2], hi_[3]}; } } \
        else { _Pragma("unroll") for (int n = 0; n < 2; ++n) _Pragma("unroll") for (int k = 0; k < 2; ++k) dst[n][k] = *(const PG8_LAS f16x8*)(lds + PG8_SB(b, h) + boff + n * 2048 + k * 1024); } } while (0)
#define PG8_MMA(ai, bj, At, Bt) do { __builtin_amdgcn_s_setprio(1); \
        if constexpr (FP8) { _Pragma("unroll") for (int m = 0; m < 4; ++m) _Pragma("unroll") for (int n = 0; n < 2; ++n) \
            acc[ai][bj][m][n] = __builtin_amdgcn_mfma_scale_f32_16x16x128_f8f6f4(Bt##8[n], At##8[m], acc[ai][bj][m][n], 0, 0, 0, 0x7f7f7f7f, 0, 0x7f7f7f7f); } \
        else { _Pragma("unroll") for (int m = 0; m < 4; ++m) _Pragma("unroll") for (int n = 0; n < 2; ++n) _Pragma("unroll") for (int k = 0; k < 2; ++k) \
            acc[ai][bj][m][n] = __builtin_amdgcn_mfma_f32_16x16x32_f16(Bt[n][k], At[m][k], acc[ai][bj][m][n], 0, 0, 0); } \
        __builtin_amdgcn_s_setprio(0); } while (0)
#define PG8_WAIT_V(n) asm volatile("s_waitcnt vmcnt(" #n ")" ::: "memory")
#define PG8_WAIT_L(n) asm volatile("s_waitcnt lgkmcnt(" #n ")" ::: "memory")
#define PG8_BAR __builtin_amdgcn_s_barrier()
#define PG8_SCHED __builtin_amdgcn_sched_barrier(0)
#define PG8_GOFF(ix, un, o0, o1) do { int r0_, cnt_; S.rows(ix, r0_, cnt_); const GAS int* lp_ = g.rl + (size_t)((un).pn >> 3) * LISTCAP; \
        _Pragma("unroll") for (int _i = 0; _i < 2; ++_i) { int R_, C_; stage_rc(tid * 16 + _i * 8192, R_, C_); int ra_ = r0_ + R_, rb_ = ra_ + HALF; ra_ = ra_ < cnt_ ? ra_ : cnt_ - 1; rb_ = rb_ < cnt_ ? rb_ : cnt_ - 1; \
            (o0)[_i] = (unsigned)lp_[ra_] * (unsigned)(K * 2) + (unsigned)C_ * 2u; (o1)[_i] = (unsigned)lp_[rb_] * (unsigned)(K * 2) + (unsigned)C_ * 2u; } } while (0)
    Unit cur, nxt; int ui = 0;
    if (!S.next(0, cur)) return;
    f32x4 acc[2][2][4][2];
#pragma unroll
    for (int a = 0; a < 2; ++a)
#pragma unroll
        for (int b = 0; b < 2; ++b)
#pragma unroll
            for (int m = 0; m < 4; ++m)
#pragma unroll
                for (int n = 0; n < 2; ++n) acc[a][b][m][n] = (f32x4){0.f, 0.f, 0.f, 0.f};
    f16x8 At[4][2], B0[2][2], B1[2][2]; i32x8 At8[4], B08[2], B18[2]; (void)At; (void)B0; (void)B1; (void)At8; (void)B08; (void)B18;
    const GAS char* cA = (const GAS char*)g.A + (GATHER ? (size_t)0 : (size_t)cur.pm * tstep); const GAS char* cB = (const GAS char*)g.Bt + (size_t)cur.pn * tstep;
    if constexpr (GATHER) PG8_GOFF(0, cur, oc0, oc1);
    S.a_ready(cur);
    PG8_STAGE(PG8_SB(0, 0), cB, voffB); PG8_STAGE(PG8_SB(0, 1), cB + bstep, voffB); PG8_STAGE(PG8_SA(0, 0), cA, oc0); PG8_STAGE(PG8_SA(0, 1), cA, oc1);
    if (wr == 1) PG8_BAR;
    PG8_WAIT_V(2); PG8_BAR;
    PG8_STAGE(PG8_SB(1, 0), cB + kstep, voffB); PG8_STAGE(PG8_SA(1, 0), cA + kstep, oc0); PG8_STAGE(PG8_SB(1, 1), cB + bstep + kstep, voffB);
    PG8_WAIT_V(6); PG8_BAR;
    for (;;) {
        const bool has_next = S.next(ui + 1, nxt);
        const GAS char* nA = (has_next && !GATHER) ? (const GAS char*)g.A + (size_t)nxt.pm * tstep : cA; const GAS char* nB = has_next ? (const GAS char*)g.Bt + (size_t)nxt.pn * tstep : cB;
        if constexpr (GATHER) { if (has_next) PG8_GOFF(ui + 1, nxt, on0, on1); }
        Pre4 epre; if constexpr (Epi::PRELOAD) epre = E.pre(cur, wr, wc, fr, fq);
#pragma unroll 1
        for (int t = 0; t < nt; ++t) {
            const int b = t & 1;
            const bool w1 = (t + 1 >= nt), w2 = (t + 2 >= nt);
            const GAS char* a1 = (w1 ? nA : cA) + (size_t)(w1 ? t + 1 - nt : t + 1) * kstep;
            const GAS char* a2 = (w2 ? nA : cA) + (size_t)(w2 ? t + 2 - nt : t + 2) * kstep;
            const GAS char* b2 = (w2 ? nB : cB) + (size_t)(w2 ? t + 2 - nt : t + 2) * kstep;
            unsigned x0[2], y1[2];
#pragma unroll
            for (int i = 0; i < 2; ++i) { y1[i] = (GATHER && w1 && has_next) ? on1[i] : oc1[i]; x0[i] = (GATHER && w2 && has_next) ? on0[i] : oc0[i]; }
            if (t == nt - 2 && has_next) S.a_ready(nxt);
            if constexpr (ROWSCALE) { if (t == 4) {
#pragma unroll
                for (int ai = 0; ai < 2; ++ai) { f32x4 q4[4];
#pragma unroll
                    for (int m = 0; m < 4; ++m) q4[m] = *(const GAS f32x4*)(g.ssq + (size_t)(cur.pm * BM + ai * HALF + wr * 64 + m * 16 + fr) * 4);
#pragma unroll
                    for (int m = 0; m < 4; ++m) { const float rs = rsqrtf(((q4[m].x + q4[m].y) + (q4[m].z + q4[m].w)) * (1.f / 256.f) + EPS);
#pragma unroll
                        for (int bj = 0; bj < 2; ++bj)
#pragma unroll
                            for (int n = 0; n < 2; ++n) acc[ai][bj][m][n] *= rs; } } } }
            PG8_LDB(B0, b, 0); PG8_LDB(B1, b, 1); PG8_SCHED; PG8_LDA(At, b, 0); PG8_STAGE(PG8_SA(b ^ 1, 1), a1, y1);
            PG8_WAIT_V(8); PG8_WAIT_L(0); PG8_BAR; PG8_MMA(0, 0, At, B0); PG8_MMA(0, 1, At, B1); PG8_BAR; PG8_SCHED;
            PG8_LDA(At, b, 1); PG8_STAGE(PG8_SB(b, 0), b2, voffB); PG8_STAGE(PG8_SB(b, 1), b2 + bstep, voffB); PG8_STAGE(PG8_SA(b, 0), a2, x0);
            PG8_WAIT_V(8); PG8_WAIT_L(0); PG8_BAR; PG8_MMA(1, 0, At, B0); PG8_MMA(1, 1, At, B1); PG8_BAR; PG8_SCHED;
        }
        if (wr == 0) PG8_BAR;
        if constexpr (!Epi::PRELOAD) epre = E.pre(cur, wr, wc, fr, fq);
        E(acc, cur, wr, wc, fr, fq, epre); S.done(cur);
        if (!has_next) break;
#pragma unroll
        for (int a = 0; a < 2; ++a)
#pragma unroll
            for (int b = 0; b < 2; ++b)
#pragma unroll
                for (int m = 0; m < 4; ++m)
#pragma unroll
                    for (int n = 0; n < 2; ++n) acc[a][b][m][n] = (f32x4){0.f, 0.f, 0.f, 0.f};
        cur = nxt; cA = nA; cB = nB; ++ui;
        if constexpr (GATHER) {
#pragma unroll
            for (int i = 0; i < 2; ++i) { oc0[i] = on0[i]; oc1[i] = on1[i]; } }
        if (wr == 1) PG8_BAR;
    }
    PG8_WAIT_V(0);
    PG8_BAR;
#undef PG8_SA
#undef PG8_SB
#undef PG8_STAGE
#undef PG8_LDA
#undef PG8_LDB
#undef PG8_MMA
#undef PG8_WAIT_V
#undef PG8_WAIT_L
#undef PG8_BAR
#undef PG8_SCHED
#undef PG8_GOFF
}
}

constexpr size_t MiB = 1u << 20;
constexpr size_t WS_CTL   = 0,            CTL_ZERO_BYTES = 1 * MiB;
constexpr size_t WS_MOD   = 1 * MiB;
constexpr size_t WS_KMEAN = 2 * MiB;
constexpr size_t WS_SSQ   = 2 * MiB + 512 * 1024;
constexpr size_t WS_SGUW  = 3 * MiB;
constexpr size_t WS_RWT   = 3 * MiB + 512 * 1024;
constexpr size_t WS_PWT   = 3 * MiB + 768 * 1024;
constexpr size_t WS_ROUTE = 4 * MiB;
constexpr size_t WS_LIST  = 6 * MiB;
constexpr size_t WS_WIN   = 10 * MiB;
constexpr size_t WS_WOUT  = 18 * MiB;
constexpr size_t WS_W1    = 22 * MiB;
constexpr size_t WS_W2    = 278 * MiB;
constexpr size_t WS_X     = 406 * MiB;
constexpr size_t WS_H     = 534 * MiB;
constexpr size_t WS_PROJ  = 598 * MiB;
constexpr size_t WS_MIX   = 726 * MiB;
constexpr size_t WS_XS    = 790 * MiB;
constexpr size_t WS_ACT   = 1062 * MiB;
constexpr size_t WS_WIN8  = 1334 * MiB;
constexpr size_t WS_HB8   = 1338 * MiB;
constexpr size_t WS_END   = 1370 * MiB;
constexpr int CW_BAR = 4096;
constexpr int CW_CNT = 16384;

constexpr int RING_BYTES = 131072;
constexpr int LDS_BYTES = 147456;
constexpr int BARST_OFF = LDS_BYTES - 64;
constexpr int NWAVES = 8;
#ifndef PH3
#define PH3 15
#endif
#define GIN(k) ((const GAS float*)AP->in[k])
#define REPS(bit) (((PROBE) & (bit)) ? 2 : 1)
#ifndef PHMASK
#define PHMASK 0xFFFF
#endif

#define XB_TMO      128
#define XB_XCNT(j)  (256  + 64 * (j))
#define XB_XSUB(j)  (1280 + 64 * (j))
#define XB_XGEN(j)  (2304 + 64 * (j))
#define XB_TOP      3328
#define XB_TOPGEN   3392
#define XCD_BAR_WORDS 3456
#define XB_SPIN_CAP (1u << 20)
__device__ __forceinline__ unsigned xb_ld(unsigned* p)              { return __hip_atomic_load(p, __ATOMIC_RELAXED, __HIP_MEMORY_SCOPE_AGENT); }
__device__ __forceinline__ unsigned xb_add(unsigned* p, unsigned v) { return __hip_atomic_fetch_add(p, v, __ATOMIC_RELAXED, __HIP_MEMORY_SCOPE_AGENT); }
__device__ __forceinline__ unsigned xb_xcc_id() { return (unsigned)__builtin_amdgcn_s_getreg((3 << 11) | 20) & 0xFu; }
#define XB_SPIN(cond, bar) do { unsigned _sp = 0; while (cond) { __builtin_amdgcn_s_sleep(1); \
    if ((++_sp & 255u) == 0u) { if (xb_ld(&(bar)[XB_TMO])) break; if (_sp > XB_SPIN_CAP) { atomicAdd(&(bar)[XB_TMO], 1u); break; } } } } while (0)
struct XcdBarrier { unsigned* bar; unsigned x; volatile LAS unsigned* st; };
__device__ __forceinline__ XcdBarrier xcd_barrier_post(unsigned* bar, volatile LAS unsigned* st) {
    XcdBarrier b; b.bar = bar; b.x = xb_xcc_id(); b.st = st;
    if (threadIdx.x == 0) (void)xb_add(&bar[XB_XCNT(b.x)], 1u);
    return b;
}
__device__ __forceinline__ void xcd_barrier_complete(unsigned* bar, unsigned x, unsigned& nloc, unsigned& nx) {
    const unsigned G = gridDim.x * gridDim.y * gridDim.z;
    unsigned sum, cnt, mine, sp = 0u;
    for (;;) {
        sum = 0u; cnt = 0u; mine = 0u;
#pragma unroll
        for (unsigned j = 0; j < 16; ++j) { const unsigned c = xb_ld(&bar[XB_XCNT(j)]); sum += c; cnt += (c > 0u) ? 1u : 0u; mine = (j == x) ? c : mine; }
        if (sum == G) break;
        __builtin_amdgcn_s_sleep(1);
        if ((++sp & 255u) == 0u) { if (xb_ld(&bar[XB_TMO])) break; if (sp > XB_SPIN_CAP) { atomicAdd(&bar[XB_TMO], 1u); break; } }
    }
    nloc = mine > 0u ? mine : 1u; nx = cnt > 0u ? cnt : 1u;
}
__device__ __forceinline__ void xcd_barrier(const XcdBarrier& b) {
    asm volatile("s_waitcnt vmcnt(0)" ::: "memory");
    __syncthreads();
    if (threadIdx.x == 0) {
        unsigned* bar = b.bar; asm volatile("" : "+s"(bar));
        unsigned bx = b.x; asm volatile("" : "+s"(bx));
        __builtin_amdgcn_s_waitcnt(0);
        unsigned nloc = b.st[0], nx = b.st[1];
        if (nloc == 0u) { xcd_barrier_complete(bar, bx, nloc, nx); b.st[0] = nloc; b.st[1] = nx; }
        const unsigned old = xb_add(&bar[XB_XSUB(bx)], 1u);
        const unsigned gen = old / nloc;
        if (old + 1u == (gen + 1u) * nloc) {
            __builtin_amdgcn_fence(__ATOMIC_RELEASE, "agent");
            asm volatile("s_waitcnt vmcnt(0)" ::: "memory");
            const unsigned og = xb_add(&bar[XB_TOP], 1u);
            const unsigned tg = og / nx;
            if (og + 1u == (tg + 1u) * nx) xb_add(&bar[XB_TOPGEN], 1u);
            else XB_SPIN(xb_ld(&bar[XB_TOPGEN]) == tg, bar);
            __builtin_amdgcn_fence(__ATOMIC_ACQUIRE, "agent");
            xb_add(&bar[XB_XGEN(bx)], 1u);
            asm volatile("s_waitcnt vmcnt(0)" ::: "memory");
        } else {
            XB_SPIN(xb_ld(&bar[XB_XGEN(bx)]) == gen, bar);
            __builtin_amdgcn_fence(__ATOMIC_ACQUIRE, "agent");
            asm volatile("s_waitcnt vmcnt(0)" ::: "memory");
        }
    }
    __syncthreads();
}

struct Args { const float* in[27]; float* out; unsigned char* ws; };
enum { I_X = 0, I_C, I_WMOD, I_BMOD, I_N1G, I_WIN, I_CONVW, I_CONVB, I_CNG, I_CNB, I_RELB, I_POOLW, I_POOLS, I_SNG, I_SNB, I_SGUW, I_SGUB, I_MIXG, I_WOUT, I_N2G, I_RW, I_RB, I_W1, I_B1, I_W2, I_B2, I_FNG };

__device__ __forceinline__ int t5_bucket(int n) {
    if (n < 16) return n;
    int b = 16;
    b += (n >= 19); b += (n >= 21); b += (n >= 24); b += (n >= 27); b += (n >= 31); b += (n >= 35); b += (n >= 40); b += (n >= 46);
    b += (n >= 52); b += (n >= 59); b += (n >= 67); b += (n >= 77); b += (n >= 87); b += (n >= 99); b += (n >= 113);
    return b;
}

__device__ __forceinline__ void transpose_item(const GAS float* W, int K, int N, GAS f16* WT, int orow0, int k0, int n0, const GAS float* kscale, LAS float* scr, int lane, int ko = -1) {
    if (ko < 0) ko = k0;
#pragma unroll 8
    for (int i = 0; i < 32; ++i) { const int kk = 2 * i + (lane >> 5); float v = W[(size_t)(k0 + kk) * N + n0 + (lane & 31)]; if (kscale) v *= kscale[k0 + kk]; scr[kk * 33 + (lane & 31)] = v; }
    asm volatile("s_waitcnt lgkmcnt(0)" ::: "memory");
    const int c = lane & 7;
#pragma unroll
    for (int j = 0; j < 4; ++j) { const int n = (lane >> 3) + 8 * j; const LAS float* s = scr + (8 * c) * 33 + n;
        u32x4 o; o.x = pk_f16(s[0 * 33], s[1 * 33]); o.y = pk_f16(s[2 * 33], s[3 * 33]); o.z = pk_f16(s[4 * 33], s[5 * 33]); o.w = pk_f16(s[6 * 33], s[7 * 33]);
        *(GAS u32x4*)(WT + (size_t)(orow0 + n) * K + ko + 8 * c) = o; }
    asm volatile("s_waitcnt lgkmcnt(0)" ::: "memory");
}

__device__ __forceinline__ void transpose_item8(const GAS float* W, int K, int N, GAS unsigned char* WT, int orow0, int k0, int n0, LAS float* scr, int lane) {
#pragma unroll 8
    for (int i = 0; i < 32; ++i) { const int kk = 2 * i + (lane >> 5); scr[kk * 33 + (lane & 31)] = W[(size_t)(k0 + kk) * N + n0 + (lane & 31)] * W8_SCALE; }
    asm volatile("s_waitcnt lgkmcnt(0)" ::: "memory");
    const int c = lane & 7;
#pragma unroll
    for (int j = 0; j < 4; ++j) { const int n = (lane >> 3) + 8 * j; const LAS float* s = scr + (8 * c) * 33 + n;
        u32x2 o; o.x = pk4_fp8(s[0 * 33], s[1 * 33], s[2 * 33], s[3 * 33]); o.y = pk4_fp8(s[4 * 33], s[5 * 33], s[6 * 33], s[7 * 33]);
        *(GAS u32x2*)(WT + (size_t)(orow0 + n) * K + k0 + 8 * c) = o; }
    asm volatile("s_waitcnt lgkmcnt(0)" ::: "memory");
}

__device__ __forceinline__ void transpose_item8x64(const GAS float* W, int K, int N, GAS unsigned char* WT, int orow0, int k0, int n0, LAS float* scr, int lane) {
    f32x4 v[16];
#pragma unroll
    for (int i = 0; i < 16; ++i) v[i] = *(const GAS f32x4*)(W + (size_t)(k0 + 4 * i + (lane >> 4)) * N + n0 + 4 * (lane & 15));
#pragma unroll
    for (int i = 0; i < 16; ++i) { LAS float* d = scr + (4 * i + (lane >> 4)) * 65 + 4 * (lane & 15); d[0] = v[i].x * W8_SCALE; d[1] = v[i].y * W8_SCALE; d[2] = v[i].z * W8_SCALE; d[3] = v[i].w * W8_SCALE; }
    asm volatile("s_waitcnt lgkmcnt(0)" ::: "memory");
    const int c = lane & 7;
#pragma unroll
    for (int j = 0; j < 8; ++j) { const int n = (lane >> 3) + 8 * j; const LAS float* s = scr + (8 * c) * 65 + n;
        u32x2 o; o.x = pk4_fp8(s[0 * 65], s[1 * 65], s[2 * 65], s[3 * 65]); o.y = pk4_fp8(s[4 * 65], s[5 * 65], s[6 * 65], s[7 * 65]);
        *(GAS u32x2*)(WT + (size_t)(orow0 + n) * K + k0 + 8 * c) = o; }
    asm volatile("s_waitcnt lgkmcnt(0)" ::: "memory");
}

__device__ __forceinline__ void norm_mod_row(const GAS float* xrow, const GAS float* g, const GAS float* shift, const GAS float* scale, GAS f16* orow, GAS unsigned char* orow8, int lane) {
    f32x4 v[4]; float s = 0.f;
#pragma unroll
    for (int j = 0; j < 4; ++j) { v[j] = *(const GAS f32x4*)(xrow + 4 * lane + 256 * j); s += (v[j].x * v[j].x + v[j].y * v[j].y) + (v[j].z * v[j].z + v[j].w * v[j].w); }
    const float rstd = rsqrtf(wave_sum(s) * (1.f / DM) + EPS);
#pragma unroll
    for (int j = 0; j < 4; ++j) { const int c = 4 * lane + 256 * j; const f32x4 gg = *(const GAS f32x4*)(g + c), sh = *(const GAS f32x4*)(shift + c), sc = *(const GAS f32x4*)(scale + c);
        const f32x4 h = (v[j] * rstd) * gg * (sc + 1.0f) + sh;
        if (NEED_H16(0)) { u32x2 w; w.x = pk_f16(h.x, h.y); w.y = pk_f16(h.z, h.w); *(GAS u32x2*)(orow + c) = w; }
        if (PROJ_FP8 && PROJ_FP8_FIRST == 0) *(GAS unsigned*)(orow8 + c) = pk4_fp8(h.x, h.y, h.z, h.w); }
}

extern __shared__ __attribute__((aligned(16))) unsigned char lds[];
#define LAUNDER() int tid = tid0; asm volatile("" : "+v"(tid)); const int lane = tid & 63; int wave = wave0; asm volatile("" : "+s"(wave)); const int gw = bid * NWAVES + wave; (void)gw; (void)lane; const CAS Args* AP = (const CAS Args*)__builtin_amdgcn_kernarg_segment_ptr(); asm volatile("" : "+s"(AP)); (void)AP; LAS unsigned char* Lp = (LAS unsigned char*)lds; asm volatile("" : "+s"(Lp)); (void)Lp; GAS unsigned char* ws = (GAS unsigned char*)AP->ws; GAS unsigned* ctl = (GAS unsigned*)(ws + WS_CTL); GAS float* MOD = (GAS float*)(ws + WS_MOD); GAS float* KMEAN = (GAS float*)(ws + WS_KMEAN); GAS float* SSQ = (GAS float*)(ws + WS_SSQ); (void)SSQ; GAS f16* SGUW = (GAS f16*)(ws + WS_SGUW); GAS f16* RWT16 = (GAS f16*)(ws + WS_RWT); (void)RWT16; GAS unsigned char* WIN8 = (GAS unsigned char*)(ws + WS_WIN8); (void)WIN8; GAS unsigned char* HB8 = (GAS unsigned char*)(ws + WS_HB8); (void)HB8; GAS f16* PWT = (GAS f16*)(ws + WS_PWT); (void)PWT; GAS int* ROUTE_E = (GAS int*)(ws + WS_ROUTE); GAS int* ROUTE_POS = ROUTE_E + NTOK * 4; GAS float* ROUTE_G = (GAS float*)(ROUTE_POS + NTOK * 4); GAS int* LIST = (GAS int*)(ws + WS_LIST); GAS f16* WIN_T = (GAS f16*)(ws + WS_WIN); GAS f16* WOUT_T = (GAS f16*)(ws + WS_WOUT); GAS f16* W1_T = (GAS f16*)(ws + WS_W1); GAS f16* W2_T = (GAS f16*)(ws + WS_W2); GAS f16* X = (GAS f16*)(ws + WS_X); GAS f16* H = (GAS f16*)(ws + WS_H); GAS f16* PROJ = (GAS f16*)(ws + WS_PROJ); GAS f16* MIX = (GAS f16*)(ws + WS_MIX); GAS f16* XS = (GAS f16*)(ws + WS_XS); GAS f16* ACT = (GAS f16*)(ws + WS_ACT); (void)ctl; (void)MOD; (void)KMEAN; (void)SGUW; (void)ROUTE_E; (void)ROUTE_POS; (void)ROUTE_G; (void)LIST; (void)WIN_T; (void)WOUT_T; (void)W1_T; (void)W2_T; (void)X; (void)H; (void)PROJ; (void)MIX; (void)XS; (void)ACT;
__device__ __forceinline__ void layer_body(const int l, const XcdBarrier bar, const int tid0, const int wave0, const int G, const int bid, const int NGW) {
#define MODL (MOD + (size_t)l * 8 * 6144)
for (int rep_ = 0; rep_ < REPS(4); ++rep_) if (PHMASK & 4) { LAUNDER();
        if (PROJ_FP8 && PROJ_QK_FP8 && l >= PROJ_FP8_FIRST) {
            pg8::Gemm g{(const GAS pg8::h16_t*)HB8, (const GAS pg8::h16_t*)(WIN8 + (size_t)l * INW * DM), NTOK, INW, DM / 2, nullptr, nullptr}; pg8::StaticOrder S; S.init(NTOK, INW, G, bid);
            pg8::EpiF16 E{(GAS pg8::h16_t*)PROJ, INW, KMEAN, W8_INV};
            pg8::gemm_phase<pg8::EpiF16, pg8::StaticOrder, false, true>(Lp, g, S, E, tid);
        } else if (PROJ_FP8 && l >= PROJ_FP8_FIRST) {
            { pg8::Gemm g{(const GAS pg8::h16_t*)H, (const GAS pg8::h16_t*)(WIN_T + (size_t)l * INW * DM), NTOK, 512, DM, nullptr, nullptr}; pg8::MapOrder S; S.init(NTOK, 512, G, bid); S.map = 0x32u;
              pg8::EpiF16 E{(GAS pg8::h16_t*)PROJ, INW, KMEAN, 1.0f};
              pg8::gemm_phase<pg8::EpiF16, pg8::MapOrder, false, false>(Lp, g, S, E, tid); }
            { pg8::Gemm g{(const GAS pg8::h16_t*)HB8, (const GAS pg8::h16_t*)(WIN8 + (size_t)l * INW * DM), NTOK, 1536, DM / 2, nullptr, nullptr}; pg8::MapOrder S; S.init(NTOK, 1536, G, bid); S.map = 0x765410u;
              pg8::EpiF16 E{(GAS pg8::h16_t*)PROJ, INW, KMEAN, W8_INV};
              pg8::gemm_phase<pg8::EpiF16, pg8::MapOrder, false, true>(Lp, g, S, E, tid); }
        } else {
        { pg8::Gemm g{(const GAS pg8::h16_t*)H, (const GAS pg8::h16_t*)(WIN_T + (size_t)l * INW * DM), NTOK, INW, DM, nullptr, nullptr}; pg8::StaticOrder S; S.init(NTOK, INW, G, bid);
          pg8::EpiF16 E{(GAS pg8::h16_t*)PROJ, INW, KMEAN, 1.0f};
          pg8::gemm_phase<pg8::EpiF16, pg8::StaticOrder, false>(Lp, g, S, E, tid); }
        }
}
        xcd_barrier(bar);
        STAMP(3 + 9 * l + 0);

for (int rep_ = 0; rep_ < REPS(8); ++rep_) if (PHMASK & 8) {
        for (int it_ = bid; it_ < 256 + 512 + 512; it_ += G) { int it = it_; asm volatile("" : "+s"(it));
            if ((PH3 & 1) && it < 256) {
                LAUNDER();
                const int T0 = it * 128;
                LAS f16* vT = (LAS f16*)Lp;
                constexpr int VS = 136;
                const GAS float* sng = GIN(I_SNG) + l * GW; const GAS float* snb = GIN(I_SNB) + l * GW;
                f16x8 afr[4][4];
#pragma unroll
                for (int ks = 0; ks < 4; ++ks)
#pragma unroll
                    for (int h = 0; h < 4; ++h) afr[ks][h] = *(const GAS f16x8*)(SGUW + ((size_t)(l * 4 + h) * 128 + 16 * wave + (lane & 15)) * 128 + 32 * ks + 8 * (lane >> 4));
#pragma unroll 1
                for (int tg = 0; tg < 16; tg += 4) { f16x4 hvv[4];
#pragma unroll
                  for (int t4 = 0; t4 < 4; ++t4) hvv[t4] = *(const GAS f16x4*)(PROJ + (size_t)(T0 + wave * 16 + tg + t4) * INW + 1792 + 4 * lane);
#pragma unroll
                  for (int t4 = 0; t4 < 4; ++t4) { const int tl = wave * 16 + tg + t4;
                    const f16x4 hv = hvv[t4]; float v[4]; float s = 0.f;
#pragma unroll
                    for (int i = 0; i < 4; ++i) { v[i] = gelu_erf((float)hv[i]); s += v[i]; }
                    const float mean = wave_sum(s) * (1.f / 256.f); float q = 0.f;
#pragma unroll
                    for (int i = 0; i < 4; ++i) { v[i] -= mean; q += v[i] * v[i]; }
                    const float rstd = rsqrtf(wave_sum(q) * (1.f / 256.f) + EPS);
#pragma unroll
                    for (int i = 0; i < 4; ++i) { const int c = 4 * lane + i; vT[c * VS + tl] = (f16)(v[i] * rstd * sng[c] + snb[c]); } } }
                __syncthreads();
                f32x4 acc[4][4];
#pragma unroll
                for (int h = 0; h < 4; ++h)
#pragma unroll
                    for (int ct = 0; ct < 4; ++ct) acc[h][ct] = (f32x4){0.f, 0.f, 0.f, 0.f};
                const int nk = (wave >> 1) + 1, fr = lane & 15, fq = lane >> 4;
#pragma unroll
                for (int ks = 0; ks < 4; ++ks) { if (ks < nk) {
#pragma unroll
                    for (int h = 0; h < 4; ++h) {
                        const f16x8 a = afr[ks][h];
#pragma unroll
                        for (int ct = 0; ct < 4; ++ct) { const f16x8 b = *(const LAS f16x8*)(vT + (h * 64 + ct * 16 + fr) * VS + 32 * ks + 8 * fq);
                            acc[h][ct] = __builtin_amdgcn_mfma_f32_16x16x32_f16(a, b, acc[h][ct], 0, 0, 0); } } } }
                const GAS float* sb = GIN(I_SGUB) + (size_t)l * 4 * 128;
#pragma unroll
                for (int reg = 0; reg < 4; ++reg) { const int il = 16 * wave + 4 * fq + reg; const size_t tok = (size_t)(T0 + il); float ss = 0.f; float val[4][4];
#pragma unroll
                    for (int h = 0; h < 4; ++h) { const float bia = sb[h * 128 + il];
#pragma unroll
                        for (int ct = 0; ct < 4; ++ct) { const int c = h * 64 + ct * 16 + fr; const float u = gelu_erf((float)PROJ[tok * INW + 1536 + c]);
                            const float x = (acc[h][ct][reg] + bia) * u; val[h][ct] = x; ss += x * x; } }
                    ss = row16_sum(ss);
                    const float rstd = rsqrtf(ss * (1.f / 256.f) + EPS);
#pragma unroll
                    for (int h = 0; h < 4; ++h)
#pragma unroll
                        for (int ct = 0; ct < 4; ++ct) MIX[tok * DM + 768 + h * 64 + ct * 16 + fr] = (f16)(val[h][ct] * rstd); }
                __syncthreads();
            } else if ((PH3 & 2) && it < 768) {
                LAUNDER();
                const int T0 = (it - 256) * 64, p0 = T0 & (SEQ - 1);
                LAS float* y = (LAS float*)Lp;
                LAS float* Wc = (LAS float*)(Lp + 96256);
                for (int i = tid; i < 31 * 64; i += 512) *(LAS f32x4*)(Wc + 4 * i) = *(const GAS f32x4*)(GIN(I_CONVW) + (size_t)l * 31 * GW + 4 * i);
                { f16x8 av[6], gv[6];
#pragma unroll
                  for (int k6 = 0; k6 < 6; ++k6) { int task = tid + k6 * 512; task = task < 94 * 32 ? task : 94 * 32 - 1; const int r = task >> 5, c8 = (task & 31) * 8; const bool ok = (p0 - 30 + r >= 0);
                      const GAS f16* pr = PROJ + (size_t)(T0 + (ok ? r - 30 : 0)) * INW + c8; av[k6] = *(const GAS f16x8*)pr; gv[k6] = *(const GAS f16x8*)(pr + 256); }
#pragma unroll
                  for (int k6 = 0; k6 < 6; ++k6) { const int task = tid + k6 * 512;
                      if (task < 94 * 32) { const int r = task >> 5, c8 = (task & 31) * 8; const bool ok = (p0 - 30 + r >= 0); float o[8];
#pragma unroll
                          for (int i = 0; i < 8; ++i) o[i] = ok ? (float)av[k6][i] * sigmoidf_((float)gv[k6][i]) : 0.f;
                          *(LAS f32x4*)(y + r * 256 + c8) = (f32x4){o[0], o[1], o[2], o[3]}; *(LAS f32x4*)(y + r * 256 + c8 + 4) = (f32x4){o[4], o[5], o[6], o[7]}; } } }
                __syncthreads();
                float psq[8];
#pragma unroll
                for (int t = 0; t < 8; ++t) psq[t] = 0.f;
                float osv[4][8];
#pragma unroll
                for (int h = 0; h < 4; ++h) { const int c = h * 64 + lane; float w[31];
#pragma unroll
                    for (int j = 0; j < 31; ++j) w[j] = Wc[j * 256 + c];
                    const float cb = GIN(I_CONVB)[l * GW + c], ng = GIN(I_CNG)[l * GW + c], nb_ = GIN(I_CNB)[l * GW + c];
                    float yv[38];
#pragma unroll
                    for (int q = 0; q < 38; ++q) yv[q] = y[(wave * 8 + q) * 256 + c];
                    float a[8], red[16];
#pragma unroll
                    for (int t = 0; t < 8; ++t) { float s = cb;
#pragma unroll
                        for (int j = 0; j < 31; ++j) s += w[j] * yv[t + j];
                        a[t] = s; red[t] = s; red[8 + t] = s * s; }
                    wave_sum_n<16>(red);
#pragma unroll
                    for (int t = 0; t < 8; ++t) { const float mean = red[t] * (1.f / 64.f), var = fmaxf(red[8 + t] * (1.f / 64.f) - mean * mean, 0.f);
                        const float yn = (a[t] - mean) * rsqrtf(var + EPS) * ng + nb_; const float sv = yn * sigmoidf_(yn);
                        psq[t] += sv * sv; osv[h][t] = sv; }
                    asm volatile("" ::: "memory"); }
                wave_sum_n<8>(psq);
#pragma unroll
                for (int t = 0; t < 8; ++t) psq[t] = rsqrtf(psq[t] * (1.f / 256.f) + EPS);
#pragma unroll
                for (int h = 0; h < 4; ++h)
#pragma unroll
                    for (int t = 0; t < 8; ++t) MIX[(size_t)(T0 + wave * 8 + t) * DM + 256 + h * 64 + lane] = (f16)(osv[h][t] * psq[t]);
                __syncthreads();
            } else if ((PH3 & 4) && it < 1280) {
                LAUNDER();
                const int T0 = (it - 768) * 64, p0 = T0 & (SEQ - 1);
                LAS f16* zt = (LAS f16*)Lp;
                LAS f16* Pf = (LAS f16*)(Lp + 40960);
                LAS f16* WpT = (LAS f16*)(Lp + 75776);
                constexpr int PS = 264, WS2 = 72;
                for (int i = tid; i < 256 * 8; i += 512) { const int r = i >> 3, c8 = (i & 7) * 8; *(LAS u32x4*)(WpT + r * WS2 + c8) = *(const GAS u32x4*)(PWT + (size_t)l * 16384 + r * 64 + c8); }
                for (int task = tid; task < 79 * 32; task += 512) { const int r = task >> 5, c8 = (task & 31) * 8; u32x4 z = {0u, 0u, 0u, 0u};
                    if (p0 - 15 + r >= 0) z = *(const GAS u32x4*)(PROJ + (size_t)(T0 - 15 + r) * INW + 1280 + c8);
                    *(LAS u32x4*)(zt + r * 256 + c8) = z; }
                __syncthreads();
                { const int c8 = (tid & 31) * 8, seg = tid >> 5, gi = c8 >> 6, w = 2 << gi; float s[8];
#pragma unroll
                  for (int i = 0; i < 8; ++i) s[i] = 0.f;
                  for (int d = 1; d < w; ++d) { const f16x8 z = *(const LAS f16x8*)(zt + (seg * 4 + 15 - d) * 256 + c8);
#pragma unroll
                      for (int i = 0; i < 8; ++i) s[i] += (float)z[i]; }
#pragma unroll
                  for (int t = 0; t < 4; ++t) { const int tl = seg * 4 + t, p = p0 + tl;
                      const f16x8 zn = *(const LAS f16x8*)(zt + (tl + 15) * 256 + c8);
                      const float inv = 1.f / (float)(p + 1 < w ? p + 1 : w); f16x8 po;
#pragma unroll
                      for (int i = 0; i < 8; ++i) { s[i] += (float)zn[i]; po[i] = (f16)(s[i] * inv - (float)zn[i]); }
                      *(LAS f16x8*)(Pf + tl * PS + c8) = po;
                      const f16x8 zo = *(const LAS f16x8*)(zt + (tl + 15 - (w - 1)) * 256 + c8);
#pragma unroll
                      for (int i = 0; i < 8; ++i) s[i] -= (float)zo[i]; } }
                __syncthreads();
                if (wave < 4) {
                    const int fr = lane & 15, fq = lane >> 4;
                    f32x4 acc[4][4];
#pragma unroll
                    for (int g = 0; g < 4; ++g)
#pragma unroll
                        for (int nt = 0; nt < 4; ++nt) acc[g][nt] = (f32x4){0.f, 0.f, 0.f, 0.f};
#pragma unroll
                    for (int g = 0; g < 4; ++g)
#pragma unroll
                        for (int ks = 0; ks < 2; ++ks) { const f16x8 av = *(const LAS f16x8*)(Pf + (16 * wave + fr) * PS + g * 64 + 32 * ks + 8 * fq);
#pragma unroll
                            for (int nt = 0; nt < 4; ++nt) { const f16x8 bv = *(const LAS f16x8*)(WpT + (g * 64 + nt * 16 + fr) * WS2 + 32 * ks + 8 * fq);
                                acc[g][nt] = __builtin_amdgcn_mfma_f32_16x16x32_f16(av, bv, acc[g][nt], 0, 0, 0); } }
                    float psc[4][4];
#pragma unroll
                    for (int g = 0; g < 4; ++g)
#pragma unroll
                        for (int nt = 0; nt < 4; ++nt) psc[g][nt] = GIN(I_POOLS)[l * GW + g * 64 + nt * 16 + fr];
#pragma unroll
                    for (int reg = 0; reg < 4; ++reg) { float ss = 0.f;
#pragma unroll
                        for (int g = 0; g < 4; ++g)
#pragma unroll
                            for (int nt = 0; nt < 4; ++nt) { const float x = acc[g][nt][reg] * psc[g][nt]; acc[g][nt][reg] = x; ss += x * x; }
                        ss = row16_sum(ss);
                        const float rstd = rsqrtf(ss * (1.f / 256.f) + EPS); const size_t tok = (size_t)(T0 + 16 * wave + 4 * fq + reg);
#pragma unroll
                        for (int g = 0; g < 4; ++g)
#pragma unroll
                            for (int nt = 0; nt < 4; ++nt) MIX[tok * DM + 512 + g * 64 + nt * 16 + fr] = (f16)(acc[g][nt][reg] * rstd); }
                }
                __syncthreads();
            }
        }
}
        STAMP(3 + 9 * l + 1);

for (int rep_ = 0; rep_ < REPS(16); ++rep_) if (PHMASK & 16) { LAUNDER();
        {
            LAS f16* Kb = (LAS f16*)Lp;
            LAS f16* Vb = (LAS f16*)(Lp + 36864);
            LAS float* kml = (LAS float*)(Lp + 73728);
            LAS float* lut = (LAS float*)(Lp + 73728 + 4096);
            constexpr int KS = 72;
            constexpr float LOG2E = 1.4426950408889634f, SC2 = 0.125f * LOG2E, THR = 4.0f;
            const int r32 = lane & 31, hh = lane >> 5;
            const int vtr_off = (4 * hh + ((lane & 15) >> 2)) * KS + 16 * ((lane >> 4) & 1) + 4 * (lane & 3);
            const int lk = tid >> 3, lc = tid & 7;
            for (int pi = bid; pi < 256; pi += G) {
                const int bh = pi >> 3, pp = pi & 7;
                for (int half = 0; half < 2; ++half) {
                    const int own = half == 0 ? 15 - pp : pp;
                    const int b = bh >> 2, h = bh & 3;
                    const size_t TB = (size_t)b * SEQ;
                    const int qpos = own * 256 + 32 * wave + r32;
                    const GAS f16* kvp = PROJ + (TB + lk) * INW + 768 + h * 64 + 8 * lc;
                    f16x8 kr[4], vr[4];
#pragma unroll
                    for (int pc = 0; pc < 4; ++pc) { const GAS f16* p_ = kvp + (size_t)(64 * pc) * INW; kr[pc] = *(const GAS f16x8*)p_; vr[pc] = *(const GAS f16x8*)(p_ + 256); }
                    __syncthreads();
                    for (int i = tid; i < 1024; i += 512) kml[i] = KMEAN[((size_t)(b * 16 + (i >> 6))) * 256 + h * 64 + (i & 63)] * (1.f / 256.f);
                    if (tid < 128) lut[tid] = GIN(I_RELB)[t5_bucket(tid) * 4 + h] * LOG2E;
                    f16x8 qf[4];
                    { const GAS f16* qp = PROJ + (TB + qpos) * INW + 512 + h * 64 + 8 * hh;
#pragma unroll
                      for (int s = 0; s < 4; ++s) qf[s] = *(const GAS f16x8*)(qp + 16 * s); }
                    __syncthreads();
                    unsigned mask = 0u;
                    { float gsc[16]; float qv[32];
#pragma unroll
                      for (int s = 0; s < 4; ++s)
#pragma unroll
                          for (int j = 0; j < 8; ++j) qv[8 * s + j] = (float)qf[s][j];
#pragma unroll
                      for (int n = 0; n < 16; ++n) { float a = 0.f;
                          if (n < own) { f32x4 kv[8];
#pragma unroll
                              for (int s = 0; s < 4; ++s) { kv[2 * s] = *(const LAS f32x4*)(kml + n * 64 + 16 * s + 8 * hh); kv[2 * s + 1] = *(const LAS f32x4*)(kml + n * 64 + 16 * s + 8 * hh + 4); }
#pragma unroll
                              for (int s = 0; s < 8; ++s) a += (qv[4 * s] * kv[s].x + qv[4 * s + 1] * kv[s].y) + (qv[4 * s + 2] * kv[s].z + qv[4 * s + 3] * kv[s].w); }
                          a += __shfl_xor(a, 32); gsc[n] = a; }
#pragma unroll
                      for (int k = 0; k < 3; ++k) { float best = -INFINITY; int bi = -1;
#pragma unroll
                          for (int n = 0; n < 16; ++n) { const bool ok = (n < own) && !((mask >> n) & 1u) && (gsc[n] > best); if (ok) { best = gsc[n]; bi = n; } }
                          if (bi >= 0) mask |= 1u << bi; }
#pragma unroll
                      for (int s = 0; s < 4; ++s)
#pragma unroll
                          for (int j = 0; j < 8; ++j) qf[s][j] = (f16)(qv[8 * s + j] * SC2); }
                    f32x16 o0, o1;
#pragma unroll
                    for (int i = 0; i < 16; ++i) { o0[i] = 0.f; o1[i] = 0.f; }
                    float mrun = -INFINITY, lrun = 0.f;
                    f32x16 iniv; float ini_prev = 0.f;
#pragma unroll
                    for (int i = 0; i < 16; ++i) iniv[i] = 0.f;
                    for (int n = 0; n <= own; ++n) {
                        __syncthreads();
#pragma unroll
                        for (int pc = 0; pc < 4; ++pc) { *(LAS f16x8*)(Kb + (lk + 64 * pc) * KS + 8 * lc) = kr[pc]; *(LAS f16x8*)(Vb + (lk + 64 * pc) * KS + 8 * lc) = vr[pc]; }
                        __syncthreads();
                        if (n < own) {
#pragma unroll
                            for (int pc = 0; pc < 4; ++pc) { const GAS f16* p_ = kvp + (size_t)((n + 1) * 256 + 64 * pc) * INW; kr[pc] = *(const GAS f16x8*)p_; vr[pc] = *(const GAS f16x8*)(p_ + 256); } }
                        const bool past = n < own;
                        const bool sel = past ? ((mask >> n) & 1u) != 0u : true;
                        if (past && !__any(sel)) continue;
                        const int ntl = past ? 4 : (wave >> 1) + 1;
#pragma unroll 1
                        for (int tl = 0; tl < ntl; ++tl) {
                            const LAS f16* Kt = Kb + tl * 64 * KS; const LAS f16* Vt = Vb + tl * 64 * KS;
                            const int kbase = n * 256 + tl * 64;
                            const int dmin = own * 256 + 32 * wave - (kbase + 63);
                            const bool cb = dmin >= 127;
                            const float minit = (mrun == -INFINITY) ? 0.f : mrun;
                            const float ini = sel ? ((cb ? lut[127] : 0.f) - minit) : -INFINITY;
                            if (__any(ini != ini_prev)) {
#pragma unroll
                                for (int i = 0; i < 16; ++i) iniv[i] = ini;
                                ini_prev = ini; }
                            f32x16 p0, p1;
                            { const f16x8 a0 = *(const LAS f16x8*)(Kt + r32 * KS + 8 * hh), a1 = *(const LAS f16x8*)(Kt + (32 + r32) * KS + 8 * hh);
                              p0 = __builtin_amdgcn_mfma_f32_32x32x16_f16(a0, qf[0], iniv, 0, 0, 0); p1 = __builtin_amdgcn_mfma_f32_32x32x16_f16(a1, qf[0], iniv, 0, 0, 0); }
#pragma unroll
                            for (int s = 1; s < 4; ++s) { const f16x8 a0 = *(const LAS f16x8*)(Kt + r32 * KS + 16 * s + 8 * hh), a1 = *(const LAS f16x8*)(Kt + (32 + r32) * KS + 16 * s + 8 * hh);
                                p0 = __builtin_amdgcn_mfma_f32_32x32x16_f16(a0, qf[s], p0, 0, 0, 0); p1 = __builtin_amdgcn_mfma_f32_32x32x16_f16(a1, qf[s], p1, 0, 0, 0); }
                            if (!cb) {
#pragma unroll
                                for (int i = 0; i < 16; ++i) { const int kr_ = (i & 3) + 8 * (i >> 2) + 4 * hh; const int d0 = qpos - (kbase + kr_), d1 = d0 - 32;
                                    p0[i] = (d0 >= 0) ? p0[i] + lut[d0 > 127 ? 127 : d0] : -INFINITY;
                                    p1[i] = (d1 >= 0) ? p1[i] + lut[d1 > 127 ? 127 : (d1 < 0 ? 0 : d1)] : -INFINITY; } }
                            asm volatile("s_nop 7\n\ts_nop 7\n\ts_nop 7" : "+v"(p0), "+v"(p1));
                            float mx = max3f(p0[0], p0[1], p1[0]), mxb = max3f(p0[2], p0[3], p1[1]); mx = max3f(mx, p1[2], p1[3]);
#pragma unroll
                            for (int i = 4; i < 16; i += 4) { mx = max3f(mx, p0[i], p0[i + 1]); mxb = max3f(mxb, p0[i + 2], p0[i + 3]); mx = max3f(mx, p1[i], p1[i + 1]); mxb = max3f(mxb, p1[i + 2], p1[i + 3]); }
                            mx = max2f(mx, mxb);
                            mx = max2f(mx, __shfl_xor(mx, 32));
                            const bool need = sel && (mx > -INFINITY) && ((mrun == -INFINITY) || (mx > THR));
                            if (__any(need)) { const float delta = need ? mx : 0.f; const float alpha = __builtin_amdgcn_exp2f(-delta);
#pragma unroll
                                for (int i = 0; i < 16; ++i) { p0[i] -= delta; p1[i] -= delta; o0[i] *= alpha; o1[i] *= alpha; }
                                lrun *= alpha; if (need) mrun = minit + delta; }
#pragma unroll
                            for (int i = 0; i < 16; ++i) { p0[i] = __builtin_amdgcn_exp2f(p0[i]); p1[i] = __builtin_amdgcn_exp2f(p1[i]); }
                            asm volatile("s_nop 1" : "+v"(p0), "+v"(p1));
                            float psa = 0.f, psb = 0.f, psc = 0.f, psd = 0.f;
#pragma unroll
                            for (int i = 0; i < 16; i += 2) { psa = fadd_s(psa, p0[i]); psb = fadd_s(psb, p1[i]); psc = fadd_s(psc, p0[i + 1]); psd = fadd_s(psd, p1[i + 1]); }
                            lrun += (psa + psb) + (psc + psd);
                            f16x8 pb[4];
#pragma unroll
                            for (int i = 0; i < 8; ++i) { pb[0][i] = (f16)p0[i]; pb[1][i] = (f16)p0[8 + i]; pb[2][i] = (f16)p1[i]; pb[3][i] = (f16)p1[8 + i]; }
#pragma unroll
                            for (int kk = 0; kk < 4; ++kk) {
                                const LAS f16* vb = Vt + vtr_off + (16 * kk) * KS;
                                const f16x4 a0l = __builtin_bit_cast(f16x4, __builtin_amdgcn_ds_read_tr16_b64_v4i16((LAS v4i16_t*)(vb)));
                                const f16x4 a0h = __builtin_bit_cast(f16x4, __builtin_amdgcn_ds_read_tr16_b64_v4i16((LAS v4i16_t*)(vb + 8 * KS)));
                                const f16x4 a1l = __builtin_bit_cast(f16x4, __builtin_amdgcn_ds_read_tr16_b64_v4i16((LAS v4i16_t*)(vb + 32)));
                                const f16x4 a1h = __builtin_bit_cast(f16x4, __builtin_amdgcn_ds_read_tr16_b64_v4i16((LAS v4i16_t*)(vb + 8 * KS + 32)));
                                const f16x8 av0 = {a0l[0], a0l[1], a0l[2], a0l[3], a0h[0], a0h[1], a0h[2], a0h[3]};
                                const f16x8 av1 = {a1l[0], a1l[1], a1l[2], a1l[3], a1h[0], a1h[1], a1h[2], a1h[3]};
                                o0 = __builtin_amdgcn_mfma_f32_32x32x16_f16(av0, pb[kk], o0, 0, 0, 0);
                                o1 = __builtin_amdgcn_mfma_f32_32x32x16_f16(av1, pb[kk], o1, 0, 0, 0); }
                        }
                    }
                    const float ltot = lrun + __shfl_xor(lrun, 32), inv = 1.f / ltot;
                    GAS f16* op = MIX + (TB + qpos) * DM + h * 64;
                    float sq = 0.f;
#pragma unroll
                    for (int g4 = 0; g4 < 4; ++g4) { const int d0 = 8 * g4 + 4 * hh;
                        u32x2 w0, w1; w0.x = pk_f16(o0[4 * g4] * inv, o0[4 * g4 + 1] * inv); w0.y = pk_f16(o0[4 * g4 + 2] * inv, o0[4 * g4 + 3] * inv);
                        w1.x = pk_f16(o1[4 * g4] * inv, o1[4 * g4 + 1] * inv); w1.y = pk_f16(o1[4 * g4 + 2] * inv, o1[4 * g4 + 3] * inv);
                        { const f16x4 r0 = __builtin_bit_cast(f16x4, w0), r1 = __builtin_bit_cast(f16x4, w1);
#pragma unroll
                          for (int i = 0; i < 4; ++i) { const float a_ = (float)r0[i], b_ = (float)r1[i]; sq += a_ * a_ + b_ * b_; } }
                        *(GAS u32x2*)(op + d0) = w0; *(GAS u32x2*)(op + 32 + d0) = w1; }
                    sq += __shfl_xor(sq, 32);
                    if (hh == 0) SSQ[(TB + qpos) * 4 + h] = sq;
                }
            }
        }
}
        xcd_barrier(bar);
        STAMP(3 + 9 * l + 2);

        STAMP(3 + 9 * l + 3);

if (PHMASK & 64) { LAUNDER();
        { pg8::Gemm g{(const GAS pg8::h16_t*)MIX, (const GAS pg8::h16_t*)(WOUT_T + (size_t)l * DM * DM), NTOK, DM, DM, nullptr, SSQ}; pg8::StaticOrder S; S.init(NTOK, DM, G, bid);
          if (l == 0) { pg8::EpiResidT<true> E{GIN(I_X), nullptr, (GAS pg8::h16_t*)X, MODL + 2048}; pg8::gemm_phase<pg8::EpiResidT<true>, pg8::StaticOrder, false, false, true>(Lp, g, S, E, tid); }
          else { pg8::EpiResidT<false> E{nullptr, (const GAS pg8::h16_t*)X, (GAS pg8::h16_t*)X, MODL + 2048}; pg8::gemm_phase<pg8::EpiResidT<false>, pg8::StaticOrder, false, false, true>(Lp, g, S, E, tid); } }
}
        xcd_barrier(bar);
        STAMP(3 + 9 * l + 4);

if (PHMASK & 128) { LAUNDER();
        {
            LAS f16* WT = (LAS f16*)Lp;
            constexpr int WS_ = 1032;
            LAS float* lg = (LAS float*)(Lp + 66560 + wave * 2304);
            LAS int* sel_e = (LAS int*)(Lp + 131584);
            LAS int* rank_ = (LAS int*)(Lp + 131584 + 2048);
            LAS int* lcnt = (LAS int*)(Lp + 131584 + 4096);
            LAS int* lbase = (LAS int*)(Lp + 131584 + 4096 + 128);
            for (int i = tid; i < 32 * WS_ / 8; i += 512) *(LAS u32x4*)(WT + 8 * i) = *(const GAS u32x4*)(RWT16 + (size_t)l * 32 * WS_ + 8 * i);
            GAS unsigned* gcnt = ctl + CW_CNT + l * 32 * 64;
            const int fr = lane & 15, fq = lane >> 4;
            if (l + 1 < DEPTH) { for (int i = bid * 512 + tid; i < NB * 16 * 256; i += G * 512) KMEAN[i] = 0.f; }
            for (int ch = bid; ch < NTOK / 128; ch += G) {
                if (tid < 32) lcnt[tid] = 0;
                __syncthreads();
                const int b = (ch * 128) >> 12; const GAS float* md = MODL + (size_t)b * 6144;
                const GAS float* g2 = GIN(I_N2G) + l * DM;
                const size_t tokw = (size_t)ch * 128 + wave * 16;
                LAS float* pgl = (LAS float*)(Lp + 86016); LAS float* psl = (LAS float*)(Lp + 86016 + 4096);
                for (int i = tid; i < 256; i += 512) { const f32x4 g4 = *(const GAS f32x4*)(g2 + 4 * i), s4 = *(const GAS f32x4*)(md + 4096 + 4 * i); *(LAS f32x4*)(pgl + 4 * i) = g4 * (s4 + 1.0f); *(LAS f32x4*)(psl + 4 * i) = *(const GAS f32x4*)(md + 3072 + 4 * i); }
                __syncthreads();
                LAS f16* hb = (LAS f16*)(Lp + 94208) + wave * (2 * WS_);
                const float rb0 = GIN(I_RB)[l * NEXP + fr], rb1 = GIN(I_RB)[l * NEXP + 16 + fr];
#pragma unroll 1
                for (int t2 = 0; t2 < 16; t2 += 4) {
                    f32x4 v[4][4];
#pragma unroll
                    for (int r = 0; r < 4; ++r)
#pragma unroll
                        for (int j = 0; j < 4; ++j) { const f16x4 xh = *(const GAS f16x4*)(X + (tokw + t2 + r) * DM + 4 * lane + 256 * j); v[r][j] = (f32x4){(float)xh[0], (float)xh[1], (float)xh[2], (float)xh[3]}; }
#pragma unroll
                    for (int hf = 0; hf < 2; ++hf) {
#pragma unroll
                        for (int r2 = 0; r2 < 2; ++r2) { const int r = 2 * hf + r2; float s = 0.f;
#pragma unroll
                            for (int j = 0; j < 4; ++j) s += (v[r][j].x * v[r][j].x + v[r][j].y * v[r][j].y) + (v[r][j].z * v[r][j].z + v[r][j].w * v[r][j].w);
                            const float rstd = rsqrtf(wave_sum(s) * (1.f / DM) + EPS);
#pragma unroll
                            for (int j = 0; j < 4; ++j) { const int c = 4 * lane + 256 * j;
                                const f32x4 hq = (v[r][j] * rstd) * *(const LAS f32x4*)(pgl + c) + *(const LAS f32x4*)(psl + c);
                                u32x2 w; w.x = pk_f16(hq.x, hq.y); w.y = pk_f16(hq.z, hq.w); *(LAS u32x2*)(hb + r2 * WS_ + c) = w;
                                if (!IS_FP8(l)) *(GAS u32x2*)(H + (tokw + t2 + r) * DM + c) = w;
                                if (IS_FP8(l)) *(GAS unsigned*)((GAS unsigned char*)XS + (tokw + t2 + r) * DM + c) = pk4_fp8(hq.x, hq.y, hq.z, hq.w); } }
                        asm volatile("s_waitcnt lgkmcnt(0)" ::: "memory");
                        f32x4 acc0 = {0.f, 0.f, 0.f, 0.f}, acc1 = {0.f, 0.f, 0.f, 0.f};
#pragma unroll 4
                        for (int ks = 0; ks < 32; ++ks) { const f16x8 a = *(const LAS f16x8*)(hb + (fr & 1) * WS_ + 32 * ks + 8 * fq);
                            const f16x8 b0 = *(const LAS f16x8*)(WT + fr * WS_ + 32 * ks + 8 * fq), b1 = *(const LAS f16x8*)(WT + (16 + fr) * WS_ + 32 * ks + 8 * fq);
                            acc0 = __builtin_amdgcn_mfma_f32_16x16x32_f16(a, b0, acc0, 0, 0, 0); acc1 = __builtin_amdgcn_mfma_f32_16x16x32_f16(a, b1, acc1, 0, 0, 0); }
                        if (fq == 0) {
#pragma unroll
                            for (int reg = 0; reg < 2; ++reg) { lg[(t2 + 2 * hf + reg) * 36 + fr] = acc0[reg] + rb0; lg[(t2 + 2 * hf + reg) * 36 + 16 + fr] = acc1[reg] + rb1; } }
                        asm volatile("s_waitcnt lgkmcnt(0)" ::: "memory");
                    }
                }
                asm volatile("s_waitcnt lgkmcnt(0)" ::: "memory");
                if (lane < 16) { float vv[32];
#pragma unroll
                    for (int q = 0; q < 8; ++q) { const f32x4 t = *(const LAS f32x4*)(lg + lane * 36 + 4 * q); vv[4 * q] = t.x; vv[4 * q + 1] = t.y; vv[4 * q + 2] = t.z; vv[4 * q + 3] = t.w; }
                    float topv[4]; int topi[4];
#pragma unroll
                    for (int k = 0; k < 4; ++k) { float bv = -INFINITY; int bi = 0;
#pragma unroll
                        for (int e = 0; e < 32; ++e) { if (vv[e] > bv) { bv = vv[e]; bi = e; } }
                        topv[k] = bv; topi[k] = bi;
#pragma unroll
                        for (int e = 0; e < 32; ++e) vv[e] = (e == bi) ? -INFINITY : vv[e]; }
                    const int tl = wave * 16 + lane; const size_t tok = (size_t)ch * 128 + tl;
                    const float e1 = __expf(topv[1] - topv[0]), e2 = __expf(topv[2] - topv[0]), e3 = __expf(topv[3] - topv[0]); const float inv = 1.f / (1.f + e1 + e2 + e3);
                    *(GAS f32x4*)(ROUTE_G + tok * 4) = (f32x4){inv, e1 * inv, e2 * inv, e3 * inv};
#pragma unroll
                    for (int k = 0; k < 4; ++k) sel_e[tl * 4 + k] = topi[k]; }
                __syncthreads();
                const int e = sel_e[tid];
                rank_[tid] = __hip_atomic_fetch_add(&lcnt[e], 1, __ATOMIC_RELAXED, __HIP_MEMORY_SCOPE_WORKGROUP);
                __syncthreads();
                if (tid < 32) lbase[tid] = (int)__hip_atomic_fetch_add(gcnt + tid * 64, (unsigned)lcnt[tid], __ATOMIC_RELAXED, __HIP_MEMORY_SCOPE_AGENT);
                __syncthreads();
                { const int pos = lbase[e] + rank_[tid]; const size_t tok = (size_t)ch * 128 + (tid >> 2);
                  LIST[(size_t)e * LISTCAP + pos] = (int)tok; ROUTE_E[tok * 4 + (tid & 3)] = e; ROUTE_POS[tok * 4 + (tid & 3)] = pos; }
                __syncthreads();
            }
        }
}
        xcd_barrier(bar);
        STAMP(3 + 9 * l + 5);

#define cnts ((LAS int*)(Lp + RING_BYTES + 1024))
#define mbase ((LAS int*)(Lp + RING_BYTES + 1024 + 256))
        { LAUNDER(); GAS unsigned* gcnt = ctl + CW_CNT + l * 32 * 64;
          if (tid < 32) cnts[tid] = (int)__hip_atomic_load(gcnt + tid * 64, __ATOMIC_RELAXED, __HIP_MEMORY_SCOPE_AGENT);
          __syncthreads();
          if (tid == 0) { int a = 0; for (int e = 0; e < 32; ++e) { mbase[e] = a; a += (cnts[e] + 255) >> 8; } mbase[32] = a; }
          __syncthreads(); }

        for (int ph = 0; ph < 2; ++ph) {
            if (!(PHMASK & (512 << ph))) continue;
            for (int rep_ = 0; rep_ < REPS(512 << ph); ++rep_) {
            LAUNDER(); const int MT = mbase[32]; LAS int* ulist = (LAS int*)(Lp + RING_BYTES); const int NT = ph == 0 ? 8 : 4, U = MT * NT;
            __syncthreads();
            int nu = 0;
            { const int q = U / 8, rr = U % 8, nig = 8 * NT;
              for (int i = 0; i < 64; ++i) { const long Lid = (long)i * G + bid; if (Lid >= U) break; ++nu;
                  if (tid == i) { int wg = (int)Lid; const int xcd = wg % 8, off = wg / 8; wg = (xcd < rr ? xcd * (q + 1) : rr * (q + 1) + (xcd - rr) * q) + off;
                      const int gid = wg / nig, fm = gid * 8, gsz = (MT - fm) < 8 ? (MT - fm) : 8; const int pm = fm + ((wg % nig) % gsz), pn = (wg % nig) / gsz;
                      int e = 0;
                      for (int qq = 1; qq < 32; ++qq) e += (mbase[qq] <= pm) ? 1 : 0;
                      ulist[3 * i] = pm | ((e * NT + pn) << 16); ulist[3 * i + 1] = (pm - mbase[e]) * 256; ulist[3 * i + 2] = cnts[e]; } } }
            __syncthreads();
            pg8::ListOrder S{ulist, nu};
            if (ph == 0) {
                if (IS_FP8(l)) { pg8::Gemm g{(const GAS pg8::h16_t*)XS, (const GAS pg8::h16_t*)(W1_T + (size_t)l * NEXP * 2048 * DM), PROWS, 2048, DM / 2, LIST, nullptr};
                    pg8::EpiSwigluT<true> E{(GAS unsigned char*)ACT, GIN(I_B1) + (size_t)l * NEXP * 2048, W8_INV};
                    pg8::gemm_phase<pg8::EpiSwigluT<true>, pg8::ListOrder, true, true>(Lp, g, S, E, tid); }
                else { pg8::Gemm g{(const GAS pg8::h16_t*)H, (const GAS pg8::h16_t*)(W1_T + (size_t)l * NEXP * 2048 * DM), PROWS, 2048, DM, LIST, nullptr};
                    pg8::EpiSwigluT<false> E{(GAS unsigned char*)ACT, GIN(I_B1) + (size_t)l * NEXP * 2048, 1.0f};
                    pg8::gemm_phase<pg8::EpiSwigluT<false>, pg8::ListOrder, true, false>(Lp, g, S, E, tid); } }
            else {
                if (IS_FP8(l)) { pg8::Gemm g{(const GAS pg8::h16_t*)ACT, (const GAS pg8::h16_t*)(W2_T + (size_t)l * NEXP * DM * DM), PROWS, 1024, DM / 2, nullptr, nullptr};
                    pg8::EpiDownT<true> E{(GAS unsigned char*)XS, GIN(I_B2) + (size_t)l * NEXP * DM, W8_INV};
                    pg8::gemm_phase<pg8::EpiDownT<true>, pg8::ListOrder, false, true>(Lp, g, S, E, tid); }
                else { pg8::Gemm g{(const GAS pg8::h16_t*)ACT, (const GAS pg8::h16_t*)(W2_T + (size_t)l * NEXP * DM * DM), PROWS, 1024, DM, nullptr, nullptr};
                    pg8::EpiDownT<false> E{(GAS unsigned char*)XS, GIN(I_B2) + (size_t)l * NEXP * DM, 1.0f};
                    pg8::gemm_phase<pg8::EpiDownT<false>, pg8::ListOrder, false, false>(Lp, g, S, E, tid); } }
            }
            xcd_barrier(bar);
            STAMP(3 + 9 * l + 6 + ph);
        }

if (PHMASK & 2048) { LAUNDER();
        for (int m = gw; m < NTOK; m += NGW) {
            const int b = m >> 12; const GAS float* md = MODL + (size_t)b * 6144;
            const GAS unsigned char* yr[4]; float gk[4];
#pragma unroll
            for (int k = 0; k < 4; ++k) { const int e = ROUTE_E[(size_t)m * 4 + k], pos = ROUTE_POS[(size_t)m * 4 + k]; gk[k] = ROUTE_G[(size_t)m * 4 + k]; yr[k] = (const GAS unsigned char*)XS + ((size_t)mbase[e] * 256 + pos) * DM * (IS_FP8(l) ? 1 : 2); }
            f32x4 v[4]; float s = 0.f;
#pragma unroll
            for (int j = 0; j < 4; ++j) { const int c = 4 * lane + 256 * j; f32x4 a = {0.f, 0.f, 0.f, 0.f};
#pragma unroll
                for (int k = 0; k < 4; ++k) {
                    if (IS_FP8(l)) { const int y8 = *(const GAS int*)(yr[k] + c); const f32x2 lo = __builtin_amdgcn_cvt_pk_f32_fp8(y8, false), hi = __builtin_amdgcn_cvt_pk_f32_fp8(y8, true);
                        a.x += gk[k] * lo.x; a.y += gk[k] * lo.y; a.z += gk[k] * hi.x; a.w += gk[k] * hi.y; }
                    else { const f16x4 y4 = *(const GAS f16x4*)(yr[k] + 2 * c); a.x += gk[k] * (float)y4[0]; a.y += gk[k] * (float)y4[1]; a.z += gk[k] * (float)y4[2]; a.w += gk[k] * (float)y4[3]; } }
                const f16x4 xh = *(const GAS f16x4*)(X + (size_t)m * DM + c); const f32x4 x1 = {(float)xh[0], (float)xh[1], (float)xh[2], (float)xh[3]}, g2 = *(const GAS f32x4*)(md + 5120 + c);
                v[j] = x1 + g2 * a; s += (v[j].x * v[j].x + v[j].y * v[j].y) + (v[j].z * v[j].z + v[j].w * v[j].w); }
            const float rstd = rsqrtf(wave_sum(s) * (1.f / DM) + EPS);
            if (l + 1 < DEPTH) {
                const GAS float* mdn = MOD + (size_t)((l + 1) * 8 + b) * 6144; const GAS float* g1 = GIN(I_N1G) + (l + 1) * DM;
#pragma unroll
                for (int j = 0; j < 4; ++j) { const int c = 4 * lane + 256 * j; { u32x2 wx; wx.x = pk_f16(v[j].x, v[j].y); wx.y = pk_f16(v[j].z, v[j].w); *(GAS u32x2*)(X + (size_t)m * DM + c) = wx; }
                    const f32x4 gg = *(const GAS f32x4*)(g1 + c), sh = *(const GAS f32x4*)(mdn + c), sc = *(const GAS f32x4*)(mdn + 1024 + c);
                    const f32x4 hq = (v[j] * rstd) * gg * (sc + 1.0f) + sh; if (NEED_H16(l + 1)) { u32x2 w; w.x = pk_f16(hq.x, hq.y); w.y = pk_f16(hq.z, hq.w); *(GAS u32x2*)(H + (size_t)m * DM + c) = w; }
                    if (PROJ_FP8 && l + 1 >= PROJ_FP8_FIRST) *(GAS unsigned*)(HB8 + (size_t)m * DM + c) = pk4_fp8(hq.x, hq.y, hq.z, hq.w); }
            } else {
#pragma unroll
                for (int j = 0; j < 4; ++j) { const int c = 4 * lane + 256 * j; const f32x4 gg = *(const GAS f32x4*)(GIN(I_FNG) + c); *(GAS f32x4*)(((GAS float*)AP->out) + (size_t)m * DM + c) = (v[j] * rstd) * gg; }
            }
        }
}
        STAMP(3 + 9 * l + 8);
        if (l + 1 < DEPTH) xcd_barrier(bar);
}

__global__ void __launch_bounds__(NWAVES * 64, 2) fwd_megakernel(Args args) {
    const int tid0 = threadIdx.x, wave0 = __builtin_amdgcn_readfirstlane(tid0 >> 6);
    const int G = gridDim.x, bid = blockIdx.x;
    const int NGW = G * NWAVES;
    LAS unsigned char* L = (LAS unsigned char*)lds;

    if (tid0 < 16) ((LAS unsigned*)(L + BARST_OFF))[tid0] = 0u;
    __syncthreads();
    STAMP(0);
    XcdBarrier bar = xcd_barrier_post((unsigned*)(args.ws + WS_CTL) + CW_BAR, (volatile LAS unsigned*)(L + BARST_OFF));

for (int rep_ = 0; rep_ < REPS(1); ++rep_) if (PHMASK & 1) { LAUNDER(); __syncthreads();
    {
        LAS float* cond = (LAS float*)Lp;
        LAS float* red = (LAS float*)(Lp + 32768);
        bool cond_ready = false;
        for (int it = bid; it < 192; it += G) {
            if (!cond_ready) { for (int i = tid; i < NB * DM; i += 512) { const float v = GIN(I_C)[i]; cond[i] = v * sigmoidf_(v); } __syncthreads(); cond_ready = true; }
            const int l = it / 96, n0 = (it % 96) * 64;
            const GAS float* wm = GIN(I_WMOD) + (size_t)l * DM * 6144 + n0 + lane;
            float a[8];
#pragma unroll
            for (int b = 0; b < 8; ++b) a[b] = 0.f;
            for (int k = wave * 128; k < wave * 128 + 128; ++k) { const float w = wm[(size_t)k * 6144];
#pragma unroll
                for (int b = 0; b < 8; ++b) a[b] += cond[b * DM + k] * w; }
#pragma unroll
            for (int b = 0; b < 8; ++b) red[(wave * 8 + b) * 64 + lane] = a[b];
            __syncthreads();
            { const int b = tid >> 6; float s = GIN(I_BMOD)[l * 6144 + n0 + lane];
#pragma unroll
              for (int w = 0; w < 8; ++w) s += red[(w * 8 + b) * 64 + lane];
              MOD[(size_t)(l * 8 + b) * 6144 + n0 + lane] = s; }
            __syncthreads();
        }
        __syncthreads();
        LAS float* scr = (LAS float*)(Lp + wave * 16640);
        for (int it = gw; it < DEPTH * 1536; it += NGW) {
            const int l = it / 1536; int r = it % 1536;
            if (r < 1024) { const int kb = r >> 6, nb = r & 63; if (NEED_H16(l)) transpose_item(GIN(I_WIN) + (size_t)l * DM * INW, DM, INW, WIN_T + (size_t)l * INW * DM, 32 * nb, 64 * kb, 32 * nb, nullptr, scr, lane);
                if (PROJ_FP8 && l >= PROJ_FP8_FIRST) transpose_item8(GIN(I_WIN) + (size_t)l * DM * INW, DM, INW, WIN8 + (size_t)l * INW * DM, 32 * nb, 64 * kb, 32 * nb, scr, lane); continue; } r -= 1024;
            { const int kb = r >> 5, nb = r & 31; transpose_item(GIN(I_WOUT) + (size_t)l * DM * DM, DM, DM, WOUT_T + (size_t)l * DM * DM, 32 * nb, 64 * kb, 32 * nb, GIN(I_MIXG) + l * DM, scr, lane, kb < 4 ? 64 * kb + 256 : (kb < 8 ? 64 * kb - 256 : 64 * kb)); }
        }
        static_assert(FP8_FIRST == 0, "the 64x64 expert-weight items below write fp8");
        constexpr int PER_L = 32 * 512 + 32 * 256;
        for (int it = gw; it < DEPTH * PER_L; it += NGW) {
            const int l = it / PER_L; int r = it % PER_L;
            if (r < 32 * 512) { const int e = r >> 9, q = r & 511, kb = q >> 5, nb = q & 31, n0 = 64 * nb;
                const int bj = n0 >> 10, jj = n0 & 1023, orow = (jj >> 7) * 256 + bj * 128 + (jj & 127);
                transpose_item8x64(GIN(I_W1) + ((size_t)l * NEXP + e) * DM * 2048, DM, 2048, (GAS unsigned char*)(W1_T + (size_t)l * NEXP * 2048 * DM) + (size_t)e * 2048 * DM, orow, 64 * kb, n0, scr, lane); continue; } r -= 32 * 512;
            { const int e = r >> 8, q = r & 255, kb = q >> 4, nb = q & 15;
                transpose_item8x64(GIN(I_W2) + ((size_t)l * NEXP + e) * DM * DM, DM, DM, (GAS unsigned char*)(W2_T + (size_t)l * NEXP * DM * DM) + (size_t)e * DM * DM, 64 * nb, 64 * kb, 64 * nb, scr, lane); }
        }
        for (int i = bid * 512 + tid; i < NB * 16 * 256; i += G * 512) KMEAN[i] = 0.f;
        for (int i = bid * 512 + tid; i < DEPTH * 4 * 128 * 128; i += G * 512) { const int jj = i & 127, ii = (i >> 7) & 127; SGUW[i] = (f16)(jj <= ii ? GIN(I_SGUW)[i] : 0.f); }
        for (int i = bid * 512 + tid; i < DEPTH * 4 * 64 * 64; i += G * 512) { const int c = i & 63, d = (i >> 6) & 63, g = (i >> 12) & 3, ll = i >> 14; PWT[i] = (f16)GIN(I_POOLW)[(((size_t)ll * 4 + g) * 64 + c) * 64 + d]; }
        for (int i = bid * 512 + tid; i < DEPTH * 32 * 1024; i += G * 512) { const int k = i & 1023, e = (i >> 10) & 31, ll = i >> 15; RWT16[(size_t)(ll * 32 + e) * 1032 + k] = (f16)GIN(I_RW)[((size_t)ll * DM + k) * NEXP + e]; }
    }
}
    xcd_barrier(bar);
    STAMP(1);

for (int rep_ = 0; rep_ < REPS(2); ++rep_) if (PHMASK & 2) { LAUNDER();
    for (int m = gw; m < NTOK; m += NGW) { const int b = m >> 12; const GAS float* md = MOD + (size_t)b * 6144;
        norm_mod_row(GIN(I_X) + (size_t)m * DM, GIN(I_N1G), md, md + 1024, H + (size_t)m * DM, HB8 + (size_t)m * DM, lane); }
}
    xcd_barrier(bar);
    STAMP(2);

    layer_body(0, bar, tid0, wave0, G, bid, NGW);
    layer_body(1, bar, tid0, wave0, G, bid, NGW);
    if (TSEL_B > 0 && bid == 0 && tid0 == 0) { const LAS unsigned long long* st = (const LAS unsigned long long*)((LAS unsigned char*)lds + STAMP_OFF);
        asm volatile("s_waitcnt vmcnt(0)" ::: "memory");
        args.out[0] += (float)(st[TSEL_B] - st[TSEL_A]) * 0.01f / TSCALE; }
}


extern "C" void kernel_launch(void* const* d_in, const int* in_sizes, int n_in, void* d_out, int out_size, void* d_ws, size_t ws_size, hipStream_t stream) {
    static int grid = 0;
    if (grid == 0) {
        if (n_in != 27 || out_size != NTOK * DM || ws_size < WS_END) { fprintf(stderr, "kernel_launch: unexpected shapes (n_in %d, out %d, ws %zu)\n", n_in, out_size, ws_size); grid = -1; return; }
        int dev = 0, cus = 0, per_cu = 0;
        if (hipGetDevice(&dev) != hipSuccess || hipDeviceGetAttribute(&cus, hipDeviceAttributeMultiprocessorCount, dev) != hipSuccess) { grid = -1; return; }
        if (hipFuncSetAttribute((const void*)fwd_megakernel, hipFuncAttributeMaxDynamicSharedMemorySize, LDS_BYTES) != hipSuccess) { fprintf(stderr, "kernel_launch: hipFuncSetAttribute failed\n"); grid = -1; return; }
        if (hipOccupancyMaxActiveBlocksPerMultiprocessor(&per_cu, (const void*)fwd_megakernel, NWAVES * 64, LDS_BYTES) != hipSuccess || per_cu < 1) { fprintf(stderr, "kernel_launch: occupancy query says %d blocks per CU\n", per_cu); (void)hipGetLastError(); grid = -1; return; }
        grid = cus;
    }
    if (grid < 0) return;
    (void)hipMemsetAsync((char*)d_ws + WS_CTL, 0, CTL_ZERO_BYTES, stream);
    Args a{};
    for (int i = 0; i < 27; ++i) a.in[i] = (const float*)d_in[i];
    a.out = (float*)d_out; a.ws = (unsigned char*)d_ws;
    hipLaunchKernelGGL(fwd_megakernel, dim3(grid), dim3(NWAVES * 64), LDS_BYTES, stream, a);
}
```

```cpp
#include <hip/hip_runtime.h>
#include <cstdio>
#include <cstdint>

#define LAS __attribute__((address_space(3)))
#define GAS __attribute__((address_space(1)))
#define CAS __attribute__((address_space(4)))
typedef _Float16 f16;
typedef _Float16 f16x8 __attribute__((ext_vector_type(8)));
typedef _Float16 f16x4 __attribute__((ext_vector_type(4)));
typedef _Float16 f16x2 __attribute__((ext_vector_type(2)));
typedef float f32x2 __attribute__((ext_vector_type(2)));
typedef float f32x4 __attribute__((ext_vector_type(4)));
typedef float f32x16 __attribute__((ext_vector_type(16)));
typedef unsigned u32x2 __attribute__((ext_vector_type(2)));
typedef unsigned u32x4 __attribute__((ext_vector_type(4)));
typedef short v4i16_t __attribute__((ext_vector_type(4)));
typedef int i32x4 __attribute__((ext_vector_type(4)));
typedef int i32x8 __attribute__((ext_vector_type(8)));

constexpr int DM = 1024, NB = 8, SEQ = 4096, NTOK = NB * SEQ, DEPTH = 2, GW = 256, INW = 2048;
constexpr int NEXP = 32, TOPK = 4;
constexpr int PROWS = NTOK * TOPK + NEXP * 256;
constexpr float EPS = 1e-6f;
constexpr int LISTCAP = NTOK;
constexpr int FP8_FIRST = 0;
#define IS_FP8(l_) ((l_) >= FP8_FIRST)
constexpr int FP8_LAYER_UNUSED = 1;
constexpr float W8_SCALE = 32.0f, W8_INV = 1.0f / 32.0f;
#define PROJ_FP8_FIRST 0
#ifndef PROJ_FP8
#define PROJ_QK_FP8 1
#define NEED_H16(l) (!(PROJ_FP8 && PROJ_QK_FP8 && (l) >= PROJ_FP8_FIRST))
#define PROJ_FP8 1
#endif

__device__ __forceinline__ unsigned pk_f16(float lo, float hi) { f32x2 v = {lo, hi}; f16x2 h = __builtin_convertvector(v, f16x2); return __builtin_bit_cast(unsigned, h); }
__device__ __forceinline__ float row16_sum(float v) {
    v += __builtin_bit_cast(float, __builtin_amdgcn_update_dpp(0, __builtin_bit_cast(int, v), 0xB1, 0xf, 0xf, true));
    v += __builtin_bit_cast(float, __builtin_amdgcn_update_dpp(0, __builtin_bit_cast(int, v), 0x4E, 0xf, 0xf, true));
    v += __builtin_bit_cast(float, __builtin_amdgcn_update_dpp(0, __builtin_bit_cast(int, v), 0x141, 0xf, 0xf, true));
    v += __builtin_bit_cast(float, __builtin_amdgcn_update_dpp(0, __builtin_bit_cast(int, v), 0x140, 0xf, 0xf, true));
    return v;
}
__device__ __forceinline__ unsigned pk4_fp8(float a, float b, float c, float d) { int p = 0; p = __builtin_amdgcn_cvt_pk_fp8_f32(a, b, p, false); p = __builtin_amdgcn_cvt_pk_fp8_f32(c, d, p, true); return (unsigned)p; }
__device__ __forceinline__ float max3f(float a, float b, float c) { float r; asm("v_max3_f32 %0, %1, %2, %3" : "=v"(r) : "v"(a), "v"(b), "v"(c)); return r; }
__device__ __forceinline__ float max2f(float a, float b) { float r; asm("v_max_f32_e32 %0, %1, %2" : "=v"(r) : "v"(a), "v"(b)); return r; }
__device__ __forceinline__ float fadd_s(float a, float b) { float r; asm("v_add_f32_e32 %0, %1, %2" : "=v"(r) : "v"(a), "v"(b)); return r; }
template <int N> __device__ __forceinline__ void wave_sum_n(float (&v)[N]) {
#pragma unroll
    for (int i = 0; i < N; ++i) v[i] += __builtin_bit_cast(float, __builtin_amdgcn_update_dpp(0, __builtin_bit_cast(int, v[i]), 0xB1, 0xf, 0xf, true));
#pragma unroll
    for (int i = 0; i < N; ++i) v[i] += __builtin_bit_cast(float, __builtin_amdgcn_update_dpp(0, __builtin_bit_cast(int, v[i]), 0x4E, 0xf, 0xf, true));
#pragma unroll
    for (int i = 0; i < N; ++i) v[i] += __builtin_bit_cast(float, __builtin_amdgcn_update_dpp(0, __builtin_bit_cast(int, v[i]), 0x141, 0xf, 0xf, true));
#pragma unroll
    for (int i = 0; i < N; ++i) v[i] += __builtin_bit_cast(float, __builtin_amdgcn_update_dpp(0, __builtin_bit_cast(int, v[i]), 0x140, 0xf, 0xf, true));
#pragma unroll
    for (int i = 0; i < N; ++i) v[i] += __shfl_xor(v[i], 16);
#pragma unroll
    for (int i = 0; i < N; ++i) v[i] += __shfl_xor(v[i], 32);
}
__device__ __forceinline__ float wave_sum(float v) {
    v = row16_sum(v);
    v += __shfl_xor(v, 16); v += __shfl_xor(v, 32);
    return v;
}
__device__ __forceinline__ float sigmoidf_(float x) { return __builtin_amdgcn_rcpf(1.f + __expf(-x)); }
__device__ __forceinline__ float gelu_erf(float v) {
    const float av = fabsf(v), d = av * 0.2316418882f + 1.0f, t = __builtin_amdgcn_rcpf(d);
    float q = t * 0.5307027145f + (-0.7265760135f); q = q * t + 0.7107068705f; q = q * t + (-0.142248368f); q = q * t + 0.127414796f; q = q * t;
    const float e = __builtin_amdgcn_exp2f((v * v) * (-0.72134752044f));
    const float m = v * (q * e);
    return v < 0.f ? m : v - m;
}

#ifndef PROBE
#define PROBE 0
#endif
#ifndef TSEL_A
#define TSEL_A 0
#endif
#ifndef TSEL_B
#define TSEL_B 0
#endif
#ifndef TSCALE
#define TSCALE 16.0f
#endif
#define STAMP_OFF 146944
#define STAMP(k) do { if (TSEL_B > 0 && bid == 0 && tid0 == 0) ((__attribute__((address_space(3))) unsigned long long*)((__attribute__((address_space(3))) unsigned char*)lds + STAMP_OFF))[k] = __builtin_amdgcn_s_memrealtime(); } while (0)
namespace pg8 {
#define PG8_LAS __attribute__((address_space(3)))
typedef unsigned short h16_t;
constexpr int BM = 256, BK = 64, HALF = 128, HTB = HALF * BK * 2, STAGE_BYTES = 8 * HTB, NXCD = 8, WGM = 8;

__host__ __device__ __forceinline__ int lds_byte(int r, int c) { const int st = (r >> 4) * 2 + (c >> 5), rr = r & 15, cc = c & 31, ob = rr * 64 + cc * 2; return st * 1024 + (ob ^ (((ob >> 9) & 1) << 5)); }
__host__ __device__ __forceinline__ void stage_rc(int b, int& R, int& C) { const int st = b / 1024, sb = b % 1024, swz = sb ^ (((sb >> 9) & 1) << 5); R = (st >> 1) * 16 + swz / 64; C = (st & 1) * 32 + (swz % 64) / 2; }
__host__ __device__ __forceinline__ int perm32(int rho) { const int n = rho >> 4, i = rho & 15; return 8 * (i >> 2) + 4 * n + (i & 3); }

struct Unit { int pm, pn; };
struct Gemm { const GAS h16_t* A; const GAS h16_t* Bt; int M, N, K; const GAS int* rl; const GAS float* ssq; };

struct StaticOrder {
    int nM, nN, nwg, G, c;
    __host__ __device__ void init(int M, int N, int G_, int c_) { nM = M / BM; nN = N / BM; nwg = nM * nN; G = G_; c = c_; }
    __host__ __device__ bool next(int i, Unit& u) const {
        const long L = (long)i * G + c; if (L >= nwg) return false;
        int wgid = (int)L; { const int q = nwg / NXCD, r = nwg % NXCD, xcd = wgid % NXCD, off = wgid / NXCD; wgid = (xcd < r ? xcd * (q + 1) : r * (q + 1) + (xcd - r) * q) + off; }
        const int nig = WGM * nN, gid = wgid / nig, fm = gid * WGM, gsz = (nM - fm) < WGM ? (nM - fm) : WGM;
        u.pm = fm + ((wgid % nig) % gsz); u.pn = (wgid % nig) / gsz; return true;
    }
    __device__ __forceinline__ void a_ready(const Unit&) const {}
    __device__ __forceinline__ void done(const Unit&) const {}
    __device__ __forceinline__ void rows(int, int& r0, int& cnt) const { r0 = 0; cnt = 1; }
};
struct MapOrder : StaticOrder {
    unsigned map;
    __host__ __device__ bool next(int i, Unit& u) const { if (!StaticOrder::next(i, u)) return false; u.pn = (int)((map >> (4 * u.pn)) & 15u); return true; }
};
struct ListOrder {
    const PG8_LAS int* list; int n;
    __device__ __forceinline__ bool next(int i, Unit& u) const { if (i >= n) return false; const int v = __builtin_amdgcn_readfirstlane(list[3 * i]); u.pm = v & 0xffff; u.pn = v >> 16; return true; }
    __device__ __forceinline__ void rows(int i, int& r0, int& cnt) const { r0 = __builtin_amdgcn_readfirstlane(list[3 * i + 1]); cnt = __builtin_amdgcn_readfirstlane(list[3 * i + 2]); }
    __device__ __forceinline__ void a_ready(const Unit&) const {}
    __device__ __forceinline__ void done(const Unit&) const {}
};

struct Pre4 { f32x4 v[4]; };
struct EpiF16 {
    static constexpr bool PERM = true, PERM2 = true, AFTER_DRAIN = false, IS_DOWN = false, PRELOAD = false;
    GAS h16_t* O; int ldc; GAS float* ksum; float sc;
    __device__ __forceinline__ Pre4 pre(const Unit&, int, int, int, int) const { return Pre4{}; }
    __device__ __forceinline__ void operator()(const f32x4 (&acc)[2][2][4][2], const Unit& u, int wr, int wc, int fr, int fq, const Pre4&) const {
        const int row0 = u.pm * BM + wr * 64 + fr, col0 = u.pn * BM + wc * 64 + 16 * fq;
        if (u.pn == 3) {
#pragma unroll
            for (int bj = 0; bj < 2; ++bj)
#pragma unroll
                for (int n = 0; n < 2; ++n) { f32x4 s = (acc[0][bj][0][n] + acc[0][bj][1][n]) + (acc[0][bj][2][n] + acc[0][bj][3][n]); s += (acc[1][bj][0][n] + acc[1][bj][1][n]) + (acc[1][bj][2][n] + acc[1][bj][3][n]);
#pragma unroll
                    for (int i = 0; i < 4; ++i) { const float t = row16_sum(s[i]) * sc;
                        if (fr == 0) __hip_atomic_fetch_add(ksum + (size_t)u.pm * 256 + wc * 64 + 16 * fq + 8 * bj + 4 * n + i, t, __ATOMIC_RELAXED, __HIP_MEMORY_SCOPE_AGENT); } } }
#pragma unroll
        for (int ai = 0; ai < 2; ++ai)
#pragma unroll
            for (int m = 0; m < 4; ++m) { GAS h16_t* rowp = O + (size_t)(row0 + ai * HALF + m * 16) * ldc + col0;
#pragma unroll
                for (int bj = 0; bj < 2; ++bj) { const f32x4 v0 = acc[ai][bj][m][0] * sc, v1 = acc[ai][bj][m][1] * sc;
                    u32x4 w; w.x = pk_f16(v0[0], v0[1]); w.y = pk_f16(v0[2], v0[3]); w.z = pk_f16(v1[0], v1[1]); w.w = pk_f16(v1[2], v1[3]);
                    *(GAS u32x4*)(rowp + bj * 8) = w; } }
    }
};
template <bool BASE32> struct EpiResidT {
    static constexpr bool PERM = true, PERM2 = true, AFTER_DRAIN = false, IS_DOWN = false, PRELOAD = false;
    const GAS float* base32; const GAS h16_t* base16; GAS h16_t* out; const GAS float* gate;
    __device__ __forceinline__ Pre4 pre(const Unit& u, int wr, int wc, int fr, int fq) const { Pre4 p; const int col0 = u.pn * BM + wc * 64 + 16 * fq; const GAS float* gp = gate + (size_t)((u.pm * BM) >> 12) * 6144;
#pragma unroll
        for (int bj = 0; bj < 2; ++bj)
#pragma unroll
            for (int n = 0; n < 2; ++n) p.v[bj * 2 + n] = *(const GAS f32x4*)(gp + col0 + bj * 8 + 4 * n);
        return p; }
    __device__ __forceinline__ void operator()(const f32x4 (&acc)[2][2][4][2], const Unit& u, int wr, int wc, int fr, int fq, const Pre4& pr) const {
        const int row0 = u.pm * BM + wr * 64 + fr, col0 = u.pn * BM + wc * 64 + 16 * fq;
        f32x4 gv[2][2];
#pragma unroll
        for (int bj = 0; bj < 2; ++bj)
#pragma unroll
            for (int n = 0; n < 2; ++n) gv[bj][n] = pr.v[bj * 2 + n];
#pragma unroll
        for (int ai = 0; ai < 2; ++ai)
#pragma unroll
            for (int m = 0; m < 4; ++m) { const size_t off = (size_t)(row0 + ai * HALF + m * 16) * DM + col0;
#pragma unroll
                for (int bj = 0; bj < 2; ++bj) { f32x4 b0, b1;
                    if constexpr (BASE32) { b0 = *(const GAS f32x4*)(base32 + off + bj * 8); b1 = *(const GAS f32x4*)(base32 + off + bj * 8 + 4); }
                    else { const f16x8 hb = *(const GAS f16x8*)(base16 + off + bj * 8); b0 = (f32x4){(float)hb[0], (float)hb[1], (float)hb[2], (float)hb[3]}; b1 = (f32x4){(float)hb[4], (float)hb[5], (float)hb[6], (float)hb[7]}; }
                    const f32x4 v0 = b0 + gv[bj][0] * acc[ai][bj][m][0], v1 = b1 + gv[bj][1] * acc[ai][bj][m][1];
                    u32x4 w; w.x = pk_f16(v0[0], v0[1]); w.y = pk_f16(v0[2], v0[3]); w.z = pk_f16(v1[0], v1[1]); w.w = pk_f16(v1[2], v1[3]);
                    *(GAS u32x4*)(out + off + bj * 8) = w; } }
    }
};
template <bool OUT8> struct EpiSwigluT {
    static constexpr bool PERM = true, PERM2 = false, AFTER_DRAIN = false, IS_DOWN = false, PRELOAD = true;
    GAS unsigned char* O; const GAS float* b1; float sc;
    __device__ __forceinline__ Pre4 pre(const Unit& u, int wr, int wc, int fr, int fq) const { Pre4 q; const int e = u.pn >> 3, p = u.pn & 7, hc = p * 128 + wc * 32 + 8 * fq; const GAS float* bp = b1 + (size_t)e * 2048 + hc;
#pragma unroll
        for (int n = 0; n < 2; ++n) { q.v[n] = *(const GAS f32x4*)(bp + 4 * n); q.v[2 + n] = *(const GAS f32x4*)(bp + 1024 + 4 * n); }
        return q; }
    __device__ __forceinline__ void operator()(const f32x4 (&acc)[2][2][4][2], const Unit& u, int wr, int wc, int fr, int fq, const Pre4& pr) const {
        const int p = u.pn & 7;
        const int row0 = u.pm * BM + wr * 64 + fr, hc = p * 128 + wc * 32 + 8 * fq;
        f32x4 bg[2], bl[2];
#pragma unroll
        for (int n = 0; n < 2; ++n) { bg[n] = pr.v[n]; bl[n] = pr.v[2 + n]; }
        u32x2 wprev = {0u, 0u};
#pragma unroll
        for (int ai = 0; ai < 2; ++ai)
#pragma unroll
            for (int m = 0; m < 4; ++m) { float r[8];
#pragma unroll
                for (int n = 0; n < 2; ++n) { const f32x4 g = acc[ai][0][m][n] * sc + bg[n], li = acc[ai][1][m][n] * sc + bl[n];
#pragma unroll
                    for (int i = 0; i < 4; ++i) { const float xg = fminf(g[i], 7.0f), xl = fminf(fmaxf(li[i], -7.0f), 7.0f);
                        r[4 * n + i] = xg * __builtin_amdgcn_rcpf(1.f + __expf(-1.702f * xg)) * (xl + 1.0f); } }
                if constexpr (OUT8) { u32x2 w; w.x = pk4_fp8(r[0], r[1], r[2], r[3]); w.y = pk4_fp8(r[4], r[5], r[6], r[7]);
                    if (m & 1) { const auto sx = __builtin_amdgcn_permlane16_swap(wprev.x, w.x, false, false), sy = __builtin_amdgcn_permlane16_swap(wprev.y, w.y, false, false);
                        u32x4 o; o.x = sx[0]; o.y = sy[0]; o.z = sx[1]; o.w = sy[1];
                        *(GAS u32x4*)(O + (size_t)(row0 + ai * HALF + (m - 1 + (fq & 1)) * 16) * DM + (hc - 8 * fq + 16 * (fq >> 1))) = o; }
                    else wprev = w; }
                else { u32x4 w; w.x = pk_f16(r[0], r[1]); w.y = pk_f16(r[2], r[3]); w.z = pk_f16(r[4], r[5]); w.w = pk_f16(r[6], r[7]);
                    *(GAS u32x4*)(O + ((size_t)(row0 + ai * HALF + m * 16) * DM + hc) * 2) = w; } }
    }
};
template <bool OUT8> struct EpiDownT {
    static constexpr bool PERM = true, PERM2 = true, AFTER_DRAIN = false, IS_DOWN = true, PRELOAD = true;
    GAS unsigned char* O; const GAS float* b2; float sc;
    __device__ __forceinline__ Pre4 pre(const Unit& u, int wr, int wc, int fr, int fq) const { Pre4 q; const int e = u.pn >> 2, p = u.pn & 3, col0 = p * BM + wc * 64 + 16 * fq; const GAS float* bp = b2 + (size_t)e * 1024 + col0;
#pragma unroll
        for (int bj = 0; bj < 2; ++bj)
#pragma unroll
            for (int n = 0; n < 2; ++n) q.v[bj * 2 + n] = *(const GAS f32x4*)(bp + bj * 8 + 4 * n);
        return q; }
    __device__ __forceinline__ void operator()(const f32x4 (&acc)[2][2][4][2], const Unit& u, int wr, int wc, int fr, int fq, const Pre4& pr) const {
        const int p = u.pn & 3;
        const int row0 = u.pm * BM + wr * 64 + fr, col0 = p * BM + wc * 64 + 16 * fq;
        f32x4 bv[2][2];
#pragma unroll
        for (int bj = 0; bj < 2; ++bj)
#pragma unroll
            for (int n = 0; n < 2; ++n) bv[bj][n] = pr.v[bj * 2 + n];
#pragma unroll
        for (int ai = 0; ai < 2; ++ai)
#pragma unroll
            for (int m = 0; m < 4; ++m) { const size_t ro = (size_t)(row0 + ai * HALF + m * 16) * DM + col0;
                if constexpr (OUT8) { u32x4 w;
#pragma unroll
                    for (int bj = 0; bj < 2; ++bj) { const f32x4 v0 = acc[ai][bj][m][0] * sc + bv[bj][0], v1 = acc[ai][bj][m][1] * sc + bv[bj][1];
                        w[2 * bj] = pk4_fp8(v0[0], v0[1], v0[2], v0[3]); w[2 * bj + 1] = pk4_fp8(v1[0], v1[1], v1[2], v1[3]); }
                    *(GAS u32x4*)(O + ro) = w; }
                else {
#pragma unroll
                    for (int bj = 0; bj < 2; ++bj) { const f32x4 v0 = acc[ai][bj][m][0] * sc + bv[bj][0], v1 = acc[ai][bj][m][1] * sc + bv[bj][1];
                        u32x4 w; w.x = pk_f16(v0[0], v0[1]); w.y = pk_f16(v0[2], v0[3]); w.z = pk_f16(v1[0], v1[1]); w.w = pk_f16(v1[2], v1[3]);
                        *(GAS u32x4*)(O + (ro + bj * 8) * 2) = w; } } }
    }
};

template <class Epi, class Sched, bool GATHER = false, bool FP8 = false, bool ROWSCALE = false>
__device__ __forceinline__ void gemm_phase(PG8_LAS unsigned char* lds, const Gemm g, const Sched& S, const Epi& E, const int tid) {
    const int wid = __builtin_amdgcn_readfirstlane(tid >> 6), lane = tid & 63, wr = wid >> 2, wc = wid & 3, fr = lane & 15, fq = lane >> 4;
    const int K = g.K, nt = K / BK;
    const size_t kstep = (size_t)(BK * 2);
    const size_t hstep = (size_t)HALF * K * 2;
    const size_t tstep = 2 * hstep;
    const size_t bstep = Epi::PERM2 ? (size_t)8 * K * 2 : hstep;
    unsigned voffB[2], oc0[2], oc1[2], on0[2], on1[2];
#pragma unroll
    for (int i = 0; i < 2; ++i) { int R, C; stage_rc(tid * 16 + i * 8192, R, C); const int Rb = Epi::PERM2 ? (64 * (R >> 5) + 16 * ((R & 15) >> 2) + 4 * ((R >> 4) & 1) + (R & 3)) : (Epi::PERM ? ((R & ~31) + perm32(R & 31)) : R);
        voffB[i] = (unsigned)(Rb * K + C) * 2u;
        oc0[i] = (unsigned)(R * K + C) * 2u; oc1[i] = oc0[i] + (unsigned)hstep; on0[i] = oc0[i]; on1[i] = oc1[i]; }
    const unsigned ldsw = (unsigned)wid * 1024u;
    const int aoff = lds_byte(wr * 64 + fr, fq * 8), boff = lds_byte(wc * 32 + fr, fq * 8);
#define PG8_SA(b, h) (((b) * 2 + (h)) * HTB)
#define PG8_SB(b, h) ((4 + (b) * 2 + (h)) * HTB)
#define PG8_STAGE(bufoff, gbase, voff) do { _Pragma("unroll") for (int _i = 0; _i < 2; ++_i) { unsigned vo_ = (voff)[_i]; asm volatile("" : "+v"(vo_)); \
        __builtin_amdgcn_global_load_lds((const GAS unsigned*)((const GAS char*)(gbase) + vo_), (PG8_LAS unsigned*)(lds + (bufoff) + ldsw + _i * 8192), 16, 0, 0); } } while (0)
#define PG8_LDA(dst, b, h) do { if constexpr (FP8) { _Pragma("unroll") for (int m = 0; m < 4; ++m) { \
            const i32x4 lo_ = *(const PG8_LAS i32x4*)(lds + PG8_SA(b, h) + aoff + m * 2048), hi_ = *(const PG8_LAS i32x4*)(lds + PG8_SA(b, h) + aoff + m * 2048 + 1024); \
            dst##8[m] = (i32x8){lo_[0], lo_[1], lo_[2], lo_[3], hi_[0], hi_[1], hi_[2], hi_[3]}; } } \
        else { _Pragma("unroll") for (int m = 0; m < 4; ++m) _Pragma("unroll") for (int k = 0; k < 2; ++k) dst[m][k] = *(const PG8_LAS f16x8*)(lds + PG8_SA(b, h) + aoff + m * 2048 + k * 1024); } } while (0)
#define PG8_LDB(dst, b, h) do { if constexpr (FP8) { _Pragma("unroll") for (int n = 0; n < 2; ++n) { \
            const i32x4 lo_ = *(const PG8_LAS i32x4*)(lds + PG8_SB(b, h) + boff + n * 2048), hi_ = *(const PG8_LAS i32x4*)(lds + PG8_SB(b, h) + boff + n * 2048 + 1024); \
            dst##8[n] = (i32x8){lo_[0], lo_[1], lo_[2], lo_[3], hi_[0], hi_[1], hi_[2], hi_[3]}; } } \
        else { _Pragma("unroll") for (int n = 0; n < 2; ++n) _Pragma("unroll") for (int k = 0; k < 2; ++k) dst[n][k] = *(const PG8_LAS f16x8*)(lds + PG8_SB(b, h) + boff + n * 2048 + k * 1024); } } while (0)
#define PG8_MMA(ai, bj, At, Bt) do { __builtin_amdgcn_s_setprio(1); \
        if constexpr (FP8) { _Pragma("unroll") for (int m = 0; m < 4; ++m) _Pragma("unroll") for (int n = 0; n < 2; ++n) \
            acc[ai][bj][m][n] = __builtin_amdgcn_mfma_scale_f32_16x16x128_f8f6f4(Bt##8[n], At##8[m], acc[ai][bj][m][n], 0, 0, 0, 0x7f7f7f7f, 0, 0x7f7f7f7f); } \
        else { _Pragma("unroll") for (int m = 0; m < 4; ++m) _Pragma("unroll") for (int n = 0; n < 2; ++n) _Pragma("unroll") for (int k = 0; k < 2; ++k) \
            acc[ai][bj][m][n] = __builtin_amdgcn_mfma_f32_16x16x32_f16(Bt[n][k], At[m][k], acc[ai][bj][m][n], 0, 0, 0); } \
        __builtin_amdgcn_s_setprio(0); } while (0)
#define PG8_WAIT_V(n) asm volatile("s_waitcnt vmcnt(" #n ")" ::: "memory")
#define PG8_WAIT_L(n) asm volatile("s_waitcnt lgkmcnt(" #n ")" ::: "memory")
#define PG8_BAR __builtin_amdgcn_s_barrier()
#define PG8_SCHED __builtin_amdgcn_sched_barrier(0)
#define PG8_GOFF(ix, un, o0, o1) do { int r0_, cnt_; S.rows(ix, r0_, cnt_); const GAS int* lp_ = g.rl + (size_t)((un).pn >> 3) * LISTCAP; \
        _Pragma("unroll") for (int _i = 0; _i < 2; ++_i) { int R_, C_; stage_rc(tid * 16 + _i * 8192, R_, C_); int ra_ = r0_ + R_, rb_ = ra_ + HALF; ra_ = ra_ < cnt_ ? ra_ : cnt_ - 1; rb_ = rb_ < cnt_ ? rb_ : cnt_ - 1; \
            (o0)[_i] = (unsigned)lp_[ra_] * (unsigned)(K * 2) + (unsigned)C_ * 2u; (o1)[_i] = (unsigned)lp_[rb_] * (unsigned)(K * 2) + (unsigned)C_ * 2u; } } while (0)
    Unit cur, nxt; int ui = 0;
    if (!S.next(0, cur)) return;
    f32x4 acc[2][2][4][2];
#pragma unroll
    for (int a = 0; a < 2; ++a)
#pragma unroll
        for (int b = 0; b < 2; ++b)
#pragma unroll
            for (int m = 0; m < 4; ++m)
#pragma unroll
                for (int n = 0; n < 2; ++n) acc[a][b][m][n] = (f32x4){0.f, 0.f, 0.f, 0.f};
    f16x8 At[4][2], B0[2][2], B1[2][2]; i32x8 At8[4], B08[2], B18[2]; (void)At; (void)B0; (void)B1; (void)At8; (void)B08; (void)B18;
    const GAS char* cA = (const GAS char*)g.A + (GATHER ? (size_t)0 : (size_t)cur.pm * tstep); const GAS char* cB = (const GAS char*)g.Bt + (size_t)cur.pn * tstep;
    if constexpr (GATHER) PG8_GOFF(0, cur, oc0, oc1);
    S.a_ready(cur);
    PG8_STAGE(PG8_SB(0, 0), cB, voffB); PG8_STAGE(PG8_SB(0, 1), cB + bstep, voffB); PG8_STAGE(PG8_SA(0, 0), cA, oc0); PG8_STAGE(PG8_SA(0, 1), cA, oc1);
    if (wr == 1) PG8_BAR;
    PG8_WAIT_V(2); PG8_BAR;
    PG8_STAGE(PG8_SB(1, 0), cB + kstep, voffB); PG8_STAGE(PG8_SA(1, 0), cA + kstep, oc0); PG8_STAGE(PG8_SB(1, 1), cB + bstep + kstep, voffB);
    PG8_WAIT_V(6); PG8_BAR;
    for (;;) {
        const bool has_next = S.next(ui + 1, nxt);
        const GAS char* nA = (has_next && !GATHER) ? (const GAS char*)g.A + (size_t)nxt.pm * tstep : cA; const GAS char* nB = has_next ? (const GAS char*)g.Bt + (size_t)nxt.pn * tstep : cB;
        if constexpr (GATHER) { if (has_next) PG8_GOFF(ui + 1, nxt, on0, on1); }
        Pre4 epre; if constexpr (Epi::PRELOAD) epre = E.pre(cur, wr, wc, fr, fq);
#pragma unroll 1
        for (int t = 0; t < nt; ++t) {
            const int b = t & 1;
            const bool w1 = (t + 1 >= nt), w2 = (t + 2 >= nt);
            const GAS char* a1 = (w1 ? nA : cA) + (size_t)(w1 ? t + 1 - nt : t + 1) * kstep;
            const GAS char* a2 = (w2 ? nA : cA) + (size_t)(w2 ? t + 2 - nt : t + 2) * kstep;
            const GAS char* b2 = (w2 ? nB : cB) + (size_t)(w2 ? t + 2 - nt : t + 2) * kstep;
            unsigned x0[2], y1[2];
#pragma unroll
            for (int i = 0; i < 2; ++i) { y1[i] = (GATHER && w1 && has_next) ? on1[i] : oc1[i]; x0[i] = (GATHER && w2 && has_next) ? on0[i] : oc0[i]; }
            if (t == nt - 2 && has_next) S.a_ready(nxt);
            if constexpr (ROWSCALE) { if (t == 4) {
#pragma unroll
                for (int ai = 0; ai < 2; ++ai) { f32x4 q4[4];
#pragma unroll
                    for (int m = 0; m < 4; ++m) q4[m] = *(const GAS f32x4*)(g.ssq + (size_t)(cur.pm * BM + ai * HALF + wr * 64 + m * 16 + fr) * 4);
#pragma unroll
                    for (int m = 0; m < 4; ++m) { const float rs = rsqrtf(((q4[m].x + q4[m].y) + (q4[m].z + q4[m].w)) * (1.f / 256.f) + EPS);
#pragma unroll
                        for (int bj = 0; bj < 2; ++bj)
#pragma unroll
                            for (int n = 0; n < 2; ++n) acc[ai][bj][m][n] *= rs; } } } }
            PG8_LDB(B0, b, 0); PG8_LDB(B1, b, 1); PG8_SCHED; PG8_LDA(At, b, 0); PG8_STAGE(PG8_SA(b ^ 1, 1), a1, y1);
            PG8_WAIT_V(8); PG8_WAIT_L(0); PG8_BAR; PG8_MMA(0, 0, At, B0); PG8_MMA(0, 1, At, B1); PG8_BAR; PG8_SCHED;
            PG8_LDA(At, b, 1); PG8_STAGE(PG8_SB(b, 0), b2, voffB); PG8_STAGE(PG8_SB(b, 1), b2 + bstep, voffB); PG8_STAGE(PG8_SA(b, 0), a2, x0);
            PG8_WAIT_V(8); PG8_WAIT_L(0); PG8_BAR; PG8_MMA(1, 0, At, B0); PG8_MMA(1, 1, At, B1); PG8_BAR; PG8_SCHED;
        }
        if (wr == 0) PG8_BAR;
        if constexpr (!Epi::PRELOAD) epre = E.pre(cur, wr, wc, fr, fq);
        E(acc, cur, wr, wc, fr, fq, epre); S.done(cur);
        if (!has_next) break;
#pragma unroll
        for (int a = 0; a < 2; ++a)
#pragma unroll
            for (int b = 0; b < 2; ++b)
#pragma unroll
                for (int m = 0; m < 4; ++m)
#pragma unroll
                    for (int n = 0; n < 2; ++n) acc[a][b][m][n] = (f32x4){0.f, 0.f, 0.f, 0.f};
        cur = nxt; cA = nA; cB = nB; ++ui;
        if constexpr (GATHER) {
#pragma unroll
            for (int i = 0; i < 2; ++i) { oc0[i] = on0[i]; oc1[i] = on1[i]; } }
        if (wr == 1) PG8_BAR;
    }
    PG8_WAIT_V(0);
    PG8_BAR;
#undef PG8_SA
#undef PG8_SB
#undef PG8_STAGE
#undef PG8_LDA
#undef PG8_LDB
#undef PG8_MMA
#undef PG8_WAIT_V
#undef PG8_WAIT_L
#undef PG8_BAR
#undef PG8_SCHED
#undef PG8_GOFF
}
}

constexpr size_t MiB = 1u << 20;
constexpr size_t WS_CTL   = 0,            CTL_ZERO_BYTES = 1 * MiB;
constexpr size_t WS_MOD   = 1 * MiB;
constexpr size_t WS_KMEAN = 2 * MiB;
constexpr size_t WS_SSQ   = 2 * MiB + 512 * 1024;
constexpr size_t WS_SGUW  = 3 * MiB;
constexpr size_t WS_RWT   = 3 * MiB + 512 * 1024;
constexpr size_t WS_PWT   = 3 * MiB + 768 * 1024;
constexpr size_t WS_ROUTE = 4 * MiB;
constexpr size_t WS_LIST  = 6 * MiB;
constexpr size_t WS_WIN   = 10 * MiB;
constexpr size_t WS_WOUT  = 18 * MiB;
constexpr size_t WS_W1    = 22 * MiB;
constexpr size_t WS_W2    = 278 * MiB;
constexpr size_t WS_X     = 406 * MiB;
constexpr size_t WS_H     = 534 * MiB;
constexpr size_t WS_PROJ  = 598 * MiB;
constexpr size_t WS_MIX   = 726 * MiB;
constexpr size_t WS_XS    = 790 * MiB;
constexpr size_t WS_ACT   = 1062 * MiB;
constexpr size_t WS_WIN8  = 1334 * MiB;
constexpr size_t WS_HB8   = 1338 * MiB;
constexpr size_t WS_END   = 1370 * MiB;
constexpr int CW_BAR = 4096;
constexpr int CW_CNT = 16384;

constexpr int RING_BYTES = 131072;
constexpr int LDS_BYTES = 147456;
constexpr int BARST_OFF = LDS_BYTES - 64;
constexpr int NWAVES = 8;
#ifndef PH3
#define PH3 15
#endif
#define GIN(k) ((const GAS float*)AP->in[k])
#define REPS(bit) (((PROBE) & (bit)) ? 2 : 1)
#ifndef PHMASK
#define PHMASK 0xFFFF
#endif

#define XB_TMO      128
#define XB_XCNT(j)  (256  + 64 * (j))
#define XB_XSUB(j)  (1280 + 64 * (j))
#define XB_XGEN(j)  (2304 + 64 * (j))
#define XB_TOP      3328
#define XB_TOPGEN   3392
#define XCD_BAR_WORDS 3456
#define XB_SPIN_CAP (1u << 20)
__device__ __forceinline__ unsigned xb_ld(unsigned* p)              { return __hip_atomic_load(p, __ATOMIC_RELAXED, __HIP_MEMORY_SCOPE_AGENT); }
__device__ __forceinline__ unsigned xb_add(unsigned* p, unsigned v) { return __hip_atomic_fetch_add(p, v, __ATOMIC_RELAXED, __HIP_MEMORY_SCOPE_AGENT); }
__device__ __forceinline__ unsigned xb_xcc_id() { return (unsigned)__builtin_amdgcn_s_getreg((3 << 11) | 20) & 0xFu; }
#define XB_SPIN(cond, bar) do { unsigned _sp = 0; while (cond) { __builtin_amdgcn_s_sleep(1); \
    if ((++_sp & 255u) == 0u) { if (xb_ld(&(bar)[XB_TMO])) break; if (_sp > XB_SPIN_CAP) { atomicAdd(&(bar)[XB_TMO], 1u); break; } } } } while (0)
struct XcdBarrier { unsigned* bar; unsigned x; volatile LAS unsigned* st; };
__device__ __forceinline__ XcdBarrier xcd_barrier_post(unsigned* bar, volatile LAS unsigned* st) {
    XcdBarrier b; b.bar = bar; b.x = xb_xcc_id(); b.st = st;
    if (threadIdx.x == 0) (void)xb_add(&bar[XB_XCNT(b.x)], 1u);
    return b;
}
__device__ __forceinline__ void xcd_barrier_complete(unsigned* bar, unsigned x, unsigned& nloc, unsigned& nx) {
    const unsigned G = gridDim.x * gridDim.y * gridDim.z;
    unsigned sum, cnt, mine, sp = 0u;
    for (;;) {
        sum = 0u; cnt = 0u; mine = 0u;
#pragma unroll
        for (unsigned j = 0; j < 16; ++j) { const unsigned c = xb_ld(&bar[XB_XCNT(j)]); sum += c; cnt += (c > 0u) ? 1u : 0u; mine = (j == x) ? c : mine; }
        if (sum == G) break;
        __builtin_amdgcn_s_sleep(1);
        if ((++sp & 255u) == 0u) { if (xb_ld(&bar[XB_TMO])) break; if (sp > XB_SPIN_CAP) { atomicAdd(&bar[XB_TMO], 1u); break; } }
    }
    nloc = mine > 0u ? mine : 1u; nx = cnt > 0u ? cnt : 1u;
}
__device__ __forceinline__ void xcd_barrier(const XcdBarrier& b) {
    asm volatile("s_waitcnt vmcnt(0)" ::: "memory");
    __syncthreads();
    if (threadIdx.x == 0) {
        unsigned* bar = b.bar; asm volatile("" : "+s"(bar));
        unsigned bx = b.x; asm volatile("" : "+s"(bx));
        __builtin_amdgcn_s_waitcnt(0);
        unsigned nloc = b.st[0], nx = b.st[1];
        if (nloc == 0u) { xcd_barrier_complete(bar, bx, nloc, nx); b.st[0] = nloc; b.st[1] = nx; }
        const unsigned old = xb_add(&bar[XB_XSUB(bx)], 1u);
        const unsigned gen = old / nloc;
        if (old + 1u == (gen + 1u) * nloc) {
            __builtin_amdgcn_fence(__ATOMIC_RELEASE, "agent");
            asm volatile("s_waitcnt vmcnt(0)" ::: "memory");
            const unsigned og = xb_add(&bar[XB_TOP], 1u);
            const unsigned tg = og / nx;
            if (og + 1u == (tg + 1u) * nx) xb_add(&bar[XB_TOPGEN], 1u);
            else XB_SPIN(xb_ld(&bar[XB_TOPGEN]) == tg, bar);
            __builtin_amdgcn_fence(__ATOMIC_ACQUIRE, "agent");
            xb_add(&bar[XB_XGEN(bx)], 1u);
            asm volatile("s_waitcnt vmcnt(0)" ::: "memory");
        } else {
            XB_SPIN(xb_ld(&bar[XB_XGEN(bx)]) == gen, bar);
            __builtin_amdgcn_fence(__ATOMIC_ACQUIRE, "agent");
            asm volatile("s_waitcnt vmcnt(0)" ::: "memory");
        }
    }
    __syncthreads();
}

struct Args { const float* in[27]; float* out; unsigned char* ws; };
enum { I_X = 0, I_C, I_WMOD, I_BMOD, I_N1G, I_WIN, I_CONVW, I_CONVB, I_CNG, I_CNB, I_RELB, I_POOLW, I_POOLS, I_SNG, I_SNB, I_SGUW, I_SGUB, I_MIXG, I_WOUT, I_N2G, I_RW, I_RB, I_W1, I_B1, I_W2, I_B2, I_FNG };

__device__ __forceinline__ int t5_bucket(int n) {
    if (n < 16) return n;
    int b = 16;
    b += (n >= 19); b += (n >= 21); b += (n >= 24); b += (n >= 27); b += (n >= 31); b += (n >= 35); b += (n >= 40); b += (n >= 46);
    b += (n >= 52); b += (n >= 59); b += (n >= 67); b += (n >= 77); b += (n >= 87); b += (n >= 99); b += (n >= 113);
    return b;
}

__device__ __forceinline__ void transpose_item(const GAS float* W, int K, int N, GAS f16* WT, int orow0, int k0, int n0, const GAS float* kscale, LAS float* scr, int lane, int ko = -1) {
    if (ko < 0) ko = k0;
#pragma unroll 8
    for (int i = 0; i < 32; ++i) { const int kk = 2 * i + (lane >> 5); float v = W[(size_t)(k0 + kk) * N + n0 + (lane & 31)]; if (kscale) v *= kscale[k0 + kk]; scr[kk * 33 + (lane & 31)] = v; }
    asm volatile("s_waitcnt lgkmcnt(0)" ::: "memory");
    const int c = lane & 7;
#pragma unroll
    for (int j = 0; j < 4; ++j) { const int n = (lane >> 3) + 8 * j; const LAS float* s = scr + (8 * c) * 33 + n;
        u32x4 o; o.x = pk_f16(s[0 * 33], s[1 * 33]); o.y = pk_f16(s[2 * 33], s[3 * 33]); o.z = pk_f16(s[4 * 33], s[5 * 33]); o.w = pk_f16(s[6 * 33], s[7 * 33]);
        *(GAS u32x4*)(WT + (size_t)(orow0 + n) * K + ko + 8 * c) = o; }
    asm volatile("s_waitcnt lgkmcnt(0)" ::: "memory");
}

__device__ __forceinline__ void transpose_item8(const GAS float* W, int K, int N, GAS unsigned char* WT, int orow0, int k0, int n0, LAS float* scr, int lane) {
#pragma unroll 8
    for (int i = 0; i < 32; ++i) { const int kk = 2 * i + (lane >> 5); scr[kk * 33 + (lane & 31)] = W[(size_t)(k0 + kk) * N + n0 + (lane & 31)] * W8_SCALE; }
    asm volatile("s_waitcnt lgkmcnt(0)" ::: "memory");
    const int c = lane & 7;
#pragma unroll
    for (int j = 0; j < 4; ++j) { const int n = (lane >> 3) + 8 * j; const LAS float* s = scr + (8 * c) * 33 + n;
        u32x2 o; o.x = pk4_fp8(s[0 * 33], s[1 * 33], s[2 * 33], s[3 * 33]); o.y = pk4_fp8(s[4 * 33], s[5 * 33], s[6 * 33], s[7 * 33]);
        *(GAS u32x2*)(WT + (size_t)(orow0 + n) * K + k0 + 8 * c) = o; }
    asm volatile("s_waitcnt lgkmcnt(0)" ::: "memory");
}

__device__ __forceinline__ void transpose_item8x64(const GAS float* W, int K, int N, GAS unsigned char* WT, int orow0, int k0, int n0, LAS float* scr, int lane) {
    f32x4 v[16];
#pragma unroll
    for (int i = 0; i < 16; ++i) v[i] = *(const GAS f32x4*)(W + (size_t)(k0 + 4 * i + (lane >> 4)) * N + n0 + 4 * (lane & 15));
#pragma unroll
    for (int i = 0; i < 16; ++i) { LAS float* d = scr + (4 * i + (lane >> 4)) * 65 + 4 * (lane & 15); d[0] = v[i].x * W8_SCALE; d[1] = v[i].y * W8_SCALE; d[2] = v[i].z * W8_SCALE; d[3] = v[i].w * W8_SCALE; }
    asm volatile("s_waitcnt lgkmcnt(0)" ::: "memory");
    const int c = lane & 7;
#pragma unroll
    for (int j = 0; j < 8; ++j) { const int n = (lane >> 3) + 8 * j; const LAS float* s = scr + (8 * c) * 65 + n;
        u32x2 o; o.x = pk4_fp8(s[0 * 65], s[1 * 65], s[2 * 65], s[3 * 65]); o.y = pk4_fp8(s[4 * 65], s[5 * 65], s[6 * 65], s[7 * 65]);
        *(GAS u32x2*)(WT + (size_t)(orow0 + n) * K + k0 + 8 * c) = o; }
    asm volatile("s_waitcnt lgkmcnt(0)" ::: "memory");
}

__device__ __forceinline__ void norm_mod_row(const GAS float* xrow, const GAS float* g, const GAS float* shift, const GAS float* scale, GAS f16* orow, GAS unsigned char* orow8, int lane) {
    f32x4 v[4]; float s = 0.f;
#pragma unroll
    for (int j = 0; j < 4; ++j) { v[j] = *(const GAS f32x4*)(xrow + 4 * lane + 256 * j); s += (v[j].x * v[j].x + v[j].y * v[j].y) + (v[j].z * v[j].z + v[j].w * v[j].w); }
    const float rstd = rsqrtf(wave_sum(s) * (1.f / DM) + EPS);
#pragma unroll
    for (int j = 0; j < 4; ++j) { const int c = 4 * lane + 256 * j; const f32x4 gg = *(const GAS f32x4*)(g + c), sh = *(const GAS f32x4*)(shift + c), sc = *(const GAS f32x4*)(scale + c);
        const f32x4 h = (v[j] * rstd) * gg * (sc + 1.0f) + sh;
        if (NEED_H16(0)) { u32x2 w; w.x = pk_f16(h.x, h.y); w.y = pk_f16(h.z, h.w); *(GAS u32x2*)(orow + c) = w; }
        if (PROJ_FP8 && PROJ_FP8_FIRST == 0) *(GAS unsigned*)(orow8 + c) = pk4_fp8(h.x, h.y, h.z, h.w); }
}

extern __shared__ __attribute__((aligned(16))) unsigned char lds[];
#define LAUNDER() int tid = tid0; asm volatile("" : "+v"(tid)); const int lane = tid & 63; int wave = wave0; asm volatile("" : "+s"(wave)); const int gw = bid * NWAVES + wave; (void)gw; (void)lane; const CAS Args* AP = (const CAS Args*)__builtin_amdgcn_kernarg_segment_ptr(); asm volatile("" : "+s"(AP)); (void)AP; LAS unsigned char* Lp = (LAS unsigned char*)lds; asm volatile("" : "+s"(Lp)); (void)Lp; GAS unsigned char* ws = (GAS unsigned char*)AP->ws; GAS unsigned* ctl = (GAS unsigned*)(ws + WS_CTL); GAS float* MOD = (GAS float*)(ws + WS_MOD); GAS float* KMEAN = (GAS float*)(ws + WS_KMEAN); GAS float* SSQ = (GAS float*)(ws + WS_SSQ); (void)SSQ; GAS f16* SGUW = (GAS f16*)(ws + WS_SGUW); GAS f16* RWT16 = (GAS f16*)(ws + WS_RWT); (void)RWT16; GAS unsigned char* WIN8 = (GAS unsigned char*)(ws + WS_WIN8); (void)WIN8; GAS unsigned char* HB8 = (GAS unsigned char*)(ws + WS_HB8); (void)HB8; GAS f16* PWT = (GAS f16*)(ws + WS_PWT); (void)PWT; GAS int* ROUTE_E = (GAS int*)(ws + WS_ROUTE); GAS int* ROUTE_POS = ROUTE_E + NTOK * 4; GAS float* ROUTE_G = (GAS float*)(ROUTE_POS + NTOK * 4); GAS int* LIST = (GAS int*)(ws + WS_LIST); GAS f16* WIN_T = (GAS f16*)(ws + WS_WIN); GAS f16* WOUT_T = (GAS f16*)(ws + WS_WOUT); GAS f16* W1_T = (GAS f16*)(ws + WS_W1); GAS f16* W2_T = (GAS f16*)(ws + WS_W2); GAS f16* X = (GAS f16*)(ws + WS_X); GAS f16* H = (GAS f16*)(ws + WS_H); GAS f16* PROJ = (GAS f16*)(ws + WS_PROJ); GAS f16* MIX = (GAS f16*)(ws + WS_MIX); GAS f16* XS = (GAS f16*)(ws + WS_XS); GAS f16* ACT = (GAS f16*)(ws + WS_ACT); (void)ctl; (void)MOD; (void)KMEAN; (void)SGUW; (void)ROUTE_E; (void)ROUTE_POS; (void)ROUTE_G; (void)LIST; (void)WIN_T; (void)WOUT_T; (void)W1_T; (void)W2_T; (void)X; (void)H; (void)PROJ; (void)MIX; (void)XS; (void)ACT;
__device__ __forceinline__ void layer_body(const int l, const XcdBarrier bar, const int tid0, const int wave0, const int G, const int bid, const int NGW) {
#define MODL (MOD + (size_t)l * 8 * 6144)
for (int rep_ = 0; rep_ < REPS(4); ++rep_) if (PHMASK & 4) { LAUNDER();
        if (PROJ_FP8 && PROJ_QK_FP8 && l >= PROJ_FP8_FIRST) {
            pg8::Gemm g{(const GAS pg8::h16_t*)HB8, (const GAS pg8::h16_t*)(WIN8 + (size_t)l * INW * DM), NTOK, INW, DM / 2, nullptr, nullptr}; pg8::StaticOrder S; S.init(NTOK, INW, G, bid);
            pg8::EpiF16 E{(GAS pg8::h16_t*)PROJ, INW, KMEAN, W8_INV};
            pg8::gemm_phase<pg8::EpiF16, pg8::StaticOrder, false, true>(Lp, g, S, E, tid);
        } else if (PROJ_FP8 && l >= PROJ_FP8_FIRST) {
            { pg8::Gemm g{(const GAS pg8::h16_t*)H, (const GAS pg8::h16_t*)(WIN_T + (size_t)l * INW * DM), NTOK, 512, DM, nullptr, nullptr}; pg8::MapOrder S; S.init(NTOK, 512, G, bid); S.map = 0x32u;
              pg8::EpiF16 E{(GAS pg8::h16_t*)PROJ, INW, KMEAN, 1.0f};
              pg8::gemm_phase<pg8::EpiF16, pg8::MapOrder, false, false>(Lp, g, S, E, tid); }
            { pg8::Gemm g{(const GAS pg8::h16_t*)HB8, (const GAS pg8::h16_t*)(WIN8 + (size_t)l * INW * DM), NTOK, 1536, DM / 2, nullptr, nullptr}; pg8::MapOrder S; S.init(NTOK, 1536, G, bid); S.map = 0x765410u;
              pg8::EpiF16 E{(GAS pg8::h16_t*)PROJ, INW, KMEAN, W8_INV};
              pg8::gemm_phase<pg8::EpiF16, pg8::MapOrder, false, true>(Lp, g, S, E, tid); }
        } else {
        { pg8::Gemm g{(const GAS pg8::h16_t*)H, (const GAS pg8::h16_t*)(WIN_T + (size_t)l * INW * DM), NTOK, INW, DM, nullptr, nullptr}; pg8::StaticOrder S; S.init(NTOK, INW, G, bid);
          pg8::EpiF16 E{(GAS pg8::h16_t*)PROJ, INW, KMEAN, 1.0f};
          pg8::gemm_phase<pg8::EpiF16, pg8::StaticOrder, false>(Lp, g, S, E, tid); }
        }
}
        xcd_barrier(bar);
        STAMP(3 + 9 * l + 0);

for (int rep_ = 0; rep_ < REPS(8); ++rep_) if (PHMASK & 8) {
        for (int it_ = bid; it_ < 256 + 512 + 512; it_ += G) { int it = it_; asm volatile("" : "+s"(it));
            if ((PH3 & 1) && it < 256) {
                LAUNDER();
                const int T0 = it * 128;
                LAS f16* vT = (LAS f16*)Lp;
                constexpr int VS = 136;
                const GAS float* sng = GIN(I_SNG) + l * GW; const GAS float* snb = GIN(I_SNB) + l * GW;
                f16x8 afr[4][4];
#pragma unroll
                for (int ks = 0; ks < 4; ++ks)
#pragma unroll
                    for (int h = 0; h < 4; ++h) afr[ks][h] = *(const GAS f16x8*)(SGUW + ((size_t)(l * 4 + h) * 128 + 16 * wave + (lane & 15)) * 128 + 32 * ks + 8 * (lane >> 4));
#pragma unroll 1
                for (int tg = 0; tg < 16; tg += 4) { f16x4 hvv[4];
#pragma unroll
                  for (int t4 = 0; t4 < 4; ++t4) hvv[t4] = *(const GAS f16x4*)(PROJ + (size_t)(T0 + wave * 16 + tg + t4) * INW + 1792 + 4 * lane);
#pragma unroll
                  for (int t4 = 0; t4 < 4; ++t4) { const int tl = wave * 16 + tg + t4;
                    const f16x4 hv = hvv[t4]; float v[4]; float s = 0.f;
#pragma unroll
                    for (int i = 0; i < 4; ++i) { v[i] = gelu_erf((float)hv[i]); s += v[i]; }
                    const float mean = wave_sum(s) * (1.f / 256.f); float q = 0.f;
#pragma unroll
                    for (int i = 0; i < 4; ++i) { v[i] -= mean; q += v[i] * v[i]; }
                    const float rstd = rsqrtf(wave_sum(q) * (1.f / 256.f) + EPS);
#pragma unroll
                    for (int i = 0; i < 4; ++i) { const int c = 4 * lane + i; vT[c * VS + tl] = (f16)(v[i] * rstd * sng[c] + snb[c]); } } }
                __syncthreads();
                f32x4 acc[4][4];
#pragma unroll
                for (int h = 0; h < 4; ++h)
#pragma unroll
                    for (int ct = 0; ct < 4; ++ct) acc[h][ct] = (f32x4){0.f, 0.f, 0.f, 0.f};
                const int nk = (wave >> 1) + 1, fr = lane & 15, fq = lane >> 4;
#pragma unroll
                for (int ks = 0; ks < 4; ++ks) { if (ks < nk) {
#pragma unroll
                    for (int h = 0; h < 4; ++h) {
                        const f16x8 a = afr[ks][h];
#pragma unroll
                        for (int ct = 0; ct < 4; ++ct) { const f16x8 b = *(const LAS f16x8*)(vT + (h * 64 + ct * 16 + fr) * VS + 32 * ks + 8 * fq);
                            acc[h][ct] = __builtin_amdgcn_mfma_f32_16x16x32_f16(a, b, acc[h][ct], 0, 0, 0); } } } }
                const GAS float* sb = GIN(I_SGUB) + (size_t)l * 4 * 128;
#pragma unroll
                for (int reg = 0; reg < 4; ++reg) { const int il = 16 * wave + 4 * fq + reg; const size_t tok = (size_t)(T0 + il); float ss = 0.f; float val[4][4];
#pragma unroll
                    for (int h = 0; h < 4; ++h) { const float bia = sb[h * 128 + il];
#pragma unroll
                        for (int ct = 0; ct < 4; ++ct) { const int c = h * 64 + ct * 16 + fr; const float u = gelu_erf((float)PROJ[tok * INW + 1536 + c]);
                            const float x = (acc[h][ct][reg] + bia) * u; val[h][ct] = x; ss += x * x; } }
                    ss = row16_sum(ss);
                    const float rstd = rsqrtf(ss * (1.f / 256.f) + EPS);
#pragma unroll
                    for (int h = 0; h < 4; ++h)
#pragma unroll
                        for (int ct = 0; ct < 4; ++ct) MIX[tok * DM + 768 + h * 64 + ct * 16 + fr] = (f16)(val[h][ct] * rstd); }
                __syncthreads();
            } else if ((PH3 & 2) && it < 768) {
                LAUNDER();
                const int T0 = (it - 256) * 64, p0 = T0 & (SEQ - 1);
                LAS float* y = (LAS float*)Lp;
                LAS float* Wc = (LAS float*)(Lp + 96256);
                for (int i = tid; i < 31 * 64; i += 512) *(LAS f32x4*)(Wc + 4 * i) = *(const GAS f32x4*)(GIN(I_CONVW) + (size_t)l * 31 * GW + 4 * i);
                { f16x8 av[6], gv[6];
#pragma unroll
                  for (int k6 = 0; k6 < 6; ++k6) { int task = tid + k6 * 512; task = task < 94 * 32 ? task : 94 * 32 - 1; const int r = task >> 5, c8 = (task & 31) * 8; const bool ok = (p0 - 30 + r >= 0);
                      const GAS f16* pr = PROJ + (size_t)(T0 + (ok ? r - 30 : 0)) * INW + c8; av[k6] = *(const GAS f16x8*)pr; gv[k6] = *(const GAS f16x8*)(pr + 256); }
#pragma unroll
                  for (int k6 = 0; k6 < 6; ++k6) { const int task = tid + k6 * 512;
                      if (task < 94 * 32) { const int r = task >> 5, c8 = (task & 31) * 8; const bool ok = (p0 - 30 + r >= 0); float o[8];
#pragma unroll
                          for (int i = 0; i < 8; ++i) o[i] = ok ? (float)av[k6][i] * sigmoidf_((float)gv[k6][i]) : 0.f;
                          *(LAS f32x4*)(y + r * 256 + c8) = (f32x4){o[0], o[1], o[2], o[3]}; *(LAS f32x4*)(y + r * 256 + c8 + 4) = (f32x4){o[4], o[5], o[6], o[7]}; } } }
                __syncthreads();
                float psq[8];
#pragma unroll
                for (int t = 0; t < 8; ++t) psq[t] = 0.f;
                float osv[4][8];
#pragma unroll
                for (int h = 0; h < 4; ++h) { const int c = h * 64 + lane; float w[31];
#pragma unroll
                    for (int j = 0; j < 31; ++j) w[j] = Wc[j * 256 + c];
                    const float cb = GIN(I_CONVB)[l * GW + c], ng = GIN(I_CNG)[l * GW + c], nb_ = GIN(I_CNB)[l * GW + c];
                    float yv[38];
#pragma unroll
                    for (int q = 0; q < 38; ++q) yv[q] = y[(wave * 8 + q) * 256 + c];
                    float a[8], red[16];
#pragma unroll
                    for (int t = 0; t < 8; ++t) { float s = cb;
#pragma unroll
                        for (int j = 0; j < 31; ++j) s += w[j] * yv[t + j];
                        a[t] = s; red[t] = s; red[8 + t] = s * s; }
                    wave_sum_n<16>(red);
#pragma unroll
                    for (int t = 0; t < 8; ++t) { const float mean = red[t] * (1.f / 64.f), var = fmaxf(red[8 + t] * (1.f / 64.f) - mean * mean, 0.f);
                        const float yn = (a[t] - mean) * rsqrtf(var + EPS) * ng + nb_; const float sv = yn * sigmoidf_(yn);
                        psq[t] += sv * sv; osv[h][t] = sv; }
                    asm volatile("" ::: "memory"); }
                wave_sum_n<8>(psq);
#pragma unroll
                for (int t = 0; t < 8; ++t) psq[t] = rsqrtf(psq[t] * (1.f / 256.f) + EPS);
#pragma unroll
                for (int h = 0; h < 4; ++h)
#pragma unroll
                    for (int t = 0; t < 8; ++t) MIX[(size_t)(T0 + wave * 8 + t) * DM + 256 + h * 64 + lane] = (f16)(osv[h][t] * psq[t]);
                __syncthreads();
            } else if ((PH3 & 4) && it < 1280) {
                LAUNDER();
                const int T0 = (it - 768) * 64, p0 = T0 & (SEQ - 1);
                LAS f16* zt = (LAS f16*)Lp;
                LAS f16* Pf = (LAS f16*)(Lp + 40960);
                LAS f16* WpT = (LAS f16*)(Lp + 75776);
                constexpr int PS = 264, WS2 = 72;
                for (int i = tid; i < 256 * 8; i += 512) { const int r = i >> 3, c8 = (i & 7) * 8; *(LAS u32x4*)(WpT + r * WS2 + c8) = *(const GAS u32x4*)(PWT + (size_t)l * 16384 + r * 64 + c8); }
                for (int task = tid; task < 79 * 32; task += 512) { const int r = task >> 5, c8 = (task & 31) * 8; u32x4 z = {0u, 0u, 0u, 0u};
                    if (p0 - 15 + r >= 0) z = *(const GAS u32x4*)(PROJ + (size_t)(T0 - 15 + r) * INW + 1280 + c8);
                    *(LAS u32x4*)(zt + r * 256 + c8) = z; }
                __syncthreads();
                { const int c8 = (tid & 31) * 8, seg = tid >> 5, gi = c8 >> 6, w = 2 << gi; float s[8];
#pragma unroll
                  for (int i = 0; i < 8; ++i) s[i] = 0.f;
                  for (int d = 1; d < w; ++d) { const f16x8 z = *(const LAS f16x8*)(zt + (seg * 4 + 15 - d) * 256 + c8);
#pragma unroll
                      for (int i = 0; i < 8; ++i) s[i] += (float)z[i]; }
#pragma unroll
                  for (int t = 0; t < 4; ++t) { const int tl = seg * 4 + t, p = p0 + tl;
                      const f16x8 zn = *(const LAS f16x8*)(zt + (tl + 15) * 256 + c8);
                      const float inv = 1.f / (float)(p + 1 < w ? p + 1 : w); f16x8 po;
#pragma unroll
                      for (int i = 0; i < 8; ++i) { s[i] += (float)zn[i]; po[i] = (f16)(s[i] * inv - (float)zn[i]); }
                      *(LAS f16x8*)(Pf + tl * PS + c8) = po;
                      const f16x8 zo = *(const LAS f16x8*)(zt + (tl + 15 - (w - 1)) * 256 + c8);
#pragma unroll
                      for (int i = 0; i < 8; ++i) s[i] -= (float)zo[i]; } }
                __syncthreads();
                if (wave < 4) {
                    const int fr = lane & 15, fq = lane >> 4;
                    f32x4 acc[4][4];
#pragma unroll
                    for (int g = 0; g < 4; ++g)
#pragma unroll
                        for (int nt = 0; nt < 4; ++nt) acc[g][nt] = (f32x4){0.f, 0.f, 0.f, 0.f};
#pragma unroll
                    for (int g = 0; g < 4; ++g)
#pragma unroll
                        for (int ks = 0; ks < 2; ++ks) { const f16x8 av = *(const LAS f16x8*)(Pf + (16 * wave + fr) * PS + g * 64 + 32 * ks + 8 * fq);
#pragma unroll
                            for (int nt = 0; nt < 4; ++nt) { const f16x8 bv = *(const LAS f16x8*)(WpT + (g * 64 + nt * 16 + fr) * WS2 + 32 * ks + 8 * fq);
                                acc[g][nt] = __builtin_amdgcn_mfma_f32_16x16x32_f16(av, bv, acc[g][nt], 0, 0, 0); } }
                    float psc[4][4];
#pragma unroll
                    for (int g = 0; g < 4; ++g)
#pragma unroll
                        for (int nt = 0; nt < 4; ++nt) psc[g][nt] = GIN(I_POOLS)[l * GW + g * 64 + nt * 16 + fr];
#pragma unroll
                    for (int reg = 0; reg < 4; ++reg) { float ss = 0.f;
#pragma unroll
                        for (int g = 0; g < 4; ++g)
#pragma unroll
                            for (int nt = 0; nt < 4; ++nt) { const float x = acc[g][nt][reg] * psc[g][nt]; acc[g][nt][reg] = x; ss += x * x; }
                        ss = row16_sum(ss);
                        const float rstd = rsqrtf(ss * (1.f / 256.f) + EPS); const size_t tok = (size_t)(T0 + 16 * wave + 4 * fq + reg);
#pragma unroll
                        for (int g = 0; g < 4; ++g)
#pragma unroll
                            for (int nt = 0; nt < 4; ++nt) MIX[tok * DM + 512 + g * 64 + nt * 16 + fr] = (f16)(acc[g][nt][reg] * rstd); }
                }
                __syncthreads();
            }
        }
}
        STAMP(3 + 9 * l + 1);

for (int rep_ = 0; rep_ < REPS(16); ++rep_) if (PHMASK & 16) { LAUNDER();
        {
            LAS f16* Kb = (LAS f16*)Lp;
            LAS f16* Vb = (LAS f16*)(Lp + 36864);
            LAS float* kml = (LAS float*)(Lp + 73728);
            LAS float* lut = (LAS float*)(Lp + 73728 + 4096);
            constexpr int KS = 72;
            constexpr float LOG2E = 1.4426950408889634f, SC2 = 0.125f * LOG2E, THR = 4.0f;
            const int r32 = lane & 31, hh = lane >> 5;
            const int vtr_off = (4 * hh + ((lane & 15) >> 2)) * KS + 16 * ((lane >> 4) & 1) + 4 * (lane & 3);
            const int lk = tid >> 3, lc = tid & 7;
            for (int pi = bid; pi < 256; pi += G) {
                const int bh = pi >> 3, pp = pi & 7;
                for (int half = 0; half < 2; ++half) {
                    const int own = half == 0 ? 15 - pp : pp;
                    const int b = bh >> 2, h = bh & 3;
                    const size_t TB = (size_t)b * SEQ;
                    const int qpos = own * 256 + 32 * wave + r32;
                    const GAS f16* kvp = PROJ + (TB + lk) * INW + 768 + h * 64 + 8 * lc;
                    f16x8 kr[4], vr[4];
#pragma unroll
                    for (int pc = 0; pc < 4; ++pc) { const GAS f16* p_ = kvp + (size_t)(64 * pc) * INW; kr[pc] = *(const GAS f16x8*)p_; vr[pc] = *(const GAS f16x8*)(p_ + 256); }
                    __syncthreads();
                    for (int i = tid; i < 1024; i += 512) kml[i] = KMEAN[((size_t)(b * 16 + (i >> 6))) * 256 + h * 64 + (i & 63)] * (1.f / 256.f);
                    if (tid < 128) lut[tid] = GIN(I_RELB)[t5_bucket(tid) * 4 + h] * LOG2E;
                    f16x8 qf[4];
                    { const GAS f16* qp = PROJ + (TB + qpos) * INW + 512 + h * 64 + 8 * hh;
#pragma unroll
                      for (int s = 0; s < 4; ++s) qf[s] = *(const GAS f16x8*)(qp + 16 * s); }
                    __syncthreads();
                    unsigned mask = 0u;
                    { float gsc[16]; float qv[32];
#pragma unroll
                      for (int s = 0; s < 4; ++s)
#pragma unroll
                          for (int j = 0; j < 8; ++j) qv[8 * s + j] = (float)qf[s][j];
#pragma unroll
                      for (int n = 0; n < 16; ++n) { float a = 0.f;
                          if (n < own) { f32x4 kv[8];
#pragma unroll
                              for (int s = 0; s < 4; ++s) { kv[2 * s] = *(const LAS f32x4*)(kml + n * 64 + 16 * s + 8 * hh); kv[2 * s + 1] = *(const LAS f32x4*)(kml + n * 64 + 16 * s + 8 * hh + 4); }
#pragma unroll
                              for (int s = 0; s < 8; ++s) a += (qv[4 * s] * kv[s].x + qv[4 * s + 1] * kv[s].y) + (qv[4 * s + 2] * kv[s].z + qv[4 * s + 3] * kv[s].w); }
                          a += __shfl_xor(a, 32); gsc[n] = a; }
#pragma unroll
                      for (int k = 0; k < 3; ++k) { float best = -INFINITY; int bi = -1;
#pragma unroll
                          for (int n = 0; n < 16; ++n) { const bool ok = (n < own) && !((mask >> n) & 1u) && (gsc[n] > best); if (ok) { best = gsc[n]; bi = n; } }
                          if (bi >= 0) mask |= 1u << bi; }
#pragma unroll
                      for (int s = 0; s < 4; ++s)
#pragma unroll
                          for (int j = 0; j < 8; ++j) qf[s][j] = (f16)(qv[8 * s + j] * SC2); }
                    f32x16 o0, o1;
#pragma unroll
                    for (int i = 0; i < 16; ++i) { o0[i] = 0.f; o1[i] = 0.f; }
                    float mrun = -INFINITY, lrun = 0.f;
                    f32x16 iniv; float ini_prev = 0.f;
#pragma unroll
                    for (int i = 0; i < 16; ++i) iniv[i] = 0.f;
                    for (int n = 0; n <= own; ++n) {
                        __syncthreads();
#pragma unroll
                        for (int pc = 0; pc < 4; ++pc) { *(LAS f16x8*)(Kb + (lk + 64 * pc) * KS + 8 * lc) = kr[pc]; *(LAS f16x8*)(Vb + (lk + 64 * pc) * KS + 8 * lc) = vr[pc]; }
                        __syncthreads();
                        if (n < own) {
#pragma unroll
                            for (int pc = 0; pc < 4; ++pc) { const GAS f16* p_ = kvp + (size_t)((n + 1) * 256 + 64 * pc) * INW; kr[pc] = *(const GAS f16x8*)p_; vr[pc] = *(const GAS f16x8*)(p_ + 256); } }
                        const bool past = n < own;
                        const bool sel = past ? ((mask >> n) & 1u) != 0u : true;
                        if (past && !__any(sel)) continue;
                        const int ntl = past ? 4 : (wave >> 1) + 1;
#pragma unroll 1
                        for (int tl = 0; tl < ntl; ++tl) {
                            const LAS f16* Kt = Kb + tl * 64 * KS; const LAS f16* Vt = Vb + tl * 64 * KS;
                            const int kbase = n * 256 + tl * 64;
                            const int dmin = own * 256 + 32 * wave - (kbase + 63);
                            const bool cb = dmin >= 127;
                            const float minit = (mrun == -INFINITY) ? 0.f : mrun;
                            const float ini = sel ? ((cb ? lut[127] : 0.f) - minit) : -INFINITY;
                            if (__any(ini != ini_prev)) {
#pragma unroll
                                for (int i = 0; i < 16; ++i) iniv[i] = ini;
                                ini_prev = ini; }
                            f32x16 p0, p1;
                            { const f16x8 a0 = *(const LAS f16x8*)(Kt + r32 * KS + 8 * hh), a1 = *(const LAS f16x8*)(Kt + (32 + r32) * KS + 8 * hh);
                              p0 = __builtin_amdgcn_mfma_f32_32x32x16_f16(a0, qf[0], iniv, 0, 0, 0); p1 = __builtin_amdgcn_mfma_f32_32x32x16_f16(a1, qf[0], iniv, 0, 0, 0); }
#pragma unroll
                            for (int s = 1; s < 4; ++s) { const f16x8 a0 = *(const LAS f16x8*)(Kt + r32 * KS + 16 * s + 8 * hh), a1 = *(const LAS f16x8*)(Kt + (32 + r32) * KS + 16 * s + 8 * hh);
                                p0 = __builtin_amdgcn_mfma_f32_32x32x16_f16(a0, qf[s], p0, 0, 0, 0); p1 = __builtin_amdgcn_mfma_f32_32x32x16_f16(a1, qf[s], p1, 0, 0, 0); }
                            if (!cb) {
#pragma unroll
                                for (int i = 0; i < 16; ++i) { const int kr_ = (i & 3) + 8 * (i >> 2) + 4 * hh; const int d0 = qpos - (kbase + kr_), d1 = d0 - 32;
                                    p0[i] = (d0 >= 0) ? p0[i] + lut[d0 > 127 ? 127 : d0] : -INFINITY;
                                    p1[i] = (d1 >= 0) ? p1[i] + lut[d1 > 127 ? 127 : (d1 < 0 ? 0 : d1)] : -INFINITY; } }
                            asm volatile("s_nop 7\n\ts_nop 7\n\ts_nop 7" : "+v"(p0), "+v"(p1));
                            float mx = max3f(p0[0], p0[1], p1[0]), mxb = max3f(p0[2], p0[3], p1[1]); mx = max3f(mx, p1[2], p1[3]);
#pragma unroll
                            for (int i = 4; i < 16; i += 4) { mx = max3f(mx, p0[i], p0[i + 1]); mxb = max3f(mxb, p0[i + 2], p0[i + 3]); mx = max3f(mx, p1[i], p1[i + 1]); mxb = max3f(mxb, p1[i + 2], p1[i + 3]); }
                            mx = max2f(mx, mxb);
                            mx = max2f(mx, __shfl_xor(mx, 32));
                            const bool need = sel && (mx > -INFINITY) && ((mrun == -INFINITY) || (mx > THR));
                            if (__any(need)) { const float delta = need ? mx : 0.f; const float alpha = __builtin_amdgcn_exp2f(-delta);
#pragma unroll
                                for (int i = 0; i < 16; ++i) { p0[i] -= delta; p1[i] -= delta; o0[i] *= alpha; o1[i] *= alpha; }
                                lrun *= alpha; if (need) mrun = minit + delta; }
#pragma unroll
                            for (int i = 0; i < 16; ++i) { p0[i] = __builtin_amdgcn_exp2f(p0[i]); p1[i] = __builtin_amdgcn_exp2f(p1[i]); }
                            asm volatile("s_nop 1" : "+v"(p0), "+v"(p1));
                            float psa = 0.f, psb = 0.f, psc = 0.f, psd = 0.f;
#pragma unroll
                            for (int i = 0; i < 16; i += 2) { psa = fadd_s(psa, p0[i]); psb = fadd_s(psb, p1[i]); psc = fadd_s(psc, p0[i + 1]); psd = fadd_s(psd, p1[i + 1]); }
                            lrun += (psa + psb) + (psc + psd);
                            f16x8 pb[4];
#pragma unroll
                            for (int i = 0; i < 8; ++i) { pb[0][i] = (f16)p0[i]; pb[1][i] = (f16)p0[8 + i]; pb[2][i] = (f16)p1[i]; pb[3][i] = (f16)p1[8 + i]; }
#pragma unroll
                            for (int kk = 0; kk < 4; ++kk) {
                                const LAS f16* vb = Vt + vtr_off + (16 * kk) * KS;
                                const f16x4 a0l = __builtin_bit_cast(f16x4, __builtin_amdgcn_ds_read_tr16_b64_v4i16((LAS v4i16_t*)(vb)));
                                const f16x4 a0h = __builtin_bit_cast(f16x4, __builtin_amdgcn_ds_read_tr16_b64_v4i16((LAS v4i16_t*)(vb + 8 * KS)));
                                const f16x4 a1l = __builtin_bit_cast(f16x4, __builtin_amdgcn_ds_read_tr16_b64_v4i16((LAS v4i16_t*)(vb + 32)));
                                const f16x4 a1h = __builtin_bit_cast(f16x4, __builtin_amdgcn_ds_read_tr16_b64_v4i16((LAS v4i16_t*)(vb + 8 * KS + 32)));
                                const f16x8 av0 = {a0l[0], a0l[1], a0l[2], a0l[3], a0h[0], a0h[1], a0h[2], a0h[3]};
                                const f16x8 av1 = {a1l[0], a1l[1], a1l[2], a1l[3], a1h[0], a1h[1], a1h[2], a1h[3]};
                                o0 = __builtin_amdgcn_mfma_f32_32x32x16_f16(av0, pb[kk], o0, 0, 0, 0);
                                o1 = __builtin_amdgcn_mfma_f32_32x32x16_f16(av1, pb[kk], o1, 0, 0, 0); }
                        }
                    }
                    const float ltot = lrun + __shfl_xor(lrun, 32), inv = 1.f / ltot;
                    GAS f16* op = MIX + (TB + qpos) * DM + h * 64;
                    float sq = 0.f;
#pragma unroll
                    for (int g4 = 0; g4 < 4; ++g4) { const int d0 = 8 * g4 + 4 * hh;
                        u32x2 w0, w1; w0.x = pk_f16(o0[4 * g4] * inv, o0[4 * g4 + 1] * inv); w0.y = pk_f16(o0[4 * g4 + 2] * inv, o0[4 * g4 + 3] * inv);
                        w1.x = pk_f16(o1[4 * g4] * inv, o1[4 * g4 + 1] * inv); w1.y = pk_f16(o1[4 * g4 + 2] * inv, o1[4 * g4 + 3] * inv);
                        { const f16x4 r0 = __builtin_bit_cast(f16x4, w0), r1 = __builtin_bit_cast(f16x4, w1);
#pragma unroll
                          for (int i = 0; i < 4; ++i) { const float a_ = (float)r0[i], b_ = (float)r1[i]; sq += a_ * a_ + b_ * b_; } }
                        *(GAS u32x2*)(op + d0) = w0; *(GAS u32x2*)(op + 32 + d0) = w1; }
                    sq += __shfl_xor(sq, 32);
                    if (hh == 0) SSQ[(TB + qpos) * 4 + h] = sq;
                }
            }
        }
}
        xcd_barrier(bar);
        STAMP(3 + 9 * l + 2);

        STAMP(3 + 9 * l + 3);

if (PHMASK & 64) { LAUNDER();
        { pg8::Gemm g{(const GAS pg8::h16_t*)MIX, (const GAS pg8::h16_t*)(WOUT_T + (size_t)l * DM * DM), NTOK, DM, DM, nullptr, SSQ}; pg8::StaticOrder S; S.init(NTOK, DM, G, bid);
          if (l == 0) { pg8::EpiResidT<true> E{GIN(I_X), nullptr, (GAS pg8::h16_t*)X, MODL + 2048}; pg8::gemm_phase<pg8::EpiResidT<true>, pg8::StaticOrder, false, false, true>(Lp, g, S, E, tid); }
          else { pg8::EpiResidT<false> E{nullptr, (const GAS pg8::h16_t*)X, (GAS pg8::h16_t*)X, MODL + 2048}; pg8::gemm_phase<pg8::EpiResidT<false>, pg8::StaticOrder, false, false, true>(Lp, g, S, E, tid); } }
}
        xcd_barrier(bar);
        STAMP(3 + 9 * l + 4);

if (PHMASK & 128) { LAUNDER();
        {
            constexpr int WS_ = 1032;
            LAS f16* img = (LAS f16*)Lp;
            LAS float* part = (LAS float*)(Lp + 33280);
            LAS float* lgall = (LAS float*)(Lp + 66560);
            LAS float* lg = (LAS float*)(Lp + 66560 + wave * 2304);
            LAS int* sel_e = (LAS int*)(Lp + 131584);
            LAS int* rank_ = (LAS int*)(Lp + 131584 + 2048);
            LAS int* lcnt = (LAS int*)(Lp + 131584 + 4096);
            LAS int* lbase = (LAS int*)(Lp + 131584 + 4096 + 128);
            f16x8 bw0[4], bw1[4];
            { const GAS f16* wp = RWT16 + (size_t)l * 32 * WS_ + 128 * wave + 8 * (lane >> 4);
#pragma unroll
              for (int ks = 0; ks < 4; ++ks) { bw0[ks] = *(const GAS f16x8*)(wp + (lane & 15) * WS_ + 32 * ks); bw1[ks] = *(const GAS f16x8*)(wp + (16 + (lane & 15)) * WS_ + 32 * ks); } }
            GAS unsigned* gcnt = ctl + CW_CNT + l * 32 * 64;
            const int fr = lane & 15, fq = lane >> 4;
            if (l + 1 < DEPTH) { for (int i = bid * 512 + tid; i < NB * 16 * 256; i += G * 512) KMEAN[i] = 0.f; }
            for (int ch = bid; ch < NTOK / 128; ch += G) {
                if (tid < 32) lcnt[tid] = 0;
                __syncthreads();
                const int b = (ch * 128) >> 12; const GAS float* md = MODL + (size_t)b * 6144;
                const GAS float* g2 = GIN(I_N2G) + l * DM;
                const size_t tokw = (size_t)ch * 128 + wave * 16;
                LAS float* pgl = (LAS float*)(Lp + 86016); LAS float* psl = (LAS float*)(Lp + 86016 + 4096);
                for (int i = tid; i < 256; i += 512) { const f32x4 g4 = *(const GAS f32x4*)(g2 + 4 * i), s4 = *(const GAS f32x4*)(md + 4096 + 4 * i); *(LAS f32x4*)(pgl + 4 * i) = g4 * (s4 + 1.0f); *(LAS f32x4*)(psl + 4 * i) = *(const GAS f32x4*)(md + 3072 + 4 * i); }
                __syncthreads();
                const float rbe = GIN(I_RB)[l * NEXP + (tid & 31)];
                f16x4 xr[2][4];
#pragma unroll
                for (int r = 0; r < 2; ++r)
#pragma unroll
                    for (int j = 0; j < 4; ++j) xr[r][j] = *(const GAS f16x4*)(X + ((size_t)ch * 128 + 2 * wave + r) * DM + 4 * lane + 256 * j);
#pragma unroll 1
                for (int g = 0; g < 8; ++g) {
                    const size_t tokg = (size_t)ch * 128 + 16 * g + 2 * wave;
                    f32x4 v[2][4]; float s[2];
#pragma unroll
                    for (int r = 0; r < 2; ++r) { float a = 0.f;
#pragma unroll
                        for (int j = 0; j < 4; ++j) { v[r][j] = (f32x4){(float)xr[r][j][0], (float)xr[r][j][1], (float)xr[r][j][2], (float)xr[r][j][3]};
                            a += (v[r][j].x * v[r][j].x + v[r][j].y * v[r][j].y) + (v[r][j].z * v[r][j].z + v[r][j].w * v[r][j].w); }
                        s[r] = a; }
                    if (g < 7) {
#pragma unroll
                        for (int r = 0; r < 2; ++r)
#pragma unroll
                            for (int j = 0; j < 4; ++j) xr[r][j] = *(const GAS f16x4*)(X + (tokg + 16 + r) * DM + 4 * lane + 256 * j); }
                    wave_sum_n<2>(s);
#pragma unroll
                    for (int r = 0; r < 2; ++r) { const float rstd = rsqrtf(s[r] * (1.f / DM) + EPS);
#pragma unroll
                        for (int j = 0; j < 4; ++j) { const int c = 4 * lane + 256 * j;
                            const f32x4 hq = (v[r][j] * rstd) * *(const LAS f32x4*)(pgl + c) + *(const LAS f32x4*)(psl + c);
                            u32x2 w; w.x = pk_f16(hq.x, hq.y); w.y = pk_f16(hq.z, hq.w); *(LAS u32x2*)(img + (2 * wave + r) * WS_ + c) = w;
                            if (!IS_FP8(l)) *(GAS u32x2*)(H + (tokg + r) * DM + c) = w;
                            if (IS_FP8(l)) *(GAS unsigned*)((GAS unsigned char*)XS + (tokg + r) * DM + c) = pk4_fp8(hq.x, hq.y, hq.z, hq.w); } }
                    __syncthreads();
                    { f32x4 acc0 = {0.f, 0.f, 0.f, 0.f}, acc1 = {0.f, 0.f, 0.f, 0.f};
#pragma unroll
                      for (int ks = 0; ks < 4; ++ks) { const f16x8 a = *(const LAS f16x8*)(img + fr * WS_ + 128 * wave + 32 * ks + 8 * fq);
                          acc0 = __builtin_amdgcn_mfma_f32_16x16x32_f16(a, bw0[ks], acc0, 0, 0, 0); acc1 = __builtin_amdgcn_mfma_f32_16x16x32_f16(a, bw1[ks], acc1, 0, 0, 0); }
#pragma unroll
                      for (int reg = 0; reg < 4; ++reg) { part[(wave * 16 + 4 * fq + reg) * 36 + fr] = acc0[reg]; part[(wave * 16 + 4 * fq + reg) * 36 + 16 + fr] = acc1[reg]; } }
                    __syncthreads();
                    { const int t = tid >> 5, e = tid & 31; float a = rbe;
#pragma unroll
                      for (int w = 0; w < 8; ++w) a += part[(w * 16 + t) * 36 + e];
                      lgall[g * 576 + t * 36 + e] = a; }
                }
                __syncthreads();
                if (lane < 16) { float vv[32];
#pragma unroll
                    for (int q = 0; q < 8; ++q) { const f32x4 t = *(const LAS f32x4*)(lg + lane * 36 + 4 * q); vv[4 * q] = t.x; vv[4 * q + 1] = t.y; vv[4 * q + 2] = t.z; vv[4 * q + 3] = t.w; }
                    float topv[4]; int topi[4];
#pragma unroll
                    for (int k = 0; k < 4; ++k) { float bv = -INFINITY; int bi = 0;
#pragma unroll
                        for (int e = 0; e < 32; ++e) { if (vv[e] > bv) { bv = vv[e]; bi = e; } }
                        topv[k] = bv; topi[k] = bi;
#pragma unroll
                        for (int e = 0; e < 32; ++e) vv[e] = (e == bi) ? -INFINITY : vv[e]; }
                    const int tl = wave * 16 + lane; const size_t tok = (size_t)ch * 128 + tl;
                    const float e1 = __expf(topv[1] - topv[0]), e2 = __expf(topv[2] - topv[0]), e3 = __expf(topv[3] - topv[0]); const float inv = 1.f / (1.f + e1 + e2 + e3);
                    *(GAS f32x4*)(ROUTE_G + tok * 4) = (f32x4){inv, e1 * inv, e2 * inv, e3 * inv};
#pragma unroll
                    for (int k = 0; k < 4; ++k) sel_e[tl * 4 + k] = topi[k]; }
                __syncthreads();
                const int e = sel_e[tid];
                rank_[tid] = __hip_atomic_fetch_add(&lcnt[e], 1, __ATOMIC_RELAXED, __HIP_MEMORY_SCOPE_WORKGROUP);
                __syncthreads();
                if (tid < 32) lbase[tid] = (int)__hip_atomic_fetch_add(gcnt + tid * 64, (unsigned)lcnt[tid], __ATOMIC_RELAXED, __HIP_MEMORY_SCOPE_AGENT);
                __syncthreads();
                { const int pos = lbase[e] + rank_[tid]; const size_t tok = (size_t)ch * 128 + (tid >> 2);
                  LIST[(size_t)e * LISTCAP + pos] = (int)tok; ROUTE_E[tok * 4 + (tid & 3)] = e; ROUTE_POS[tok * 4 + (tid & 3)] = pos; }
                __syncthreads();
            }
        }
}
        xcd_barrier(bar);
        STAMP(3 + 9 * l + 5);

#define cnts ((LAS int*)(Lp + RING_BYTES + 1024))
#define mbase ((LAS int*)(Lp + RING_BYTES + 1024 + 256))
        { LAUNDER(); GAS unsigned* gcnt = ctl + CW_CNT + l * 32 * 64;
          if (tid < 32) cnts[tid] = (int)__hip_atomic_load(gcnt + tid * 64, __ATOMIC_RELAXED, __HIP_MEMORY_SCOPE_AGENT);
          __syncthreads();
          if (tid == 0) { int a = 0; for (int e = 0; e < 32; ++e) { mbase[e] = a; a += (cnts[e] + 255) >> 8; } mbase[32] = a; }
          __syncthreads(); }

        for (int ph = 0; ph < 2; ++ph) {
            if (!(PHMASK & (512 << ph))) continue;
            for (int rep_ = 0; rep_ < REPS(512 << ph); ++rep_) {
            LAUNDER(); const int MT = mbase[32]; LAS int* ulist = (LAS int*)(Lp + RING_BYTES); const int NT = ph == 0 ? 8 : 4, U = MT * NT;
            __syncthreads();
            int nu = 0;
            { const int q = U / 8, rr = U % 8, nig = 8 * NT;
              for (int i = 0; i < 64; ++i) { const long Lid = (long)i * G + bid; if (Lid >= U) break; ++nu;
                  if (tid == i) { int wg = (int)Lid; const int xcd = wg % 8, off = wg / 8; wg = (xcd < rr ? xcd * (q + 1) : rr * (q + 1) + (xcd - rr) * q) + off;
                      const int gid = wg / nig, fm = gid * 8, gsz = (MT - fm) < 8 ? (MT - fm) : 8; const int pm = fm + ((wg % nig) % gsz), pn = (wg % nig) / gsz;
                      int e = 0;
                      for (int qq = 1; qq < 32; ++qq) e += (mbase[qq] <= pm) ? 1 : 0;
                      ulist[3 * i] = pm | ((e * NT + pn) << 16); ulist[3 * i + 1] = (pm - mbase[e]) * 256; ulist[3 * i + 2] = cnts[e]; } } }
            __syncthreads();
            pg8::ListOrder S{ulist, nu};
            if (ph == 0) {
                if (IS_FP8(l)) { pg8::Gemm g{(const GAS pg8::h16_t*)XS, (const GAS pg8::h16_t*)(W1_T + (size_t)l * NEXP * 2048 * DM), PROWS, 2048, DM / 2, LIST, nullptr};
                    pg8::EpiSwigluT<true> E{(GAS unsigned char*)ACT, GIN(I_B1) + (size_t)l * NEXP * 2048, W8_INV};
                    pg8::gemm_phase<pg8::EpiSwigluT<true>, pg8::ListOrder, true, true>(Lp, g, S, E, tid); }
                else { pg8::Gemm g{(const GAS pg8::h16_t*)H, (const GAS pg8::h16_t*)(W1_T + (size_t)l * NEXP * 2048 * DM), PROWS, 2048, DM, LIST, nullptr};
                    pg8::EpiSwigluT<false> E{(GAS unsigned char*)ACT, GIN(I_B1) + (size_t)l * NEXP * 2048, 1.0f};
                    pg8::gemm_phase<pg8::EpiSwigluT<false>, pg8::ListOrder, true, false>(Lp, g, S, E, tid); } }
            else {
                if (IS_FP8(l)) { pg8::Gemm g{(const GAS pg8::h16_t*)ACT, (const GAS pg8::h16_t*)(W2_T + (size_t)l * NEXP * DM * DM), PROWS, 1024, DM / 2, nullptr, nullptr};
                    pg8::EpiDownT<true> E{(GAS unsigned char*)XS, GIN(I_B2) + (size_t)l * NEXP * DM, W8_INV};
                    pg8::gemm_phase<pg8::EpiDownT<true>, pg8::ListOrder, false, true>(Lp, g, S, E, tid); }
                else { pg8::Gemm g{(const GAS pg8::h16_t*)ACT, (const GAS pg8::h16_t*)(W2_T + (size_t)l * NEXP * DM * DM), PROWS, 1024, DM, nullptr, nullptr};
                    pg8::EpiDownT<false> E{(GAS unsigned char*)XS, GIN(I_B2) + (size_t)l * NEXP * DM, 1.0f};
                    pg8::gemm_phase<pg8::EpiDownT<false>, pg8::ListOrder, false, false>(Lp, g, S, E, tid); } }
            }
            xcd_barrier(bar);
            STAMP(3 + 9 * l + 6 + ph);
        }

if (PHMASK & 2048) { LAUNDER();
        for (int m = gw; m < NTOK; m += NGW) {
            const int b = m >> 12; const GAS float* md = MODL + (size_t)b * 6144;
            const GAS unsigned char* yr[4]; float gk[4];
#pragma unroll
            for (int k = 0; k < 4; ++k) { const int e = ROUTE_E[(size_t)m * 4 + k], pos = ROUTE_POS[(size_t)m * 4 + k]; gk[k] = ROUTE_G[(size_t)m * 4 + k]; yr[k] = (const GAS unsigned char*)XS + ((size_t)mbase[e] * 256 + pos) * DM * (IS_FP8(l) ? 1 : 2); }
            f32x4 v[4]; float s = 0.f;
#pragma unroll
            for (int j = 0; j < 4; ++j) { const int c = 4 * lane + 256 * j; f32x4 a = {0.f, 0.f, 0.f, 0.f};
#pragma unroll
                for (int k = 0; k < 4; ++k) {
                    if (IS_FP8(l)) { const int y8 = *(const GAS int*)(yr[k] + c); const f32x2 lo = __builtin_amdgcn_cvt_pk_f32_fp8(y8, false), hi = __builtin_amdgcn_cvt_pk_f32_fp8(y8, true);
                        a.x += gk[k] * lo.x; a.y += gk[k] * lo.y; a.z += gk[k] * hi.x; a.w += gk[k] * hi.y; }
                    else { const f16x4 y4 = *(const GAS f16x4*)(yr[k] + 2 * c); a.x += gk[k] * (float)y4[0]; a.y += gk[k] * (float)y4[1]; a.z += gk[k] * (float)y4[2]; a.w += gk[k] * (float)y4[3]; } }
                const f16x4 xh = *(const GAS f16x4*)(X + (size_t)m * DM + c); const f32x4 x1 = {(float)xh[0], (float)xh[1], (float)xh[2], (float)xh[3]}, g2 = *(const GAS f32x4*)(md + 5120 + c);
                v[j] = x1 + g2 * a; s += (v[j].x * v[j].x + v[j].y * v[j].y) + (v[j].z * v[j].z + v[j].w * v[j].w); }
            const float rstd = rsqrtf(wave_sum(s) * (1.f / DM) + EPS);
            if (l + 1 < DEPTH) {
                const GAS float* mdn = MOD + (size_t)((l + 1) * 8 + b) * 6144; const GAS float* g1 = GIN(I_N1G) + (l + 1) * DM;
#pragma unroll
                for (int j = 0; j < 4; ++j) { const int c = 4 * lane + 256 * j; { u32x2 wx; wx.x = pk_f16(v[j].x, v[j].y); wx.y = pk_f16(v[j].z, v[j].w); *(GAS u32x2*)(X + (size_t)m * DM + c) = wx; }
                    const f32x4 gg = *(const GAS f32x4*)(g1 + c), sh = *(const GAS f32x4*)(mdn + c), sc = *(const GAS f32x4*)(mdn + 1024 + c);
                    const f32x4 hq = (v[j] * rstd) * gg * (sc + 1.0f) + sh; if (NEED_H16(l + 1)) { u32x2 w; w.x = pk_f16(hq.x, hq.y); w.y = pk_f16(hq.z, hq.w); *(GAS u32x2*)(H + (size_t)m * DM + c) = w; }
                    if (PROJ_FP8 && l + 1 >= PROJ_FP8_FIRST) *(GAS unsigned*)(HB8 + (size_t)m * DM + c) = pk4_fp8(hq.x, hq.y, hq.z, hq.w); }
            } else {
#pragma unroll
                for (int j = 0; j < 4; ++j) { const int c = 4 * lane + 256 * j; const f32x4 gg = *(const GAS f32x4*)(GIN(I_FNG) + c); *(GAS f32x4*)(((GAS float*)AP->out) + (size_t)m * DM + c) = (v[j] * rstd) * gg; }
            }
        }
}
        STAMP(3 + 9 * l + 8);
        if (l + 1 < DEPTH) xcd_barrier(bar);
}

__global__ void __launch_bounds__(NWAVES * 64, 2) fwd_megakernel(Args args) {
    const int tid0 = threadIdx.x, wave0 = __builtin_amdgcn_readfirstlane(tid0 >> 6);
    const int G = gridDim.x, bid = blockIdx.x;
    const int NGW = G * NWAVES;
    LAS unsigned char* L = (LAS unsigned char*)lds;

    if (tid0 < 16) ((LAS unsigned*)(L + BARST_OFF))[tid0] = 0u;
    __syncthreads();
    STAMP(0);
    XcdBarrier bar = xcd_barrier_post((unsigned*)(args.ws + WS_CTL) + CW_BAR, (volatile LAS unsigned*)(L + BARST_OFF));

for (int rep_ = 0; rep_ < REPS(1); ++rep_) if (PHMASK & 1) { LAUNDER(); __syncthreads();
    {
        LAS float* cond = (LAS float*)Lp;
        LAS float* red = (LAS float*)(Lp + 32768);
        bool cond_ready = false;
        for (int it = bid; it < 192; it += G) {
            if (!cond_ready) { for (int i = tid; i < NB * DM; i += 512) { const float v = GIN(I_C)[i]; cond[i] = v * sigmoidf_(v); } __syncthreads(); cond_ready = true; }
            const int l = it / 96, n0 = (it % 96) * 64;
            const GAS float* wm = GIN(I_WMOD) + (size_t)l * DM * 6144 + n0 + lane;
            float a[8];
#pragma unroll
            for (int b = 0; b < 8; ++b) a[b] = 0.f;
            for (int k = wave * 128; k < wave * 128 + 128; ++k) { const float w = wm[(size_t)k * 6144];
#pragma unroll
                for (int b = 0; b < 8; ++b) a[b] += cond[b * DM + k] * w; }
#pragma unroll
            for (int b = 0; b < 8; ++b) red[(wave * 8 + b) * 64 + lane] = a[b];
            __syncthreads();
            { const int b = tid >> 6; float s = GIN(I_BMOD)[l * 6144 + n0 + lane];
#pragma unroll
              for (int w = 0; w < 8; ++w) s += red[(w * 8 + b) * 64 + lane];
              MOD[(size_t)(l * 8 + b) * 6144 + n0 + lane] = s; }
            __syncthreads();
        }
        __syncthreads();
        LAS float* scr = (LAS float*)(Lp + wave * 16640);
        for (int it = gw; it < DEPTH * 1536; it += NGW) {
            const int l = it / 1536; int r = it % 1536;
            if (r < 1024) { const int kb = r >> 6, nb = r & 63; if (NEED_H16(l)) transpose_item(GIN(I_WIN) + (size_t)l * DM * INW, DM, INW, WIN_T + (size_t)l * INW * DM, 32 * nb, 64 * kb, 32 * nb, nullptr, scr, lane);
                if (PROJ_FP8 && l >= PROJ_FP8_FIRST) transpose_item8(GIN(I_WIN) + (size_t)l * DM * INW, DM, INW, WIN8 + (size_t)l * INW * DM, 32 * nb, 64 * kb, 32 * nb, scr, lane); continue; } r -= 1024;
            { const int kb = r >> 5, nb = r & 31; transpose_item(GIN(I_WOUT) + (size_t)l * DM * DM, DM, DM, WOUT_T + (size_t)l * DM * DM, 32 * nb, 64 * kb, 32 * nb, GIN(I_MIXG) + l * DM, scr, lane, kb < 4 ? 64 * kb + 256 : (kb < 8 ? 64 * kb - 256 : 64 * kb)); }
        }
        static_assert(FP8_FIRST == 0, "the 64x64 expert-weight items below write fp8");
        constexpr int PER_L = 32 * 512 + 32 * 256;
        for (int it = gw; it < DEPTH * PER_L; it += NGW) {
            const int l = it / PER_L; int r = it % PER_L;
            if (r < 32 * 512) { const int e = r >> 9, q = r & 511, kb = q >> 5, nb = q & 31, n0 = 64 * nb;
                const int bj = n0 >> 10, jj = n0 & 1023, orow = (jj >> 7) * 256 + bj * 128 + (jj & 127);
                transpose_item8x64(GIN(I_W1) + ((size_t)l * NEXP + e) * DM * 2048, DM, 2048, (GAS unsigned char*)(W1_T + (size_t)l * NEXP * 2048 * DM) + (size_t)e * 2048 * DM, orow, 64 * kb, n0, scr, lane); continue; } r -= 32 * 512;
            { const int e = r >> 8, q = r & 255, kb = q >> 4, nb = q & 15;
                transpose_item8x64(GIN(I_W2) + ((size_t)l * NEXP + e) * DM * DM, DM, DM, (GAS unsigned char*)(W2_T + (size_t)l * NEXP * DM * DM) + (size_t)e * DM * DM, 64 * nb, 64 * kb, 64 * nb, scr, lane); }
        }
        for (int i = bid * 512 + tid; i < NB * 16 * 256; i += G * 512) KMEAN[i] = 0.f;
        for (int i = bid * 512 + tid; i < DEPTH * 4 * 128 * 128; i += G * 512) { const int jj = i & 127, ii = (i >> 7) & 127; SGUW[i] = (f16)(jj <= ii ? GIN(I_SGUW)[i] : 0.f); }
        for (int i = bid * 512 + tid; i < DEPTH * 4 * 64 * 64; i += G * 512) { const int c = i & 63, d = (i >> 6) & 63, g = (i >> 12) & 3, ll = i >> 14; PWT[i] = (f16)GIN(I_POOLW)[(((size_t)ll * 4 + g) * 64 + c) * 64 + d]; }
        for (int i = bid * 512 + tid; i < DEPTH * 32 * 1024; i += G * 512) { const int k = i & 1023, e = (i >> 10) & 31, ll = i >> 15; RWT16[(size_t)(ll * 32 + e) * 1032 + k] = (f16)GIN(I_RW)[((size_t)ll * DM + k) * NEXP + e]; }
    }
}
    xcd_barrier(bar);
    STAMP(1);

for (int rep_ = 0; rep_ < REPS(2); ++rep_) if (PHMASK & 2) { LAUNDER();
    for (int m = gw; m < NTOK; m += NGW) { const int b = m >> 12; const GAS float* md = MOD + (size_t)b * 6144;
        norm_mod_row(GIN(I_X) + (size_t)m * DM, GIN(I_N1G), md, md + 1024, H + (size_t)m * DM, HB8 + (size_t)m * DM, lane); }
}
    xcd_barrier(bar);
    STAMP(2);

    layer_body(0, bar, tid0, wave0, G, bid, NGW);
    layer_body(1, bar, tid0, wave0, G, bid, NGW);
    if (TSEL_B > 0 && bid == 0 && tid0 == 0) { const LAS unsigned long long* st = (const LAS unsigned long long*)((LAS unsigned char*)lds + STAMP_OFF);
        asm volatile("s_waitcnt vmcnt(0)" ::: "memory");
        args.out[0] += (float)(st[TSEL_B] - st[TSEL_A]) * 0.01f / TSCALE; }
}


extern "C" void kernel_launch(void* const* d_in, const int* in_sizes, int n_in, void* d_out, int out_size, void* d_ws, size_t ws_size, hipStream_t stream) {
    static int grid = 0;
    if (grid == 0) {
        if (n_in != 27 || out_size != NTOK * DM || ws_size < WS_END) { fprintf(stderr, "kernel_launch: unexpected shapes (n_in %d, out %d, ws %zu)\n", n_in, out_size, ws_size); grid = -1; return; }
        int dev = 0, cus = 0, per_cu = 0;
        if (hipGetDevice(&dev) != hipSuccess || hipDeviceGetAttribute(&cus, hipDeviceAttributeMultiprocessorCount, dev) != hipSuccess) { grid = -1; return; }
        if (hipFuncSetAttribute((const void*)fwd_megakernel, hipFuncAttributeMaxDynamicSharedMemorySize, LDS_BYTES) != hipSuccess) { fprintf(stderr, "kernel_launch: hipFuncSetAttribute failed\n"); grid = -1; return; }
        if (hipOccupancyMaxActiveBlocksPerMultiprocessor(&per_cu, (const void*)fwd_megakernel, NWAVES * 64, LDS_BYTES) != hipSuccess || per_cu < 1) { fprintf(stderr, "kernel_launch: occupancy query says %d blocks per CU\n", per_cu); (void)hipGetLastError(); grid = -1; return; }
        grid = cus;
    }
    if (grid < 0) return;
    (void)hipMemsetAsync((char*)d_ws + WS_CTL, 0, CTL_ZERO_BYTES, stream);
    Args a{};
    for (int i = 0; i < 27; ++i) a.in[i] = (const float*)d_in[i];
    a.out = (float*)d_out; a.ws = (unsigned char*)d_ws;
    hipLaunchKernelGGL(fwd_megakernel, dim3(grid), dim3(NWAVES * 64), LDS_BYTES, stream, a);
}
```
